# Optimizing an MI355X kernel written in HIP

```python
import math
import jax, jax.numpy as jnp
from jax import lax
import numpy as np

D_MODEL = 1024
BATCH = 4
SEQ = 4096
DEPTH = 1

HEAD_DIM = 64
N_HEADS_DIL = 8
N_HEADS_NSA = 8
N_KV_NSA = 2
NSA_REP = N_HEADS_NSA // N_KV_NSA
MIX_WIDTH = (N_HEADS_DIL + N_HEADS_NSA) * HEAD_DIM
DIL_PAIRS = ((128, 1), (512, 4), (2048, 16))
ROPE_THETA = 500000.0
ROT_DIM = HEAD_DIM // 4
BLOCK_Q = 128
CMP_LEN = 32
CMP_STRIDE = 16
CMP_HIDDEN = 128
SEL_BLOCK = 64
SEL_TOP = 16
NSA_WINDOW = 512
N_EXPERTS = 256
TOP_K = 8
N_GROUPS = 8
TOPK_GROUPS = 4
EXPERT_FF = 256
SHARED_FF = 256
ROUTED_SCALE = 2.5
MOE_BLOCK = 128
EPS = 1e-6

QKV_DIL = N_HEADS_DIL * HEAD_DIM
Q_NSA = N_HEADS_NSA * HEAD_DIM
KV_NSA = N_KV_NSA * HEAD_DIM
IN_SPLITS = (QKV_DIL, QKV_DIL, QKV_DIL, Q_NSA, KV_NSA, KV_NSA, KV_NSA, KV_NSA, KV_NSA, KV_NSA, 3 * N_HEADS_NSA)
IN_COLS = sum(IN_SPLITS)

kernel_name = "hybrid_dilated_nsa_moe_adaln"


def rms_norm(x, g):
    xf = x.astype(jnp.float32)
    y = xf * lax.rsqrt(jnp.mean(xf * xf, axis=-1, keepdims=True) + EPS)
    return (y * g.astype(jnp.float32)).astype(x.dtype)


def partial_rope(x, pos):
    half = ROT_DIM // 2
    inv_freq = ROPE_THETA ** (-jnp.arange(half, dtype=jnp.float32) / half)
    ang = pos.astype(jnp.float32)[:, None] * inv_freq[None, :]
    cos = jnp.cos(ang)[:, None, :]
    sin = jnp.sin(ang)[:, None, :]
    xf = x.astype(jnp.float32)
    x1, x2, rest = xf[..., :half], xf[..., half:ROT_DIM], xf[..., ROT_DIM:]
    return jnp.concatenate([x1 * cos - x2 * sin, x2 * cos + x1 * sin, rest], axis=-1).astype(x.dtype)


def banded_attention(q, k, v, max_dist):
    N, L, Hk, R, hd = q.shape
    blk = BLOCK_Q
    nb = -(-L // blk)
    Lp = nb * blk
    n_prev = -(-max_dist // blk)
    pad_end = Lp - L
    qp = jnp.pad(q, ((0, 0), (0, pad_end), (0, 0), (0, 0), (0, 0)))
    kp = jnp.pad(k, ((0, 0), (n_prev * blk, pad_end), (0, 0), (0, 0)))
    vp = jnp.pad(v, ((0, 0), (n_prev * blk, pad_end), (0, 0), (0, 0)))
    qb = qp.reshape(N, nb, blk, Hk, R, hd)
    kb = kp.reshape(N, nb + n_prev, blk, Hk, hd)
    vb = vp.reshape(N, nb + n_prev, blk, Hk, hd)
    kwin = jnp.concatenate([kb[:, j:j + nb] for j in range(n_prev + 1)], axis=2)
    vwin = jnp.concatenate([vb[:, j:j + nb] for j in range(n_prev + 1)], axis=2)
    qpos = jnp.arange(Lp).reshape(nb, blk)
    kpos = (jnp.arange((nb + n_prev) * blk) - n_prev * blk).reshape(nb + n_prev, blk)
    kposw = jnp.concatenate([kpos[j:j + nb] for j in range(n_prev + 1)], axis=1)
    dist = qpos[:, :, None] - kposw[:, None, :]
    mask = (dist >= 0) & (dist <= max_dist) & (kposw[:, None, :] >= 0)
    s = jnp.einsum('nbqhrd,nbkhd->nbhrqk', qb, kwin, preferred_element_type=jnp.float32) / math.sqrt(hd)
    s = jnp.where(mask[None, :, None, None], s, -jnp.inf)
    m = jnp.max(s, axis=-1, keepdims=True)
    p = jnp.exp(s - m)
    l = jnp.sum(p, axis=-1, keepdims=True)
    o = jnp.einsum('nbhrqk,nbkhd->nbqhrd', (p / l).astype(v.dtype), vwin)
    lse = (m + jnp.log(l))[..., 0]
    o = o.reshape(N, Lp, Hk, R, hd)[:, :L]
    lse = lse.transpose(0, 1, 4, 2, 3).reshape(N, Lp, Hk, R)[:, :L]
    return o, lse


def dilated_attention(q, k, v):
    B, S, H, hd = q.shape
    outs, lses = [], []
    for window, dil in DIL_PAIRS:
        L = S // dil

        def to_strided(t):
            return t.reshape(B, L, dil, H, hd).transpose(0, 2, 1, 3, 4).reshape(B * dil, L, H, hd)

        o, lse = banded_attention(to_strided(q)[:, :, :, None, :], to_strided(k), to_strided(v), window // dil)
        o = o[:, :, :, 0, :].reshape(B, dil, L, H, hd).transpose(0, 2, 1, 3, 4).reshape(B, S, H, hd)
        lse = lse[..., 0].reshape(B, dil, L, H).transpose(0, 2, 1, 3).reshape(B, S, H)
        outs.append(o)
        lses.append(lse)
    w = jax.nn.softmax(jnp.stack(lses, axis=0), axis=0)
    out = jnp.einsum('gbsh,gbshd->bshd', w.astype(q.dtype), jnp.stack(outs, axis=0))
    return out.reshape(B, S, H * hd)


def compress_blocks(t, pe, w1, w2):
    B, S, G, hd = t.shape
    n_c = (S - CMP_LEN) // CMP_STRIDE + 1
    idx = jnp.arange(n_c)[:, None] * CMP_STRIDE + jnp.arange(CMP_LEN)[None, :]
    blocks = t[:, idx] + pe[None, None, :, None, :]
    flat = blocks.transpose(0, 1, 3, 2, 4).reshape(B, n_c, G, CMP_LEN * hd)
    return jax.nn.gelu(flat @ w1) @ w2


def nsa_attention(q, q_rope, k_cmp, v_cmp, k_slc, v_slc, k_win, v_win, gate_logits, pos):
    B, S, G, R, hd = q.shape
    scale = 1.0 / math.sqrt(hd)
    n_c = k_cmp.shape[1]
    s = jnp.einsum('bsgrd,bcgd->bgrsc', q, k_cmp, preferred_element_type=jnp.float32) * scale
    cend = jnp.arange(n_c) * CMP_STRIDE + CMP_LEN - 1
    valid = cend[None, :] <= pos[:, None]
    s = jnp.where(valid, s, -jnp.inf)
    m = jnp.max(s, axis=-1, keepdims=True)
    m = jnp.where(jnp.isfinite(m), m, 0.0)
    p = jnp.exp(s - m)
    l = jnp.sum(p, axis=-1, keepdims=True)
    p = p / jnp.where(l > 0, l, 1.0)
    o_cmp = jnp.einsum('bgrsc,bcgd->bsgrd', p.astype(v_cmp.dtype), v_cmp)
    n_sel = S // SEL_BLOCK
    top = min(SEL_TOP, n_sel)
    cs = jnp.arange(n_c) * CMP_STRIDE
    ss = jnp.arange(n_sel) * SEL_BLOCK
    ov = jnp.clip(jnp.minimum(cs[:, None] + CMP_LEN, ss[None, :] + SEL_BLOCK) - jnp.maximum(cs[:, None], ss[None, :]), 0, None)
    ov = ov.astype(jnp.float32) / CMP_STRIDE
    p_slc = jnp.einsum('bgrsc,cj->bgsj', p, ov)
    blk_ids = jnp.arange(n_sel)[None, :]
    cur = (pos // SEL_BLOCK)[:, None]
    forced = (blk_ids == 0) | (blk_ids == cur) | (blk_ids == cur - 1)
    score = jnp.where(forced, jnp.inf, jnp.where(blk_ids <= cur, p_slc, -jnp.inf))
    _, sel_idx = lax.top_k(score, top)
    ks = k_slc.reshape(B, n_sel, SEL_BLOCK, G, hd).transpose(0, 3, 1, 2, 4)
    vs = v_slc.reshape(B, n_sel, SEL_BLOCK, G, hd).transpose(0, 3, 1, 2, 4)
    nq = S // BLOCK_Q
    qc = q_rope.reshape(B, nq, BLOCK_Q, G, R, hd).transpose(1, 0, 3, 4, 2, 5)
    ic = sel_idx.reshape(B, G, nq, BLOCK_Q, top).transpose(2, 0, 1, 3, 4)
    pc = pos.reshape(nq, BLOCK_Q)
    gather = jax.vmap(jax.vmap(lambda kb, ib: kb[ib]))

    def sel_block(args):
        qb, ib, pb = args
        kg = gather(ks, ib).reshape(B, G, BLOCK_Q, top * SEL_BLOCK, hd)
        vg = gather(vs, ib).reshape(B, G, BLOCK_Q, top * SEL_BLOCK, hd)
        kpos = (ib[..., None] * SEL_BLOCK + jnp.arange(SEL_BLOCK)).reshape(B, G, BLOCK_Q, top * SEL_BLOCK)
        sb = jnp.einsum('bgrqd,bgqkd->bgrqk', qb, kg, preferred_element_type=jnp.float32) * scale
        sb = jnp.where((kpos <= pb[None, None, :, None])[:, :, None], sb, -jnp.inf)
        pb_ = jax.nn.softmax(sb, axis=-1)
        return jnp.einsum('bgrqk,bgqkd->bgrqd', pb_.astype(vg.dtype), vg)

    o_slc = lax.map(sel_block, (qc, ic, pc)).transpose(1, 0, 4, 2, 3, 5).reshape(B, S, G, R, hd)
    o_win, _ = banded_attention(q_rope, k_win, v_win, NSA_WINDOW - 1)
    g = jax.nn.sigmoid(gate_logits.astype(jnp.float32)).reshape(B, S, G, R, 3)
    o = g[..., 0:1] * o_cmp + g[..., 1:2] * o_slc + g[..., 2:3] * o_win
    return o.astype(q.dtype).reshape(B, S, G * R * hd)


def moe_ffn(h, w_router, router_bias, w_gate, w_up, w_down, ws_gate, ws_up, ws_down):
    B, S, D = h.shape
    T = B * S
    xf = h.reshape(T, D)
    aff = jax.nn.sigmoid(jnp.dot(xf, w_router, preferred_element_type=jnp.float32))
    biased = aff + router_bias.astype(jnp.float32)
    grp = biased.reshape(T, N_GROUPS, N_EXPERTS // N_GROUPS)
    grp_score = lax.top_k(grp, 2)[0].sum(-1)
    _, gidx = lax.top_k(grp_score, TOPK_GROUPS)
    gmask = jax.nn.one_hot(gidx, N_GROUPS, dtype=jnp.float32).sum(-2) > 0
    emask = jnp.repeat(gmask, N_EXPERTS // N_GROUPS, axis=-1)
    _, eidx = lax.top_k(jnp.where(emask, biased, -jnp.inf), TOP_K)
    sel = jnp.take_along_axis(aff, eidx, axis=-1)
    gates = sel / jnp.sum(sel, axis=-1, keepdims=True) * ROUTED_SCALE
    A = T * TOP_K
    flat_e = eidx.reshape(A)
    flat_t = jnp.repeat(jnp.arange(T, dtype=jnp.int32), TOP_K)
    flat_w = gates.reshape(A)
    order = jnp.argsort(flat_e)
    se, st, sw = flat_e[order], flat_t[order], flat_w[order]
    counts = jnp.bincount(flat_e, length=N_EXPERTS)
    padded = (counts + MOE_BLOCK - 1) // MOE_BLOCK * MOE_BLOCK
    pend = jnp.cumsum(padded)
    pstart = pend - padded
    ustart = jnp.cumsum(counts) - counts
    dest = pstart[se] + jnp.arange(A) - ustart[se]
    P = A + N_EXPERTS * MOE_BLOCK
    nb = P // MOE_BLOCK
    tok_buf = jnp.full((P,), T, dtype=jnp.int32).at[dest].set(st)
    w_buf = jnp.zeros((P,), jnp.float32).at[dest].set(sw)
    blk_e = jnp.minimum(jnp.searchsorted(pend, jnp.arange(nb) * MOE_BLOCK, side='right'), N_EXPERTS - 1)
    x_pad = jnp.concatenate([xf, jnp.zeros((1, D), xf.dtype)], axis=0)

    def expert_block(args):
        e, toks, wts = args
        xb = x_pad[toks]
        y = (jax.nn.silu(xb @ w_gate[e]) * (xb @ w_up[e])) @ w_down[e]
        return y * wts[:, None].astype(y.dtype)

    y = lax.map(expert_block, (blk_e, tok_buf.reshape(nb, MOE_BLOCK), w_buf.reshape(nb, MOE_BLOCK)))
    routed = jax.ops.segment_sum(y.reshape(P, D), tok_buf, num_segments=T + 1)[:T]
    shared = (jax.nn.silu(xf @ ws_gate) * (xf @ ws_up)) @ ws_down
    return (routed + shared).reshape(B, S, D)


def setup_inputs(seed: int = 0) -> dict:
    key = jax.random.key(seed)
    ks = jax.random.split(key, 32)
    f32 = jnp.float32
    D, L = D_MODEL, DEPTH

    def nrm(k, shape, scale):
        return jax.random.normal(k, shape, f32) * scale

    def gain(k, shape):
        return 1.0 + 0.02 * jax.random.normal(k, shape, f32)

    return {
        "x": nrm(ks[0], (BATCH, SEQ, D), 1.0),
        "c": nrm(ks[1], (BATCH, D), 1.0),
        "w_ada": nrm(ks[2], (L, D, 6 * D), 0.5 * D ** -0.5),
        "b_ada": nrm(ks[3], (L, 6 * D), 0.02),
        "g_norm_mix": gain(ks[4], (L, D)),
        "g_norm_ffn": gain(ks[5], (L, D)),
        "w_in": nrm(ks[6], (L, D, IN_COLS), D ** -0.5),
        "g_q_dil": gain(ks[7], (L, HEAD_DIM)),
        "g_k_dil": gain(ks[8], (L, HEAD_DIM)),
        "g_q_nsa": gain(ks[9], (L, HEAD_DIM)),
        "g_k_cmp": gain(ks[10], (L, HEAD_DIM)),
        "g_k_slc": gain(ks[11], (L, HEAD_DIM)),
        "g_k_win": gain(ks[12], (L, HEAD_DIM)),
        "cmp_pe_k": nrm(ks[13], (L, CMP_LEN, HEAD_DIM), 0.1),
        "cmp_w1_k": nrm(ks[14], (L, CMP_LEN * HEAD_DIM, CMP_HIDDEN), (CMP_LEN * HEAD_DIM) ** -0.5),
        "cmp_w2_k": nrm(ks[15], (L, CMP_HIDDEN, HEAD_DIM), CMP_HIDDEN ** -0.5),
        "cmp_pe_v": nrm(ks[16], (L, CMP_LEN, HEAD_DIM), 0.1),
        "cmp_w1_v": nrm(ks[17], (L, CMP_LEN * HEAD_DIM, CMP_HIDDEN), (CMP_LEN * HEAD_DIM) ** -0.5),
        "cmp_w2_v": nrm(ks[18], (L, CMP_HIDDEN, HEAD_DIM), CMP_HIDDEN ** -0.5),
        "w_out": nrm(ks[19], (L, MIX_WIDTH, D), MIX_WIDTH ** -0.5),
        "w_router": nrm(ks[20], (L, D, N_EXPERTS), D ** -0.5),
        "router_bias": nrm(ks[21], (L, N_EXPERTS), 0.01),
        "w_gate": nrm(ks[22], (L, N_EXPERTS, D, EXPERT_FF), D ** -0.5),
        "w_up": nrm(ks[23], (L, N_EXPERTS, D, EXPERT_FF), D ** -0.5),
        "w_down": nrm(ks[24], (L, N_EXPERTS, EXPERT_FF, D), EXPERT_FF ** -0.5),
        "ws_gate": nrm(ks[25], (L, D, SHARED_FF), D ** -0.5),
        "ws_up": nrm(ks[26], (L, D, SHARED_FF), D ** -0.5),
        "ws_down": nrm(ks[27], (L, SHARED_FF, D), SHARED_FF ** -0.5),
    }


def reference(x, c, w_ada, b_ada, g_norm_mix, g_norm_ffn, w_in, g_q_dil, g_k_dil, g_q_nsa, g_k_cmp, g_k_slc, g_k_win,
              cmp_pe_k, cmp_w1_k, cmp_w2_k, cmp_pe_v, cmp_w1_v, cmp_w2_v, w_out, w_router, router_bias,
              w_gate, w_up, w_down, ws_gate, ws_up, ws_down):
    B, S, D = x.shape
    hd = HEAD_DIM
    G, R = N_KV_NSA, NSA_REP
    pos = jnp.arange(S)
    split_at = np.cumsum(IN_SPLITS)[:-1].tolist()
    for l in range(DEPTH):
        mod = jnp.dot(jax.nn.silu(c), w_ada[l]) + b_ada[l]
        sh1, sc1, gt1, sh2, sc2, gt2 = jnp.split(mod[:, None, :], 6, axis=-1)
        h = rms_norm(x, g_norm_mix[l]) * (1.0 + sc1) + sh1
        proj = h @ w_in[l]
        qa, ka, va, qb, kc, vc, ksl, vsl, kw, vw, gb = jnp.split(proj, split_at, axis=-1)
        qa = partial_rope(rms_norm(qa.reshape(B, S, N_HEADS_DIL, hd), g_q_dil[l]), pos)
        ka = partial_rope(rms_norm(ka.reshape(B, S, N_HEADS_DIL, hd), g_k_dil[l]), pos)
        o_a = dilated_attention(qa, ka, va.reshape(B, S, N_HEADS_DIL, hd))
        qn = rms_norm(qb.reshape(B, S, N_HEADS_NSA, hd), g_q_nsa[l])
        q_rope = partial_rope(qn, pos).reshape(B, S, G, R, hd)
        qn = qn.reshape(B, S, G, R, hd)
        k_cmp = rms_norm(compress_blocks(kc.reshape(B, S, G, hd), cmp_pe_k[l], cmp_w1_k[l], cmp_w2_k[l]), g_k_cmp[l])
        v_cmp = compress_blocks(vc.reshape(B, S, G, hd), cmp_pe_v[l], cmp_w1_v[l], cmp_w2_v[l])
        k_slc = partial_rope(rms_norm(ksl.reshape(B, S, G, hd), g_k_slc[l]), pos)
        k_win = partial_rope(rms_norm(kw.reshape(B, S, G, hd), g_k_win[l]), pos)
        o_b = nsa_attention(qn, q_rope, k_cmp, v_cmp, k_slc, vsl.reshape(B, S, G, hd), k_win,
                            vw.reshape(B, S, G, hd), gb, pos)
        mix = jnp.concatenate([o_a, o_b.astype(o_a.dtype)], axis=-1) @ w_out[l]
        x = x + gt1 * mix
        h = rms_norm(x, g_norm_ffn[l]) * (1.0 + sc2) + sh2
        x = x + gt2 * moe_ffn(h, w_router[l], router_bias[l], w_gate[l], w_up[l], w_down[l],
                              ws_gate[l], ws_up[l], ws_down[l])
    return x
```

```cpp
#include <hip/hip_runtime.h>
#include <stdint.h>

namespace {
constexpr int D = 1024, NB = 4, S = 4096, T = NB * S, HD = 64;
constexpr int INC = 2840;
constexpr int C_QA = 0, C_KA = 512, C_VA = 1024, C_QB = 1536, C_KC = 2048, C_VC = 2176, C_KSL = 2304, C_VSL = 2432,
              C_KW = 2560, C_VW = 2688, C_GB = 2816;
constexpr int NC = 255, NE = 256, TOPK = 8, FF = 256;
constexpr float EPS = 1e-6f;

struct P {
  const float *x, *c, *w_ada, *b_ada, *g_mix, *g_ffn, *w_in, *g_q_dil, *g_k_dil, *g_q_nsa, *g_k_cmp, *g_k_slc, *g_k_win;
  const float *pe_k, *w1_k, *w2_k, *pe_v, *w1_v, *w2_v, *w_out, *w_router, *r_bias, *w_gate, *w_up, *w_down, *ws_gate, *ws_up, *ws_down;
  float* out;
  float *mod, *rope, *h1, *proj, *qrope, *kcmp, *vcmp, *ocmp, *oslc, *owin, *mixin, *x1, *h2, *logits, *gates, *hs_g, *hs, *shared, *Hbuf;
  unsigned long long* selmask;
  int *eidx, *cnt, *off, *pos, *sorted;
};

__device__ __forceinline__ float silu(float v) { return v / (1.f + expf(-v)); }
__device__ __forceinline__ float sigmoidf(float v) { return 1.f / (1.f + expf(-v)); }
__device__ __forceinline__ float wave_sum(float v) { for (int o = 32; o; o >>= 1) v += __shfl_xor(v, o); return v; }
__device__ __forceinline__ float wave_max(float v) { for (int o = 32; o; o >>= 1) v = fmaxf(v, __shfl_xor(v, o)); return v; }

__global__ void k_ada(P p) {
  int j = blockIdx.x * 256 + threadIdx.x, b = blockIdx.y;
  float acc = p.b_ada[j];
  for (int k = 0; k < D; ++k) acc += silu(p.c[b * D + k]) * p.w_ada[(size_t)k * 6 * D + j];
  p.mod[b * 6 * D + j] = acc;
}
__global__ void k_rope_tab(P p) {
  int i = blockIdx.x * 256 + threadIdx.x;
  if (i >= S * 8) return;
  int pos = i >> 3, f = i & 7;
  double ang = (double)pos * pow(500000.0, -(double)f / 8.0);
  p.rope[i * 2] = (float)cos(ang);
  p.rope[i * 2 + 1] = (float)sin(ang);
}
__global__ void k_norm_mod(const float* in, const float* g, const float* mod, int shift_off, int scale_off, float* out) {
  int t = blockIdx.x, b = t / S, tid = threadIdx.x;
  __shared__ float red[4];
  float4 v = ((const float4*)(in + (size_t)t * D))[tid];
  float ss = v.x * v.x + v.y * v.y + v.z * v.z + v.w * v.w;
  ss = wave_sum(ss);
  if ((tid & 63) == 0) red[tid >> 6] = ss;
  __syncthreads();
  float tot = red[0] + red[1] + red[2] + red[3];
  float r = rsqrtf(tot / D + EPS);
  float vv[4] = {v.x, v.y, v.z, v.w};
  float o[4];
#pragma unroll
  for (int i = 0; i < 4; ++i) {
    int d = tid * 4 + i;
    o[i] = vv[i] * r * g[d] * (1.f + mod[b * 6 * D + scale_off + d]) + mod[b * 6 * D + shift_off + d];
  }
  ((float4*)(out + (size_t)t * D))[tid] = make_float4(o[0], o[1], o[2], o[3]);
}

template <class AF, class EF>
__device__ __forceinline__ void gemm64(int m0, int n0, int M, int N, int K, AF arow, const float* Bm, int ldb, EF epi) {
  __shared__ float sA[16][68];
  __shared__ float sB[16][68];
  const int tid = threadIdx.x, tx = tid & 15, ty = tid >> 4;
  float acc[4][4];
#pragma unroll
  for (int i = 0; i < 4; ++i)
#pragma unroll
    for (int j = 0; j < 4; ++j) acc[i][j] = 0.f;
  const int ar = tid >> 2, ak = (tid & 3) * 4;
  const float* ap = (m0 + ar < M) ? arow(m0 + ar) : nullptr;
  const int bk = tid >> 4, bn = (tid & 15) * 4;
  for (int k0 = 0; k0 < K; k0 += 16) {
    float4 av = ap ? *(const float4*)(ap + k0 + ak) : make_float4(0, 0, 0, 0);
    float4 bv = (n0 + bn < N) ? *(const float4*)(Bm + (size_t)(k0 + bk) * ldb + n0 + bn) : make_float4(0, 0, 0, 0);
    __syncthreads();
    sA[ak + 0][ar] = av.x; sA[ak + 1][ar] = av.y; sA[ak + 2][ar] = av.z; sA[ak + 3][ar] = av.w;
    *(float4*)&sB[bk][bn] = bv;
    __syncthreads();
#pragma unroll
    for (int kk = 0; kk < 16; ++kk) {
      float4 a = *(const float4*)&sA[kk][ty * 4];
      float4 b = *(const float4*)&sB[kk][tx * 4];
      float aa[4] = {a.x, a.y, a.z, a.w}, bb[4] = {b.x, b.y, b.z, b.w};
#pragma unroll
      for (int i = 0; i < 4; ++i)
#pragma unroll
        for (int j = 0; j < 4; ++j) acc[i][j] += aa[i] * bb[j];
    }
  }
#pragma unroll
  for (int i = 0; i < 4; ++i)
#pragma unroll
    for (int j = 0; j < 4; ++j) {
      int m = m0 + ty * 4 + i, n = n0 + tx * 4 + j;
      if (m < M && n < N) epi(m, n, acc[i][j]);
    }
}

__global__ void __launch_bounds__(256) k_proj(P p) {
  const float* A = p.h1; float* C = p.proj;
  gemm64(blockIdx.y * 64, blockIdx.x * 64, T, INC, D, [=](int m) { return A + (size_t)m * D; }, p.w_in, INC,
         [=](int m, int n, float v) { C[(size_t)m * INC + n] = v; });
}
__global__ void __launch_bounds__(256) k_outproj(P p) {
  const float* A = p.mixin; float* C = p.x1; const float* x = p.x; const float* mod = p.mod;
  gemm64(blockIdx.y * 64, blockIdx.x * 64, T, D, D, [=](int m) { return A + (size_t)m * D; }, p.w_out, D,
         [=](int m, int n, float v) { C[(size_t)m * D + n] = x[(size_t)m * D + n] + mod[(m / S) * 6 * D + 2 * D + n] * v; });
}
__global__ void __launch_bounds__(256) k_router(P p) {
  const float* A = p.h2; float* C = p.logits;
  gemm64(blockIdx.y * 64, blockIdx.x * 64, T, NE, D, [=](int m) { return A + (size_t)m * D; }, p.w_router, NE,
         [=](int m, int n, float v) { C[(size_t)m * NE + n] = v; });
}
__global__ void __launch_bounds__(256) k_shared_g(P p) {
  const float* A = p.h2; float* C = p.hs_g;
  gemm64(blockIdx.y * 64, blockIdx.x * 64, T, FF, D, [=](int m) { return A + (size_t)m * D; }, p.ws_gate, FF,
         [=](int m, int n, float v) { C[(size_t)m * FF + n] = v; });
}
__global__ void __launch_bounds__(256) k_shared_u(P p) {
  const float* A = p.h2; float* C = p.hs; const float* G = p.hs_g;
  gemm64(blockIdx.y * 64, blockIdx.x * 64, T, FF, D, [=](int m) { return A + (size_t)m * D; }, p.ws_up, FF,
         [=](int m, int n, float v) { C[(size_t)m * FF + n] = silu(G[(size_t)m * FF + n]) * v; });
}
__global__ void __launch_bounds__(256) k_shared_d(P p) {
  const float* A = p.hs; float* C = p.shared;
  gemm64(blockIdx.y * 64, blockIdx.x * 64, T, D, FF, [=](int m) { return A + (size_t)m * FF; }, p.ws_down, D,
         [=](int m, int n, float v) { C[(size_t)m * D + n] = v; });
}

__global__ void k_headnorm(P p) {
  int wave = (blockIdx.x * 256 + threadIdx.x) >> 6, lane = threadIdx.x & 63;
  int t = wave / 28, slot = wave % 28;
  if (t >= T) return;
  int pos = t % S;
  int col; const float* g; bool dorope = true; bool isqb = false;
  if (slot < 8) { col = C_QA + slot * 64; g = p.g_q_dil; }
  else if (slot < 16) { col = C_KA + (slot - 8) * 64; g = p.g_k_dil; }
  else if (slot < 24) { col = C_QB + (slot - 16) * 64; g = p.g_q_nsa; isqb = true; }
  else if (slot < 26) { col = C_KSL + (slot - 24) * 64; g = p.g_k_slc; }
  else { col = C_KW + (slot - 26) * 64; g = p.g_k_win; }
  float* ptr = p.proj + (size_t)t * INC + col;
  float v = ptr[lane];
  float ss = wave_sum(v * v);
  float y = v * rsqrtf(ss / 64.f + EPS) * g[lane];
  float partner = __shfl_xor(y, 8);
  float yr = y;
  if (dorope && lane < 16) {
    int f = lane & 7;
    float cs = p.rope[(pos * 8 + f) * 2], sn = p.rope[(pos * 8 + f) * 2 + 1];
    yr = (lane < 8) ? (y * cs - partner * sn) : (y * cs + partner * sn);
  }
  if (isqb) { ptr[lane] = y; p.qrope[(size_t)t * 512 + (slot - 16) * 64 + lane] = yr; }
  else ptr[lane] = yr;
}

__global__ void __launch_bounds__(256) k_dilated(P p) {
  __shared__ float sq[4][64];
  int w = threadIdx.x >> 6, lane = threadIdx.x & 63;
  int wave = blockIdx.x * 4 + w;
  int t = wave >> 3, h = wave & 7, b = t / S, s = t % S;
  sq[w][lane] = p.proj[(size_t)t * INC + C_QA + h * 64 + lane];
  __syncthreads();
  const int dils[3] = {1, 4, 16};
  float sc[9];
  float m = -INFINITY;
#pragma unroll
  for (int g = 0; g < 3; ++g)
#pragma unroll
    for (int i = 0; i < 3; ++i) {
      int k = lane + 64 * i;
      int kp = s - dils[g] * k;
      float v = -INFINITY;
      if (k <= 128 && kp >= 0) {
        const float* kr = p.proj + (size_t)(b * S + kp) * INC + C_KA + h * 64;
        float a = 0.f;
        for (int d = 0; d < 64; ++d) a += sq[w][d] * kr[d];
        v = a * 0.125f;
      }
      sc[g * 3 + i] = v;
      m = fmaxf(m, v);
    }
  m = wave_max(m);
  float l = 0.f;
#pragma unroll
  for (int i = 0; i < 9; ++i) { sc[i] = expf(sc[i] - m); l += sc[i]; }
  l = wave_sum(l);
  float o = 0.f;
#pragma unroll
  for (int g = 0; g < 3; ++g)
#pragma unroll
    for (int i = 0; i < 3; ++i) {
      for (int src = 0; src < 64; ++src) {
        int k = src + 64 * i;
        int kp = s - dils[g] * k;
        if (k > 128 || kp < 0) break;
        float pj = __shfl(sc[g * 3 + i], src);
        o += pj * p.proj[(size_t)(b * S + kp) * INC + C_VA + h * 64 + lane];
      }
    }
  p.mixin[(size_t)t * D + h * 64 + lane] = o / l;
}

__global__ void __launch_bounds__(128) k_compress(P p) {
  __shared__ float sin_[2048];
  __shared__ float hid[128];
  __shared__ float red[2];
  int idx = blockIdx.x;
  int which = idx / 2040, rem = idx % 2040, bg = rem / 255, c = rem % 255, b = bg >> 1, g = bg & 1;
  const float* pe = which ? p.pe_v : p.pe_k; const float* w1 = which ? p.w1_v : p.w1_k; const float* w2 = which ? p.w2_v : p.w2_k;
  int col = (which ? C_VC : C_KC) + g * 64;
  int tid = threadIdx.x;
  for (int i = tid; i < 2048; i += 128) {
    int l = i >> 6, d = i & 63;
    sin_[i] = p.proj[(size_t)(b * S + 16 * c + l) * INC + col + d] + pe[i];
  }
  __syncthreads();
  float a = 0.f;
  for (int k = 0; k < 2048; ++k) a += sin_[k] * w1[(size_t)k * 128 + tid];
  float u = 0.7978845608028654f * (a + 0.044715f * a * a * a);
  hid[tid] = 0.5f * a * (1.f + tanhf(u));
  __syncthreads();
  float o = 0.f;
  if (tid < 64) { for (int n = 0; n < 128; ++n) o += hid[n] * w2[n * 64 + tid]; }
  float* dst = (which ? p.vcmp : p.kcmp) + ((size_t)(bg * 256 + c)) * 64;
  if (which == 0) {
    float ss = (tid < 64) ? o * o : 0.f;
    ss = wave_sum(ss);
    if ((tid & 63) == 0) red[tid >> 6] = ss;
    __syncthreads();
    float r = rsqrtf((red[0] + red[1]) / 64.f + EPS);
    if (tid < 64) dst[tid] = o * r * p.g_k_cmp[tid];
  } else if (tid < 64) dst[tid] = o;
}

__global__ void __launch_bounds__(256) k_cmpattn(P p) {
  __shared__ float sq[4][64];
  __shared__ float sp[4][256];
  int w = threadIdx.x >> 6, lane = threadIdx.x & 63;
  int wave = blockIdx.x * 4 + w;
  int t = wave >> 1, g = wave & 1, b = t / S, s = t % S;
  const float* kc = p.kcmp + (size_t)(b * 2 + g) * 256 * 64;
  const float* vc = p.vcmp + (size_t)(b * 2 + g) * 256 * 64;
  float pslc = 0.f;
  for (int r = 0; r < 4; ++r) {
    __syncthreads();
    sq[w][lane] = p.proj[(size_t)t * INC + C_QB + (g * 4 + r) * 64 + lane];
    __syncthreads();
    float sc[4]; float m = -INFINITY;
#pragma unroll
    for (int i = 0; i < 4; ++i) {
      int c = lane + 64 * i; float v = -INFINITY;
      if (c < NC && 16 * c + 31 <= s) { float a = 0.f; for (int d = 0; d < 64; ++d) a += sq[w][d] * kc[c * 64 + d]; v = a * 0.125f; }
      sc[i] = v; m = fmaxf(m, v);
    }
    m = wave_max(m);
    if (m == -INFINITY) m = 0.f;
    float l = 0.f;
#pragma unroll
    for (int i = 0; i < 4; ++i) { sc[i] = expf(sc[i] - m); l += sc[i]; }
    l = wave_sum(l);
    float inv = l > 0.f ? 1.f / l : 1.f;
#pragma unroll
    for (int i = 0; i < 4; ++i) sp[w][lane + 64 * i] = sc[i] * inv;
    __syncthreads();
    float o = 0.f;
    for (int c = 0; c < NC; ++c) { if (16 * c + 31 > s) break; o += sp[w][c] * vc[c * 64 + lane]; }
    p.ocmp[(size_t)t * 512 + (g * 4 + r) * 64 + lane] = o;
    int j = lane;
    float q = 2.f * (sp[w][4 * j] + sp[w][4 * j + 1] + sp[w][4 * j + 2]) + (4 * j + 3 < NC ? sp[w][4 * j + 3] : 0.f) + (j > 0 ? sp[w][4 * j - 1] : 0.f);
    pslc += q;
  }
  int cur = s >> 6, j = lane;
  bool forced = (j == 0) || (j == cur) || (j == cur - 1);
  float score = forced ? INFINITY : (j <= cur ? pslc : -INFINITY);
  int rank = 0;
  for (int i = 0; i < 64; ++i) { float si = __shfl(score, i); rank += (si > score) || (si == score && i < j); }
  unsigned long long mask = __ballot(rank < 16 && j <= cur);
  if (lane == 0) p.selmask[(size_t)t * 2 + g] = mask;
}

__global__ void __launch_bounds__(256) k_slcattn(P p) {
  __shared__ float sq[4][64];
  int w = threadIdx.x >> 6, lane = threadIdx.x & 63;
  int wave = blockIdx.x * 4 + w;
  int t = wave >> 1, g = wave & 1, b = t / S, s = t % S;
  unsigned long long mask = p.selmask[(size_t)t * 2 + g];
  for (int r = 0; r < 4; ++r) {
    __syncthreads();
    sq[w][lane] = p.qrope[(size_t)t * 512 + (g * 4 + r) * 64 + lane];
    __syncthreads();
    float sc[16]; float m = -INFINITY;
    unsigned long long mm = mask;
#pragma unroll
    for (int i = 0; i < 16; ++i) {
      float v = -INFINITY;
      if (mm) {
        int blk = __ffsll((long long)mm) - 1; mm &= mm - 1;
        int kp = blk * 64 + lane;
        if (kp <= s) {
          const float* kr = p.proj + (size_t)(b * S + kp) * INC + C_KSL + g * 64;
          float a = 0.f; for (int d = 0; d < 64; ++d) a += sq[w][d] * kr[d];
          v = a * 0.125f;
        }
      }
      sc[i] = v; m = fmaxf(m, v);
    }
    m = wave_max(m);
    float l = 0.f;
#pragma unroll
    for (int i = 0; i < 16; ++i) { sc[i] = expf(sc[i] - m); l += sc[i]; }
    l = wave_sum(l);
    float o = 0.f;
    mm = mask;
#pragma unroll
    for (int i = 0; i < 16; ++i) {
      if (mm) {
        int blk = __ffsll((long long)mm) - 1; mm &= mm - 1;
        for (int src = 0; src < 64; ++src) {
          int kp = blk * 64 + src;
          if (kp > s) break;
          o += __shfl(sc[i], src) * p.proj[(size_t)(b * S + kp) * INC + C_VSL + g * 64 + lane];
        }
      }
    }
    p.oslc[(size_t)t * 512 + (g * 4 + r) * 64 + lane] = o / l;
  }
}

__global__ void __launch_bounds__(256) k_winattn(P p) {
  __shared__ float sq[4][64];
  int w = threadIdx.x >> 6, lane = threadIdx.x & 63;
  int wave = blockIdx.x * 4 + w;
  int t = wave >> 1, g = wave & 1, b = t / S, s = t % S;
  for (int r = 0; r < 4; ++r) {
    __syncthreads();
    sq[w][lane] = p.qrope[(size_t)t * 512 + (g * 4 + r) * 64 + lane];
    __syncthreads();
    float sc[8]; float m = -INFINITY;
#pragma unroll
    for (int i = 0; i < 8; ++i) {
      int kp = s - (lane + 64 * i); float v = -INFINITY;
      if (kp >= 0) {
        const float* kr = p.proj + (size_t)(b * S + kp) * INC + C_KW + g * 64;
        float a = 0.f; for (int d = 0; d < 64; ++d) a += sq[w][d] * kr[d];
        v = a * 0.125f;
      }
      sc[i] = v; m = fmaxf(m, v);
    }
    m = wave_max(m);
    float l = 0.f;
#pragma unroll
    for (int i = 0; i < 8; ++i) { sc[i] = expf(sc[i] - m); l += sc[i]; }
    l = wave_sum(l);
    float o = 0.f;
#pragma unroll
    for (int i = 0; i < 8; ++i)
      for (int src = 0; src < 64; ++src) {
        int kp = s - (src + 64 * i);
        if (kp < 0) break;
        o += __shfl(sc[i], src) * p.proj[(size_t)(b * S + kp) * INC + C_VW + g * 64 + lane];
      }
    p.owin[(size_t)t * 512 + (g * 4 + r) * 64 + lane] = o / l;
  }
}

__global__ void k_merge(P p) {
  size_t i = (size_t)blockIdx.x * 256 + threadIdx.x;
  int t = (int)(i >> 9), c = (int)(i & 511), hr = c >> 6;
  const float* gl = p.proj + (size_t)t * INC + C_GB + hr * 3;
  float o = sigmoidf(gl[0]) * p.ocmp[i] + sigmoidf(gl[1]) * p.oslc[i] + sigmoidf(gl[2]) * p.owin[i];
  p.mixin[(size_t)t * D + 512 + c] = o;
}

__global__ void __launch_bounds__(32) k_route(P p) {
  __shared__ float sb[32][257];
  int tl = threadIdx.x, t = blockIdx.x * 32 + tl;
  const float* lg = p.logits + (size_t)t * NE;
  for (int j = 0; j < NE; ++j) sb[tl][j] = sigmoidf(lg[j]) + p.r_bias[j];
  float gs[8];
#pragma unroll
  for (int g = 0; g < 8; ++g) {
    float m1 = -INFINITY, m2 = -INFINITY;
    for (int j = 0; j < 32; ++j) { float v = sb[tl][g * 32 + j]; if (v > m1) { m2 = m1; m1 = v; } else if (v > m2) m2 = v; }
    gs[g] = m1 + m2;
  }
  unsigned gmask = 0;
#pragma unroll
  for (int g = 0; g < 8; ++g) {
    int rank = 0;
#pragma unroll
    for (int i = 0; i < 8; ++i) rank += (gs[i] > gs[g]) || (gs[i] == gs[g] && i < g);
    if (rank < 4) gmask |= 1u << g;
  }
  float sel[8]; int ei[8]; float ssum = 0.f;
#pragma unroll
  for (int k = 0; k < 8; ++k) {
    float best = -INFINITY; int bi = 0;
    for (int j = 0; j < NE; ++j) { if (!((gmask >> (j >> 5)) & 1)) continue; float v = sb[tl][j]; if (v > best) { best = v; bi = j; } }
    sb[tl][bi] = -INFINITY;
    ei[k] = bi; sel[k] = sigmoidf(lg[bi]); ssum += sel[k];
  }
#pragma unroll
  for (int k = 0; k < 8; ++k) { p.eidx[t * 8 + k] = ei[k]; p.gates[t * 8 + k] = sel[k] / ssum * 2.5f; }
}
__global__ void k_zero_cnt(P p) { p.cnt[threadIdx.x] = 0; }
__global__ void k_count(P p) { int a = blockIdx.x * 256 + threadIdx.x; p.pos[a] = atomicAdd(&p.cnt[p.eidx[a]], 1); }
__global__ void k_scan(P p) { if (threadIdx.x == 0) { int s = 0; for (int e = 0; e < NE; ++e) { p.off[e] = s; s += p.cnt[e]; } p.off[NE] = s; } }
__global__ void k_fill(P p) { int a = blockIdx.x * 256 + threadIdx.x; p.sorted[p.off[p.eidx[a]] + p.pos[a]] = a; }

__global__ void __launch_bounds__(256) k_moe1(P p) {
  __shared__ float sh[D];
  int a = p.sorted[blockIdx.x], t = a >> 3, e = p.eidx[a], f = threadIdx.x;
  for (int i = f; i < D; i += 256) sh[i] = p.h2[(size_t)t * D + i];
  __syncthreads();
  const float* wg = p.w_gate + (size_t)e * D * FF; const float* wu = p.w_up + (size_t)e * D * FF;
  float g = 0.f, u = 0.f;
  for (int d = 0; d < D; ++d) { g += sh[d] * wg[(size_t)d * FF + f]; u += sh[d] * wu[(size_t)d * FF + f]; }
  p.Hbuf[(size_t)a * FF + f] = silu(g) * u * p.gates[a];
}
__global__ void __launch_bounds__(256) k_moe2(P p) {
  __shared__ float sh[8][FF];
  int t = blockIdx.x, b = t / S, tid = threadIdx.x;
  for (int i = tid; i < 8 * FF; i += 256) sh[i >> 8][i & 255] = p.Hbuf[(size_t)t * 8 * FF + i];
  __syncthreads();
  float acc[4] = {0.f, 0.f, 0.f, 0.f};
  for (int k = 0; k < 8; ++k) {
    int e = p.eidx[t * 8 + k];
    const float* wd = p.w_down + (size_t)e * FF * D;
    for (int f = 0; f < FF; ++f) {
      float hv = sh[k][f];
#pragma unroll
      for (int i = 0; i < 4; ++i) acc[i] += hv * wd[(size_t)f * D + tid + 256 * i];
    }
  }
#pragma unroll
  for (int i = 0; i < 4; ++i) {
    int n = tid + 256 * i;
    p.out[(size_t)t * D + n] = p.x1[(size_t)t * D + n] + p.mod[b * 6 * D + 5 * D + n] * (acc[i] + p.shared[(size_t)t * D + n]);
  }
}
}

extern "C" void kernel_launch(void* const* d_in, const int* in_sizes, int n_in, void* d_out, int out_size, void* d_ws, size_t ws_size,
                              hipStream_t stream) {
  P p{};
  const float** f = (const float**)d_in;
  p.x = f[0]; p.c = f[1]; p.w_ada = f[2]; p.b_ada = f[3]; p.g_mix = f[4]; p.g_ffn = f[5]; p.w_in = f[6]; p.g_q_dil = f[7]; p.g_k_dil = f[8];
  p.g_q_nsa = f[9]; p.g_k_cmp = f[10]; p.g_k_slc = f[11]; p.g_k_win = f[12]; p.pe_k = f[13]; p.w1_k = f[14]; p.w2_k = f[15]; p.pe_v = f[16];
  p.w1_v = f[17]; p.w2_v = f[18]; p.w_out = f[19]; p.w_router = f[20]; p.r_bias = f[21]; p.w_gate = f[22]; p.w_up = f[23]; p.w_down = f[24];
  p.ws_gate = f[25]; p.ws_up = f[26]; p.ws_down = f[27];
  p.out = (float*)d_out;
  char* w = (char*)d_ws; size_t o = 0;
  auto alloc = [&](size_t bytes) { void* r = w + o; o += (bytes + 255) & ~(size_t)255; return r; };
  p.mod = (float*)alloc(4 * 6 * D * 4);
  p.rope = (float*)alloc(S * 16 * 4);
  p.kcmp = (float*)alloc(8 * 256 * 64 * 4);
  p.vcmp = (float*)alloc(8 * 256 * 64 * 4);
  p.selmask = (unsigned long long*)alloc((size_t)T * 2 * 8);
  p.eidx = (int*)alloc(T * 8 * 4); p.gates = (float*)alloc(T * 8 * 4);
  p.cnt = (int*)alloc(NE * 4); p.off = (int*)alloc((NE + 1) * 4); p.pos = (int*)alloc(T * 8 * 4); p.sorted = (int*)alloc(T * 8 * 4);
  p.logits = (float*)alloc((size_t)T * NE * 4);
  p.hs_g = (float*)alloc((size_t)T * FF * 4); p.hs = (float*)alloc((size_t)T * FF * 4);
  p.x1 = (float*)alloc((size_t)T * D * 4);
  p.mixin = (float*)alloc((size_t)T * D * 4);
  float* R1 = (float*)alloc((size_t)T * D * 4);
  p.h1 = R1; p.h2 = R1;
  float* R2 = (float*)alloc((size_t)T * (8 * FF + D) * 4);
  p.proj = R2; p.Hbuf = R2; p.shared = R2 + (size_t)T * 8 * FF;
  p.qrope = (float*)alloc((size_t)T * 512 * 4);
  p.ocmp = (float*)alloc((size_t)T * 512 * 4); p.oslc = (float*)alloc((size_t)T * 512 * 4); p.owin = (float*)alloc((size_t)T * 512 * 4);

  k_ada<<<dim3(6 * D / 256, NB), 256, 0, stream>>>(p);
  k_rope_tab<<<S * 8 / 256, 256, 0, stream>>>(p);
  k_norm_mod<<<T, 256, 0, stream>>>(p.x, p.g_mix, p.mod, 0, D, p.h1);
  k_proj<<<dim3((INC + 63) / 64, T / 64), 256, 0, stream>>>(p);
  k_headnorm<<<T * 28 / 4, 256, 0, stream>>>(p);
  k_dilated<<<T * 8 / 4, 256, 0, stream>>>(p);
  k_compress<<<2 * 2040, 128, 0, stream>>>(p);
  k_cmpattn<<<T * 2 / 4, 256, 0, stream>>>(p);
  k_slcattn<<<T * 2 / 4, 256, 0, stream>>>(p);
  k_winattn<<<T * 2 / 4, 256, 0, stream>>>(p);
  k_merge<<<T * 512 / 256, 256, 0, stream>>>(p);
  k_outproj<<<dim3(D / 64, T / 64), 256, 0, stream>>>(p);
  k_norm_mod<<<T, 256, 0, stream>>>(p.x1, p.g_ffn, p.mod, 3 * D, 4 * D, p.h2);
  k_router<<<dim3(NE / 64, T / 64), 256, 0, stream>>>(p);
  k_route<<<T / 32, 32, 0, stream>>>(p);
  k_zero_cnt<<<1, NE, 0, stream>>>(p);
  k_count<<<T * 8 / 256, 256, 0, stream>>>(p);
  k_scan<<<1, 64, 0, stream>>>(p);
  k_fill<<<T * 8 / 256, 256, 0, stream>>>(p);
  k_shared_g<<<dim3(FF / 64, T / 64), 256, 0, stream>>>(p);
  k_shared_u<<<dim3(FF / 64, T / 64), 256, 0, stream>>>(p);
  k_shared_d<<<dim3(D / 64, T / 64), 256, 0, stream>>>(p);
  k_moe1<<<T * 8, 256, 0, stream>>>(p);
  k_moe2<<<T, 256, 0, stream>>>(p);
}
```

```cpp
#include <hip/hip_runtime.h>
#include <hip/hip_cooperative_groups.h>
#include <stdint.h>
#include <cstdio>
namespace cg = cooperative_groups;

namespace {
constexpr int D = 1024, NB = 4, S = 4096, T = NB * S, HD = 64;
constexpr int INC = 2840;
constexpr int C_QA = 0, C_KA = 512, C_VA = 1024, C_QB = 1536, C_KC = 2048, C_VC = 2176, C_KSL = 2304, C_VSL = 2432,
              C_KW = 2560, C_VW = 2688, C_GB = 2816;
constexpr int NC = 255, NE = 256, TOPK = 8, FF = 256;
constexpr float EPS = 1e-6f;
#ifndef DUP
#define DUP 0
#endif
constexpr int SMEM_BYTES = 74 * 1024;
typedef unsigned short bf16_t;
typedef short bf16x8 __attribute__((ext_vector_type(8)));
typedef float f32x4 __attribute__((ext_vector_type(4)));
typedef unsigned u32x4 __attribute__((ext_vector_type(4)));
typedef unsigned u32x2 __attribute__((ext_vector_type(2)));
typedef __bf16 bf2_t __attribute__((ext_vector_type(2)));
typedef float f32x2 __attribute__((ext_vector_type(2)));
typedef float f32x16 __attribute__((ext_vector_type(16)));
typedef short s16x4 __attribute__((ext_vector_type(4)));
#define LAS __attribute__((address_space(3)))
#define MFMA32(a, b, c) __builtin_amdgcn_mfma_f32_32x32x16_bf16((a), (b), (c), 0, 0, 0)
constexpr float LOG2E = 1.4426950408889634f;

struct P {
  const float *x, *c, *w_ada, *b_ada, *g_mix, *g_ffn, *w_in, *g_q_dil, *g_k_dil, *g_q_nsa, *g_k_cmp, *g_k_slc, *g_k_win;
  const float *pe_k, *w1_k, *w2_k, *pe_v, *w1_v, *w2_v, *w_out, *w_router, *r_bias, *w_gate, *w_up, *w_down, *ws_gate, *ws_up, *ws_down;
  float* out;
  float *mod, *rope, *h1, *proj, *qrope, *kcmp, *vcmp, *ocmp, *oslc, *owin, *mixin, *x1, *h2, *logits, *gates, *hs_g, *hs, *shared, *Hbuf;
  unsigned long long* selmask;
  int *eidx, *cnt, *off, *pos, *sorted, *tstart;
  bf16_t *h1b, *h2s, *mixinb, *Hb, *Hs, *Ybuf, *Ys;
  bf16_t *QA, *KA, *VA, *QN, *QR, *KC, *VC, *KSL, *VSL, *KW, *VW;
  float *GS, *smaxv, *b1c;
  bf16_t *kcb, *vcb;
  int* ctr;
  int* bhist;
  unsigned char *h2q, *Hq, *Wq_g, *Wq_u, *Wq_d, *h1q, *Wq_in, *Yq;
  unsigned* bar;
  bf16_t *zrow, *Wt_in, *Wt_out, *Wt_rth, *Wt_rtl, *Wt_sg, *Wt_su, *Wt_sd, *Wt_c1k, *Wt_c1v, *Wt_g, *Wt_u, *Wt_d;
};

#define WLOOP(w, n) for (int w = blockIdx.x; w < (n); w += gridDim.x)

__device__ __forceinline__ int otid() { int t = threadIdx.x; asm volatile("" : "+v"(t)); return t; }
__device__ __forceinline__ unsigned pk_bf16(float lo, float hi) {
  f32x2 v = {lo, hi};
  bf2_t r = __builtin_convertvector(v, bf2_t);
  return __builtin_bit_cast(unsigned, r);
}
__device__ __forceinline__ float clamp_e4m3(float v) { return __builtin_amdgcn_fmed3f(v, -448.f, 448.f); }
__device__ __forceinline__ unsigned pk4_fp8(float a, float b, float c, float d) {
  int t = __builtin_amdgcn_cvt_pk_fp8_f32(a, b, 0, false);
  t = __builtin_amdgcn_cvt_pk_fp8_f32(c, d, t, true);
  return (unsigned)t;
}
constexpr float WQ_SCALE = 64.f, HQ_SCALE = 8.f, YQ_SCALE = 16.f;
__device__ __forceinline__ float bf16_to_f32(unsigned short b) { return __uint_as_float((unsigned)b << 16); }
__device__ __forceinline__ float bf16_round(float v) { return __uint_as_float(pk_bf16(v, 0.f) << 16); }
__device__ __forceinline__ float silu(float v) { return v / (1.f + expf(-v)); }
__device__ __forceinline__ float sigmoidf(float v) { return 1.f / (1.f + expf(-v)); }
__device__ __forceinline__ float wave_sum(float v) { for (int o = 32; o; o >>= 1) v += __shfl_xor(v, o); return v; }
__device__ __forceinline__ float wave_max(float v) { for (int o = 32; o; o >>= 1) v = fmaxf(v, __shfl_xor(v, o)); return v; }

__device__ __forceinline__ void ph_ada(const P& p, char* smem) {
  float* sc = (float*)smem;
  f32x4* red = (f32x4*)(smem + 16384);
  bool loaded = false;
  WLOOP(w, 6 * D / 32) {
    const int tid = threadIdx.x, kg = tid >> 3, cl = tid & 7, j0 = w * 32 + cl * 4;
    __syncthreads();
    if (!loaded) { for (int i = tid; i < 4 * D; i += 256) sc[i] = silu(p.c[i]); loaded = true; __syncthreads(); }
    f32x4 acc[4];
#pragma unroll
    for (int b = 0; b < 4; ++b) acc[b] = (f32x4){0.f, 0.f, 0.f, 0.f};
#pragma unroll 8
    for (int it = 0; it < 32; ++it) {
      const int k = kg + 32 * it;
      const f32x4 wv = *(const f32x4*)(p.w_ada + (size_t)k * 6 * D + j0);
#pragma unroll
      for (int b = 0; b < 4; ++b) acc[b] += wv * sc[b * D + k];
    }
#pragma unroll
    for (int b = 0; b < 4; ++b) red[(kg * 8 + cl) * 4 + b] = acc[b];
    __syncthreads();
    if (tid < 128) {
      const int b = tid >> 5, c = tid & 31;
      float s = p.b_ada[w * 32 + c];
      for (int g = 0; g < 32; ++g) s += ((const float*)&red[(g * 8 + (c >> 2)) * 4 + b])[c & 3];
      p.mod[b * 6 * D + w * 32 + c] = s;
    }
  }
}
__device__ __forceinline__ void ph_rope_tab(const P& p) {
  WLOOP(w, S * 8 / 256) {
    int i = w * 256 + threadIdx.x;
    int pos = i >> 3, f = i & 7;
    double ang = (double)pos * pow(500000.0, -(double)f / 8.0);
    p.rope[i * 2] = (float)cos(ang);
    p.rope[i * 2 + 1] = (float)sin(ang);
  }
}
template <bool SPLIT, bool INBF = false>
__device__ __forceinline__ void ph_norm_mod(const float* in, const float* g, const float* mod, int shift_off, int scale_off, bf16_t* out, unsigned char* outq = nullptr) {
  const int lane = threadIdx.x & 63, wv = threadIdx.x >> 6;
  WLOOP(w, T / 4) {
    const int t = w * 4 + wv, b = t / S;
    f32x4 v[4];
    float ss = 0.f;
#pragma unroll
    for (int i = 0; i < 4; ++i) {
      if (INBF) { const u32x2 q = *(const u32x2*)((const bf16_t*)in + (size_t)t * D + i * 256 + lane * 4); v[i] = (f32x4){__uint_as_float(q.x << 16), __uint_as_float(q.x & 0xffff0000u), __uint_as_float(q.y << 16), __uint_as_float(q.y & 0xffff0000u)}; }
      else v[i] = *(const f32x4*)(in + (size_t)t * D + i * 256 + lane * 4);
      ss += v[i][0] * v[i][0] + v[i][1] * v[i][1] + v[i][2] * v[i][2] + v[i][3] * v[i][3]; }
    ss = wave_sum(ss);
    const float r = rsqrtf(ss * (1.f / D) + EPS);
    const int ld = SPLIT ? 2 * D : D;
#pragma unroll
    for (int i = 0; i < 4; ++i) {
      const int d = i * 256 + lane * 4;
      const f32x4 gg = *(const f32x4*)(g + d), sc = *(const f32x4*)(mod + b * 6 * D + scale_off + d), sh = *(const f32x4*)(mod + b * 6 * D + shift_off + d);
      const f32x4 o = v[i] * r * gg * (sc + 1.f) + sh;
      u32x2 hi = {pk_bf16(o[0], o[1]), pk_bf16(o[2], o[3])};
      if (out) *(u32x2*)(out + (size_t)t * ld + d) = hi;
      if (!SPLIT && outq) *(unsigned*)(outq + (size_t)t * D + d) = pk4_fp8(o[0], o[1], o[2], o[3]);
      if (SPLIT) {
        *(unsigned*)(outq + (size_t)t * D + d) = pk4_fp8(o[0], o[1], o[2], o[3]);
        const float l0 = o[0] - __uint_as_float(hi.x << 16), l1 = o[1] - __uint_as_float(hi.x & 0xffff0000u);
        const float l2 = o[2] - __uint_as_float(hi.y << 16), l3 = o[3] - __uint_as_float(hi.y & 0xffff0000u);
        u32x2 lo = {pk_bf16(l0, l1), pk_bf16(l2, l3)};
        *(u32x2*)(out + (size_t)t * ld + D + d) = lo;
      }
    }
  }
}

template <bool SPLIT3, class AF, class BF, class EF>
__device__ __forceinline__ void gemm128(char* smem, int K, int ldb, AF arow, BF bcol, EF epi) {
  const int tid = otid(), lane = tid & 63, wid = tid >> 6, wm = wid >> 1, wn = wid & 1;
  const int l15 = lane & 15, l4 = lane >> 4;
  char* As = smem; char* Bs = smem + 16384;
  const int ac = tid & 7, ar0 = tid >> 3;
  const bf16_t* ap[4];
#pragma unroll
  for (int i = 0; i < 4; ++i) ap[i] = arow(ar0 + 32 * i);
  const int kg = tid >> 5, ng = tid & 31;
  const float* bp = bcol(ng * 4);
  if (bp) bp += (size_t)(kg * 8) * ldb;
  u32x4 areg[4]; f32x4 breg[8];
  const int nk1 = K / 64, nk = SPLIT3 ? 3 * nk1 : nk1;
  auto gload = [&](int kt) {
    const int seg = SPLIT3 ? kt / nk1 : 0, k0 = (SPLIT3 ? kt % nk1 : kt) * 64;
    const int aoff = (seg == 2 ? K : 0) + k0 + ac * 8;
#pragma unroll
    for (int i = 0; i < 4; ++i) areg[i] = ap[i] ? *(const u32x4*)(ap[i] + aoff) : (u32x4){0u, 0u, 0u, 0u};
#pragma unroll
    for (int i = 0; i < 8; ++i) breg[i] = bp ? *(const f32x4*)(bp + (size_t)(k0 + i) * ldb) : (f32x4){0.f, 0.f, 0.f, 0.f};
    if (SPLIT3 && seg == 1) {
#pragma unroll
      for (int i = 0; i < 8; ++i)
#pragma unroll
        for (int j = 0; j < 4; ++j) breg[i][j] = breg[i][j] - bf16_round(breg[i][j]);
    }
  };
  auto lstore = [&]() {
#pragma unroll
    for (int i = 0; i < 4; ++i) { const int r = ar0 + 32 * i; *(u32x4*)(As + r * 128 + ((ac ^ ((r >> 1) & 7)) << 4)) = areg[i]; }
#pragma unroll
    for (int j = 0; j < 4; ++j) {
      const int n = ng * 4 + j;
      u32x4 v = {pk_bf16(breg[0][j], breg[1][j]), pk_bf16(breg[2][j], breg[3][j]), pk_bf16(breg[4][j], breg[5][j]), pk_bf16(breg[6][j], breg[7][j])};
      *(u32x4*)(Bs + n * 128 + ((kg ^ ((n >> 1) & 7)) << 4)) = v;
    }
  };
  f32x4 acc[4][4];
#pragma unroll
  for (int i = 0; i < 4; ++i)
#pragma unroll
    for (int j = 0; j < 4; ++j) acc[i][j] = (f32x4){0.f, 0.f, 0.f, 0.f};
  gload(0);
  const int sw = l15 >> 1;
  for (int kt = 0; kt < nk; ++kt) {
    __syncthreads();
    lstore();
    __syncthreads();
    if (kt + 1 < nk) gload(kt + 1);
#pragma unroll
    for (int ks = 0; ks < 2; ++ks) {
      const int coff = ((ks * 4 + l4) ^ sw) << 4;
      bf16x8 af[4], bfr[4];
#pragma unroll
      for (int mt = 0; mt < 4; ++mt) af[mt] = *(const bf16x8*)(As + (wm * 64 + mt * 16 + l15) * 128 + coff);
#pragma unroll
      for (int nt = 0; nt < 4; ++nt) bfr[nt] = *(const bf16x8*)(Bs + (wn * 64 + nt * 16 + l15) * 128 + coff);
#pragma unroll
      for (int mt = 0; mt < 4; ++mt)
#pragma unroll
        for (int nt = 0; nt < 4; ++nt) acc[mt][nt] = __builtin_amdgcn_mfma_f32_16x16x32_bf16(bfr[nt], af[mt], acc[mt][nt], 0, 0, 0);
    }
  }
  epi(acc, wm * 64 + l15, wn * 64 + l4 * 4);
}

typedef unsigned u32x2v __attribute__((ext_vector_type(2)));
__device__ __forceinline__ void xpose4(unsigned (&d)[4][2], int) {
#pragma unroll
  for (int a = 0; a < 2; ++a)
#pragma unroll
    for (int h = 0; h < 2; ++h) { const u32x2v r = __builtin_amdgcn_permlane16_swap(d[2 * a][h], d[2 * a + 1][h], false, false); d[2 * a][h] = r.x; d[2 * a + 1][h] = r.y; }
#pragma unroll
  for (int j = 0; j < 2; ++j)
#pragma unroll
    for (int h = 0; h < 2; ++h) { const u32x2v r = __builtin_amdgcn_permlane32_swap(d[j][h], d[2 + j][h], false, false); d[j][h] = r.x; d[2 + j][h] = r.y; }
}
__device__ __forceinline__ void store_row64_bf16(const f32x4& a0, const f32x4& a1, const f32x4& a2, const f32x4& a3, int l4, bf16_t* rowp, bool doit) {
  unsigned d[4][2] = {{pk_bf16(a0[0], a0[1]), pk_bf16(a0[2], a0[3])}, {pk_bf16(a1[0], a1[1]), pk_bf16(a1[2], a1[3])},
                      {pk_bf16(a2[0], a2[1]), pk_bf16(a2[2], a2[3])}, {pk_bf16(a3[0], a3[1]), pk_bf16(a3[2], a3[3])}};
  xpose4(d, l4);
  if (doit) {
    *(u32x4*)(rowp + 16 * l4) = (u32x4){d[0][0], d[0][1], d[1][0], d[1][1]};
    *(u32x4*)(rowp + 16 * l4 + 8) = (u32x4){d[2][0], d[2][1], d[3][0], d[3][1]};
  }
}

template <bool LO>
__device__ __forceinline__ void cvt_kn_tile(const float* src, int ldn, bf16_t* dst, int ldk, int k0, int n0, int nmax) {
  const int tid = threadIdx.x, kg = tid & 7, ng = tid >> 3, n = n0 + ng * 4;
  if (n >= nmax) return;
  f32x4 r[8];
#pragma unroll
  for (int i = 0; i < 8; ++i) r[i] = *(const f32x4*)(src + (size_t)(k0 + kg * 8 + i) * ldn + n);
  if (LO) {
#pragma unroll
    for (int i = 0; i < 8; ++i)
#pragma unroll
      for (int j = 0; j < 4; ++j) r[i][j] = r[i][j] - bf16_round(r[i][j]);
  }
#pragma unroll
  for (int j = 0; j < 4; ++j) {
    u32x4 v = {pk_bf16(r[0][j], r[1][j]), pk_bf16(r[2][j], r[3][j]), pk_bf16(r[4][j], r[5][j]), pk_bf16(r[6][j], r[7][j])};
    *(u32x4*)(dst + (size_t)(n + j) * ldk + k0 + kg * 8) = v;
  }
}
template <bool LO>
__device__ __forceinline__ void cvt_matrix(const float* src, bf16_t* dst, int K, int N, int& item_base) {
  const int nkt = K / 64, nnt = (N + 127) / 128, total = nkt * nnt;
  for (int it = (int)blockIdx.x - item_base; it < total; it += gridDim.x) {
    if (it < 0) continue;
    cvt_kn_tile<LO>(src, N, dst, K, (it % nkt) * 64, (it / nkt) * 128, N);
  }
  item_base = (item_base + total) % gridDim.x;
}

constexpr int G2_STAGE = 24576;
template <int NSEG, int AB = 0, class AF, class BF, class EF>
__device__ __forceinline__ void gemm2(char* smem_, int K, AF arow, BF brow, EF epi, int aseg1 = 0, int bseg1 = 0, int aseg2 = 0, int bseg2 = 0) {
  LAS char* smem = (LAS char*)smem_;
  const int tid = otid(), lane = tid & 63, wv = __builtin_amdgcn_readfirstlane(tid >> 6), wm = wv >> 1, wn = wv & 1;
  const int l15 = lane & 15, l4 = lane >> 4;
  const int row_l = lane >> 2, csrc = ((lane & 3) ^ (((row_l >> 3) & 1) * 3)) * 8;
  const bf16_t* ap[4]; const bf16_t* bp[2];
#pragma unroll
  for (int j = 0; j < 4; ++j) ap[j] = arow((wv + 4 * j) * 16 + row_l) + csrc;
#pragma unroll
  for (int j = 0; j < 2; ++j) bp[j] = brow((wv + 4 * j) * 16 + row_l) + csrc;
  const int nk1 = K / 32, nk = NSEG * nk1;
  auto issue = [&](int kt) {
    LAS char* st = smem + (kt % 3) * G2_STAGE;
    int ka = kt * 32, kb = kt * 32;
    if (NSEG > 1) { const int seg = kt / nk1, kk = (kt - seg * nk1) * 32; ka = kk + (seg == 1 ? aseg1 : (seg == 2 ? aseg2 : 0)); kb = kk + (seg == 1 ? bseg1 : (seg == 2 ? bseg2 : 0)); }
#pragma unroll
    for (int j = 0; j < 4; ++j) __builtin_amdgcn_global_load_lds((const unsigned*)(ap[j] + ka), (LAS unsigned*)(st + (wv + 4 * j) * 1024), 16, 0, 0);
#pragma unroll
    for (int j = 0; j < 2; ++j) __builtin_amdgcn_global_load_lds((const unsigned*)(bp[j] + kb), (LAS unsigned*)(st + 16384 + (wv + 4 * j) * 1024), 16, 0, 0);
  };
  f32x4 acc[8][4];
#pragma unroll
  for (int i = 0; i < 8; ++i)
#pragma unroll
    for (int j = 0; j < 4; ++j) acc[i][j] = (f32x4){0.f, 0.f, 0.f, 0.f};
  const int coff = (l4 ^ (((l15 >> 3) & 1) * 3)) << 4;
  const int aoff = (wm * 128 + l15) * 64 + coff, boff = 16384 + (wn * 64 + l15) * 64 + coff;
  asm volatile("s_waitcnt lgkmcnt(0)" ::: "memory");
  __builtin_amdgcn_s_barrier();
  asm volatile("" ::: "memory");
  issue(0);
  if (nk > 1) issue(1);
  for (int kt = 0; kt < nk; ++kt) {
    if (kt + 1 < nk) asm volatile("s_waitcnt vmcnt(6)" ::: "memory"); else asm volatile("s_waitcnt vmcnt(0)" ::: "memory");
    __builtin_amdgcn_s_barrier();
    asm volatile("" ::: "memory");
    if (AB != 2 && kt + 2 < nk) issue(kt + 2);
    const LAS char* st = smem + (kt % 3) * G2_STAGE;
    bf16x8 bfr[4], af[8];
    if (AB != 3) {
#pragma unroll
    for (int nt = 0; nt < 4; ++nt) bfr[nt] = *(const LAS bf16x8*)(st + boff + nt * 1024);
#pragma unroll
    for (int mt = 0; mt < 8; ++mt) af[mt] = *(const LAS bf16x8*)(st + aoff + mt * 1024);
    }
    __builtin_amdgcn_sched_barrier(0);
    if (AB == 1) {
#pragma unroll
      for (int nt = 0; nt < 4; ++nt) asm volatile("" :: "v"(bfr[nt]));
#pragma unroll
      for (int mt = 0; mt < 8; ++mt) asm volatile("" :: "v"(af[mt]));
    }
    if (AB == 0 || AB == 2) {
    __builtin_amdgcn_s_setprio(1);
#pragma unroll
    for (int mt = 0; mt < 8; ++mt)
#pragma unroll
      for (int nt = 0; nt < 4; ++nt) acc[mt][nt] = __builtin_amdgcn_mfma_f32_16x16x32_bf16(bfr[nt], af[mt], acc[mt][nt], 0, 0, 0);
    __builtin_amdgcn_s_setprio(0);
    }
    __builtin_amdgcn_sched_barrier(0);
  }
  epi(acc, wm * 128 + l15, wn * 64 + l4 * 4);
}

template <int NREP = 1, class AF, class BF, class EF>
__device__ __forceinline__ void gemm2q(char* smem_, int K, AF arow, BF brow, EF epi, size_t bstep = 0) {
  LAS char* smem = (LAS char*)smem_;
  const int tid = otid(), lane = tid & 63, wv = __builtin_amdgcn_readfirstlane(tid >> 6), wm = wv >> 1, wn = wv & 1;
  const int l15 = lane & 15, l4 = lane >> 4;
  const int row_l = lane >> 2, csrc = ((lane & 3) ^ ((row_l >> 2) & 3)) * 16;
  const unsigned char* ap[4]; const unsigned char* bp[2];
#pragma unroll
  for (int j = 0; j < 4; ++j) ap[j] = arow((wv + 4 * j) * 16 + row_l) + csrc;
#pragma unroll
  for (int j = 0; j < 2; ++j) bp[j] = brow((wv + 4 * j) * 16 + row_l) + csrc;
  const int nk1 = K / 64, nk = nk1 * NREP;
  auto issue = [&](int kt) {
    LAS char* st = smem + (kt % 3) * G2_STAGE;
    const int rp = NREP > 1 ? kt / nk1 : 0, kk = NREP > 1 ? kt - rp * nk1 : kt;
#pragma unroll
    for (int j = 0; j < 4; ++j) __builtin_amdgcn_global_load_lds((const unsigned*)(ap[j] + kk * 64), (LAS unsigned*)(st + (wv + 4 * j) * 1024), 16, 0, 0);
#pragma unroll
    for (int j = 0; j < 2; ++j) __builtin_amdgcn_global_load_lds((const unsigned*)(bp[j] + rp * bstep + kk * 64), (LAS unsigned*)(st + 16384 + (wv + 4 * j) * 1024), 16, 0, 0);
  };
  f32x4 acc[8][4];
#pragma unroll
  for (int i = 0; i < 8; ++i)
#pragma unroll
    for (int j = 0; j < 4; ++j) acc[i][j] = (f32x4){0.f, 0.f, 0.f, 0.f};
  const int sw = (l15 >> 2) & 3, sub = (l4 & 1) * 8, ch = l4 >> 1;
  const int aoff = (wm * 128 + l15) * 64 + sub, boff = 16384 + (wn * 64 + l15) * 64 + sub;
  asm volatile("s_waitcnt lgkmcnt(0)" ::: "memory");
  __builtin_amdgcn_s_barrier();
  asm volatile("" ::: "memory");
  issue(0);
  if (nk > 1) issue(1);
  for (int kt = 0; kt < nk; ++kt) {
    if (kt + 1 < nk) asm volatile("s_waitcnt vmcnt(6)" ::: "memory"); else asm volatile("s_waitcnt vmcnt(0)" ::: "memory");
    __builtin_amdgcn_s_barrier();
    asm volatile("" ::: "memory");
    if (kt + 2 < nk) issue(kt + 2);
    const LAS char* st = smem + (kt % 3) * G2_STAGE;
#pragma unroll
    for (int ks = 0; ks < 2; ++ks) {
      const int coff = ((2 * ks + ch) ^ sw) << 4;
      long bfr[4], af[8];
#pragma unroll
      for (int nt = 0; nt < 4; ++nt) bfr[nt] = *(const LAS long*)(st + boff + nt * 1024 + coff);
#pragma unroll
      for (int mt = 0; mt < 8; ++mt) af[mt] = *(const LAS long*)(st + aoff + mt * 1024 + coff);
      __builtin_amdgcn_s_setprio(1);
#pragma unroll
      for (int mt = 0; mt < 8; ++mt)
#pragma unroll
        for (int nt = 0; nt < 4; ++nt) acc[mt][nt] = __builtin_amdgcn_mfma_f32_16x16x32_fp8_fp8(bfr[nt], af[mt], acc[mt][nt], 0, 0, 0);
      __builtin_amdgcn_s_setprio(0);
    }
    __builtin_amdgcn_sched_barrier(0);
    if (NREP > 1 && (kt + 1) % nk1 == 0 && kt + 1 < nk) {
      epi(acc, wm * 128 + l15, wn * 64 + l4 * 4, kt / nk1);
#pragma unroll
      for (int i = 0; i < 8; ++i)
#pragma unroll
        for (int j = 0; j < 4; ++j) acc[i][j] = (f32x4){0.f, 0.f, 0.f, 0.f};
    }
  }
  epi(acc, wm * 128 + l15, wn * 64 + l4 * 4, NREP - 1);
}

template <class F>
__device__ __forceinline__ void gemm2_grid(int NT, F body) {
  const int xcd = blockIdx.x & 7, lb = blockIdx.x >> 3, nlb = gridDim.x >> 3;
  for (int i = lb; i < 8 * NT; i += nlb) body(xcd * 8 + (i & 7), i >> 3);
}

template <class F>
__device__ __forceinline__ void gemm_grid(int NT, F body) {
  const int xcd = blockIdx.x & 7, lb = blockIdx.x >> 3, nlb = gridDim.x >> 3;
  for (int i = lb; i < 16 * NT; i += nlb) {
    const int g = i / (8 * NT), rem = i % (8 * NT), nt = rem >> 3, mi = rem & 7;
    body(xcd * 16 + g * 8 + mi, nt);
  }
}

template <int MT>
__device__ __forceinline__ void proj_epi(const P& p, const f32x4 (&acc)[MT][4], int row_base, int ntile, int r0, int c0, float ascale = 1.f, const float* rope_tile = nullptr) {
  const int wn = c0 >> 6, l4 = (c0 & 63) >> 2;
  const int col0 = ntile * 128 + wn * 64;
  if (col0 >= INC) return;
  if (col0 == C_GB) {
#pragma unroll
    for (int mt = 0; mt < MT; ++mt) {
      const int m = row_base + r0 + mt * 16;
      f32x4 a = acc[mt][0] * ascale, g0 = {sigmoidf(a[0]), sigmoidf(a[1]), sigmoidf(a[2]), sigmoidf(a[3])};
      *(f32x4*)(p.GS + (size_t)m * 24 + 4 * l4) = g0;
      if (l4 < 2) { a = acc[mt][1] * ascale; f32x4 g1 = {sigmoidf(a[0]), sigmoidf(a[1]), sigmoidf(a[2]), sigmoidf(a[3])}; *(f32x4*)(p.GS + (size_t)m * 24 + 16 + 4 * l4) = g1; }
    }
    return;
  }
  const float* g = nullptr; bf16_t* dst; bf16_t* dst2 = nullptr; int hh, H; float qs = 1.f; bool dorope = false;
  if (col0 < 512) { g = p.g_q_dil; dst = p.QA; hh = col0 >> 6; H = 8; qs = 0.125f; dorope = true; }
  else if (col0 < 1024) { g = p.g_k_dil; dst = p.KA; hh = (col0 - 512) >> 6; H = 8; dorope = true; }
  else if (col0 < 1536) { dst = p.VA; hh = (col0 - 1024) >> 6; H = 8; }
  else if (col0 < 2048) { g = p.g_q_nsa; dst = p.QR; dst2 = p.QN; hh = (col0 - 1536) >> 6; H = 8; qs = 0.125f; dorope = true; }
  else {
    const int idx = (col0 - 2048) >> 6, which = idx >> 1; hh = idx & 1; H = 2;
    if (which == 0) dst = p.KC; else if (which == 1) dst = p.VC;
    else if (which == 2) { dst = p.KSL; g = p.g_k_slc; dorope = true; } else if (which == 3) dst = p.VSL;
    else if (which == 4) { dst = p.KW; g = p.g_k_win; dorope = true; } else dst = p.VW;
  }
  f32x4 gv[4];
  if (g) {
#pragma unroll
    for (int nt = 0; nt < 4; ++nt) gv[nt] = *(const f32x4*)(g + nt * 16 + 4 * l4);
  }
  const int bb = row_base / S;
#pragma unroll
  for (int mt = 0; mt < MT; ++mt) {
    const int m = row_base + r0 + mt * 16, s = m - bb * S;
    f32x4 v[4];
#pragma unroll
    for (int nt = 0; nt < 4; ++nt) v[nt] = acc[mt][nt] * ascale;
    if (g) {
      float ss = 0.f;
#pragma unroll
      for (int nt = 0; nt < 4; ++nt) ss += v[nt][0] * v[nt][0] + v[nt][1] * v[nt][1] + v[nt][2] * v[nt][2] + v[nt][3] * v[nt][3];
      ss += __shfl_xor(ss, 16); ss += __shfl_xor(ss, 32);
      const float r = rsqrtf(ss * (1.f / 64.f) + EPS) * qs;
#pragma unroll
      for (int nt = 0; nt < 4; ++nt) v[nt] = v[nt] * gv[nt] * r;
    }
    f32x4 vr = v[0];
    if (dorope) {
      const float* rp = rope_tile ? rope_tile + ((size_t)(m - row_base) * 8 + 4 * (l4 & 1)) * 2 : p.rope + ((size_t)s * 8 + 4 * (l4 & 1)) * 2;
      const f32x4 ra = *(const f32x4*)rp, rb = *(const f32x4*)(rp + 4);
      const float cs[4] = {ra[0], ra[2], rb[0], rb[2]}, sn[4] = {ra[1], ra[3], rb[1], rb[3]};
#pragma unroll
      for (int i = 0; i < 4; ++i) {
        const float pt = __shfl_xor(v[0][i], 32);
        vr[i] = (l4 < 2) ? (v[0][i] * cs[i] - pt * sn[i]) : (v[0][i] * cs[i] + pt * sn[i]);
      }
    }
    bf16_t* row = dst + ((size_t)(bb * H + hh) * S + s) * 64 + 16 * l4;
    unsigned dd[4][2] = {{pk_bf16(vr[0], vr[1]), pk_bf16(vr[2], vr[3])}, {pk_bf16(v[1][0], v[1][1]), pk_bf16(v[1][2], v[1][3])},
                         {pk_bf16(v[2][0], v[2][1]), pk_bf16(v[2][2], v[2][3])}, {pk_bf16(v[3][0], v[3][1]), pk_bf16(v[3][2], v[3][3])}};
    if (dst2) {
      unsigned d2[4][2] = {{pk_bf16(v[0][0], v[0][1]), pk_bf16(v[0][2], v[0][3])}, {dd[1][0], dd[1][1]}, {dd[2][0], dd[2][1]}, {dd[3][0], dd[3][1]}};
      xpose4(d2, l4);
      bf16_t* row2 = dst2 + ((size_t)(bb * H + hh) * S + s) * 64 + 16 * l4;
      *(u32x4*)row2 = (u32x4){d2[0][0], d2[0][1], d2[1][0], d2[1][1]};
      *(u32x4*)(row2 + 8) = (u32x4){d2[2][0], d2[2][1], d2[3][0], d2[3][1]};
    }
    xpose4(dd, l4);
    *(u32x4*)row = (u32x4){dd[0][0], dd[0][1], dd[1][0], dd[1][1]};
    *(u32x4*)(row + 8) = (u32x4){dd[2][0], dd[2][1], dd[3][0], dd[3][1]};
    asm volatile("" ::: "memory");
  }
}
__device__ __forceinline__ void ph_proj(const P& p, char* smem) {
  gemm2_grid(23, [&](int mtile, int ntile) {
    const unsigned char* A = p.h1q + (size_t)mtile * 256 * D; const unsigned char* W = p.Wq_in + (size_t)ntile * 128 * D; const unsigned char* Z = (const unsigned char*)p.zrow;
    const int nvalid = INC - ntile * 128;
    gemm2q<1>(smem, D, [=](int r) { return A + (size_t)r * D; }, [=](int n) { return n < nvalid ? W + (size_t)n * D : Z; },
              [&](const f32x4 (&acc)[8][4], int r0, int c0, int) {
                float* rl = (float*)smem;
                __syncthreads();
                { const int s0 = (mtile * 256) % S; const f32x4* srcp = (const f32x4*)(p.rope + (size_t)s0 * 16);
#pragma unroll
                  for (int i = 0; i < 4; ++i) ((f32x4*)rl)[threadIdx.x + 256 * i] = srcp[threadIdx.x + 256 * i]; }
                __syncthreads();
                proj_epi<8>(p, acc, mtile * 256, ntile, r0, c0, 1.f / WQ_SCALE, rl);
              });
  });
}
__device__ __forceinline__ void ph_outproj(const P& p, char* smem) {
  gemm2_grid(8, [&](int mtile, int ntile) {
    const bf16_t* A = p.mixinb + (size_t)mtile * 256 * D; const bf16_t* W = p.Wt_out + (size_t)ntile * 128 * D; bf16_t* C = (bf16_t*)p.x1; const float* x = p.x;
    const float* gt = p.mod + ((mtile * 256) / S) * 6 * D + 2 * D;
    gemm2<1>(smem, D, [=](int r) { return A + (size_t)r * D; }, [=](int n) { return W + (size_t)n * D; },
             [=](const f32x4 (&acc)[8][4], int r0, int c0) {
               const int l4 = (c0 & 63) >> 2;
#pragma unroll
               for (int mt = 0; mt < 8; ++mt) {
                 const int m = mtile * 256 + r0 + mt * 16;
                 f32x4 o[4];
#pragma unroll
                 for (int nt = 0; nt < 4; ++nt) {
                   const int n = ntile * 128 + c0 + nt * 16;
                   o[nt] = *(const f32x4*)(x + (size_t)m * D + n) + *(const f32x4*)(gt + n) * acc[mt][nt];
                 }
                 store_row64_bf16(o[0], o[1], o[2], o[3], l4, C + (size_t)m * D + ntile * 128 + (c0 & ~63), true);
                 asm volatile("" ::: "memory");
               }
             });
  });
}
template <int AB>
__device__ __forceinline__ void ph_outproj_abl(const P& p, char* smem) {
  gemm2_grid(8, [&](int mtile, int ntile) {
    const bf16_t* A = p.mixinb + (size_t)mtile * 256 * D; const bf16_t* W = p.Wt_out + (size_t)ntile * 128 * D; float* C = (float*)p.Ybuf;
    gemm2<1, AB>(smem, D, [=](int r) { return A + (size_t)r * D; }, [=](int n) { return W + (size_t)n * D; },
             [=](const f32x4 (&acc)[8][4], int r0, int c0) {
#pragma unroll
               for (int mt = 0; mt < 8; ++mt)
#pragma unroll
                 for (int nt = 0; nt < 4; ++nt) {
                   const int m = mtile * 256 + r0 + mt * 16, n = ntile * 128 + c0 + nt * 16;
                   *(f32x4*)(C + (size_t)m * D + n) = acc[mt][nt];
                 }
             });
  });
}
__device__ __forceinline__ void router_unit(const P& p, char* smem, int mtile, int j) {
  const int seg = j >> 1, ntile = j & 1;
  const bf16_t* A = p.h2s + (size_t)mtile * 256 * 2 * D + (seg == 2 ? D : 0);
  const bf16_t* W = (seg == 1 ? p.Wt_rtl : p.Wt_rth) + (size_t)ntile * 128 * D; float* C = p.logits + (size_t)seg * T * NE;
  gemm2<1>(smem, D, [=](int r) { return A + (size_t)r * 2 * D; }, [=](int n) { return W + (size_t)n * D; },
           [=](const f32x4 (&acc)[8][4], int r0, int c0) {
#pragma unroll
             for (int mt = 0; mt < 8; ++mt)
#pragma unroll
               for (int nt = 0; nt < 4; ++nt) {
                 const int m = mtile * 256 + r0 + mt * 16, n = ntile * 128 + c0 + nt * 16;
                 *(f32x4*)(C + (size_t)m * NE + n) = acc[mt][nt];
               }
           });
}
__device__ __forceinline__ const bf16_t* gu_row(const bf16_t* Wg, const bf16_t* Wu, int f0, int n) {
  const int wn = n >> 6, wi = n & 63;
  return (wi >= 32 ? Wu : Wg) + (size_t)(f0 + wn * 32 + (wi & 31)) * D;
}
template <int MT>
__device__ __forceinline__ void gu_store(const f32x4 (&acc)[MT][4], int mt, float scale, bf16_t* dstrow  ) {
#pragma unroll
  for (int q = 0; q < 2; ++q) {
    const f32x4 g = acc[mt][q], u = acc[mt][q + 2];
    float h[4];
#pragma unroll
    for (int i = 0; i < 4; ++i) h[i] = silu(g[i]) * u[i] * scale;
    u32x2 v = {pk_bf16(h[0], h[1]), pk_bf16(h[2], h[3])};
    *(u32x2*)(dstrow + q * 16) = v;
  }
}
__device__ __forceinline__ void shared_gu_unit(const P& p, char* smem, int mtile, int ntile) {
  const bf16_t* A = p.h2s + (size_t)mtile * 256 * 2 * D; const bf16_t* Wg = p.Wt_sg; const bf16_t* Wu = p.Wt_su; bf16_t* H = p.Hs;
  gemm2<1>(smem, D, [=](int r) { return A + (size_t)r * 2 * D; }, [=](int n) { return gu_row(Wg, Wu, ntile * 64, n); },
           [=](const f32x4 (&acc)[8][4], int r0, int c0) {
             const int wn = c0 >> 6, l4x4 = c0 & 63;
#pragma unroll
             for (int mt = 0; mt < 8; ++mt) gu_store<8>(acc, mt, 1.f, H + (size_t)(mtile * 256 + r0 + mt * 16) * FF + ntile * 64 + wn * 32 + l4x4);
           });
}
__device__ __forceinline__ void ph_router_shared_gu(const P& p, char* smem) {
  gemm2_grid(10, [&](int mtile, int j) { if (j < 6) router_unit(p, smem, mtile, j); else shared_gu_unit(p, smem, mtile, j - 6); });
}
__device__ __forceinline__ void ph_shared_d(const P& p, char* smem) {
  gemm2_grid(8, [&](int mtile, int ntile) {
    const bf16_t* A = p.Hs + (size_t)mtile * 256 * FF; const bf16_t* W = p.Wt_sd + (size_t)ntile * 128 * FF; bf16_t* Y = p.Ys;
    gemm2<1>(smem, FF, [=](int r) { return A + (size_t)r * FF; }, [=](int n) { return W + (size_t)n * FF; },
             [=](const f32x4 (&acc)[8][4], int r0, int c0) {
#pragma unroll
               for (int mt = 0; mt < 8; ++mt)
                 store_row64_bf16(acc[mt][0], acc[mt][1], acc[mt][2], acc[mt][3], (c0 & 63) >> 2, Y + (size_t)(mtile * 256 + r0 + mt * 16) * D + ntile * 128 + (c0 & ~63), true);
             });
  });
}
struct CvtQ { const float* src; unsigned char* dst; int ldn, ldk; };
__device__ __forceinline__ void cvtq_load(const CvtQ& d, f32x4 (&r)[16]) {
#pragma unroll
  for (int i = 0; i < 16; ++i) r[i] = __builtin_nontemporal_load((const f32x4*)(d.src + (size_t)i * d.ldn));
}
__device__ __forceinline__ void cvtq_store(const CvtQ& d, const f32x4 (&r)[16]) {
#pragma unroll
  for (int j = 0; j < 4; ++j) {
    u32x4 v = {pk4_fp8(r[0][j] * WQ_SCALE, r[1][j] * WQ_SCALE, r[2][j] * WQ_SCALE, r[3][j] * WQ_SCALE), pk4_fp8(r[4][j] * WQ_SCALE, r[5][j] * WQ_SCALE, r[6][j] * WQ_SCALE, r[7][j] * WQ_SCALE),
               pk4_fp8(r[8][j] * WQ_SCALE, r[9][j] * WQ_SCALE, r[10][j] * WQ_SCALE, r[11][j] * WQ_SCALE), pk4_fp8(r[12][j] * WQ_SCALE, r[13][j] * WQ_SCALE, r[14][j] * WQ_SCALE, r[15][j] * WQ_SCALE)};
    *(u32x4*)(d.dst + (size_t)j * d.ldk) = v;
  }
}
__device__ __forceinline__ CvtQ cvtq_desc(const float* src, int ldn, unsigned char* dst, int ldk, int k0, int n0) {
  const int kg = threadIdx.x & 7, n = n0 + (threadIdx.x >> 3) * 4;
  CvtQ d; d.src = src + (size_t)(k0 + kg * 16) * ldn + n; d.dst = dst + (size_t)n * ldk + k0 + kg * 16; d.ldn = ldn; d.ldk = ldk; return d;
}
__device__ __forceinline__ void cvtq_tile(const float* src, int ldn, unsigned char* dst, int ldk, int k0, int n0, int nmax = 1 << 30) {
  if (n0 + (int)(threadIdx.x >> 3) * 4 >= nmax) return;
  const CvtQ d = cvtq_desc(src, ldn, dst, ldk, k0, n0); f32x4 r[16]; cvtq_load(d, r); cvtq_store(d, r);
}
__device__ __forceinline__ CvtQ cvt_expert_desc(const P& p, int it) {
  const int e = it / 48, q = it - e * 48;
  if (q < 32) { const int up = q >> 4, qq = q & 15;
    return cvtq_desc((up ? p.w_up : p.w_gate) + (size_t)e * D * FF, FF, (up ? p.Wq_u : p.Wq_g) + (size_t)e * FF * D, D, (qq & 7) * 128, (qq >> 3) * 128);
  }
  const int qq = q - 32;
  return cvtq_desc(p.w_down + (size_t)e * FF * D, D, p.Wq_d + (size_t)e * D * FF, FF, (qq & 1) * 128, (qq >> 1) * 128);
}
__device__ __forceinline__ void cvt_expert_item(const P& p, int it) { const CvtQ d = cvt_expert_desc(p, it); f32x4 r[16]; cvtq_load(d, r); cvtq_store(d, r); }
__device__ __forceinline__ void ph_cvt_experts(const P& p) { WLOOP(w, NE * 48) cvt_expert_item(p, w); }

__device__ __forceinline__ bf16x8 pack8(const f32x16& x, int s) {
  u32x4 r = {pk_bf16(x[8 * s], x[8 * s + 1]), pk_bf16(x[8 * s + 2], x[8 * s + 3]), pk_bf16(x[8 * s + 4], x[8 * s + 5]), pk_bf16(x[8 * s + 6], x[8 * s + 7])};
  return __builtin_bit_cast(bf16x8, r);
}
__device__ __forceinline__ bf16x8 tr_pair(const LAS char* a) {
  const s16x4 lo = __builtin_amdgcn_ds_read_tr16_b64_v4i16((LAS s16x4*)a);
  const s16x4 hi = __builtin_amdgcn_ds_read_tr16_b64_v4i16((LAS s16x4*)(a + 8 * 128));
  return __builtin_shufflevector(lo, hi, 0, 1, 2, 3, 4, 5, 6, 7);
}
__device__ __forceinline__ int next_item(int* ctr, char* smem) {
  volatile int* slot = (volatile int*)(smem + SMEM_BYTES - 16);
  __syncthreads();
  if (threadIdx.x == 0) *slot = atomicAdd(ctr, 1);
  __syncthreads();
  return *slot;
}

__device__ __forceinline__ void compress_item(const P& p, char* smem, int item) {
  const int which = item >> 3, mtile = item & 7;
  const bf16_t* X = which ? p.VC : p.KC; const bf16_t* W1 = which ? p.Wt_c1v : p.Wt_c1k; const bf16_t* Z = p.zrow;
  const float* b1 = p.b1c + which * 128; bf16_t* hid = (bf16_t*)smem;
  gemm2<1>(smem, 2048,
           [=](int r) { const int R = mtile * 256 + r; if (R >= 2040) return Z; const int bg = R / 255, c = R - bg * 255; return X + ((size_t)bg * S + 16 * c) * 64; },
           [=](int n) { return W1 + (size_t)n * 2048; },
           [=](const f32x4 (&acc)[8][4], int r0, int c0) {
             __syncthreads();
#pragma unroll
             for (int nt = 0; nt < 4; ++nt) {
               const f32x4 bv = *(const f32x4*)(b1 + c0 + nt * 16);
#pragma unroll
               for (int mt = 0; mt < 8; ++mt) {
                 float h[4];
#pragma unroll
                 for (int i = 0; i < 4; ++i) { const float a = acc[mt][nt][i] + bv[i]; const float u = 0.7978845608028654f * (a + 0.044715f * a * a * a); h[i] = a - a / (1.f + __expf(2.f * u)); }
                 u32x2 w = {pk_bf16(h[0], h[1]), pk_bf16(h[2], h[3])};
                 *(u32x2*)(hid + (r0 + mt * 16) * 136 + c0 + nt * 16) = w;
               }
             }
           });
  __syncthreads();
  const float* W2 = which ? p.w2_v : p.w2_k;
  const int rl = threadIdx.x >> 3, pt = threadIdx.x & 7;
#pragma unroll 1
  for (int g = 0; g < 8; ++g) {
    const int row = g * 32 + rl, R = mtile * 256 + row;
    float o[8];
#pragma unroll
    for (int d = 0; d < 8; ++d) o[d] = 0.f;
#pragma unroll 2
    for (int n8 = 0; n8 < 16; ++n8) {
      const u32x4 hv4 = *(const u32x4*)(hid + row * 136 + n8 * 8);
#pragma unroll
      for (int k = 0; k < 8; ++k) {
        const float hv = (k & 1) ? __uint_as_float(hv4[k >> 1] & 0xffff0000u) : __uint_as_float(hv4[k >> 1] << 16);
        const f32x4 w0 = *(const f32x4*)(W2 + (n8 * 8 + k) * 64 + pt * 8), w1 = *(const f32x4*)(W2 + (n8 * 8 + k) * 64 + pt * 8 + 4);
        o[0] += hv * w0[0]; o[1] += hv * w0[1]; o[2] += hv * w0[2]; o[3] += hv * w0[3];
        o[4] += hv * w1[0]; o[5] += hv * w1[1]; o[6] += hv * w1[2]; o[7] += hv * w1[3];
      }
    }
    float rs = 1.f;
    if (!which) {
      float ss = 0.f;
#pragma unroll
      for (int d = 0; d < 8; ++d) ss += o[d] * o[d];
      ss += __shfl_xor(ss, 1); ss += __shfl_xor(ss, 2); ss += __shfl_xor(ss, 4);
      rs = rsqrtf(ss * (1.f / 64.f) + EPS);
    }
    if (R < 2040) {
      const int bg = R / 255, c = R - bg * 255;
      bf16_t* orow = (which ? p.vcb : p.kcb) + ((size_t)bg * 256 + c) * 64 + pt * 8;
      float gg[8];
      if (!which) { const f32x4 g0 = *(const f32x4*)(p.g_k_cmp + pt * 8), g1 = *(const f32x4*)(p.g_k_cmp + pt * 8 + 4); gg[0] = g0[0]; gg[1] = g0[1]; gg[2] = g0[2]; gg[3] = g0[3]; gg[4] = g1[0]; gg[5] = g1[1]; gg[6] = g1[2]; gg[7] = g1[3]; }
      else {
#pragma unroll
        for (int k = 0; k < 8; ++k) gg[k] = 1.f;
      }
      u32x4 w = {pk_bf16(o[0] * rs * gg[0], o[1] * rs * gg[1]), pk_bf16(o[2] * rs * gg[2], o[3] * rs * gg[3]), pk_bf16(o[4] * rs * gg[4], o[5] * rs * gg[5]), pk_bf16(o[6] * rs * gg[6], o[7] * rs * gg[7])};
      *(u32x4*)orow = w;
    }
  }
}

template <int MODE, int NSLOT>
__device__ __forceinline__ void nsa_pass(LAS char* kv, const bf16_t* Kg, const bf16_t* Vg, int t_lo, int t_hi, const bf16x8 (&qf)[4], float shf, int si,
                                         unsigned long long selm, f32x16& o0, f32x16& o1, float& l, LAS float* psl  ,
                                         int pos0 = 0, int pstride = 1, int kkmin = 0) {
  const int tid = otid(), lane = tid & 63, wv = __builtin_amdgcn_readfirstlane(tid >> 6), i = lane & 31, h5 = lane >> 5;
  const int ksw = (i >> 1) & 7;
  const int tq = (lane & 15) >> 2, tp = lane & 3, tds = (lane >> 4) & 1, vsw = ((tq >> 1) & 1) << 2;
  const int row_l = lane >> 3, cpos = lane & 7;
  const int kc8 = (cpos ^ ((wv & 1) * 4 + (row_l >> 1))) * 8, vc8 = (cpos ^ (((row_l >> 1) & 1) << 2)) * 8;
  const bf16_t* kgl = Kg + (size_t)(wv * 8 + row_l) * 64 + kc8;
  const bf16_t* vgl = Vg + (size_t)(wv * 8 + row_l) * 64 + vc8;
  auto stage = [&](int t, int buf) {
    LAS char* Ks = kv + buf * 16384 + wv * 1024; LAS char* Vs = Ks + 8192;
#pragma unroll
    for (int q = 0; q < 2; ++q) {
      if (MODE >= 3) {
        int pos = pos0 + pstride * (64 * t + 32 * q + wv * 8 + row_l);
        pos = pos < 0 ? 0 : (pos > S - 1 ? S - 1 : pos);
        __builtin_amdgcn_global_load_lds((const unsigned*)(Kg + (size_t)pos * 64 + kc8), (LAS unsigned*)(Ks + q * 4096), 16, 0, 0);
        __builtin_amdgcn_global_load_lds((const unsigned*)(Vg + (size_t)pos * 64 + vc8), (LAS unsigned*)(Vs + q * 4096), 16, 0, 0);
      } else {
        __builtin_amdgcn_global_load_lds((const unsigned*)(kgl + (size_t)(64 * t + 32 * q) * 64), (LAS unsigned*)(Ks + q * 4096), 16, 0, 0);
        __builtin_amdgcn_global_load_lds((const unsigned*)(vgl + (size_t)(64 * t + 32 * q) * 64), (LAS unsigned*)(Vs + q * 4096), 16, 0, 0);
      }
    }
  };
  float carry = 0.f;
  if (t_lo > t_hi) return;
  float dm16[4] = {0.f, 0.f, 0.f, 0.f}; int dmaxA = 0, dmaxB = 0; const int wq = wv & 3;
  if (MODE == 3) {
#pragma unroll
    for (int rg = 0; rg < 4; ++rg) dm16[rg] = (((wv - h5 - 2 * rg) & 3) == 0) ? 3.f : 2.f;
    dmaxA = si - kkmin < 128 ? si - kkmin : 128;
  }
  if (MODE == 4) { const int lim = si - kkmin; dmaxA = lim < 128 ? lim : 128; dmaxB = lim < 512 ? lim : 512; }
  asm volatile("s_waitcnt vmcnt(0) lgkmcnt(0)" ::: "memory");
  __builtin_amdgcn_s_barrier();
  asm volatile("" ::: "memory");
#pragma unroll
  for (int k = 0; k < NSLOT - 1; ++k) if (t_lo + k <= t_hi) stage(t_lo + k, k);
  for (int t = t_lo; t <= t_hi; ++t) {
    const int buf = (t - t_lo) % NSLOT;
    const int ahead = t_hi - t;
    if (NSLOT == 4 && ahead >= 2) asm volatile("s_waitcnt vmcnt(8)" ::: "memory");
    else if (NSLOT == 4 && ahead == 1) asm volatile("s_waitcnt vmcnt(4)" ::: "memory");
    else asm volatile("s_waitcnt vmcnt(0)" ::: "memory");
    __builtin_amdgcn_s_barrier();
    asm volatile("" ::: "memory");
    if (t + NSLOT - 1 <= t_hi) stage(t + NSLOT - 1, (t + NSLOT - 1 - t_lo) % NSLOT);
    const LAS char* Ks = kv + buf * 16384; const LAS char* Vs = Ks + 8192;
    const bool tsel = MODE == 1 ? ((selm >> t) & 1ull) != 0ull : true;
#pragma unroll
    for (int sub = 0; sub < 2; ++sub) {
      f32x16 sa;
#pragma unroll
      for (int q = 0; q < 16; ++q) sa[q] = 0.f;
#pragma unroll
      for (int s4 = 0; s4 < 4; ++s4) {
        const bf16x8 kf = *(const LAS bf16x8*)(Ks + (32 * sub + i) * 128 + (((2 * s4 + h5) ^ ksw) << 4));
        sa = MFMA32(kf, qf[s4], sa);
      }
      const int k0 = 64 * t + 32 * sub + 4 * h5;
#pragma unroll
      for (int q = 0; q < 16; ++q) {
        const int kidx = k0 + (q & 3) + 8 * (q >> 2);
        float pv;
        if (MODE >= 3) {
          const int dl = si - kidx;
          const float e = __builtin_amdgcn_exp2f(sa[q] * LOG2E - shf);
          if (MODE == 3) {
            const float cw = (q & 3) ? 1.f : dm16[q >> 2];
            pv = (unsigned)dl <= (unsigned)dmaxA ? cw * e : 0.f;
          } else {
            const bool lo = dl >= 33;
            float cw = (lo && dl <= dmaxA) ? 1.f : 0.f;
            if ((q & 3) == wq) cw += (lo && dl <= dmaxB) ? 1.f : 0.f;
            pv = cw * e;
          }
        } else {
          bool valid;
          if (MODE == 0) valid = 16 * kidx + 31 <= si;
          else if (MODE == 1) valid = tsel && kidx <= si;
          else valid = (unsigned)(si - kidx) <= 511u;
          pv = valid ? __builtin_amdgcn_exp2f(sa[q] * LOG2E - shf) : 0.f;
        }
        l += pv; sa[q] = pv;
      }
      if (MODE == 0) {
#pragma unroll
        for (int rg = 0; rg < 4; ++rg) {
          const float a = 2.f * (sa[4 * rg] + sa[4 * rg + 1] + sa[4 * rg + 2]) + sa[4 * rg + 3];
          const float recv = __shfl_xor(sa[4 * rg + 3], 32);
          const float val = h5 ? a + recv : a + carry;
          carry = recv;
          psl[16 * t + 8 * sub + 2 * rg + h5] = val;
        }
      }
      const bf16x8 pf0 = pack8(sa, 0), pf1 = pack8(sa, 1);
#pragma unroll
      for (int s2 = 0; s2 < 2; ++s2) {
        const LAS char* vb = Vs + (32 * sub + 16 * s2 + 4 * h5 + tq) * 128 + 8 * (tp & 1);
        const bf16x8 v0 = tr_pair(vb + (((tds * 2 + (tp >> 1)) ^ vsw) << 4));
        const bf16x8 v1 = tr_pair(vb + (((4 + tds * 2 + (tp >> 1)) ^ vsw) << 4));
        o0 = MFMA32(v0, s2 ? pf1 : pf0, o0);
        o1 = MFMA32(v1, s2 ? pf1 : pf0, o1);
      }
    }
    __builtin_amdgcn_sched_barrier(0);
  }
}

__device__ __forceinline__ void dilated_item(const P& p, char* smem_, int unit) {
  LAS char* kv = (LAS char*)smem_;
  const int tid = otid(), lane = tid & 63, wv = tid >> 6, i = lane & 31, h5 = lane >> 5;
  const int r4 = unit & 3, ti = (unit >> 2) & 7, hh = (unit >> 5) & 7, b = unit >> 8;
  const size_t hb = (size_t)(b * 8 + hh) * S * 64;
  const int si = ti * 512 + r4 + 4 * wv + 16 * i;
  bf16x8 qf[4];
#pragma unroll
  for (int s4 = 0; s4 < 4; ++s4) qf[s4] = *(const bf16x8*)(p.QA + hb + (size_t)si * 64 + 16 * s4 + 8 * h5);
  f32x16 o0, o1;
#pragma unroll
  for (int q = 0; q < 16; ++q) { o0[q] = 0.f; o1[q] = 0.f; }
  float l = 0.f;
  const float shf = p.smaxv[0] * LOG2E;
  const int pbase = ti * 512 + r4 - 128, ubase = ti * 128 - 512;
  nsa_pass<3, 4>(kv, p.KA + hb, p.VA + hb, 0, 9, qf, shf, 4 * wv + 16 * i + 128, 0ull, o0, o1, l, nullptr, pbase, 1, pbase < 0 ? -pbase : 0);
  nsa_pass<4, 4>(kv, p.KA + hb, p.VA + hb, 0, 9, qf, shf, wv + 4 * i + 512, 0ull, o0, o1, l, nullptr, r4 + 4 * ubase, 4, ubase < 0 ? -ubase : 0);
  l += __shfl_xor(l, 32);
  const float inv = 1.f / l;
  bf16_t* orow = p.mixinb + (size_t)(b * S + si) * D + hh * 64 + 4 * h5;
#pragma unroll
  for (int rg = 0; rg < 4; ++rg) {
    u32x2 w0 = {pk_bf16(o0[4 * rg] * inv, o0[4 * rg + 1] * inv), pk_bf16(o0[4 * rg + 2] * inv, o0[4 * rg + 3] * inv)};
    u32x2 w1 = {pk_bf16(o1[4 * rg] * inv, o1[4 * rg + 1] * inv), pk_bf16(o1[4 * rg + 2] * inv, o1[4 * rg + 3] * inv)};
    *(u32x2*)(orow + 8 * rg) = w0;
    *(u32x2*)(orow + 32 + 8 * rg) = w1;
  }
}

__device__ __forceinline__ void nsa_item(const P& p, char* smem_, int item) {
  LAS char* smem = (LAS char*)smem_;
  LAS char* kv = smem;
  LAS float* pslcw = (LAS float*)(smem + 32768);
  LAS float* invl = (LAS float*)(smem + 32768 + 33280);
  LAS unsigned* msk = (LAS unsigned*)(smem + 32768 + 33280 + 512);
  const int tid = otid(), lane = tid & 63, wv = tid >> 6, i = lane & 31, h5 = lane >> 5;
  const int qt = 127 - (item >> 3), bg = item & 7, b = bg >> 1, g = bg & 1, hq = g * 4 + wv;
  const int s0 = qt * 32, si = s0 + i, cur = s0 >> 6;
  const size_t qoff = ((size_t)(b * 8 + hq) * S + si) * 64 + 8 * h5;
  bf16x8 qf[4];
#pragma unroll
  for (int s4 = 0; s4 < 4; ++s4) qf[s4] = *(const bf16x8*)(p.QN + qoff + 16 * s4);
  const float* gs = p.GS + (size_t)(b * S + si) * 24 + hq * 3;
  const float g0 = gs[0], g1 = gs[1], g2 = gs[2];
  f32x16 oa0, oa1, o0, o1;
#pragma unroll
  for (int q = 0; q < 16; ++q) { o0[q] = 0.f; o1[q] = 0.f; }
  float l = 0.f;
  LAS float* psl = pslcw + (wv * 32 + i) * 65;
  const int ncv = (s0 + 31 - 31) >> 4;
  const int tc_hi = (ncv < 254 ? ncv : 254) >> 6;
#pragma unroll
  for (int k = 0; k < 32; ++k) psl[2 * k + h5] = 0.f;
  nsa_pass<0, 2>(kv, p.kcb + (size_t)bg * 256 * 64, p.vcb + (size_t)bg * 256 * 64, 0, tc_hi, qf, p.smaxv[1] * LOG2E, si, 0ull, o0, o1, l, psl);
  l += __shfl_xor(l, 32);
  {
    const float il = l > 0.f ? 1.f / l : 0.f;
    if (h5 == 0) invl[wv * 32 + i] = il;
    const float sc = g0 * il;
#pragma unroll
    for (int q = 0; q < 16; ++q) { oa0[q] = o0[q] * sc; oa1[q] = o1[q] * sc; o0[q] = 0.f; o1[q] = 0.f; }
  }
  __syncthreads();
  LAS float* scr = pslcw;
  {
    const int q = tid >> 3, jj = tid & 7;
    float tot[8];
#pragma unroll
    for (int k = 0; k < 8; ++k) {
      const int j = jj + 8 * k;
      float v = 0.f;
#pragma unroll
      for (int w4 = 0; w4 < 4; ++w4) v += pslcw[(w4 * 32 + q) * 65 + j] * invl[w4 * 32 + q];
      const bool forced = (j == 0) || (j == cur) || (j == cur - 1);
      tot[k] = forced ? INFINITY : (j <= cur ? v : -INFINITY);
    }
    __syncthreads();
#pragma unroll
    for (int k = 0; k < 8; ++k) scr[q * 65 + jj + 8 * k] = tot[k];
    if (tid < 64) msk[tid] = 0u;
    __syncthreads();
    unsigned lo = 0u, hi = 0u;
#pragma unroll
    for (int k = 0; k < 8; ++k) {
      const int j = jj + 8 * k; const float v = tot[k];
      int rank = 0;
      for (int c = 0; c < 64; ++c) { const float sv = scr[q * 65 + c]; rank += (sv > v) || (sv == v && c < j); }
      if (rank < 16 && j <= cur) { if (j < 32) lo |= 1u << j; else hi |= 1u << (j - 32); }
    }
    if (lo) atomicOr((unsigned*)&msk[q * 2], lo);
    if (hi) atomicOr((unsigned*)&msk[q * 2 + 1], hi);
    __syncthreads();
  }
  const unsigned long long selm = (unsigned long long)msk[i * 2] | ((unsigned long long)msk[i * 2 + 1] << 32);
#pragma unroll
  for (int s4 = 0; s4 < 4; ++s4) qf[s4] = *(const bf16x8*)(p.QR + qoff + 16 * s4);
  const size_t kvoff = (size_t)bg * S * 64;
  l = 0.f;
  nsa_pass<1, 4>(kv, p.KSL + kvoff, p.VSL + kvoff, 0, cur, qf, p.smaxv[2] * LOG2E, si, selm, o0, o1, l, nullptr);
  l += __shfl_xor(l, 32);
  {
    const float sc = g1 / l;
#pragma unroll
    for (int q = 0; q < 16; ++q) { oa0[q] += o0[q] * sc; oa1[q] += o1[q] * sc; o0[q] = 0.f; o1[q] = 0.f; }
  }
  l = 0.f;
  const int tw_lo = s0 >= 511 ? (s0 - 511) >> 6 : 0;
  nsa_pass<2, 4>(kv, p.KW + kvoff, p.VW + kvoff, tw_lo, cur, qf, p.smaxv[3] * LOG2E, si, 0ull, o0, o1, l, nullptr);
  l += __shfl_xor(l, 32);
  {
    const float sc = g2 / l;
#pragma unroll
    for (int q = 0; q < 16; ++q) { oa0[q] += o0[q] * sc; oa1[q] += o1[q] * sc; }
  }
  bf16_t* orow = p.mixinb + (size_t)(b * S + si) * D + 512 + hq * 64 + 4 * h5;
#pragma unroll
  for (int rg = 0; rg < 4; ++rg) {
    u32x2 w0 = {pk_bf16(oa0[4 * rg], oa0[4 * rg + 1]), pk_bf16(oa0[4 * rg + 2], oa0[4 * rg + 3])};
    u32x2 w1 = {pk_bf16(oa1[4 * rg], oa1[4 * rg + 1]), pk_bf16(oa1[4 * rg + 2], oa1[4 * rg + 3])};
    *(u32x2*)(orow + 8 * rg) = w0;
    *(u32x2*)(orow + 32 + 8 * rg) = w1;
  }
}
__device__ __forceinline__ void cvt_queue_item(const P& p, int ci) {
  f32x4 ra[16], rb[16];
  const CvtQ d0 = cvt_expert_desc(p, ci * 4), d1 = cvt_expert_desc(p, ci * 4 + 1), d2 = cvt_expert_desc(p, ci * 4 + 2), d3 = cvt_expert_desc(p, ci * 4 + 3);
  cvtq_load(d0, ra); cvtq_load(d1, rb);
  cvtq_store(d0, ra); cvtq_load(d2, ra);
  cvtq_store(d1, rb); cvtq_load(d3, rb);
  cvtq_store(d2, ra); cvtq_store(d3, rb);
}
__device__ __forceinline__ void ph_attn_a(const P& p, char* smem) {
  for (;;) {
    const int q = next_item(p.ctr + 0, smem);
    if (q >= 16 + 2560) break;
    if (q < 16) { compress_item(p, smem, q); continue; }
    const int j = q - 16, g = j / 5, r = j - g * 5;
    if (r == 0 || r == 3) dilated_item(p, smem, g * 2 + (r == 3)); else cvt_queue_item(p, g * 3 + (r == 1 ? 0 : (r == 2 ? 1 : 2)));
  }
}
__device__ __forceinline__ void ph_attn_b(const P& p, char* smem) {
  for (;;) {
    const int q = next_item(p.ctr + 1, smem);
    if (q >= 2560) break;
    const int g = q / 5, r = q - g * 5;
    if (r == 0 || r == 3) nsa_item(p, smem, g * 2 + (r == 3)); else cvt_queue_item(p, 1536 + g * 3 + (r == 1 ? 0 : (r == 2 ? 1 : 2)));
  }
}

__device__ __forceinline__ void ph_route(const P& p, char* smem) {
  const int lane = threadIdx.x & 63, wv = threadIdx.x >> 6;
  int* hist = (int*)smem;
  __syncthreads();
  hist[threadIdx.x] = 0;
  __syncthreads();
  const int tpb = T / gridDim.x, t0 = blockIdx.x * tpb;
  float bias[4];
#pragma unroll
  for (int i = 0; i < 4; ++i) bias[i] = p.r_bias[lane + 64 * i];
  for (int tt = wv; tt < tpb; tt += 4) {
    const int t = t0 + tt;
    float aff[4], bv[4], ta[4], tb[4];
#pragma unroll
    for (int i = 0; i < 4; ++i) { { const size_t li = (size_t)t * NE + lane + 64 * i; aff[i] = sigmoidf((p.logits[li] + p.logits[li + (size_t)T * NE]) + p.logits[li + (size_t)2 * T * NE]); } bv[i] = aff[i] + bias[i]; ta[i] = bv[i]; tb[i] = -INFINITY; }
#pragma unroll
    for (int o = 16; o; o >>= 1)
#pragma unroll
      for (int i = 0; i < 4; ++i) {
        const float a2 = __shfl_xor(ta[i], o), b2 = __shfl_xor(tb[i], o);
        const float na = fmaxf(ta[i], a2), nb = fmaxf(fminf(ta[i], a2), fmaxf(tb[i], b2));
        ta[i] = na; tb[i] = nb;
      }
    float gs[8];
#pragma unroll
    for (int i = 0; i < 4; ++i) { const float s2 = ta[i] + tb[i]; gs[2 * i] = __shfl(s2, 0); gs[2 * i + 1] = __shfl(s2, 32); }
    unsigned gmask = 0;
#pragma unroll
    for (int g = 0; g < 8; ++g) {
      int rank = 0;
#pragma unroll
      for (int i = 0; i < 8; ++i) rank += (gs[i] > gs[g]) || (gs[i] == gs[g] && i < g);
      if (rank < 4) gmask |= 1u << g;
    }
#pragma unroll
    for (int i = 0; i < 4; ++i) if (!((gmask >> (2 * i + (lane >> 5))) & 1u)) bv[i] = -INFINITY;
    unsigned key[4];
#pragma unroll
    for (int i = 0; i < 4; ++i) { const unsigned u = __float_as_uint(bv[i]); key[i] = (u & 0x80000000u) ? ~u : (u | 0x80000000u); }
    unsigned thr = 0u;
#pragma unroll 1
    for (int bit = 31; bit >= 0; --bit) {
      const unsigned trial = thr | (1u << bit);
      int c = 0;
#pragma unroll
      for (int i = 0; i < 4; ++i) c += __builtin_popcountll(__ballot(key[i] >= trial));
      if (c >= 8) thr = trial;
    }
    int ngt = 0;
#pragma unroll
    for (int i = 0; i < 4; ++i) ngt += __builtin_popcountll(__ballot(key[i] > thr));
    const int need = 8 - ngt;
    const unsigned long long ltmask = (1ull << lane) - 1ull;
    int eqbefore = 0, selbefore = 0;
    bool sel[4]; int slot[4];
#pragma unroll
    for (int i = 0; i < 4; ++i) {
      const unsigned long long eqm = __ballot(key[i] == thr);
      const bool s = key[i] > thr || (key[i] == thr && eqbefore + __builtin_popcountll(eqm & ltmask) < need);
      eqbefore += __builtin_popcountll(eqm);
      const unsigned long long sm = __ballot(s);
      sel[i] = s; slot[i] = selbefore + __builtin_popcountll(sm & ltmask);
      selbefore += __builtin_popcountll(sm);
    }
    float part = 0.f;
#pragma unroll
    for (int i = 0; i < 4; ++i) part += sel[i] ? aff[i] : 0.f;
    const float ssum = wave_sum(part);
#pragma unroll
    for (int i = 0; i < 4; ++i)
      if (sel[i]) {
        const int e = lane + 64 * i;
        p.eidx[t * 8 + slot[i]] = e;
        p.gates[t * 8 + slot[i]] = aff[i] / ssum * 2.5f;
        p.pos[t * 8 + slot[i]] = atomicAdd(&hist[e], 1);
      }
  }
  __syncthreads();
  p.bhist[(size_t)blockIdx.x * NE + threadIdx.x] = hist[threadIdx.x];
}
__device__ __forceinline__ void ph_fill(const P& p, char* smem) {
  int* soff = (int*)smem;
  int* wsum = soff + 260;
  int* sbase = soff + 272;
  const int tid = threadIdx.x, lane = tid & 63, wv = tid >> 6;
  __syncthreads();
  int c = 0, before = 0;
  for (int bb = 0; bb < (int)gridDim.x; ++bb) { const int v = p.bhist[(size_t)bb * NE + tid]; c += v; before += (bb < (int)blockIdx.x) ? v : 0; }
  int incl = c;
#pragma unroll
  for (int o = 1; o < 64; o <<= 1) { const int v = __shfl_up(incl, o); if (lane >= o) incl += v; }
  if (lane == 63) wsum[wv] = incl;
  __syncthreads();
  int base = 0;
  for (int i = 0; i < wv; ++i) base += wsum[i];
  soff[tid] = base + incl - c;
  sbase[tid] = base + incl - c + before;
  if (tid == 255) soff[256] = base + incl;
  __syncthreads();
  if (blockIdx.x == 0) {
    p.off[tid] = soff[tid]; p.cnt[tid] = c;
    if (tid == 255) p.off[256] = soff[256];
  }
  if (blockIdx.x == 1) {
    const int x = tid >> 5, i = tid & 31, e = x + 8 * i;
    const int tl = (soff[e + 1] - soff[e] + 255) >> 8;
    int inc2 = tl;
#pragma unroll
    for (int o = 1; o < 32; o <<= 1) { const int v = __shfl_up(inc2, o, 32); if (i >= o) inc2 += v; }
    p.tstart[x * 33 + i] = inc2 - tl;
    if (i == 31) p.tstart[x * 33 + 32] = inc2;
  }
  const int tpb = T / gridDim.x, a0 = blockIdx.x * tpb * 8;
  for (int a = a0 + tid; a < a0 + tpb * 8; a += 256) p.sorted[sbase[p.eidx[a]] + p.pos[a]] = a;
}

template <int NTL, class F>
__device__ __forceinline__ void moe_grid(const P& p, F body) {
  const int xcd = blockIdx.x & 7, lb = blockIdx.x >> 3, nlb = gridDim.x >> 3;
  const int* ts = p.tstart + xcd * 33;
  const int total = ts[32] * NTL;
  int i = 0;
  for (int j = lb; j < total; j += nlb) {
    while (ts[i + 1] * NTL <= j) ++i;
    const int tiles = ts[i + 1] - ts[i], rem = j - ts[i] * NTL;
    body(xcd + 8 * i, rem / tiles, rem % tiles);
  }
}
__device__ __forceinline__ const unsigned char* gu_rowq(const unsigned char* Wg, const unsigned char* Wu, int f0, int n) {
  const int wn = n >> 6, wi = n & 63;
  return (wi >= 32 ? Wu : Wg) + (size_t)(f0 + wn * 32 + (wi & 31)) * D;
}
__device__ __forceinline__ void ph_moe_gu(const P& p, char* smem) {
  moe_grid<4>(p, [&](int e, int ntile, int mtile) {
    const int cnt = p.cnt[e] - mtile * 256; const int* srt = p.sorted + p.off[e] + mtile * 256;
    const unsigned char* A = p.h2q; const unsigned char* Wg = p.Wq_g + (size_t)e * FF * D; const unsigned char* Wu = p.Wq_u + (size_t)e * FF * D; unsigned char* H = p.Hq;
    const float* gates = p.gates; const unsigned char* Z = (const unsigned char*)p.zrow;
    gemm2q(smem, D, [=](int r) { return r < cnt ? A + (size_t)(srt[r] >> 3) * D : Z; }, [=](int n) { return gu_rowq(Wg, Wu, ntile * 64, n); },
           [=](const f32x4 (&acc)[8][4], int r0, int c0, int) {
             const int wn = c0 >> 6, l4 = (c0 & 63) >> 2;
#pragma unroll
             for (int mt = 0; mt < 8; ++mt) {
               const int r = r0 + mt * 16; const bool ok = r < cnt; const int a = ok ? srt[r] : 0;
               const float sc = ok ? gates[a] * (HQ_SCALE / (WQ_SCALE * WQ_SCALE)) : 0.f;
               unsigned d[2];
#pragma unroll
               for (int q = 0; q < 2; ++q) {
                 const f32x4 g = acc[mt][q], u = acc[mt][q + 2];
                 float h[4];
#pragma unroll
                 for (int i = 0; i < 4; ++i) h[i] = clamp_e4m3(silu(g[i] * (1.f / WQ_SCALE)) * u[i] * (sc * WQ_SCALE));
                 d[q] = pk4_fp8(h[0], h[1], h[2], h[3]);
               }
               const bool b0 = l4 & 1;
               const unsigned send = b0 ? d[0] : d[1], recv = __shfl_xor(send, 16);
               u32x2 w = b0 ? (u32x2){recv, d[1]} : (u32x2){d[0], recv};
               if (ok) *(u32x2*)(H + (size_t)a * FF + ntile * 64 + wn * 32 + (b0 ? 16 + 4 * (l4 - 1) : 4 * l4)) = w;
             }
           });
  });
}
__device__ __forceinline__ void ph_moe_d(const P& p, char* smem) {
  moe_grid<4>(p, [&](int e, int ntp, int mtile) {
    const int cnt = p.cnt[e] - mtile * 256; const int* srt = p.sorted + p.off[e] + mtile * 256;
    const unsigned char* A = p.Hq; const unsigned char* W = p.Wq_d + (size_t)e * D * FF + (size_t)ntp * 256 * FF; unsigned char* Yq = p.Yq; const unsigned char* Z = (const unsigned char*)p.zrow;
    const int tid_ = otid(), lrow = ((tid_ >> 7) & 1) * 128 + (tid_ & 15);
    LAS int* ridt = (LAS int*)((LAS char*)smem + 3 * G2_STAGE);
    __syncthreads();
    ridt[tid_] = tid_ < cnt ? srt[tid_] : -1;
    gemm2q<2>(smem, FF, [=](int r) { return r < cnt ? A + (size_t)srt[r] * FF : Z; }, [=](int n) { return W + (size_t)n * FF; },
           [=](const f32x4 (&acc)[8][4], int r0, int c0, int rp) {
             const int wn64 = c0 & ~63, l4 = (c0 & 63) >> 2;
             const float s = YQ_SCALE / (WQ_SCALE * HQ_SCALE);
#pragma unroll
             for (int mt = 0; mt < 8; ++mt) {
               const int rd = ridt[lrow + mt * 16]; const bool ok = rd >= 0;
               unsigned dq[4];
#pragma unroll
               for (int nt = 0; nt < 4; ++nt) { const f32x4 a = acc[mt][nt] * s; dq[nt] = pk4_fp8(clamp_e4m3(a[0]), clamp_e4m3(a[1]), clamp_e4m3(a[2]), clamp_e4m3(a[3])); }
               { u32x2v r = __builtin_amdgcn_permlane16_swap(dq[0], dq[1], false, false); dq[0] = r.x; dq[1] = r.y; r = __builtin_amdgcn_permlane16_swap(dq[2], dq[3], false, false); dq[2] = r.x; dq[3] = r.y;
                 r = __builtin_amdgcn_permlane32_swap(dq[0], dq[2], false, false); dq[0] = r.x; dq[2] = r.y; r = __builtin_amdgcn_permlane32_swap(dq[1], dq[3], false, false); dq[1] = r.x; dq[3] = r.y; }
               if (ok) *(u32x4*)(Yq + (size_t)rd * D + (ntp * 2 + rp) * 128 + wn64 + 16 * l4) = (u32x4){dq[0], dq[1], dq[2], dq[3]};
               asm volatile("" ::: "memory");
             }
           }, (size_t)128 * FF);
  });
}
__device__ __forceinline__ void ph_combine(const P& p) {
  WLOOP(w, T / 4) {
    const int tid_ = otid(), t = w * 4 + (tid_ >> 6), c = (tid_ & 63) * 16, b = t / S;
    float acc[16];
#pragma unroll
    for (int i = 0; i < 16; ++i) acc[i] = 0.f;
#pragma unroll
    for (int k = 0; k < 8; ++k) {
      const u32x4 v = *(const u32x4*)(p.Yq + ((size_t)t * 8 + k) * D + c);
#pragma unroll
      for (int i = 0; i < 4; ++i) {
        const f32x2 lo = __builtin_amdgcn_cvt_pk_f32_fp8((int)v[i], false), hi = __builtin_amdgcn_cvt_pk_f32_fp8((int)v[i], true);
        acc[4 * i] += lo[0]; acc[4 * i + 1] += lo[1]; acc[4 * i + 2] += hi[0]; acc[4 * i + 3] += hi[1];
      }
    }
    const bf16_t* ys = p.Ys + (size_t)t * D + c; const float* gt = p.mod + b * 6 * D + 5 * D + c; const bf16_t* x1 = (const bf16_t*)p.x1 + (size_t)t * D + c; float* o = p.out + (size_t)t * D + c;
#pragma unroll
    for (int h = 0; h < 4; ++h) {
      const u32x2 sv = *(const u32x2*)(ys + 4 * h);
      const float s0 = __uint_as_float(sv.x << 16), s1 = __uint_as_float(sv.x & 0xffff0000u), s2 = __uint_as_float(sv.y << 16), s3 = __uint_as_float(sv.y & 0xffff0000u);
      const u32x2 xq = *(const u32x2*)(x1 + 4 * h);
      const f32x4 xv = {__uint_as_float(xq.x << 16), __uint_as_float(xq.x & 0xffff0000u), __uint_as_float(xq.y << 16), __uint_as_float(xq.y & 0xffff0000u)}, gv = *(const f32x4*)(gt + 4 * h);
      f32x4 r = {xv[0] + gv[0] * (s0 + acc[4 * h] * (1.f / YQ_SCALE)), xv[1] + gv[1] * (s1 + acc[4 * h + 1] * (1.f / YQ_SCALE)),
                 xv[2] + gv[2] * (s2 + acc[4 * h + 2] * (1.f / YQ_SCALE)), xv[3] + gv[3] * (s3 + acc[4 * h + 3] * (1.f / YQ_SCALE))};
      *(f32x4*)(o + 4 * h) = r;
    }
  }
}


#define XB_TMO      128
#define XB_XCNT(j)  (256  + 64 * (j))
#define XB_XSUB(j)  (1280 + 64 * (j))
#define XB_XGEN(j)  (2304 + 64 * (j))
#define XB_TOP      3328
#define XB_TOPGEN   3392
#define XCD_BAR_WORDS 3456
#define XB_SPIN_CAP (1u << 22)
__device__ __forceinline__ unsigned xb_ld(unsigned* p)              { return __hip_atomic_load(p, __ATOMIC_RELAXED, __HIP_MEMORY_SCOPE_AGENT); }
__device__ __forceinline__ unsigned xb_add(unsigned* p, unsigned v) { return __hip_atomic_fetch_add(p, v, __ATOMIC_RELAXED, __HIP_MEMORY_SCOPE_AGENT); }
__device__ __forceinline__ unsigned xb_xcc_id() { return (unsigned)__builtin_amdgcn_s_getreg((3 << 11) | 20) & 0xFu; }
#define XB_SPIN(cond, bar) do { unsigned _sp = 0; while (cond) { __builtin_amdgcn_s_sleep(1); \
    if ((++_sp & 255u) == 0u) { if (xb_ld(&(bar)[XB_TMO])) break; if (_sp > XB_SPIN_CAP) { atomicAdd(&(bar)[XB_TMO], 1u); break; } } } } while (0)
struct XcdBarrier { unsigned* bar; unsigned x; volatile LAS unsigned* st; };
__device__ __forceinline__ XcdBarrier xcd_barrier_post(unsigned* bar, volatile LAS unsigned* st) {
  XcdBarrier b; b.bar = bar; b.x = xb_xcc_id(); b.st = st;
  if (threadIdx.x == 0) (void)xb_add(&bar[XB_XCNT(b.x)], 1u);
  return b;
}
__device__ __forceinline__ void xcd_barrier_complete(unsigned* bar, unsigned x, unsigned& nloc, unsigned& nx) {
  const unsigned G = gridDim.x * gridDim.y * gridDim.z;
  unsigned sum, cnt, mine, sp = 0u;
  for (;;) {
    sum = 0u; cnt = 0u; mine = 0u;
#pragma unroll
    for (unsigned j = 0; j < 16; ++j) { const unsigned c = xb_ld(&bar[XB_XCNT(j)]); sum += c; cnt += (c > 0u) ? 1u : 0u; mine = (j == x) ? c : mine; }
    if (sum == G) break;
    __builtin_amdgcn_s_sleep(1);
    if ((++sp & 255u) == 0u) { if (xb_ld(&bar[XB_TMO])) break; if (sp > XB_SPIN_CAP) { atomicAdd(&bar[XB_TMO], 1u); break; } }
  }
  nloc = mine > 0u ? mine : 1u; nx = cnt > 0u ? cnt : 1u;
}
__device__ __forceinline__ void xcd_barrier(const XcdBarrier& b) {
  asm volatile("s_waitcnt vmcnt(0)" ::: "memory");
  __syncthreads();
  if (threadIdx.x == 0) {
    unsigned* bar = b.bar;
    __builtin_amdgcn_s_waitcnt(0);
    unsigned nloc = b.st[0], nx = b.st[1];
    if (nloc == 0u) { xcd_barrier_complete(bar, b.x, nloc, nx); b.st[0] = nloc; b.st[1] = nx; }
    const unsigned old = xb_add(&bar[XB_XSUB(b.x)], 1u);
    const unsigned gen = old / nloc;
    if (old + 1u == (gen + 1u) * nloc) {
      __builtin_amdgcn_fence(__ATOMIC_RELEASE, "agent");
      asm volatile("s_waitcnt vmcnt(0)" ::: "memory");
      const unsigned og = xb_add(&bar[XB_TOP], 1u);
      const unsigned tg = og / nx;
      if (og + 1u == (tg + 1u) * nx) xb_add(&bar[XB_TOPGEN], 1u);
      else XB_SPIN(xb_ld(&bar[XB_TOPGEN]) == tg, bar);
      __builtin_amdgcn_fence(__ATOMIC_ACQUIRE, "agent");
      xb_add(&bar[XB_XGEN(b.x)], 1u);
      asm volatile("s_waitcnt vmcnt(0)" ::: "memory");
    } else {
      XB_SPIN(xb_ld(&bar[XB_XGEN(b.x)]) == gen, bar);
      __builtin_amdgcn_fence(__ATOMIC_ACQUIRE, "agent");
      asm volatile("s_waitcnt vmcnt(0)" ::: "memory");
    }
  }
  __syncthreads();
}

__global__ void __launch_bounds__(256, 2) mega(P p) {
  extern __shared__ __attribute__((aligned(16))) char smem[];
  {
    volatile LAS unsigned* st0 = (volatile LAS unsigned*)((LAS char*)smem + SMEM_BYTES - 32);
    if (threadIdx.x == 0) { st0[0] = 0u; st0[1] = 0u; }
    __syncthreads();
  }
  const XcdBarrier xb = xcd_barrier_post(p.bar, (volatile LAS unsigned*)((LAS char*)smem + SMEM_BYTES - 32));
  ph_ada(p, smem); ph_rope_tab(p);
  { int ib = 0;
    for (int it = (int)blockIdx.x; it < 8 * 23; it += gridDim.x) cvtq_tile(p.w_in, INC, p.Wq_in, D, (it & 7) * 128, (it >> 3) * 128, INC);
    ib = (8 * 23) % gridDim.x; cvt_matrix<false>(p.w_out, p.Wt_out, D, D, ib);
    cvt_matrix<false>(p.w_router, p.Wt_rth, D, NE, ib); cvt_matrix<true>(p.w_router, p.Wt_rtl, D, NE, ib);
    cvt_matrix<false>(p.w1_k, p.Wt_c1k, 2048, 128, ib); cvt_matrix<false>(p.w1_v, p.Wt_c1v, 2048, 128, ib);
    cvt_matrix<false>(p.ws_gate, p.Wt_sg, D, FF, ib); cvt_matrix<false>(p.ws_up, p.Wt_su, D, FF, ib); cvt_matrix<false>(p.ws_down, p.Wt_sd, FF, D, ib); }
  if (blockIdx.x == gridDim.x - 4) { for (int i = threadIdx.x; i < 2048; i += 256) p.zrow[i] = 0; }
  if (blockIdx.x == gridDim.x - 1) {
    const int which = threadIdx.x >> 7, n = threadIdx.x & 127;
    const float* pe = which ? p.pe_v : p.pe_k; const float* w1 = which ? p.w1_v : p.w1_k;
    float a = 0.f;
    for (int k = 0; k < 2048; ++k) a += pe[k] * w1[(size_t)k * 128 + n];
    p.b1c[threadIdx.x] = a;
  }
  if (blockIdx.x == gridDim.x - 2) {
    for (int i = threadIdx.x; i < 8 * 64; i += 256) { p.kcb[((size_t)(i >> 6) * 256 + 255) * 64 + (i & 63)] = 0; p.vcb[((size_t)(i >> 6) * 256 + 255) * 64 + (i & 63)] = 0; }
  }
  if (blockIdx.x == gridDim.x - 3) {
    p.cnt[threadIdx.x] = 0;
    if (threadIdx.x < 8) p.ctr[threadIdx.x] = 0;
    if (threadIdx.x < 64) {
      const int ln = threadIdx.x;
      const float a = wave_max(fabsf(p.g_q_dil[ln])), bq = wave_max(fabsf(p.g_k_dil[ln])), c = wave_max(fabsf(p.g_q_nsa[ln]));
      const float d1 = wave_max(fabsf(p.g_k_cmp[ln])), d2 = wave_max(fabsf(p.g_k_slc[ln])), d3 = wave_max(fabsf(p.g_k_win[ln]));
      if (ln == 0) { p.smaxv[0] = 8.f * a * bq; p.smaxv[1] = 8.f * c * d1; p.smaxv[2] = 8.f * c * d2; p.smaxv[3] = 8.f * c * d3; }
    }
  }
  xcd_barrier(xb);
  ph_norm_mod<false>(p.x, p.g_mix, p.mod, 0, D, nullptr, p.h1q);
  xcd_barrier(xb);
  ph_proj(p, smem);
  xcd_barrier(xb);
  ph_attn_a(p, smem);
  xcd_barrier(xb);
  ph_attn_b(p, smem);
  xcd_barrier(xb);
  ph_outproj(p, smem);
  xcd_barrier(xb);
  if (DUP == 10) { ph_outproj_abl<0>(p, smem); xcd_barrier(xb); }
  if (DUP == 11) { ph_outproj_abl<1>(p, smem); xcd_barrier(xb); }
  if (DUP == 12) { ph_outproj_abl<2>(p, smem); xcd_barrier(xb); }
  if (DUP == 13) { ph_outproj_abl<3>(p, smem); xcd_barrier(xb); }
  ph_norm_mod<true, true>(p.x1, p.g_ffn, p.mod, 3 * D, 4 * D, p.h2s, p.h2q);
  xcd_barrier(xb);
  ph_router_shared_gu(p, smem);
  xcd_barrier(xb);
  ph_route(p, smem); ph_shared_d(p, smem);
  xcd_barrier(xb);
  ph_fill(p, smem);
  xcd_barrier(xb);
  ph_moe_gu(p, smem);
  xcd_barrier(xb);
  ph_moe_d(p, smem);
  xcd_barrier(xb);
  ph_combine(p);
}
}

extern "C" void kernel_launch(void* const* d_in, const int* in_sizes, int n_in, void* d_out, int out_size, void* d_ws, size_t ws_size,
                              hipStream_t stream) {
  P p{};
  const float** f = (const float**)d_in;
  p.x = f[0]; p.c = f[1]; p.w_ada = f[2]; p.b_ada = f[3]; p.g_mix = f[4]; p.g_ffn = f[5]; p.w_in = f[6]; p.g_q_dil = f[7]; p.g_k_dil = f[8];
  p.g_q_nsa = f[9]; p.g_k_cmp = f[10]; p.g_k_slc = f[11]; p.g_k_win = f[12]; p.pe_k = f[13]; p.w1_k = f[14]; p.w2_k = f[15]; p.pe_v = f[16];
  p.w1_v = f[17]; p.w2_v = f[18]; p.w_out = f[19]; p.w_router = f[20]; p.r_bias = f[21]; p.w_gate = f[22]; p.w_up = f[23]; p.w_down = f[24];
  p.ws_gate = f[25]; p.ws_up = f[26]; p.ws_down = f[27];
  p.out = (float*)d_out;
  char* w = (char*)d_ws; size_t o = 0;
  auto alloc = [&](size_t bytes) { void* r = w + o; o += (bytes + 255) & ~(size_t)255; return r; };
  p.mod = (float*)alloc(4 * 6 * D * 4);
  p.rope = (float*)alloc(S * 16 * 4);
  p.selmask = (unsigned long long*)alloc((size_t)T * 2 * 8);
  p.eidx = (int*)alloc(T * 8 * 4); p.gates = (float*)alloc(T * 8 * 4);
  p.cnt = (int*)alloc(NE * 4); p.off = (int*)alloc((NE + 1) * 4); p.pos = (int*)alloc(T * 8 * 4); p.sorted = (int*)alloc(T * 8 * 4);
  p.tstart = (int*)alloc(8 * 33 * 4);
  p.smaxv = (float*)alloc(64);
  p.b1c = (float*)alloc(256 * 4);
  p.ctr = (int*)alloc(64);
  p.kcb = (bf16_t*)alloc(8 * 256 * 64 * 2); p.vcb = (bf16_t*)alloc(8 * 256 * 64 * 2);
  p.GS = (float*)alloc((size_t)T * 24 * 4);
  p.QA = (bf16_t*)alloc((size_t)T * 512 * 2); p.KA = (bf16_t*)alloc((size_t)T * 512 * 2); p.VA = (bf16_t*)alloc((size_t)T * 512 * 2);
  p.QN = (bf16_t*)alloc((size_t)T * 512 * 2); p.QR = (bf16_t*)alloc((size_t)T * 512 * 2);
  p.KC = (bf16_t*)alloc((size_t)T * 128 * 2); p.VC = (bf16_t*)alloc((size_t)T * 128 * 2);
  p.KSL = (bf16_t*)alloc((size_t)T * 128 * 2); p.VSL = (bf16_t*)alloc((size_t)T * 128 * 2);
  p.KW = (bf16_t*)alloc((size_t)T * 128 * 2); p.VW = (bf16_t*)alloc((size_t)T * 128 * 2);
  p.logits = (float*)alloc((size_t)3 * T * NE * 4);
  p.x1 = (float*)alloc((size_t)T * D * 4);
  p.mixinb = (bf16_t*)alloc((size_t)T * D * 2);
  p.h1b = (bf16_t*)alloc((size_t)T * D * 2);
  p.h2s = (bf16_t*)alloc((size_t)T * 2 * D * 2);
  p.Hs = (bf16_t*)alloc((size_t)T * FF * 2);
  p.Ys = (bf16_t*)alloc((size_t)T * D * 2);
  p.bar = (unsigned*)alloc(XCD_BAR_WORDS * 4);
  p.bhist = (int*)alloc((size_t)2048 * NE * 4);
  p.Wt_c1k = (bf16_t*)alloc((size_t)128 * 2048 * 2); p.Wt_c1v = (bf16_t*)alloc((size_t)128 * 2048 * 2);
  p.zrow = (bf16_t*)alloc(2048 * 2);
  p.Wt_in = (bf16_t*)alloc((size_t)2944 * D * 2);
  p.Wt_out = (bf16_t*)alloc((size_t)D * D * 2);
  p.Wt_rth = (bf16_t*)alloc((size_t)NE * D * 2); p.Wt_rtl = (bf16_t*)alloc((size_t)NE * D * 2);
  p.Wt_sg = (bf16_t*)alloc((size_t)FF * D * 2); p.Wt_su = (bf16_t*)alloc((size_t)FF * D * 2); p.Wt_sd = (bf16_t*)alloc((size_t)D * FF * 2);
  p.Wq_g = (unsigned char*)alloc((size_t)NE * FF * D); p.Wq_u = (unsigned char*)alloc((size_t)NE * FF * D); p.Wq_d = (unsigned char*)alloc((size_t)NE * D * FF);
  p.h2q = (unsigned char*)alloc((size_t)T * D); p.h1q = (unsigned char*)alloc((size_t)T * D); p.Wq_in = (unsigned char*)alloc((size_t)2944 * D); p.Hq = (unsigned char*)alloc((size_t)T * 8 * FF);
  p.Yq = (unsigned char*)alloc((size_t)T * 8 * D);
  (void)hipMemsetAsync(p.bar, 0, XCD_BAR_WORDS * 4, stream);
  static int grid_blocks = 0;
  if (!grid_blocks) {
    int dev = 0, cus = 0, per_cu = 0;
    (void)hipGetDevice(&dev);
    (void)hipDeviceGetAttribute(&cus, hipDeviceAttributeMultiprocessorCount, dev);
    (void)hipOccupancyMaxActiveBlocksPerMultiprocessor(&per_cu, mega, 256, SMEM_BYTES);
    if (per_cu > 2) per_cu = 2;
    if (per_cu < 1) per_cu = 1;
    grid_blocks = cus * per_cu;
  }
  void* args[] = {&p};
  hipError_t e = hipLaunchCooperativeKernel((void*)mega, dim3(grid_blocks), dim3(256), args, SMEM_BYTES, stream);
  if (e != hipSuccess) fprintf(stderr, "cooperative launch failed: %s (grid %d)\n", hipGetErrorString(e), grid_blocks);
}
```

```cpp
#include <hip/hip_runtime.h>
#include <hip/hip_cooperative_groups.h>
#include <stdint.h>
#include <cstdio>
namespace cg = cooperative_groups;

namespace {
constexpr int D = 1024, NB = 4, S = 4096, T = NB * S, HD = 64;
constexpr int INC = 2840;
constexpr int C_QA = 0, C_KA = 512, C_VA = 1024, C_QB = 1536, C_KC = 2048, C_VC = 2176, C_KSL = 2304, C_VSL = 2432,
              C_KW = 2560, C_VW = 2688, C_GB = 2816;
constexpr int NC = 255, NE = 256, TOPK = 8, FF = 256;
constexpr float EPS = 1e-6f;
#ifndef DUP
#define DUP 0
#endif
constexpr int SMEM_BYTES = 74 * 1024;
typedef unsigned short bf16_t;
typedef short bf16x8 __attribute__((ext_vector_type(8)));
typedef float f32x4 __attribute__((ext_vector_type(4)));
typedef unsigned u32x4 __attribute__((ext_vector_type(4)));
typedef unsigned u32x2 __attribute__((ext_vector_type(2)));
typedef __bf16 bf2_t __attribute__((ext_vector_type(2)));
typedef float f32x2 __attribute__((ext_vector_type(2)));
typedef float f32x16 __attribute__((ext_vector_type(16)));
typedef short s16x4 __attribute__((ext_vector_type(4)));
#define LAS __attribute__((address_space(3)))
#define MFMA32(a, b, c) __builtin_amdgcn_mfma_f32_32x32x16_bf16((a), (b), (c), 0, 0, 0)
constexpr float LOG2E = 1.4426950408889634f;

struct P {
  const float *x, *c, *w_ada, *b_ada, *g_mix, *g_ffn, *w_in, *g_q_dil, *g_k_dil, *g_q_nsa, *g_k_cmp, *g_k_slc, *g_k_win;
  const float *pe_k, *w1_k, *w2_k, *pe_v, *w1_v, *w2_v, *w_out, *w_router, *r_bias, *w_gate, *w_up, *w_down, *ws_gate, *ws_up, *ws_down;
  float* out;
  float *mod, *rope, *h1, *proj, *qrope, *kcmp, *vcmp, *ocmp, *oslc, *owin, *mixin, *x1, *h2, *logits, *gates, *hs_g, *hs, *shared, *Hbuf;
  unsigned long long* selmask;
  int *eidx, *cnt, *off, *pos, *sorted, *tstart;
  bf16_t *h1b, *h2s, *mixinb, *Hb, *Hs, *Ybuf, *Ys;
  bf16_t *QA, *KA, *VA, *QN, *QR, *KC, *VC, *KSL, *VSL, *KW, *VW;
  float *GS, *smaxv, *b1c;
  bf16_t *kcb, *vcb;
  int* ctr;
  int* bhist;
  unsigned char *h2q, *Hq, *Wq_g, *Wq_u, *Wq_d, *h1q, *Wq_in, *Yq;
  unsigned* bar;
  bf16_t *zrow, *Wt_in, *Wt_out, *Wt_rth, *Wt_rtl, *Wt_sg, *Wt_su, *Wt_sd, *Wt_c1k, *Wt_c1v, *Wt_g, *Wt_u, *Wt_d;
};

#define WLOOP(w, n) for (int w = blockIdx.x; w < (n); w += gridDim.x)

__device__ __forceinline__ int otid() { int t = threadIdx.x; asm volatile("" : "+v"(t)); return t; }
__device__ __forceinline__ unsigned pk_bf16(float lo, float hi) {
  f32x2 v = {lo, hi};
  bf2_t r = __builtin_convertvector(v, bf2_t);
  return __builtin_bit_cast(unsigned, r);
}
__device__ __forceinline__ float clamp_e4m3(float v) { return __builtin_amdgcn_fmed3f(v, -448.f, 448.f); }
__device__ __forceinline__ unsigned pk4_fp8(float a, float b, float c, float d) {
  int t = __builtin_amdgcn_cvt_pk_fp8_f32(a, b, 0, false);
  t = __builtin_amdgcn_cvt_pk_fp8_f32(c, d, t, true);
  return (unsigned)t;
}
constexpr float WQ_SCALE = 64.f, HQ_SCALE = 8.f, YQ_SCALE = 16.f;
__device__ __forceinline__ float bf16_to_f32(unsigned short b) { return __uint_as_float((unsigned)b << 16); }
__device__ __forceinline__ float bf16_round(float v) { return __uint_as_float(pk_bf16(v, 0.f) << 16); }
__device__ __forceinline__ float silu(float v) { return v / (1.f + expf(-v)); }
__device__ __forceinline__ float sigmoidf(float v) { return 1.f / (1.f + expf(-v)); }
__device__ __forceinline__ float wave_sum(float v) { for (int o = 32; o; o >>= 1) v += __shfl_xor(v, o); return v; }
__device__ __forceinline__ float wave_max(float v) { for (int o = 32; o; o >>= 1) v = fmaxf(v, __shfl_xor(v, o)); return v; }

__device__ __forceinline__ void ph_ada(const P& p, char* smem) {
  float* sc = (float*)smem;
  f32x4* red = (f32x4*)(smem + 16384);
  bool loaded = false;
  WLOOP(w, 6 * D / 32) {
    const int tid = threadIdx.x, kg = tid >> 3, cl = tid & 7, j0 = w * 32 + cl * 4;
    __syncthreads();
    if (!loaded) { for (int i = tid; i < 4 * D; i += 256) sc[i] = silu(p.c[i]); loaded = true; __syncthreads(); }
    f32x4 acc[4];
#pragma unroll
    for (int b = 0; b < 4; ++b) acc[b] = (f32x4){0.f, 0.f, 0.f, 0.f};
#pragma unroll 8
    for (int it = 0; it < 32; ++it) {
      const int k = kg + 32 * it;
      const f32x4 wv = *(const f32x4*)(p.w_ada + (size_t)k * 6 * D + j0);
#pragma unroll
      for (int b = 0; b < 4; ++b) acc[b] += wv * sc[b * D + k];
    }
#pragma unroll
    for (int b = 0; b < 4; ++b) red[(kg * 8 + cl) * 4 + b] = acc[b];
    __syncthreads();
    if (tid < 128) {
      const int b = tid >> 5, c = tid & 31;
      float s = p.b_ada[w * 32 + c];
      for (int g = 0; g < 32; ++g) s += ((const float*)&red[(g * 8 + (c >> 2)) * 4 + b])[c & 3];
      p.mod[b * 6 * D + w * 32 + c] = s;
    }
  }
}
__device__ __forceinline__ void ph_rope_tab(const P& p) {
  WLOOP(w, S * 8 / 256) {
    int i = w * 256 + threadIdx.x;
    int pos = i >> 3, f = i & 7;
    double ang = (double)pos * pow(500000.0, -(double)f / 8.0);
    p.rope[i * 2] = (float)cos(ang);
    p.rope[i * 2 + 1] = (float)sin(ang);
  }
}
template <bool SPLIT, bool INBF = false>
__device__ __forceinline__ void ph_norm_mod(const float* in, const float* g, const float* mod, int shift_off, int scale_off, bf16_t* out, unsigned char* outq = nullptr) {
  const int lane = threadIdx.x & 63, wv = threadIdx.x >> 6;
  WLOOP(w, T / 4) {
    const int t = w * 4 + wv, b = t / S;
    f32x4 v[4];
    float ss = 0.f;
#pragma unroll
    for (int i = 0; i < 4; ++i) {
      if (INBF) { const u32x2 q = *(const u32x2*)((const bf16_t*)in + (size_t)t * D + i * 256 + lane * 4); v[i] = (f32x4){__uint_as_float(q.x << 16), __uint_as_float(q.x & 0xffff0000u), __uint_as_float(q.y << 16), __uint_as_float(q.y & 0xffff0000u)}; }
      else v[i] = *(const f32x4*)(in + (size_t)t * D + i * 256 + lane * 4);
      ss += v[i][0] * v[i][0] + v[i][1] * v[i][1] + v[i][2] * v[i][2] + v[i][3] * v[i][3]; }
    ss = wave_sum(ss);
    const float r = rsqrtf(ss * (1.f / D) + EPS);
    const int ld = SPLIT ? 2 * D : D;
#pragma unroll
    for (int i = 0; i < 4; ++i) {
      const int d = i * 256 + lane * 4;
      const f32x4 gg = *(const f32x4*)(g + d), sc = *(const f32x4*)(mod + b * 6 * D + scale_off + d), sh = *(const f32x4*)(mod + b * 6 * D + shift_off + d);
      const f32x4 o = v[i] * r * gg * (sc + 1.f) + sh;
      u32x2 hi = {pk_bf16(o[0], o[1]), pk_bf16(o[2], o[3])};
      if (out) *(u32x2*)(out + (size_t)t * ld + d) = hi;
      if (!SPLIT && outq) *(unsigned*)(outq + (size_t)t * D + d) = pk4_fp8(o[0], o[1], o[2], o[3]);
      if (SPLIT) {
        *(unsigned*)(outq + (size_t)t * D + d) = pk4_fp8(o[0], o[1], o[2], o[3]);
        const float l0 = o[0] - __uint_as_float(hi.x << 16), l1 = o[1] - __uint_as_float(hi.x & 0xffff0000u);
        const float l2 = o[2] - __uint_as_float(hi.y << 16), l3 = o[3] - __uint_as_float(hi.y & 0xffff0000u);
        u32x2 lo = {pk_bf16(l0, l1), pk_bf16(l2, l3)};
        *(u32x2*)(out + (size_t)t * ld + D + d) = lo;
      }
    }
  }
}

template <bool SPLIT3, class AF, class BF, class EF>
__device__ __forceinline__ void gemm128(char* smem, int K, int ldb, AF arow, BF bcol, EF epi) {
  const int tid = otid(), lane = tid & 63, wid = tid >> 6, wm = wid >> 1, wn = wid & 1;
  const int l15 = lane & 15, l4 = lane >> 4;
  char* As = smem; char* Bs = smem + 16384;
  const int ac = tid & 7, ar0 = tid >> 3;
  const bf16_t* ap[4];
#pragma unroll
  for (int i = 0; i < 4; ++i) ap[i] = arow(ar0 + 32 * i);
  const int kg = tid >> 5, ng = tid & 31;
  const float* bp = bcol(ng * 4);
  if (bp) bp += (size_t)(kg * 8) * ldb;
  u32x4 areg[4]; f32x4 breg[8];
  const int nk1 = K / 64, nk = SPLIT3 ? 3 * nk1 : nk1;
  auto gload = [&](int kt) {
    const int seg = SPLIT3 ? kt / nk1 : 0, k0 = (SPLIT3 ? kt % nk1 : kt) * 64;
    const int aoff = (seg == 2 ? K : 0) + k0 + ac * 8;
#pragma unroll
    for (int i = 0; i < 4; ++i) areg[i] = ap[i] ? *(const u32x4*)(ap[i] + aoff) : (u32x4){0u, 0u, 0u, 0u};
#pragma unroll
    for (int i = 0; i < 8; ++i) breg[i] = bp ? *(const f32x4*)(bp + (size_t)(k0 + i) * ldb) : (f32x4){0.f, 0.f, 0.f, 0.f};
    if (SPLIT3 && seg == 1) {
#pragma unroll
      for (int i = 0; i < 8; ++i)
#pragma unroll
        for (int j = 0; j < 4; ++j) breg[i][j] = breg[i][j] - bf16_round(breg[i][j]);
    }
  };
  auto lstore = [&]() {
#pragma unroll
    for (int i = 0; i < 4; ++i) { const int r = ar0 + 32 * i; *(u32x4*)(As + r * 128 + ((ac ^ ((r >> 1) & 7)) << 4)) = areg[i]; }
#pragma unroll
    for (int j = 0; j < 4; ++j) {
      const int n = ng * 4 + j;
      u32x4 v = {pk_bf16(breg[0][j], breg[1][j]), pk_bf16(breg[2][j], breg[3][j]), pk_bf16(breg[4][j], breg[5][j]), pk_bf16(breg[6][j], breg[7][j])};
      *(u32x4*)(Bs + n * 128 + ((kg ^ ((n >> 1) & 7)) << 4)) = v;
    }
  };
  f32x4 acc[4][4];
#pragma unroll
  for (int i = 0; i < 4; ++i)
#pragma unroll
    for (int j = 0; j < 4; ++j) acc[i][j] = (f32x4){0.f, 0.f, 0.f, 0.f};
  gload(0);
  const int sw = l15 >> 1;
  for (int kt = 0; kt < nk; ++kt) {
    __syncthreads();
    lstore();
    __syncthreads();
    if (kt + 1 < nk) gload(kt + 1);
#pragma unroll
    for (int ks = 0; ks < 2; ++ks) {
      const int coff = ((ks * 4 + l4) ^ sw) << 4;
      bf16x8 af[4], bfr[4];
#pragma unroll
      for (int mt = 0; mt < 4; ++mt) af[mt] = *(const bf16x8*)(As + (wm * 64 + mt * 16 + l15) * 128 + coff);
#pragma unroll
      for (int nt = 0; nt < 4; ++nt) bfr[nt] = *(const bf16x8*)(Bs + (wn * 64 + nt * 16 + l15) * 128 + coff);
#pragma unroll
      for (int mt = 0; mt < 4; ++mt)
#pragma unroll
        for (int nt = 0; nt < 4; ++nt) acc[mt][nt] = __builtin_amdgcn_mfma_f32_16x16x32_bf16(bfr[nt], af[mt], acc[mt][nt], 0, 0, 0);
    }
  }
  epi(acc, wm * 64 + l15, wn * 64 + l4 * 4);
}

typedef unsigned u32x2v __attribute__((ext_vector_type(2)));
__device__ __forceinline__ void xpose4(unsigned (&d)[4][2], int) {
#pragma unroll
  for (int a = 0; a < 2; ++a)
#pragma unroll
    for (int h = 0; h < 2; ++h) { const u32x2v r = __builtin_amdgcn_permlane16_swap(d[2 * a][h], d[2 * a + 1][h], false, false); d[2 * a][h] = r.x; d[2 * a + 1][h] = r.y; }
#pragma unroll
  for (int j = 0; j < 2; ++j)
#pragma unroll
    for (int h = 0; h < 2; ++h) { const u32x2v r = __builtin_amdgcn_permlane32_swap(d[j][h], d[2 + j][h], false, false); d[j][h] = r.x; d[2 + j][h] = r.y; }
}
__device__ __forceinline__ void store_row64_bf16(const f32x4& a0, const f32x4& a1, const f32x4& a2, const f32x4& a3, int l4, bf16_t* rowp, bool doit) {
  unsigned d[4][2] = {{pk_bf16(a0[0], a0[1]), pk_bf16(a0[2], a0[3])}, {pk_bf16(a1[0], a1[1]), pk_bf16(a1[2], a1[3])},
                      {pk_bf16(a2[0], a2[1]), pk_bf16(a2[2], a2[3])}, {pk_bf16(a3[0], a3[1]), pk_bf16(a3[2], a3[3])}};
  xpose4(d, l4);
  if (doit) {
    *(u32x4*)(rowp + 16 * l4) = (u32x4){d[0][0], d[0][1], d[1][0], d[1][1]};
    *(u32x4*)(rowp + 16 * l4 + 8) = (u32x4){d[2][0], d[2][1], d[3][0], d[3][1]};
  }
}

template <bool LO>
__device__ __forceinline__ void cvt_kn_tile(const float* src, int ldn, bf16_t* dst, int ldk, int k0, int n0, int nmax) {
  const int tid = threadIdx.x, kg = tid & 7, ng = tid >> 3, n = n0 + ng * 4;
  if (n >= nmax) return;
  f32x4 r[8];
#pragma unroll
  for (int i = 0; i < 8; ++i) r[i] = *(const f32x4*)(src + (size_t)(k0 + kg * 8 + i) * ldn + n);
  if (LO) {
#pragma unroll
    for (int i = 0; i < 8; ++i)
#pragma unroll
      for (int j = 0; j < 4; ++j) r[i][j] = r[i][j] - bf16_round(r[i][j]);
  }
#pragma unroll
  for (int j = 0; j < 4; ++j) {
    u32x4 v = {pk_bf16(r[0][j], r[1][j]), pk_bf16(r[2][j], r[3][j]), pk_bf16(r[4][j], r[5][j]), pk_bf16(r[6][j], r[7][j])};
    *(u32x4*)(dst + (size_t)(n + j) * ldk + k0 + kg * 8) = v;
  }
}
template <bool LO>
__device__ __forceinline__ void cvt_matrix(const float* src, bf16_t* dst, int K, int N, int& item_base) {
  const int nkt = K / 64, nnt = (N + 127) / 128, total = nkt * nnt;
  for (int it = (int)blockIdx.x - item_base; it < total; it += gridDim.x) {
    if (it < 0) continue;
    cvt_kn_tile<LO>(src, N, dst, K, (it % nkt) * 64, (it / nkt) * 128, N);
  }
  item_base = (item_base + total) % gridDim.x;
}

constexpr int G2_STAGE = 24576;
template <int NSEG, int AB = 0, class AF, class BF, class EF>
__device__ __forceinline__ void gemm2(char* smem_, int K, AF arow, BF brow, EF epi, int aseg1 = 0, int bseg1 = 0, int aseg2 = 0, int bseg2 = 0) {
  LAS char* smem = (LAS char*)smem_;
  const int tid = otid(), lane = tid & 63, wv = __builtin_amdgcn_readfirstlane(tid >> 6), wm = wv >> 1, wn = wv & 1;
  const int l15 = lane & 15, l4 = lane >> 4;
  const int row_l = lane >> 2, csrc = ((lane & 3) ^ (((row_l >> 3) & 1) * 3)) * 8;
  const bf16_t* ap[4]; const bf16_t* bp[2];
#pragma unroll
  for (int j = 0; j < 4; ++j) ap[j] = arow((wv + 4 * j) * 16 + row_l) + csrc;
#pragma unroll
  for (int j = 0; j < 2; ++j) bp[j] = brow((wv + 4 * j) * 16 + row_l) + csrc;
  const int nk1 = K / 32, nk = NSEG * nk1;
  auto issue = [&](int kt) {
    LAS char* st = smem + (kt % 3) * G2_STAGE;
    int ka = kt * 32, kb = kt * 32;
    if (NSEG > 1) { const int seg = kt / nk1, kk = (kt - seg * nk1) * 32; ka = kk + (seg == 1 ? aseg1 : (seg == 2 ? aseg2 : 0)); kb = kk + (seg == 1 ? bseg1 : (seg == 2 ? bseg2 : 0)); }
#pragma unroll
    for (int j = 0; j < 4; ++j) __builtin_amdgcn_global_load_lds((const unsigned*)(ap[j] + ka), (LAS unsigned*)(st + (wv + 4 * j) * 1024), 16, 0, 0);
#pragma unroll
    for (int j = 0; j < 2; ++j) __builtin_amdgcn_global_load_lds((const unsigned*)(bp[j] + kb), (LAS unsigned*)(st + 16384 + (wv + 4 * j) * 1024), 16, 0, 0);
  };
  f32x4 acc[8][4];
#pragma unroll
  for (int i = 0; i < 8; ++i)
#pragma unroll
    for (int j = 0; j < 4; ++j) acc[i][j] = (f32x4){0.f, 0.f, 0.f, 0.f};
  const int coff = (l4 ^ (((l15 >> 3) & 1) * 3)) << 4;
  const int aoff = (wm * 128 + l15) * 64 + coff, boff = 16384 + (wn * 64 + l15) * 64 + coff;
  asm volatile("s_waitcnt lgkmcnt(0)" ::: "memory");
  __builtin_amdgcn_s_barrier();
  asm volatile("" ::: "memory");
  issue(0);
  if (nk > 1) issue(1);
  for (int kt = 0; kt < nk; ++kt) {
    if (kt + 1 < nk) asm volatile("s_waitcnt vmcnt(6)" ::: "memory"); else asm volatile("s_waitcnt vmcnt(0)" ::: "memory");
    __builtin_amdgcn_s_barrier();
    asm volatile("" ::: "memory");
    if (AB != 2 && kt + 2 < nk) issue(kt + 2);
    const LAS char* st = smem + (kt % 3) * G2_STAGE;
    bf16x8 bfr[4], af[8];
    if (AB != 3) {
#pragma unroll
    for (int nt = 0; nt < 4; ++nt) bfr[nt] = *(const LAS bf16x8*)(st + boff + nt * 1024);
#pragma unroll
    for (int mt = 0; mt < 8; ++mt) af[mt] = *(const LAS bf16x8*)(st + aoff + mt * 1024);
    }
    __builtin_amdgcn_sched_barrier(0);
    if (AB == 1) {
#pragma unroll
      for (int nt = 0; nt < 4; ++nt) asm volatile("" :: "v"(bfr[nt]));
#pragma unroll
      for (int mt = 0; mt < 8; ++mt) asm volatile("" :: "v"(af[mt]));
    }
    if (AB == 0 || AB == 2) {
    __builtin_amdgcn_s_setprio(1);
#pragma unroll
    for (int mt = 0; mt < 8; ++mt)
#pragma unroll
      for (int nt = 0; nt < 4; ++nt) acc[mt][nt] = __builtin_amdgcn_mfma_f32_16x16x32_bf16(bfr[nt], af[mt], acc[mt][nt], 0, 0, 0);
    __builtin_amdgcn_s_setprio(0);
    }
    __builtin_amdgcn_sched_barrier(0);
  }
  epi(acc, wm * 128 + l15, wn * 64 + l4 * 4);
}

template <int NREP = 1, class AF, class BF, class EF>
__device__ __forceinline__ void gemm2q(char* smem_, int K, AF arow, BF brow, EF epi, size_t bstep = 0) {
  LAS char* smem = (LAS char*)smem_;
  const int tid = otid(), lane = tid & 63, wv = __builtin_amdgcn_readfirstlane(tid >> 6), wm = wv >> 1, wn = wv & 1;
  const int l15 = lane & 15, l4 = lane >> 4;
  const int row_l = lane >> 2, csrc = ((lane & 3) ^ ((row_l >> 2) & 3)) * 16;
  const unsigned char* ap[4]; const unsigned char* bp[2];
#pragma unroll
  for (int j = 0; j < 4; ++j) ap[j] = arow((wv + 4 * j) * 16 + row_l) + csrc;
#pragma unroll
  for (int j = 0; j < 2; ++j) bp[j] = brow((wv + 4 * j) * 16 + row_l) + csrc;
  const int nk1 = K / 64, nk = nk1 * NREP;
  auto issue = [&](int kt) {
    LAS char* st = smem + (kt % 3) * G2_STAGE;
    const int rp = NREP > 1 ? kt / nk1 : 0, kk = NREP > 1 ? kt - rp * nk1 : kt;
#pragma unroll
    for (int j = 0; j < 4; ++j) __builtin_amdgcn_global_load_lds((const unsigned*)(ap[j] + kk * 64), (LAS unsigned*)(st + (wv + 4 * j) * 1024), 16, 0, 0);
#pragma unroll
    for (int j = 0; j < 2; ++j) __builtin_amdgcn_global_load_lds((const unsigned*)(bp[j] + rp * bstep + kk * 64), (LAS unsigned*)(st + 16384 + (wv + 4 * j) * 1024), 16, 0, 0);
  };
  f32x4 acc[8][4];
#pragma unroll
  for (int i = 0; i < 8; ++i)
#pragma unroll
    for (int j = 0; j < 4; ++j) acc[i][j] = (f32x4){0.f, 0.f, 0.f, 0.f};
  const int sw = (l15 >> 2) & 3, sub = (l4 & 1) * 8, ch = l4 >> 1;
  const int aoff = (wm * 128 + l15) * 64 + sub, boff = 16384 + (wn * 64 + l15) * 64 + sub;
  asm volatile("s_waitcnt lgkmcnt(0)" ::: "memory");
  __builtin_amdgcn_s_barrier();
  asm volatile("" ::: "memory");
  issue(0);
  if (nk > 1) issue(1);
  for (int kt = 0; kt < nk; ++kt) {
    if (kt + 1 < nk) asm volatile("s_waitcnt vmcnt(6)" ::: "memory"); else asm volatile("s_waitcnt vmcnt(0)" ::: "memory");
    __builtin_amdgcn_s_barrier();
    asm volatile("" ::: "memory");
    if (kt + 2 < nk) issue(kt + 2);
    const LAS char* st = smem + (kt % 3) * G2_STAGE;
#pragma unroll
    for (int ks = 0; ks < 2; ++ks) {
      const int coff = ((2 * ks + ch) ^ sw) << 4;
      long bfr[4], af[8];
#pragma unroll
      for (int nt = 0; nt < 4; ++nt) bfr[nt] = *(const LAS long*)(st + boff + nt * 1024 + coff);
#pragma unroll
      for (int mt = 0; mt < 8; ++mt) af[mt] = *(const LAS long*)(st + aoff + mt * 1024 + coff);
      __builtin_amdgcn_s_setprio(1);
#pragma unroll
      for (int mt = 0; mt < 8; ++mt)
#pragma unroll
        for (int nt = 0; nt < 4; ++nt) acc[mt][nt] = __builtin_amdgcn_mfma_f32_16x16x32_fp8_fp8(bfr[nt], af[mt], acc[mt][nt], 0, 0, 0);
      __builtin_amdgcn_s_setprio(0);
    }
    __builtin_amdgcn_sched_barrier(0);
    if (NREP > 1 && (kt + 1) % nk1 == 0 && kt + 1 < nk) {
      epi(acc, wm * 128 + l15, wn * 64 + l4 * 4, kt / nk1);
#pragma unroll
      for (int i = 0; i < 8; ++i)
#pragma unroll
        for (int j = 0; j < 4; ++j) acc[i][j] = (f32x4){0.f, 0.f, 0.f, 0.f};
    }
  }
  epi(acc, wm * 128 + l15, wn * 64 + l4 * 4, NREP - 1);
}

template <class F>
__device__ __forceinline__ void gemm2_grid(int NT, F body) {
  const int xcd = blockIdx.x & 7, lb = blockIdx.x >> 3, nlb = gridDim.x >> 3;
  for (int i = lb; i < 8 * NT; i += nlb) body(xcd * 8 + (i & 7), i >> 3);
}

template <class F>
__device__ __forceinline__ void gemm_grid(int NT, F body) {
  const int xcd = blockIdx.x & 7, lb = blockIdx.x >> 3, nlb = gridDim.x >> 3;
  for (int i = lb; i < 16 * NT; i += nlb) {
    const int g = i / (8 * NT), rem = i % (8 * NT), nt = rem >> 3, mi = rem & 7;
    body(xcd * 16 + g * 8 + mi, nt);
  }
}

template <int MT>
__device__ __forceinline__ void proj_epi(const P& p, const f32x4 (&acc)[MT][4], int row_base, int ntile, int r0, int c0, float ascale = 1.f, const float* rope_tile = nullptr) {
  const int wn = c0 >> 6, l4 = (c0 & 63) >> 2;
  const int col0 = ntile * 128 + wn * 64;
  if (col0 >= INC) return;
  if (col0 == C_GB) {
#pragma unroll
    for (int mt = 0; mt < MT; ++mt) {
      const int m = row_base + r0 + mt * 16;
      f32x4 a = acc[mt][0] * ascale, g0 = {sigmoidf(a[0]), sigmoidf(a[1]), sigmoidf(a[2]), sigmoidf(a[3])};
      *(f32x4*)(p.GS + (size_t)m * 24 + 4 * l4) = g0;
      if (l4 < 2) { a = acc[mt][1] * ascale; f32x4 g1 = {sigmoidf(a[0]), sigmoidf(a[1]), sigmoidf(a[2]), sigmoidf(a[3])}; *(f32x4*)(p.GS + (size_t)m * 24 + 16 + 4 * l4) = g1; }
    }
    return;
  }
  const float* g = nullptr; bf16_t* dst; bf16_t* dst2 = nullptr; int hh, H; float qs = 1.f; bool dorope = false;
  if (col0 < 512) { g = p.g_q_dil; dst = p.QA; hh = col0 >> 6; H = 8; qs = 0.125f; dorope = true; }
  else if (col0 < 1024) { g = p.g_k_dil; dst = p.KA; hh = (col0 - 512) >> 6; H = 8; dorope = true; }
  else if (col0 < 1536) { dst = p.VA; hh = (col0 - 1024) >> 6; H = 8; }
  else if (col0 < 2048) { g = p.g_q_nsa; dst = p.QR; dst2 = p.QN; hh = (col0 - 1536) >> 6; H = 8; qs = 0.125f; dorope = true; }
  else {
    const int idx = (col0 - 2048) >> 6, which = idx >> 1; hh = idx & 1; H = 2;
    if (which == 0) dst = p.KC; else if (which == 1) dst = p.VC;
    else if (which == 2) { dst = p.KSL; g = p.g_k_slc; dorope = true; } else if (which == 3) dst = p.VSL;
    else if (which == 4) { dst = p.KW; g = p.g_k_win; dorope = true; } else dst = p.VW;
  }
  f32x4 gv[4];
  if (g) {
#pragma unroll
    for (int nt = 0; nt < 4; ++nt) gv[nt] = *(const f32x4*)(g + nt * 16 + 4 * l4);
  }
  const int bb = row_base / S;
#pragma unroll
  for (int mt = 0; mt < MT; ++mt) {
    const int m = row_base + r0 + mt * 16, s = m - bb * S;
    f32x4 v[4];
#pragma unroll
    for (int nt = 0; nt < 4; ++nt) v[nt] = acc[mt][nt] * ascale;
    if (g) {
      float ss = 0.f;
#pragma unroll
      for (int nt = 0; nt < 4; ++nt) ss += v[nt][0] * v[nt][0] + v[nt][1] * v[nt][1] + v[nt][2] * v[nt][2] + v[nt][3] * v[nt][3];
      ss += __shfl_xor(ss, 16); ss += __shfl_xor(ss, 32);
      const float r = rsqrtf(ss * (1.f / 64.f) + EPS) * qs;
#pragma unroll
      for (int nt = 0; nt < 4; ++nt) v[nt] = v[nt] * gv[nt] * r;
    }
    f32x4 vr = v[0];
    if (dorope) {
      const float* rp = rope_tile ? rope_tile + ((size_t)(m - row_base) * 8 + 4 * (l4 & 1)) * 2 : p.rope + ((size_t)s * 8 + 4 * (l4 & 1)) * 2;
      const f32x4 ra = *(const f32x4*)rp, rb = *(const f32x4*)(rp + 4);
      const float cs[4] = {ra[0], ra[2], rb[0], rb[2]}, sn[4] = {ra[1], ra[3], rb[1], rb[3]};
#pragma unroll
      for (int i = 0; i < 4; ++i) {
        const float pt = __shfl_xor(v[0][i], 32);
        vr[i] = (l4 < 2) ? (v[0][i] * cs[i] - pt * sn[i]) : (v[0][i] * cs[i] + pt * sn[i]);
      }
    }
    bf16_t* row = dst + ((size_t)(bb * H + hh) * S + s) * 64 + 16 * l4;
    unsigned dd[4][2] = {{pk_bf16(vr[0], vr[1]), pk_bf16(vr[2], vr[3])}, {pk_bf16(v[1][0], v[1][1]), pk_bf16(v[1][2], v[1][3])},
                         {pk_bf16(v[2][0], v[2][1]), pk_bf16(v[2][2], v[2][3])}, {pk_bf16(v[3][0], v[3][1]), pk_bf16(v[3][2], v[3][3])}};
    if (dst2) {
      unsigned d2[4][2] = {{pk_bf16(v[0][0], v[0][1]), pk_bf16(v[0][2], v[0][3])}, {dd[1][0], dd[1][1]}, {dd[2][0], dd[2][1]}, {dd[3][0], dd[3][1]}};
      xpose4(d2, l4);
      bf16_t* row2 = dst2 + ((size_t)(bb * H + hh) * S + s) * 64 + 16 * l4;
      *(u32x4*)row2 = (u32x4){d2[0][0], d2[0][1], d2[1][0], d2[1][1]};
      *(u32x4*)(row2 + 8) = (u32x4){d2[2][0], d2[2][1], d2[3][0], d2[3][1]};
    }
    xpose4(dd, l4);
    *(u32x4*)row = (u32x4){dd[0][0], dd[0][1], dd[1][0], dd[1][1]};
    *(u32x4*)(row + 8) = (u32x4){dd[2][0], dd[2][1], dd[3][0], dd[3][1]};
    asm volatile("" ::: "memory");
  }
}
__device__ __forceinline__ void ph_proj(const P& p, char* smem) {
  gemm2_grid(23, [&](int mtile, int ntile) {
    const unsigned char* A = p.h1q + (size_t)mtile * 256 * D; const unsigned char* W = p.Wq_in + (size_t)ntile * 128 * D; const unsigned char* Z = (const unsigned char*)p.zrow;
    const int nvalid = INC - ntile * 128;
    gemm2q<1>(smem, D, [=](int r) { return A + (size_t)r * D; }, [=](int n) { return n < nvalid ? W + (size_t)n * D : Z; },
              [&](const f32x4 (&acc)[8][4], int r0, int c0, int) {
                float* rl = (float*)smem;
                __syncthreads();
                { const int s0 = (mtile * 256) % S; const f32x4* srcp = (const f32x4*)(p.rope + (size_t)s0 * 16);
#pragma unroll
                  for (int i = 0; i < 4; ++i) ((f32x4*)rl)[threadIdx.x + 256 * i] = srcp[threadIdx.x + 256 * i]; }
                __syncthreads();
                proj_epi<8>(p, acc, mtile * 256, ntile, r0, c0, 1.f / WQ_SCALE, rl);
              });
  });
}
__device__ __forceinline__ void ph_outproj(const P& p, char* smem) {
  gemm2_grid(8, [&](int mtile, int ntile) {
    const bf16_t* A = p.mixinb + (size_t)mtile * 256 * D; const bf16_t* W = p.Wt_out + (size_t)ntile * 128 * D; bf16_t* C = (bf16_t*)p.x1; const float* x = p.x;
    const float* gt = p.mod + ((mtile * 256) / S) * 6 * D + 2 * D;
    gemm2<1>(smem, D, [=](int r) { return A + (size_t)r * D; }, [=](int n) { return W + (size_t)n * D; },
             [=](const f32x4 (&acc)[8][4], int r0, int c0) {
               const int l4 = (c0 & 63) >> 2;
#pragma unroll
               for (int mt = 0; mt < 8; ++mt) {
                 const int m = mtile * 256 + r0 + mt * 16;
                 f32x4 o[4];
#pragma unroll
                 for (int nt = 0; nt < 4; ++nt) {
                   const int n = ntile * 128 + c0 + nt * 16;
                   o[nt] = *(const f32x4*)(x + (size_t)m * D + n) + *(const f32x4*)(gt + n) * acc[mt][nt];
                 }
                 store_row64_bf16(o[0], o[1], o[2], o[3], l4, C + (size_t)m * D + ntile * 128 + (c0 & ~63), true);
                 asm volatile("" ::: "memory");
               }
             });
  });
}
template <int AB>
__device__ __forceinline__ void ph_outproj_abl(const P& p, char* smem) {
  gemm2_grid(8, [&](int mtile, int ntile) {
    const bf16_t* A = p.mixinb + (size_t)mtile * 256 * D; const bf16_t* W = p.Wt_out + (size_t)ntile * 128 * D; float* C = (float*)p.Ybuf;
    gemm2<1, AB>(smem, D, [=](int r) { return A + (size_t)r * D; }, [=](int n) { return W + (size_t)n * D; },
             [=](const f32x4 (&acc)[8][4], int r0, int c0) {
#pragma unroll
               for (int mt = 0; mt < 8; ++mt)
#pragma unroll
                 for (int nt = 0; nt < 4; ++nt) {
                   const int m = mtile * 256 + r0 + mt * 16, n = ntile * 128 + c0 + nt * 16;
                   *(f32x4*)(C + (size_t)m * D + n) = acc[mt][nt];
                 }
             });
  });
}
__device__ __forceinline__ void router_unit(const P& p, char* smem, int mtile, int j) {
  const int seg = j >> 1, ntile = j & 1;
  const bf16_t* A = p.h2s + (size_t)mtile * 256 * 2 * D + (seg == 2 ? D : 0);
  const bf16_t* W = (seg == 1 ? p.Wt_rtl : p.Wt_rth) + (size_t)ntile * 128 * D; float* C = p.logits + (size_t)seg * T * NE;
  gemm2<1>(smem, D, [=](int r) { return A + (size_t)r * 2 * D; }, [=](int n) { return W + (size_t)n * D; },
           [=](const f32x4 (&acc)[8][4], int r0, int c0) {
#pragma unroll
             for (int mt = 0; mt < 8; ++mt)
#pragma unroll
               for (int nt = 0; nt < 4; ++nt) {
                 const int m = mtile * 256 + r0 + mt * 16, n = ntile * 128 + c0 + nt * 16;
                 *(f32x4*)(C + (size_t)m * NE + n) = acc[mt][nt];
               }
           });
}
__device__ __forceinline__ const bf16_t* gu_row(const bf16_t* Wg, const bf16_t* Wu, int f0, int n) {
  const int wn = n >> 6, wi = n & 63;
  return (wi >= 32 ? Wu : Wg) + (size_t)(f0 + wn * 32 + (wi & 31)) * D;
}
template <int MT>
__device__ __forceinline__ void gu_store(const f32x4 (&acc)[MT][4], int mt, float scale, bf16_t* dstrow  ) {
#pragma unroll
  for (int q = 0; q < 2; ++q) {
    const f32x4 g = acc[mt][q], u = acc[mt][q + 2];
    float h[4];
#pragma unroll
    for (int i = 0; i < 4; ++i) h[i] = silu(g[i]) * u[i] * scale;
    u32x2 v = {pk_bf16(h[0], h[1]), pk_bf16(h[2], h[3])};
    *(u32x2*)(dstrow + q * 16) = v;
  }
}
__device__ __forceinline__ void shared_gu_unit(const P& p, char* smem, int mtile, int ntile) {
  const bf16_t* A = p.h2s + (size_t)mtile * 256 * 2 * D; const bf16_t* Wg = p.Wt_sg; const bf16_t* Wu = p.Wt_su; bf16_t* H = p.Hs;
  gemm2<1>(smem, D, [=](int r) { return A + (size_t)r * 2 * D; }, [=](int n) { return gu_row(Wg, Wu, ntile * 64, n); },
           [=](const f32x4 (&acc)[8][4], int r0, int c0) {
             const int wn = c0 >> 6, l4x4 = c0 & 63;
#pragma unroll
             for (int mt = 0; mt < 8; ++mt) gu_store<8>(acc, mt, 1.f, H + (size_t)(mtile * 256 + r0 + mt * 16) * FF + ntile * 64 + wn * 32 + l4x4);
           });
}
__device__ __forceinline__ void ph_router_shared_gu(const P& p, char* smem) {
  gemm2_grid(10, [&](int mtile, int j) { if (j < 6) router_unit(p, smem, mtile, j); else shared_gu_unit(p, smem, mtile, j - 6); });
}
__device__ __forceinline__ void ph_shared_d(const P& p, char* smem) {
  gemm2_grid(8, [&](int mtile, int ntile) {
    const bf16_t* A = p.Hs + (size_t)mtile * 256 * FF; const bf16_t* W = p.Wt_sd + (size_t)ntile * 128 * FF; bf16_t* Y = p.Ys;
    gemm2<1>(smem, FF, [=](int r) { return A + (size_t)r * FF; }, [=](int n) { return W + (size_t)n * FF; },
             [=](const f32x4 (&acc)[8][4], int r0, int c0) {
#pragma unroll
               for (int mt = 0; mt < 8; ++mt)
                 store_row64_bf16(acc[mt][0], acc[mt][1], acc[mt][2], acc[mt][3], (c0 & 63) >> 2, Y + (size_t)(mtile * 256 + r0 + mt * 16) * D + ntile * 128 + (c0 & ~63), true);
             });
  });
}
struct CvtQ { const float* src; unsigned char* dst; int ldn, ldk; };
__device__ __forceinline__ void cvtq_load(const CvtQ& d, f32x4 (&r)[16]) {
#pragma unroll
  for (int i = 0; i < 16; ++i) r[i] = __builtin_nontemporal_load((const f32x4*)(d.src + (size_t)i * d.ldn));
}
__device__ __forceinline__ void cvtq_store(const CvtQ& d, const f32x4 (&r)[16]) {
#pragma unroll
  for (int j = 0; j < 4; ++j) {
    u32x4 v = {pk4_fp8(r[0][j] * WQ_SCALE, r[1][j] * WQ_SCALE, r[2][j] * WQ_SCALE, r[3][j] * WQ_SCALE), pk4_fp8(r[4][j] * WQ_SCALE, r[5][j] * WQ_SCALE, r[6][j] * WQ_SCALE, r[7][j] * WQ_SCALE),
               pk4_fp8(r[8][j] * WQ_SCALE, r[9][j] * WQ_SCALE, r[10][j] * WQ_SCALE, r[11][j] * WQ_SCALE), pk4_fp8(r[12][j] * WQ_SCALE, r[13][j] * WQ_SCALE, r[14][j] * WQ_SCALE, r[15][j] * WQ_SCALE)};
    *(u32x4*)(d.dst + (size_t)j * d.ldk) = v;
  }
}
__device__ __forceinline__ CvtQ cvtq_desc(const float* src, int ldn, unsigned char* dst, int ldk, int k0, int n0) {
  const int kg = threadIdx.x & 7, n = n0 + (threadIdx.x >> 3) * 4;
  CvtQ d; d.src = src + (size_t)(k0 + kg * 16) * ldn + n; d.dst = dst + (size_t)n * ldk + k0 + kg * 16; d.ldn = ldn; d.ldk = ldk; return d;
}
__device__ __forceinline__ void cvtq_tile(const float* src, int ldn, unsigned char* dst, int ldk, int k0, int n0, int nmax = 1 << 30) {
  if (n0 + (int)(threadIdx.x >> 3) * 4 >= nmax) return;
  const CvtQ d = cvtq_desc(src, ldn, dst, ldk, k0, n0); f32x4 r[16]; cvtq_load(d, r); cvtq_store(d, r);
}
__device__ __forceinline__ CvtQ cvt_expert_desc(const P& p, int it) {
  const int e = it / 48, q = it - e * 48;
  if (q < 32) { const int up = q >> 4, qq = q & 15;
    return cvtq_desc((up ? p.w_up : p.w_gate) + (size_t)e * D * FF, FF, (up ? p.Wq_u : p.Wq_g) + (size_t)e * FF * D, D, (qq & 7) * 128, (qq >> 3) * 128);
  }
  const int qq = q - 32;
  return cvtq_desc(p.w_down + (size_t)e * FF * D, D, p.Wq_d + (size_t)e * D * FF, FF, (qq & 1) * 128, (qq >> 1) * 128);
}
__device__ __forceinline__ void cvt_expert_item(const P& p, int it) { const CvtQ d = cvt_expert_desc(p, it); f32x4 r[16]; cvtq_load(d, r); cvtq_store(d, r); }
__device__ __forceinline__ void ph_cvt_experts(const P& p) { WLOOP(w, NE * 48) cvt_expert_item(p, w); }

__device__ __forceinline__ bf16x8 pack8(const f32x16& x, int s) {
  u32x4 r = {pk_bf16(x[8 * s], x[8 * s + 1]), pk_bf16(x[8 * s + 2], x[8 * s + 3]), pk_bf16(x[8 * s + 4], x[8 * s + 5]), pk_bf16(x[8 * s + 6], x[8 * s + 7])};
  return __builtin_bit_cast(bf16x8, r);
}
__device__ __forceinline__ bf16x8 tr_pair(const LAS char* a) {
  const s16x4 lo = __builtin_amdgcn_ds_read_tr16_b64_v4i16((LAS s16x4*)a);
  const s16x4 hi = __builtin_amdgcn_ds_read_tr16_b64_v4i16((LAS s16x4*)(a + 8 * 128));
  return __builtin_shufflevector(lo, hi, 0, 1, 2, 3, 4, 5, 6, 7);
}
__device__ __forceinline__ int next_item(int* ctr, char* smem) {
  volatile int* slot = (volatile int*)(smem + SMEM_BYTES - 16);
  __syncthreads();
  if (threadIdx.x == 0) *slot = atomicAdd(ctr, 1);
  __syncthreads();
  return *slot;
}

__device__ __forceinline__ void compress_item(const P& p, char* smem, int item) {
  const int which = item >> 3, mtile = item & 7;
  const bf16_t* X = which ? p.VC : p.KC; const bf16_t* W1 = which ? p.Wt_c1v : p.Wt_c1k; const bf16_t* Z = p.zrow;
  const float* b1 = p.b1c + which * 128; bf16_t* hid = (bf16_t*)smem;
  gemm2<1>(smem, 2048,
           [=](int r) { const int R = mtile * 256 + r; if (R >= 2040) return Z; const int bg = R / 255, c = R - bg * 255; return X + ((size_t)bg * S + 16 * c) * 64; },
           [=](int n) { return W1 + (size_t)n * 2048; },
           [=](const f32x4 (&acc)[8][4], int r0, int c0) {
             __syncthreads();
#pragma unroll
             for (int nt = 0; nt < 4; ++nt) {
               const f32x4 bv = *(const f32x4*)(b1 + c0 + nt * 16);
#pragma unroll
               for (int mt = 0; mt < 8; ++mt) {
                 float h[4];
#pragma unroll
                 for (int i = 0; i < 4; ++i) { const float a = acc[mt][nt][i] + bv[i]; const float u = 0.7978845608028654f * (a + 0.044715f * a * a * a); h[i] = a - a / (1.f + __expf(2.f * u)); }
                 u32x2 w = {pk_bf16(h[0], h[1]), pk_bf16(h[2], h[3])};
                 *(u32x2*)(hid + (r0 + mt * 16) * 136 + c0 + nt * 16) = w;
               }
             }
           });
  __syncthreads();
  const float* W2 = which ? p.w2_v : p.w2_k;
  const int rl = threadIdx.x >> 3, pt = threadIdx.x & 7;
#pragma unroll 1
  for (int g = 0; g < 8; ++g) {
    const int row = g * 32 + rl, R = mtile * 256 + row;
    float o[8];
#pragma unroll
    for (int d = 0; d < 8; ++d) o[d] = 0.f;
#pragma unroll 2
    for (int n8 = 0; n8 < 16; ++n8) {
      const u32x4 hv4 = *(const u32x4*)(hid + row * 136 + n8 * 8);
#pragma unroll
      for (int k = 0; k < 8; ++k) {
        const float hv = (k & 1) ? __uint_as_float(hv4[k >> 1] & 0xffff0000u) : __uint_as_float(hv4[k >> 1] << 16);
        const f32x4 w0 = *(const f32x4*)(W2 + (n8 * 8 + k) * 64 + pt * 8), w1 = *(const f32x4*)(W2 + (n8 * 8 + k) * 64 + pt * 8 + 4);
        o[0] += hv * w0[0]; o[1] += hv * w0[1]; o[2] += hv * w0[2]; o[3] += hv * w0[3];
        o[4] += hv * w1[0]; o[5] += hv * w1[1]; o[6] += hv * w1[2]; o[7] += hv * w1[3];
      }
    }
    float rs = 1.f;
    if (!which) {
      float ss = 0.f;
#pragma unroll
      for (int d = 0; d < 8; ++d) ss += o[d] * o[d];
      ss += __shfl_xor(ss, 1); ss += __shfl_xor(ss, 2); ss += __shfl_xor(ss, 4);
      rs = rsqrtf(ss * (1.f / 64.f) + EPS);
    }
    if (R < 2040) {
      const int bg = R / 255, c = R - bg * 255;
      bf16_t* orow = (which ? p.vcb : p.kcb) + ((size_t)bg * 256 + c) * 64 + pt * 8;
      float gg[8];
      if (!which) { const f32x4 g0 = *(const f32x4*)(p.g_k_cmp + pt * 8), g1 = *(const f32x4*)(p.g_k_cmp + pt * 8 + 4); gg[0] = g0[0]; gg[1] = g0[1]; gg[2] = g0[2]; gg[3] = g0[3]; gg[4] = g1[0]; gg[5] = g1[1]; gg[6] = g1[2]; gg[7] = g1[3]; }
      else {
#pragma unroll
        for (int k = 0; k < 8; ++k) gg[k] = 1.f;
      }
      u32x4 w = {pk_bf16(o[0] * rs * gg[0], o[1] * rs * gg[1]), pk_bf16(o[2] * rs * gg[2], o[3] * rs * gg[3]), pk_bf16(o[4] * rs * gg[4], o[5] * rs * gg[5]), pk_bf16(o[6] * rs * gg[6], o[7] * rs * gg[7])};
      *(u32x4*)orow = w;
    }
  }
}

template <int MODE, int NSLOT>
__device__ __forceinline__ void nsa_pass(LAS char* kv, const bf16_t* Kg, const bf16_t* Vg, int t_lo, int t_hi, const bf16x8 (&qf)[4], float shf, int si,
                                         unsigned long long selm, f32x16& o0, f32x16& o1, float& l, LAS float* psl  ,
                                         int pos0 = 0, int pstride = 1, int kkmin = 0) {
  const int tid = otid(), lane = tid & 63, wv = __builtin_amdgcn_readfirstlane(tid >> 6), i = lane & 31, h5 = lane >> 5;
  const int ksw = (i >> 1) & 7;
  const int tq = (lane & 15) >> 2, tp = lane & 3, tds = (lane >> 4) & 1, vsw = ((tq >> 1) & 1) << 2;
  const int row_l = lane >> 3, cpos = lane & 7;
  const int kc8 = (cpos ^ ((wv & 1) * 4 + (row_l >> 1))) * 8, vc8 = (cpos ^ (((row_l >> 1) & 1) << 2)) * 8;
  const bf16_t* kgl = Kg + (size_t)(wv * 8 + row_l) * 64 + kc8;
  const bf16_t* vgl = Vg + (size_t)(wv * 8 + row_l) * 64 + vc8;
  auto stage = [&](int t, int buf) {
    LAS char* Ks = kv + buf * 16384 + wv * 1024; LAS char* Vs = Ks + 8192;
#pragma unroll
    for (int q = 0; q < 2; ++q) {
      if (MODE >= 3) {
        int pos = pos0 + pstride * (64 * t + 32 * q + wv * 8 + row_l);
        pos = pos < 0 ? 0 : (pos > S - 1 ? S - 1 : pos);
        __builtin_amdgcn_global_load_lds((const unsigned*)(Kg + (size_t)pos * 64 + kc8), (LAS unsigned*)(Ks + q * 4096), 16, 0, 0);
        __builtin_amdgcn_global_load_lds((const unsigned*)(Vg + (size_t)pos * 64 + vc8), (LAS unsigned*)(Vs + q * 4096), 16, 0, 0);
      } else {
        __builtin_amdgcn_global_load_lds((const unsigned*)(kgl + (size_t)(64 * t + 32 * q) * 64), (LAS unsigned*)(Ks + q * 4096), 16, 0, 0);
        __builtin_amdgcn_global_load_lds((const unsigned*)(vgl + (size_t)(64 * t + 32 * q) * 64), (LAS unsigned*)(Vs + q * 4096), 16, 0, 0);
      }
    }
  };
  float carry = 0.f;
  if (t_lo > t_hi) return;
  float dm16[4] = {0.f, 0.f, 0.f, 0.f}; int dmaxA = 0, dmaxB = 0; const int wq = wv & 3;
  if (MODE == 3) {
#pragma unroll
    for (int rg = 0; rg < 4; ++rg) dm16[rg] = (((wv - h5 - 2 * rg) & 3) == 0) ? 3.f : 2.f;
    dmaxA = si - kkmin < 128 ? si - kkmin : 128;
  }
  if (MODE == 4) { const int lim = si - kkmin; dmaxA = lim < 128 ? lim : 128; dmaxB = lim < 512 ? lim : 512; }
  asm volatile("s_waitcnt vmcnt(0) lgkmcnt(0)" ::: "memory");
  __builtin_amdgcn_s_barrier();
  asm volatile("" ::: "memory");
#pragma unroll
  for (int k = 0; k < NSLOT - 1; ++k) if (t_lo + k <= t_hi) stage(t_lo + k, k);
  for (int t = t_lo; t <= t_hi; ++t) {
    const int buf = (t - t_lo) % NSLOT;
    const int ahead = t_hi - t;
    if (NSLOT == 4 && ahead >= 2) asm volatile("s_waitcnt vmcnt(8)" ::: "memory");
    else if (NSLOT == 4 && ahead == 1) asm volatile("s_waitcnt vmcnt(4)" ::: "memory");
    else asm volatile("s_waitcnt vmcnt(0)" ::: "memory");
    __builtin_amdgcn_s_barrier();
    asm volatile("" ::: "memory");
    if (t + NSLOT - 1 <= t_hi) stage(t + NSLOT - 1, (t + NSLOT - 1 - t_lo) % NSLOT);
    const LAS char* Ks = kv + buf * 16384; const LAS char* Vs = Ks + 8192;
    const bool tsel = MODE == 1 ? ((selm >> t) & 1ull) != 0ull : true;
#pragma unroll
    for (int sub = 0; sub < 2; ++sub) {
      f32x16 sa;
#pragma unroll
      for (int q = 0; q < 16; ++q) sa[q] = 0.f;
      bf16x8 kf[4];
#pragma unroll
      for (int s4 = 0; s4 < 4; ++s4) kf[s4] = *(const LAS bf16x8*)(Ks + (32 * sub + i) * 128 + (((2 * s4 + h5) ^ ksw) << 4));
      __builtin_amdgcn_s_setprio(1);
#pragma unroll
      for (int s4 = 0; s4 < 4; ++s4) sa = MFMA32(kf[s4], qf[s4], sa);
      __builtin_amdgcn_s_setprio(0);
      const int k0 = 64 * t + 32 * sub + 4 * h5;
#pragma unroll
      for (int q = 0; q < 16; ++q) {
        const int kidx = k0 + (q & 3) + 8 * (q >> 2);
        float pv;
        if (MODE >= 3) {
          const int dl = si - kidx;
          const float e = __builtin_amdgcn_exp2f(sa[q] * LOG2E - shf);
          if (MODE == 3) {
            const float cw = (q & 3) ? 1.f : dm16[q >> 2];
            pv = (unsigned)dl <= (unsigned)dmaxA ? cw * e : 0.f;
          } else {
            const bool lo = dl >= 33;
            float cw = (lo && dl <= dmaxA) ? 1.f : 0.f;
            if ((q & 3) == wq) cw += (lo && dl <= dmaxB) ? 1.f : 0.f;
            pv = cw * e;
          }
        } else {
          bool valid;
          if (MODE == 0) valid = 16 * kidx + 31 <= si;
          else if (MODE == 1) valid = tsel && kidx <= si;
          else valid = (unsigned)(si - kidx) <= 511u;
          pv = valid ? __builtin_amdgcn_exp2f(sa[q] * LOG2E - shf) : 0.f;
        }
        l += pv; sa[q] = pv;
      }
      if (MODE == 0) {
#pragma unroll
        for (int rg = 0; rg < 4; ++rg) {
          const float a = 2.f * (sa[4 * rg] + sa[4 * rg + 1] + sa[4 * rg + 2]) + sa[4 * rg + 3];
          const float recv = __shfl_xor(sa[4 * rg + 3], 32);
          const float val = h5 ? a + recv : a + carry;
          carry = recv;
          psl[16 * t + 8 * sub + 2 * rg + h5] = val;
        }
      }
      const bf16x8 pf0 = pack8(sa, 0), pf1 = pack8(sa, 1);
      bf16x8 vf[2][2];
#pragma unroll
      for (int s2 = 0; s2 < 2; ++s2) {
        const LAS char* vb = Vs + (32 * sub + 16 * s2 + 4 * h5 + tq) * 128 + 8 * (tp & 1);
        vf[s2][0] = tr_pair(vb + (((tds * 2 + (tp >> 1)) ^ vsw) << 4));
        vf[s2][1] = tr_pair(vb + (((4 + tds * 2 + (tp >> 1)) ^ vsw) << 4));
      }
      __builtin_amdgcn_s_setprio(1);
#pragma unroll
      for (int s2 = 0; s2 < 2; ++s2) { o0 = MFMA32(vf[s2][0], s2 ? pf1 : pf0, o0); o1 = MFMA32(vf[s2][1], s2 ? pf1 : pf0, o1); }
      __builtin_amdgcn_s_setprio(0);
    }
    __builtin_amdgcn_sched_barrier(0);
  }
}

__device__ __forceinline__ void dilated_item(const P& p, char* smem_, int unit) {
  LAS char* kv = (LAS char*)smem_;
  const int tid = otid(), lane = tid & 63, wv = tid >> 6, i = lane & 31, h5 = lane >> 5;
  const int r4 = unit & 3, ti = (unit >> 2) & 7, hh = (unit >> 5) & 7, b = unit >> 8;
  const size_t hb = (size_t)(b * 8 + hh) * S * 64;
  const int si = ti * 512 + r4 + 4 * wv + 16 * i;
  bf16x8 qf[4];
#pragma unroll
  for (int s4 = 0; s4 < 4; ++s4) qf[s4] = *(const bf16x8*)(p.QA + hb + (size_t)si * 64 + 16 * s4 + 8 * h5);
  f32x16 o0, o1;
#pragma unroll
  for (int q = 0; q < 16; ++q) { o0[q] = 0.f; o1[q] = 0.f; }
  float l = 0.f;
  const float shf = p.smaxv[0] * LOG2E;
  const int pbase = ti * 512 + r4 - 128, ubase = ti * 128 - 512;
  nsa_pass<3, 4>(kv, p.KA + hb, p.VA + hb, 0, 9, qf, shf, 4 * wv + 16 * i + 128, 0ull, o0, o1, l, nullptr, pbase, 1, pbase < 0 ? -pbase : 0);
  nsa_pass<4, 4>(kv, p.KA + hb, p.VA + hb, 0, 9, qf, shf, wv + 4 * i + 512, 0ull, o0, o1, l, nullptr, r4 + 4 * ubase, 4, ubase < 0 ? -ubase : 0);
  l += __shfl_xor(l, 32);
  const float inv = 1.f / l;
  bf16_t* orow = p.mixinb + (size_t)(b * S + si) * D + hh * 64 + 4 * h5;
#pragma unroll
  for (int rg = 0; rg < 4; ++rg) {
    u32x2 w0 = {pk_bf16(o0[4 * rg] * inv, o0[4 * rg + 1] * inv), pk_bf16(o0[4 * rg + 2] * inv, o0[4 * rg + 3] * inv)};
    u32x2 w1 = {pk_bf16(o1[4 * rg] * inv, o1[4 * rg + 1] * inv), pk_bf16(o1[4 * rg + 2] * inv, o1[4 * rg + 3] * inv)};
    *(u32x2*)(orow + 8 * rg) = w0;
    *(u32x2*)(orow + 32 + 8 * rg) = w1;
  }
}

__device__ __forceinline__ void nsa_item(const P& p, char* smem_, int item) {
  LAS char* smem = (LAS char*)smem_;
  LAS char* kv = smem;
  LAS float* pslcw = (LAS float*)(smem + 32768);
  LAS float* invl = (LAS float*)(smem + 32768 + 33280);
  LAS unsigned* msk = (LAS unsigned*)(smem + 32768 + 33280 + 512);
  const int tid = otid(), lane = tid & 63, wv = tid >> 6, i = lane & 31, h5 = lane >> 5;
  const int qt = 127 - (item >> 3), bg = item & 7, b = bg >> 1, g = bg & 1, hq = g * 4 + wv;
  const int s0 = qt * 32, si = s0 + i, cur = s0 >> 6;
  const size_t qoff = ((size_t)(b * 8 + hq) * S + si) * 64 + 8 * h5;
  bf16x8 qf[4];
#pragma unroll
  for (int s4 = 0; s4 < 4; ++s4) qf[s4] = *(const bf16x8*)(p.QN + qoff + 16 * s4);
  const float* gs = p.GS + (size_t)(b * S + si) * 24 + hq * 3;
  const float g0 = gs[0], g1 = gs[1], g2 = gs[2];
  f32x16 oa0, oa1, o0, o1;
#pragma unroll
  for (int q = 0; q < 16; ++q) { o0[q] = 0.f; o1[q] = 0.f; }
  float l = 0.f;
  LAS float* psl = pslcw + (wv * 32 + i) * 65;
  const int ncv = (s0 + 31 - 31) >> 4;
  const int tc_hi = (ncv < 254 ? ncv : 254) >> 6;
#pragma unroll
  for (int k = 0; k < 32; ++k) psl[2 * k + h5] = 0.f;
  nsa_pass<0, 2>(kv, p.kcb + (size_t)bg * 256 * 64, p.vcb + (size_t)bg * 256 * 64, 0, tc_hi, qf, p.smaxv[1] * LOG2E, si, 0ull, o0, o1, l, psl);
  l += __shfl_xor(l, 32);
  {
    const float il = l > 0.f ? 1.f / l : 0.f;
    if (h5 == 0) invl[wv * 32 + i] = il;
    const float sc = g0 * il;
#pragma unroll
    for (int q = 0; q < 16; ++q) { oa0[q] = o0[q] * sc; oa1[q] = o1[q] * sc; o0[q] = 0.f; o1[q] = 0.f; }
  }
  __syncthreads();
  LAS float* scr = pslcw;
  {
    const int q = tid >> 3, jj = tid & 7;
    float tot[8];
#pragma unroll
    for (int k = 0; k < 8; ++k) {
      const int j = jj + 8 * k;
      float v = 0.f;
#pragma unroll
      for (int w4 = 0; w4 < 4; ++w4) v += pslcw[(w4 * 32 + q) * 65 + j] * invl[w4 * 32 + q];
      const bool forced = (j == 0) || (j == cur) || (j == cur - 1);
      tot[k] = forced ? INFINITY : (j <= cur ? v : -INFINITY);
    }
    __syncthreads();
#pragma unroll
    for (int k = 0; k < 8; ++k) scr[q * 65 + jj + 8 * k] = tot[k];
    if (tid < 64) msk[tid] = 0u;
    __syncthreads();
    unsigned lo = 0u, hi = 0u;
#pragma unroll
    for (int k = 0; k < 8; ++k) {
      const int j = jj + 8 * k; const float v = tot[k];
      int rank = 0;
      for (int c = 0; c < 64; ++c) { const float sv = scr[q * 65 + c]; rank += (sv > v) || (sv == v && c < j); }
      if (rank < 16 && j <= cur) { if (j < 32) lo |= 1u << j; else hi |= 1u << (j - 32); }
    }
    if (lo) atomicOr((unsigned*)&msk[q * 2], lo);
    if (hi) atomicOr((unsigned*)&msk[q * 2 + 1], hi);
    __syncthreads();
  }
  const unsigned long long selm = (unsigned long long)msk[i * 2] | ((unsigned long long)msk[i * 2 + 1] << 32);
#pragma unroll
  for (int s4 = 0; s4 < 4; ++s4) qf[s4] = *(const bf16x8*)(p.QR + qoff + 16 * s4);
  const size_t kvoff = (size_t)bg * S * 64;
  l = 0.f;
  nsa_pass<1, 4>(kv, p.KSL + kvoff, p.VSL + kvoff, 0, cur, qf, p.smaxv[2] * LOG2E, si, selm, o0, o1, l, nullptr);
  l += __shfl_xor(l, 32);
  {
    const float sc = g1 / l;
#pragma unroll
    for (int q = 0; q < 16; ++q) { oa0[q] += o0[q] * sc; oa1[q] += o1[q] * sc; o0[q] = 0.f; o1[q] = 0.f; }
  }
  l = 0.f;
  const int tw_lo = s0 >= 511 ? (s0 - 511) >> 6 : 0;
  nsa_pass<2, 4>(kv, p.KW + kvoff, p.VW + kvoff, tw_lo, cur, qf, p.smaxv[3] * LOG2E, si, 0ull, o0, o1, l, nullptr);
  l += __shfl_xor(l, 32);
  {
    const float sc = g2 / l;
#pragma unroll
    for (int q = 0; q < 16; ++q) { oa0[q] += o0[q] * sc; oa1[q] += o1[q] * sc; }
  }
  bf16_t* orow = p.mixinb + (size_t)(b * S + si) * D + 512 + hq * 64 + 4 * h5;
#pragma unroll
  for (int rg = 0; rg < 4; ++rg) {
    u32x2 w0 = {pk_bf16(oa0[4 * rg], oa0[4 * rg + 1]), pk_bf16(oa0[4 * rg + 2], oa0[4 * rg + 3])};
    u32x2 w1 = {pk_bf16(oa1[4 * rg], oa1[4 * rg + 1]), pk_bf16(oa1[4 * rg + 2], oa1[4 * rg + 3])};
    *(u32x2*)(orow + 8 * rg) = w0;
    *(u32x2*)(orow + 32 + 8 * rg) = w1;
  }
}
__device__ __forceinline__ void cvt_queue_item(const P& p, int ci) {
  f32x4 ra[16], rb[16];
  const CvtQ d0 = cvt_expert_desc(p, ci * 4), d1 = cvt_expert_desc(p, ci * 4 + 1), d2 = cvt_expert_desc(p, ci * 4 + 2), d3 = cvt_expert_desc(p, ci * 4 + 3);
  cvtq_load(d0, ra); cvtq_load(d1, rb);
  cvtq_store(d0, ra); cvtq_load(d2, ra);
  cvtq_store(d1, rb); cvtq_load(d3, rb);
  cvtq_store(d2, ra); cvtq_store(d3, rb);
}
__device__ __forceinline__ void ph_attn_a(const P& p, char* smem) {
  for (;;) {
    const int q = next_item(p.ctr + 0, smem);
    if (q >= 16 + 2560) break;
    if (q < 16) { compress_item(p, smem, q); continue; }
    const int j = q - 16, g = j / 5, r = j - g * 5;
    if (r == 0 || r == 3) dilated_item(p, smem, g * 2 + (r == 3)); else cvt_queue_item(p, g * 3 + (r == 1 ? 0 : (r == 2 ? 1 : 2)));
  }
}
__device__ __forceinline__ void ph_attn_b(const P& p, char* smem) {
  for (;;) {
    const int q = next_item(p.ctr + 1, smem);
    if (q >= 2560) break;
    const int g = q / 5, r = q - g * 5;
    if (r == 0 || r == 3) nsa_item(p, smem, g * 2 + (r == 3)); else cvt_queue_item(p, 1536 + g * 3 + (r == 1 ? 0 : (r == 2 ? 1 : 2)));
  }
}

__device__ __forceinline__ void ph_route(const P& p, char* smem) {
  const int lane = threadIdx.x & 63, wv = threadIdx.x >> 6;
  int* hist = (int*)smem;
  __syncthreads();
  hist[threadIdx.x] = 0;
  __syncthreads();
  const int tpb = T / gridDim.x, t0 = blockIdx.x * tpb;
  float bias[4];
#pragma unroll
  for (int i = 0; i < 4; ++i) bias[i] = p.r_bias[lane + 64 * i];
  for (int tt = wv; tt < tpb; tt += 4) {
    const int t = t0 + tt;
    float aff[4], bv[4], ta[4], tb[4];
#pragma unroll
    for (int i = 0; i < 4; ++i) { { const size_t li = (size_t)t * NE + lane + 64 * i; aff[i] = sigmoidf((p.logits[li] + p.logits[li + (size_t)T * NE]) + p.logits[li + (size_t)2 * T * NE]); } bv[i] = aff[i] + bias[i]; ta[i] = bv[i]; tb[i] = -INFINITY; }
#pragma unroll
    for (int o = 16; o; o >>= 1)
#pragma unroll
      for (int i = 0; i < 4; ++i) {
        const float a2 = __shfl_xor(ta[i], o), b2 = __shfl_xor(tb[i], o);
        const float na = fmaxf(ta[i], a2), nb = fmaxf(fminf(ta[i], a2), fmaxf(tb[i], b2));
        ta[i] = na; tb[i] = nb;
      }
    float gs[8];
#pragma unroll
    for (int i = 0; i < 4; ++i) { const float s2 = ta[i] + tb[i]; gs[2 * i] = __shfl(s2, 0); gs[2 * i + 1] = __shfl(s2, 32); }
    unsigned gmask = 0;
#pragma unroll
    for (int g = 0; g < 8; ++g) {
      int rank = 0;
#pragma unroll
      for (int i = 0; i < 8; ++i) rank += (gs[i] > gs[g]) || (gs[i] == gs[g] && i < g);
      if (rank < 4) gmask |= 1u << g;
    }
#pragma unroll
    for (int i = 0; i < 4; ++i) if (!((gmask >> (2 * i + (lane >> 5))) & 1u)) bv[i] = -INFINITY;
    unsigned key[4];
#pragma unroll
    for (int i = 0; i < 4; ++i) { const unsigned u = __float_as_uint(bv[i]); key[i] = (u & 0x80000000u) ? ~u : (u | 0x80000000u); }
    unsigned thr = 0u;
#pragma unroll 1
    for (int bit = 31; bit >= 0; --bit) {
      const unsigned trial = thr | (1u << bit);
      int c = 0;
#pragma unroll
      for (int i = 0; i < 4; ++i) c += __builtin_popcountll(__ballot(key[i] >= trial));
      if (c >= 8) thr = trial;
    }
    int ngt = 0;
#pragma unroll
    for (int i = 0; i < 4; ++i) ngt += __builtin_popcountll(__ballot(key[i] > thr));
    const int need = 8 - ngt;
    const unsigned long long ltmask = (1ull << lane) - 1ull;
    int eqbefore = 0, selbefore = 0;
    bool sel[4]; int slot[4];
#pragma unroll
    for (int i = 0; i < 4; ++i) {
      const unsigned long long eqm = __ballot(key[i] == thr);
      const bool s = key[i] > thr || (key[i] == thr && eqbefore + __builtin_popcountll(eqm & ltmask) < need);
      eqbefore += __builtin_popcountll(eqm);
      const unsigned long long sm = __ballot(s);
      sel[i] = s; slot[i] = selbefore + __builtin_popcountll(sm & ltmask);
      selbefore += __builtin_popcountll(sm);
    }
    float part = 0.f;
#pragma unroll
    for (int i = 0; i < 4; ++i) part += sel[i] ? aff[i] : 0.f;
    const float ssum = wave_sum(part);
#pragma unroll
    for (int i = 0; i < 4; ++i)
      if (sel[i]) {
        const int e = lane + 64 * i;
        p.eidx[t * 8 + slot[i]] = e;
        p.gates[t * 8 + slot[i]] = aff[i] / ssum * 2.5f;
        p.pos[t * 8 + slot[i]] = atomicAdd(&hist[e], 1);
      }
  }
  __syncthreads();
  p.bhist[(size_t)blockIdx.x * NE + threadIdx.x] = hist[threadIdx.x];
}
__device__ __forceinline__ void ph_fill(const P& p, char* smem) {
  int* soff = (int*)smem;
  int* wsum = soff + 260;
  int* sbase = soff + 272;
  const int tid = threadIdx.x, lane = tid & 63, wv = tid >> 6;
  __syncthreads();
  int c = 0, before = 0;
  for (int bb = 0; bb < (int)gridDim.x; ++bb) { const int v = p.bhist[(size_t)bb * NE + tid]; c += v; before += (bb < (int)blockIdx.x) ? v : 0; }
  int incl = c;
#pragma unroll
  for (int o = 1; o < 64; o <<= 1) { const int v = __shfl_up(incl, o); if (lane >= o) incl += v; }
  if (lane == 63) wsum[wv] = incl;
  __syncthreads();
  int base = 0;
  for (int i = 0; i < wv; ++i) base += wsum[i];
  soff[tid] = base + incl - c;
  sbase[tid] = base + incl - c + before;
  if (tid == 255) soff[256] = base + incl;
  __syncthreads();
  if (blockIdx.x == 0) {
    p.off[tid] = soff[tid]; p.cnt[tid] = c;
    if (tid == 255) p.off[256] = soff[256];
  }
  if (blockIdx.x == 1) {
    const int x = tid >> 5, i = tid & 31, e = x + 8 * i;
    const int tl = (soff[e + 1] - soff[e] + 255) >> 8;
    int inc2 = tl;
#pragma unroll
    for (int o = 1; o < 32; o <<= 1) { const int v = __shfl_up(inc2, o, 32); if (i >= o) inc2 += v; }
    p.tstart[x * 33 + i] = inc2 - tl;
    if (i == 31) p.tstart[x * 33 + 32] = inc2;
  }
  const int tpb = T / gridDim.x, a0 = blockIdx.x * tpb * 8;
  for (int a = a0 + tid; a < a0 + tpb * 8; a += 256) p.sorted[sbase[p.eidx[a]] + p.pos[a]] = a;
}

template <int NTL, class F>
__device__ __forceinline__ void moe_grid(const P& p, F body) {
  const int xcd = blockIdx.x & 7, lb = blockIdx.x >> 3, nlb = gridDim.x >> 3;
  const int* ts = p.tstart + xcd * 33;
  const int total = ts[32] * NTL;
  int i = 0;
  for (int j = lb; j < total; j += nlb) {
    while (ts[i + 1] * NTL <= j) ++i;
    const int tiles = ts[i + 1] - ts[i], rem = j - ts[i] * NTL;
    body(xcd + 8 * i, rem / tiles, rem % tiles);
  }
}
__device__ __forceinline__ const unsigned char* gu_rowq(const unsigned char* Wg, const unsigned char* Wu, int f0, int n) {
  const int wn = n >> 6, wi = n & 63;
  return (wi >= 32 ? Wu : Wg) + (size_t)(f0 + wn * 32 + (wi & 31)) * D;
}
__device__ __forceinline__ void ph_moe_gu(const P& p, char* smem) {
  moe_grid<4>(p, [&](int e, int ntile, int mtile) {
    const int cnt = p.cnt[e] - mtile * 256; const int* srt = p.sorted + p.off[e] + mtile * 256;
    const unsigned char* A = p.h2q; const unsigned char* Wg = p.Wq_g + (size_t)e * FF * D; const unsigned char* Wu = p.Wq_u + (size_t)e * FF * D; unsigned char* H = p.Hq;
    const float* gates = p.gates; const unsigned char* Z = (const unsigned char*)p.zrow;
    gemm2q(smem, D, [=](int r) { return r < cnt ? A + (size_t)(srt[r] >> 3) * D : Z; }, [=](int n) { return gu_rowq(Wg, Wu, ntile * 64, n); },
           [=](const f32x4 (&acc)[8][4], int r0, int c0, int) {
             const int wn = c0 >> 6, l4 = (c0 & 63) >> 2;
#pragma unroll
             for (int mt = 0; mt < 8; ++mt) {
               const int r = r0 + mt * 16; const bool ok = r < cnt; const int a = ok ? srt[r] : 0;
               const float sc = ok ? gates[a] * (HQ_SCALE / (WQ_SCALE * WQ_SCALE)) : 0.f;
               unsigned d[2];
#pragma unroll
               for (int q = 0; q < 2; ++q) {
                 const f32x4 g = acc[mt][q], u = acc[mt][q + 2];
                 float h[4];
#pragma unroll
                 for (int i = 0; i < 4; ++i) h[i] = clamp_e4m3(silu(g[i] * (1.f / WQ_SCALE)) * u[i] * (sc * WQ_SCALE));
                 d[q] = pk4_fp8(h[0], h[1], h[2], h[3]);
               }
               const bool b0 = l4 & 1;
               const unsigned send = b0 ? d[0] : d[1], recv = __shfl_xor(send, 16);
               u32x2 w = b0 ? (u32x2){recv, d[1]} : (u32x2){d[0], recv};
               if (ok) *(u32x2*)(H + (size_t)a * FF + ntile * 64 + wn * 32 + (b0 ? 16 + 4 * (l4 - 1) : 4 * l4)) = w;
             }
           });
  });
}
__device__ __forceinline__ void ph_moe_d(const P& p, char* smem) {
  moe_grid<4>(p, [&](int e, int ntp, int mtile) {
    const int cnt = p.cnt[e] - mtile * 256; const int* srt = p.sorted + p.off[e] + mtile * 256;
    const unsigned char* A = p.Hq; const unsigned char* W = p.Wq_d + (size_t)e * D * FF + (size_t)ntp * 256 * FF; unsigned char* Yq = p.Yq; const unsigned char* Z = (const unsigned char*)p.zrow;
    const int tid_ = otid(), lrow = ((tid_ >> 7) & 1) * 128 + (tid_ & 15);
    LAS int* ridt = (LAS int*)((LAS char*)smem + 3 * G2_STAGE);
    __syncthreads();
    ridt[tid_] = tid_ < cnt ? srt[tid_] : -1;
    gemm2q<2>(smem, FF, [=](int r) { return r < cnt ? A + (size_t)srt[r] * FF : Z; }, [=](int n) { return W + (size_t)n * FF; },
           [=](const f32x4 (&acc)[8][4], int r0, int c0, int rp) {
             const int wn64 = c0 & ~63, l4 = (c0 & 63) >> 2;
             const float s = YQ_SCALE / (WQ_SCALE * HQ_SCALE);
#pragma unroll
             for (int mt = 0; mt < 8; ++mt) {
               const int rd = ridt[lrow + mt * 16]; const bool ok = rd >= 0;
               unsigned dq[4];
#pragma unroll
               for (int nt = 0; nt < 4; ++nt) { const f32x4 a = acc[mt][nt] * s; dq[nt] = pk4_fp8(clamp_e4m3(a[0]), clamp_e4m3(a[1]), clamp_e4m3(a[2]), clamp_e4m3(a[3])); }
               { u32x2v r = __builtin_amdgcn_permlane16_swap(dq[0], dq[1], false, false); dq[0] = r.x; dq[1] = r.y; r = __builtin_amdgcn_permlane16_swap(dq[2], dq[3], false, false); dq[2] = r.x; dq[3] = r.y;
                 r = __builtin_amdgcn_permlane32_swap(dq[0], dq[2], false, false); dq[0] = r.x; dq[2] = r.y; r = __builtin_amdgcn_permlane32_swap(dq[1], dq[3], false, false); dq[1] = r.x; dq[3] = r.y; }
               if (ok) *(u32x4*)(Yq + (size_t)rd * D + (ntp * 2 + rp) * 128 + wn64 + 16 * l4) = (u32x4){dq[0], dq[1], dq[2], dq[3]};
               asm volatile("" ::: "memory");
             }
           }, (size_t)128 * FF);
  });
}
__device__ __forceinline__ void ph_combine(const P& p) {
  WLOOP(w, T / 4) {
    const int tid_ = otid(), t = w * 4 + (tid_ >> 6), c = (tid_ & 63) * 16, b = t / S;
    float acc[16];
#pragma unroll
    for (int i = 0; i < 16; ++i) acc[i] = 0.f;
#pragma unroll
    for (int k = 0; k < 8; ++k) {
      const u32x4 v = *(const u32x4*)(p.Yq + ((size_t)t * 8 + k) * D + c);
#pragma unroll
      for (int i = 0; i < 4; ++i) {
        const f32x2 lo = __builtin_amdgcn_cvt_pk_f32_fp8((int)v[i], false), hi = __builtin_amdgcn_cvt_pk_f32_fp8((int)v[i], true);
        acc[4 * i] += lo[0]; acc[4 * i + 1] += lo[1]; acc[4 * i + 2] += hi[0]; acc[4 * i + 3] += hi[1];
      }
    }
    const bf16_t* ys = p.Ys + (size_t)t * D + c; const float* gt = p.mod + b * 6 * D + 5 * D + c; const bf16_t* x1 = (const bf16_t*)p.x1 + (size_t)t * D + c; float* o = p.out + (size_t)t * D + c;
#pragma unroll
    for (int h = 0; h < 4; ++h) {
      const u32x2 sv = *(const u32x2*)(ys + 4 * h);
      const float s0 = __uint_as_float(sv.x << 16), s1 = __uint_as_float(sv.x & 0xffff0000u), s2 = __uint_as_float(sv.y << 16), s3 = __uint_as_float(sv.y & 0xffff0000u);
      const u32x2 xq = *(const u32x2*)(x1 + 4 * h);
      const f32x4 xv = {__uint_as_float(xq.x << 16), __uint_as_float(xq.x & 0xffff0000u), __uint_as_float(xq.y << 16), __uint_as_float(xq.y & 0xffff0000u)}, gv = *(const f32x4*)(gt + 4 * h);
      f32x4 r = {xv[0] + gv[0] * (s0 + acc[4 * h] * (1.f / YQ_SCALE)), xv[1] + gv[1] * (s1 + acc[4 * h + 1] * (1.f / YQ_SCALE)),
                 xv[2] + gv[2] * (s2 + acc[4 * h + 2] * (1.f / YQ_SCALE)), xv[3] + gv[3] * (s3 + acc[4 * h + 3] * (1.f / YQ_SCALE))};
      *(f32x4*)(o + 4 * h) = r;
    }
  }
}


#define XB_TMO      128
#define XB_XCNT(j)  (256  + 64 * (j))
#define XB_XSUB(j)  (1280 + 64 * (j))
#define XB_XGEN(j)  (2304 + 64 * (j))
#define XB_TOP      3328
#define XB_TOPGEN   3392
#define XCD_BAR_WORDS 3456
#define XB_SPIN_CAP (1u << 22)
__device__ __forceinline__ unsigned xb_ld(unsigned* p)              { return __hip_atomic_load(p, __ATOMIC_RELAXED, __HIP_MEMORY_SCOPE_AGENT); }
__device__ __forceinline__ unsigned xb_add(unsigned* p, unsigned v) { return __hip_atomic_fetch_add(p, v, __ATOMIC_RELAXED, __HIP_MEMORY_SCOPE_AGENT); }
__device__ __forceinline__ unsigned xb_xcc_id() { return (unsigned)__builtin_amdgcn_s_getreg((3 << 11) | 20) & 0xFu; }
#define XB_SPIN(cond, bar) do { unsigned _sp = 0; while (cond) { __builtin_amdgcn_s_sleep(1); \
    if ((++_sp & 255u) == 0u) { if (xb_ld(&(bar)[XB_TMO])) break; if (_sp > XB_SPIN_CAP) { atomicAdd(&(bar)[XB_TMO], 1u); break; } } } } while (0)
struct XcdBarrier { unsigned* bar; unsigned x; volatile LAS unsigned* st; };
__device__ __forceinline__ XcdBarrier xcd_barrier_post(unsigned* bar, volatile LAS unsigned* st) {
  XcdBarrier b; b.bar = bar; b.x = xb_xcc_id(); b.st = st;
  if (threadIdx.x == 0) (void)xb_add(&bar[XB_XCNT(b.x)], 1u);
  return b;
}
__device__ __forceinline__ void xcd_barrier_complete(unsigned* bar, unsigned x, unsigned& nloc, unsigned& nx) {
  const unsigned G = gridDim.x * gridDim.y * gridDim.z;
  unsigned sum, cnt, mine, sp = 0u;
  for (;;) {
    sum = 0u; cnt = 0u; mine = 0u;
#pragma unroll
    for (unsigned j = 0; j < 16; ++j) { const unsigned c = xb_ld(&bar[XB_XCNT(j)]); sum += c; cnt += (c > 0u) ? 1u : 0u; mine = (j == x) ? c : mine; }
    if (sum == G) break;
    __builtin_amdgcn_s_sleep(1);
    if ((++sp & 255u) == 0u) { if (xb_ld(&bar[XB_TMO])) break; if (sp > XB_SPIN_CAP) { atomicAdd(&bar[XB_TMO], 1u); break; } }
  }
  nloc = mine > 0u ? mine : 1u; nx = cnt > 0u ? cnt : 1u;
}
__device__ __forceinline__ void xcd_barrier(const XcdBarrier& b) {
  asm volatile("s_waitcnt vmcnt(0)" ::: "memory");
  __syncthreads();
  if (threadIdx.x == 0) {
    unsigned* bar = b.bar;
    __builtin_amdgcn_s_waitcnt(0);
    unsigned nloc = b.st[0], nx = b.st[1];
    if (nloc == 0u) { xcd_barrier_complete(bar, b.x, nloc, nx); b.st[0] = nloc; b.st[1] = nx; }
    const unsigned old = xb_add(&bar[XB_XSUB(b.x)], 1u);
    const unsigned gen = old / nloc;
    if (old + 1u == (gen + 1u) * nloc) {
      __builtin_amdgcn_fence(__ATOMIC_RELEASE, "agent");
      asm volatile("s_waitcnt vmcnt(0)" ::: "memory");
      const unsigned og = xb_add(&bar[XB_TOP], 1u);
      const unsigned tg = og / nx;
      if (og + 1u == (tg + 1u) * nx) xb_add(&bar[XB_TOPGEN], 1u);
      else XB_SPIN(xb_ld(&bar[XB_TOPGEN]) == tg, bar);
      __builtin_amdgcn_fence(__ATOMIC_ACQUIRE, "agent");
      xb_add(&bar[XB_XGEN(b.x)], 1u);
      asm volatile("s_waitcnt vmcnt(0)" ::: "memory");
    } else {
      XB_SPIN(xb_ld(&bar[XB_XGEN(b.x)]) == gen, bar);
      __builtin_amdgcn_fence(__ATOMIC_ACQUIRE, "agent");
      asm volatile("s_waitcnt vmcnt(0)" ::: "memory");
    }
  }
  __syncthreads();
}

__global__ void __launch_bounds__(256, 2) mega(P p) {
  extern __shared__ __attribute__((aligned(16))) char smem[];
  {
    volatile LAS unsigned* st0 = (volatile LAS unsigned*)((LAS char*)smem + SMEM_BYTES - 32);
    if (threadIdx.x == 0) { st0[0] = 0u; st0[1] = 0u; }
    __syncthreads();
  }
  const XcdBarrier xb = xcd_barrier_post(p.bar, (volatile LAS unsigned*)((LAS char*)smem + SMEM_BYTES - 32));
  ph_ada(p, smem); ph_rope_tab(p);
  { int ib = 0;
    for (int it = (int)blockIdx.x; it < 8 * 23; it += gridDim.x) cvtq_tile(p.w_in, INC, p.Wq_in, D, (it & 7) * 128, (it >> 3) * 128, INC);
    ib = (8 * 23) % gridDim.x; cvt_matrix<false>(p.w_out, p.Wt_out, D, D, ib);
    cvt_matrix<false>(p.w_router, p.Wt_rth, D, NE, ib); cvt_matrix<true>(p.w_router, p.Wt_rtl, D, NE, ib);
    cvt_matrix<false>(p.w1_k, p.Wt_c1k, 2048, 128, ib); cvt_matrix<false>(p.w1_v, p.Wt_c1v, 2048, 128, ib);
    cvt_matrix<false>(p.ws_gate, p.Wt_sg, D, FF, ib); cvt_matrix<false>(p.ws_up, p.Wt_su, D, FF, ib); cvt_matrix<false>(p.ws_down, p.Wt_sd, FF, D, ib); }
  if (blockIdx.x == gridDim.x - 4) { for (int i = threadIdx.x; i < 2048; i += 256) p.zrow[i] = 0; }
  if (blockIdx.x == gridDim.x - 1) {
    const int which = threadIdx.x >> 7, n = threadIdx.x & 127;
    const float* pe = which ? p.pe_v : p.pe_k; const float* w1 = which ? p.w1_v : p.w1_k;
    float a = 0.f;
    for (int k = 0; k < 2048; ++k) a += pe[k] * w1[(size_t)k * 128 + n];
    p.b1c[threadIdx.x] = a;
  }
  if (blockIdx.x == gridDim.x - 2) {
    for (int i = threadIdx.x; i < 8 * 64; i += 256) { p.kcb[((size_t)(i >> 6) * 256 + 255) * 64 + (i & 63)] = 0; p.vcb[((size_t)(i >> 6) * 256 + 255) * 64 + (i & 63)] = 0; }
  }
  if (blockIdx.x == gridDim.x - 3) {
    p.cnt[threadIdx.x] = 0;
    if (threadIdx.x < 8) p.ctr[threadIdx.x] = 0;
    if (threadIdx.x < 64) {
      const int ln = threadIdx.x;
      const float a = wave_max(fabsf(p.g_q_dil[ln])), bq = wave_max(fabsf(p.g_k_dil[ln])), c = wave_max(fabsf(p.g_q_nsa[ln]));
      const float d1 = wave_max(fabsf(p.g_k_cmp[ln])), d2 = wave_max(fabsf(p.g_k_slc[ln])), d3 = wave_max(fabsf(p.g_k_win[ln]));
      if (ln == 0) { p.smaxv[0] = 8.f * a * bq; p.smaxv[1] = 8.f * c * d1; p.smaxv[2] = 8.f * c * d2; p.smaxv[3] = 8.f * c * d3; }
    }
  }
  xcd_barrier(xb);
  ph_norm_mod<false>(p.x, p.g_mix, p.mod, 0, D, nullptr, p.h1q);
  xcd_barrier(xb);
  ph_proj(p, smem);
  xcd_barrier(xb);
  ph_attn_a(p, smem);
  xcd_barrier(xb);
  ph_attn_b(p, smem);
  xcd_barrier(xb);
  ph_outproj(p, smem);
  xcd_barrier(xb);
  if (DUP == 10) { ph_outproj_abl<0>(p, smem); xcd_barrier(xb); }
  if (DUP == 11) { ph_outproj_abl<1>(p, smem); xcd_barrier(xb); }
  if (DUP == 12) { ph_outproj_abl<2>(p, smem); xcd_barrier(xb); }
  if (DUP == 13) { ph_outproj_abl<3>(p, smem); xcd_barrier(xb); }
  ph_norm_mod<true, true>(p.x1, p.g_ffn, p.mod, 3 * D, 4 * D, p.h2s, p.h2q);
  xcd_barrier(xb);
  ph_router_shared_gu(p, smem);
  xcd_barrier(xb);
  ph_route(p, smem); ph_shared_d(p, smem);
  xcd_barrier(xb);
  ph_fill(p, smem);
  xcd_barrier(xb);
  ph_moe_gu(p, smem);
  xcd_barrier(xb);
  ph_moe_d(p, smem);
  xcd_barrier(xb);
  ph_combine(p);
}
}

extern "C" void kernel_launch(void* const* d_in, const int* in_sizes, int n_in, void* d_out, int out_size, void* d_ws, size_t ws_size,
                              hipStream_t stream) {
  P p{};
  const float** f = (const float**)d_in;
  p.x = f[0]; p.c = f[1]; p.w_ada = f[2]; p.b_ada = f[3]; p.g_mix = f[4]; p.g_ffn = f[5]; p.w_in = f[6]; p.g_q_dil = f[7]; p.g_k_dil = f[8];
  p.g_q_nsa = f[9]; p.g_k_cmp = f[10]; p.g_k_slc = f[11]; p.g_k_win = f[12]; p.pe_k = f[13]; p.w1_k = f[14]; p.w2_k = f[15]; p.pe_v = f[16];
  p.w1_v = f[17]; p.w2_v = f[18]; p.w_out = f[19]; p.w_router = f[20]; p.r_bias = f[21]; p.w_gate = f[22]; p.w_up = f[23]; p.w_down = f[24];
  p.ws_gate = f[25]; p.ws_up = f[26]; p.ws_down = f[27];
  p.out = (float*)d_out;
  char* w = (char*)d_ws; size_t o = 0;
  auto alloc = [&](size_t bytes) { void* r = w + o; o += (bytes + 255) & ~(size_t)255; return r; };
  p.mod = (float*)alloc(4 * 6 * D * 4);
  p.rope = (float*)alloc(S * 16 * 4);
  p.selmask = (unsigned long long*)alloc((size_t)T * 2 * 8);
  p.eidx = (int*)alloc(T * 8 * 4); p.gates = (float*)alloc(T * 8 * 4);
  p.cnt = (int*)alloc(NE * 4); p.off = (int*)alloc((NE + 1) * 4); p.pos = (int*)alloc(T * 8 * 4); p.sorted = (int*)alloc(T * 8 * 4);
  p.tstart = (int*)alloc(8 * 33 * 4);
  p.smaxv = (float*)alloc(64);
  p.b1c = (float*)alloc(256 * 4);
  p.ctr = (int*)alloc(64);
  p.kcb = (bf16_t*)alloc(8 * 256 * 64 * 2); p.vcb = (bf16_t*)alloc(8 * 256 * 64 * 2);
  p.GS = (float*)alloc((size_t)T * 24 * 4);
  p.QA = (bf16_t*)alloc((size_t)T * 512 * 2); p.KA = (bf16_t*)alloc((size_t)T * 512 * 2); p.VA = (bf16_t*)alloc((size_t)T * 512 * 2);
  p.QN = (bf16_t*)alloc((size_t)T * 512 * 2); p.QR = (bf16_t*)alloc((size_t)T * 512 * 2);
  p.KC = (bf16_t*)alloc((size_t)T * 128 * 2); p.VC = (bf16_t*)alloc((size_t)T * 128 * 2);
  p.KSL = (bf16_t*)alloc((size_t)T * 128 * 2); p.VSL = (bf16_t*)alloc((size_t)T * 128 * 2);
  p.KW = (bf16_t*)alloc((size_t)T * 128 * 2); p.VW = (bf16_t*)alloc((size_t)T * 128 * 2);
  p.logits = (float*)alloc((size_t)3 * T * NE * 4);
  p.x1 = (float*)alloc((size_t)T * D * 4);
  p.mixinb = (bf16_t*)alloc((size_t)T * D * 2);
  p.h1b = (bf16_t*)alloc((size_t)T * D * 2);
  p.h2s = (bf16_t*)alloc((size_t)T * 2 * D * 2);
  p.Hs = (bf16_t*)alloc((size_t)T * FF * 2);
  p.Ys = (bf16_t*)alloc((size_t)T * D * 2);
  p.bar = (unsigned*)alloc(XCD_BAR_WORDS * 4);
  p.bhist = (int*)alloc((size_t)2048 * NE * 4);
  p.Wt_c1k = (bf16_t*)alloc((size_t)128 * 2048 * 2); p.Wt_c1v = (bf16_t*)alloc((size_t)128 * 2048 * 2);
  p.zrow = (bf16_t*)alloc(2048 * 2);
  p.Wt_in = (bf16_t*)alloc((size_t)2944 * D * 2);
  p.Wt_out = (bf16_t*)alloc((size_t)D * D * 2);
  p.Wt_rth = (bf16_t*)alloc((size_t)NE * D * 2); p.Wt_rtl = (bf16_t*)alloc((size_t)NE * D * 2);
  p.Wt_sg = (bf16_t*)alloc((size_t)FF * D * 2); p.Wt_su = (bf16_t*)alloc((size_t)FF * D * 2); p.Wt_sd = (bf16_t*)alloc((size_t)D * FF * 2);
  p.Wq_g = (unsigned char*)alloc((size_t)NE * FF * D); p.Wq_u = (unsigned char*)alloc((size_t)NE * FF * D); p.Wq_d = (unsigned char*)alloc((size_t)NE * D * FF);
  p.h2q = (unsigned char*)alloc((size_t)T * D); p.h1q = (unsigned char*)alloc((size_t)T * D); p.Wq_in = (unsigned char*)alloc((size_t)2944 * D); p.Hq = (unsigned char*)alloc((size_t)T * 8 * FF);
  p.Yq = (unsigned char*)alloc((size_t)T * 8 * D);
  (void)hipMemsetAsync(p.bar, 0, XCD_BAR_WORDS * 4, stream);
  static int grid_blocks = 0;
  if (!grid_blocks) {
    int dev = 0, cus = 0, per_cu = 0;
    (void)hipGetDevice(&dev);
    (void)hipDeviceGetAttribute(&cus, hipDeviceAttributeMultiprocessorCount, dev);
    (void)hipOccupancyMaxActiveBlocksPerMultiprocessor(&per_cu, mega, 256, SMEM_BYTES);
    if (per_cu > 2) per_cu = 2;
    if (per_cu < 1) per_cu = 1;
    grid_blocks = cus * per_cu;
  }
  void* args[] = {&p};
  hipError_t e = hipLaunchCooperativeKernel((void*)mega, dim3(grid_blocks), dim3(256), args, SMEM_BYTES, stream);
  if (e != hipSuccess) fprintf(stderr, "cooperative launch failed: %s (grid %d)\n", hipGetErrorString(e), grid_blocks);
}
```

```cpp
#include <hip/hip_runtime.h>
#include <hip/hip_cooperative_groups.h>
#include <stdint.h>
#include <cstdio>
namespace cg = cooperative_groups;

namespace {
constexpr int D = 1024, NB = 4, S = 4096, T = NB * S, HD = 64;
constexpr int INC = 2840;
constexpr int C_QA = 0, C_KA = 512, C_VA = 1024, C_QB = 1536, C_KC = 2048, C_VC = 2176, C_KSL = 2304, C_VSL = 2432,
              C_KW = 2560, C_VW = 2688, C_GB = 2816;
constexpr int NC = 255, NE = 256, TOPK = 8, FF = 256;
constexpr float EPS = 1e-6f;
#ifndef DUP
#define DUP 0
#endif
constexpr int SMEM_BYTES = 74 * 1024;
typedef unsigned short bf16_t;
typedef short bf16x8 __attribute__((ext_vector_type(8)));
typedef float f32x4 __attribute__((ext_vector_type(4)));
typedef unsigned u32x4 __attribute__((ext_vector_type(4)));
typedef unsigned u32x2 __attribute__((ext_vector_type(2)));
typedef __bf16 bf2_t __attribute__((ext_vector_type(2)));
typedef float f32x2 __attribute__((ext_vector_type(2)));
typedef float f32x16 __attribute__((ext_vector_type(16)));
typedef short s16x4 __attribute__((ext_vector_type(4)));
#define LAS __attribute__((address_space(3)))
#define MFMA32(a, b, c) __builtin_amdgcn_mfma_f32_32x32x16_bf16((a), (b), (c), 0, 0, 0)
constexpr float LOG2E = 1.4426950408889634f;

struct P {
  const float *x, *c, *w_ada, *b_ada, *g_mix, *g_ffn, *w_in, *g_q_dil, *g_k_dil, *g_q_nsa, *g_k_cmp, *g_k_slc, *g_k_win;
  const float *pe_k, *w1_k, *w2_k, *pe_v, *w1_v, *w2_v, *w_out, *w_router, *r_bias, *w_gate, *w_up, *w_down, *ws_gate, *ws_up, *ws_down;
  float* out;
  float *mod, *rope, *h1, *proj, *qrope, *kcmp, *vcmp, *ocmp, *oslc, *owin, *mixin, *x1, *h2, *logits, *gates, *hs_g, *hs, *shared, *Hbuf;
  unsigned long long* selmask;
  int *eidx, *cnt, *off, *pos, *sorted, *tstart;
  bf16_t *h1b, *h2s, *mixinb, *Hb, *Hs, *Ybuf, *Ys;
  bf16_t *QA, *KA, *VA, *QN, *QR, *KC, *VC, *KSL, *VSL, *KW, *VW;
  float *GS, *smaxv, *b1c;
  bf16_t *kcb, *vcb;
  int* ctr;
  int* bhist;
  unsigned char *h2q, *Hq, *Wq_g, *Wq_u, *Wq_d, *h1q, *Wq_in, *Yq;
  unsigned* bar;
  bf16_t *zrow, *Wt_in, *Wt_out, *Wt_rth, *Wt_rtl, *Wt_sg, *Wt_su, *Wt_sd, *Wt_c1k, *Wt_c1v, *Wt_g, *Wt_u, *Wt_d;
};

#define WLOOP(w, n) for (int w = blockIdx.x; w < (n); w += gridDim.x)

__device__ __forceinline__ int otid() { int t = threadIdx.x; asm volatile("" : "+v"(t)); return t; }
__device__ __forceinline__ unsigned pk_bf16(float lo, float hi) {
  f32x2 v = {lo, hi};
  bf2_t r = __builtin_convertvector(v, bf2_t);
  return __builtin_bit_cast(unsigned, r);
}
__device__ __forceinline__ float clamp_e4m3(float v) { return __builtin_amdgcn_fmed3f(v, -448.f, 448.f); }
__device__ __forceinline__ unsigned pk4_fp8(float a, float b, float c, float d) {
  int t = __builtin_amdgcn_cvt_pk_fp8_f32(a, b, 0, false);
  t = __builtin_amdgcn_cvt_pk_fp8_f32(c, d, t, true);
  return (unsigned)t;
}
constexpr float WQ_SCALE = 64.f, HQ_SCALE = 8.f, YQ_SCALE = 16.f;
__device__ __forceinline__ float bf16_to_f32(unsigned short b) { return __uint_as_float((unsigned)b << 16); }
__device__ __forceinline__ float bf16_round(float v) { return __uint_as_float(pk_bf16(v, 0.f) << 16); }
__device__ __forceinline__ float silu(float v) { return v / (1.f + expf(-v)); }
__device__ __forceinline__ float sigmoidf(float v) { return 1.f / (1.f + expf(-v)); }
__device__ __forceinline__ float wave_sum(float v) { for (int o = 32; o; o >>= 1) v += __shfl_xor(v, o); return v; }
__device__ __forceinline__ float wave_max(float v) { for (int o = 32; o; o >>= 1) v = fmaxf(v, __shfl_xor(v, o)); return v; }

__device__ __forceinline__ void ph_ada(const P& p, char* smem) {
  float* sc = (float*)smem;
  f32x4* red = (f32x4*)(smem + 16384);
  bool loaded = false;
  WLOOP(w, 6 * D / 32) {
    const int tid = threadIdx.x, kg = tid >> 3, cl = tid & 7, j0 = w * 32 + cl * 4;
    __syncthreads();
    if (!loaded) { for (int i = tid; i < 4 * D; i += 256) sc[i] = silu(p.c[i]); loaded = true; __syncthreads(); }
    f32x4 acc[4];
#pragma unroll
    for (int b = 0; b < 4; ++b) acc[b] = (f32x4){0.f, 0.f, 0.f, 0.f};
#pragma unroll 8
    for (int it = 0; it < 32; ++it) {
      const int k = kg + 32 * it;
      const f32x4 wv = *(const f32x4*)(p.w_ada + (size_t)k * 6 * D + j0);
#pragma unroll
      for (int b = 0; b < 4; ++b) acc[b] += wv * sc[b * D + k];
    }
#pragma unroll
    for (int b = 0; b < 4; ++b) red[(kg * 8 + cl) * 4 + b] = acc[b];
    __syncthreads();
    if (tid < 128) {
      const int b = tid >> 5, c = tid & 31;
      float s = p.b_ada[w * 32 + c];
      for (int g = 0; g < 32; ++g) s += ((const float*)&red[(g * 8 + (c >> 2)) * 4 + b])[c & 3];
      p.mod[b * 6 * D + w * 32 + c] = s;
    }
  }
}
__device__ __forceinline__ void ph_rope_tab(const P& p) {
  WLOOP(w, S * 8 / 256) {
    int i = w * 256 + threadIdx.x;
    int pos = i >> 3, f = i & 7;
    double ang = (double)pos * pow(500000.0, -(double)f / 8.0);
    p.rope[i * 2] = (float)cos(ang);
    p.rope[i * 2 + 1] = (float)sin(ang);
  }
}
template <bool SPLIT, bool INBF = false>
__device__ __forceinline__ void ph_norm_mod(const float* in, const float* g, const float* mod, int shift_off, int scale_off, bf16_t* out, unsigned char* outq = nullptr) {
  const int lane = threadIdx.x & 63, wv = threadIdx.x >> 6;
  WLOOP(w, T / 4) {
    const int t = w * 4 + wv, b = t / S;
    f32x4 v[4];
    float ss = 0.f;
#pragma unroll
    for (int i = 0; i < 4; ++i) {
      if (INBF) { const u32x2 q = *(const u32x2*)((const bf16_t*)in + (size_t)t * D + i * 256 + lane * 4); v[i] = (f32x4){__uint_as_float(q.x << 16), __uint_as_float(q.x & 0xffff0000u), __uint_as_float(q.y << 16), __uint_as_float(q.y & 0xffff0000u)}; }
      else v[i] = *(const f32x4*)(in + (size_t)t * D + i * 256 + lane * 4);
      ss += v[i][0] * v[i][0] + v[i][1] * v[i][1] + v[i][2] * v[i][2] + v[i][3] * v[i][3]; }
    ss = wave_sum(ss);
    const float r = rsqrtf(ss * (1.f / D) + EPS);
    const int ld = SPLIT ? 2 * D : D;
#pragma unroll
    for (int i = 0; i < 4; ++i) {
      const int d = i * 256 + lane * 4;
      const f32x4 gg = *(const f32x4*)(g + d), sc = *(const f32x4*)(mod + b * 6 * D + scale_off + d), sh = *(const f32x4*)(mod + b * 6 * D + shift_off + d);
      const f32x4 o = v[i] * r * gg * (sc + 1.f) + sh;
      u32x2 hi = {pk_bf16(o[0], o[1]), pk_bf16(o[2], o[3])};
      if (out) *(u32x2*)(out + (size_t)t * ld + d) = hi;
      if (!SPLIT && outq) *(unsigned*)(outq + (size_t)t * D + d) = pk4_fp8(o[0], o[1], o[2], o[3]);
      if (SPLIT) {
        *(unsigned*)(outq + (size_t)t * D + d) = pk4_fp8(o[0], o[1], o[2], o[3]);
        const float l0 = o[0] - __uint_as_float(hi.x << 16), l1 = o[1] - __uint_as_float(hi.x & 0xffff0000u);
        const float l2 = o[2] - __uint_as_float(hi.y << 16), l3 = o[3] - __uint_as_float(hi.y & 0xffff0000u);
        u32x2 lo = {pk_bf16(l0, l1), pk_bf16(l2, l3)};
        *(u32x2*)(out + (size_t)t * ld + D + d) = lo;
      }
    }
  }
}

template <bool SPLIT3, class AF, class BF, class EF>
__device__ __forceinline__ void gemm128(char* smem, int K, int ldb, AF arow, BF bcol, EF epi) {
  const int tid = otid(), lane = tid & 63, wid = tid >> 6, wm = wid >> 1, wn = wid & 1;
  const int l15 = lane & 15, l4 = lane >> 4;
  char* As = smem; char* Bs = smem + 16384;
  const int ac = tid & 7, ar0 = tid >> 3;
  const bf16_t* ap[4];
#pragma unroll
  for (int i = 0; i < 4; ++i) ap[i] = arow(ar0 + 32 * i);
  const int kg = tid >> 5, ng = tid & 31;
  const float* bp = bcol(ng * 4);
  if (bp) bp += (size_t)(kg * 8) * ldb;
  u32x4 areg[4]; f32x4 breg[8];
  const int nk1 = K / 64, nk = SPLIT3 ? 3 * nk1 : nk1;
  auto gload = [&](int kt) {
    const int seg = SPLIT3 ? kt / nk1 : 0, k0 = (SPLIT3 ? kt % nk1 : kt) * 64;
    const int aoff = (seg == 2 ? K : 0) + k0 + ac * 8;
#pragma unroll
    for (int i = 0; i < 4; ++i) areg[i] = ap[i] ? *(const u32x4*)(ap[i] + aoff) : (u32x4){0u, 0u, 0u, 0u};
#pragma unroll
    for (int i = 0; i < 8; ++i) breg[i] = bp ? *(const f32x4*)(bp + (size_t)(k0 + i) * ldb) : (f32x4){0.f, 0.f, 0.f, 0.f};
    if (SPLIT3 && seg == 1) {
#pragma unroll
      for (int i = 0; i < 8; ++i)
#pragma unroll
        for (int j = 0; j < 4; ++j) breg[i][j] = breg[i][j] - bf16_round(breg[i][j]);
    }
  };
  auto lstore = [&]() {
#pragma unroll
    for (int i = 0; i < 4; ++i) { const int r = ar0 + 32 * i; *(u32x4*)(As + r * 128 + ((ac ^ ((r >> 1) & 7)) << 4)) = areg[i]; }
#pragma unroll
    for (int j = 0; j < 4; ++j) {
      const int n = ng * 4 + j;
      u32x4 v = {pk_bf16(breg[0][j], breg[1][j]), pk_bf16(breg[2][j], breg[3][j]), pk_bf16(breg[4][j], breg[5][j]), pk_bf16(breg[6][j], breg[7][j])};
      *(u32x4*)(Bs + n * 128 + ((kg ^ ((n >> 1) & 7)) << 4)) = v;
    }
  };
  f32x4 acc[4][4];
#pragma unroll
  for (int i = 0; i < 4; ++i)
#pragma unroll
    for (int j = 0; j < 4; ++j) acc[i][j] = (f32x4){0.f, 0.f, 0.f, 0.f};
  gload(0);
  const int sw = l15 >> 1;
  for (int kt = 0; kt < nk; ++kt) {
    __syncthreads();
    lstore();
    __syncthreads();
    if (kt + 1 < nk) gload(kt + 1);
#pragma unroll
    for (int ks = 0; ks < 2; ++ks) {
      const int coff = ((ks * 4 + l4) ^ sw) << 4;
      bf16x8 af[4], bfr[4];
#pragma unroll
      for (int mt = 0; mt < 4; ++mt) af[mt] = *(const bf16x8*)(As + (wm * 64 + mt * 16 + l15) * 128 + coff);
#pragma unroll
      for (int nt = 0; nt < 4; ++nt) bfr[nt] = *(const bf16x8*)(Bs + (wn * 64 + nt * 16 + l15) * 128 + coff);
#pragma unroll
      for (int mt = 0; mt < 4; ++mt)
#pragma unroll
        for (int nt = 0; nt < 4; ++nt) acc[mt][nt] = __builtin_amdgcn_mfma_f32_16x16x32_bf16(bfr[nt], af[mt], acc[mt][nt], 0, 0, 0);
    }
  }
  epi(acc, wm * 64 + l15, wn * 64 + l4 * 4);
}

typedef unsigned u32x2v __attribute__((ext_vector_type(2)));
__device__ __forceinline__ void xpose4(unsigned (&d)[4][2], int) {
#pragma unroll
  for (int a = 0; a < 2; ++a)
#pragma unroll
    for (int h = 0; h < 2; ++h) { const u32x2v r = __builtin_amdgcn_permlane16_swap(d[2 * a][h], d[2 * a + 1][h], false, false); d[2 * a][h] = r.x; d[2 * a + 1][h] = r.y; }
#pragma unroll
  for (int j = 0; j < 2; ++j)
#pragma unroll
    for (int h = 0; h < 2; ++h) { const u32x2v r = __builtin_amdgcn_permlane32_swap(d[j][h], d[2 + j][h], false, false); d[j][h] = r.x; d[2 + j][h] = r.y; }
}
__device__ __forceinline__ void store_row64_bf16(const f32x4& a0, const f32x4& a1, const f32x4& a2, const f32x4& a3, int l4, bf16_t* rowp, bool doit) {
  unsigned d[4][2] = {{pk_bf16(a0[0], a0[1]), pk_bf16(a0[2], a0[3])}, {pk_bf16(a1[0], a1[1]), pk_bf16(a1[2], a1[3])},
                      {pk_bf16(a2[0], a2[1]), pk_bf16(a2[2], a2[3])}, {pk_bf16(a3[0], a3[1]), pk_bf16(a3[2], a3[3])}};
  xpose4(d, l4);
  if (doit) {
    *(u32x4*)(rowp + 16 * l4) = (u32x4){d[0][0], d[0][1], d[1][0], d[1][1]};
    *(u32x4*)(rowp + 16 * l4 + 8) = (u32x4){d[2][0], d[2][1], d[3][0], d[3][1]};
  }
}

template <bool LO>
__device__ __forceinline__ void cvt_kn_tile(const float* src, int ldn, bf16_t* dst, int ldk, int k0, int n0, int nmax) {
  const int tid = threadIdx.x, kg = tid & 7, ng = tid >> 3, n = n0 + ng * 4;
  if (n >= nmax) return;
  f32x4 r[8];
#pragma unroll
  for (int i = 0; i < 8; ++i) r[i] = *(const f32x4*)(src + (size_t)(k0 + kg * 8 + i) * ldn + n);
  if (LO) {
#pragma unroll
    for (int i = 0; i < 8; ++i)
#pragma unroll
      for (int j = 0; j < 4; ++j) r[i][j] = r[i][j] - bf16_round(r[i][j]);
  }
#pragma unroll
  for (int j = 0; j < 4; ++j) {
    u32x4 v = {pk_bf16(r[0][j], r[1][j]), pk_bf16(r[2][j], r[3][j]), pk_bf16(r[4][j], r[5][j]), pk_bf16(r[6][j], r[7][j])};
    *(u32x4*)(dst + (size_t)(n + j) * ldk + k0 + kg * 8) = v;
  }
}
template <bool LO>
__device__ __forceinline__ void cvt_matrix(const float* src, bf16_t* dst, int K, int N, int& item_base) {
  const int nkt = K / 64, nnt = (N + 127) / 128, total = nkt * nnt;
  for (int it = (int)blockIdx.x - item_base; it < total; it += gridDim.x) {
    if (it < 0) continue;
    cvt_kn_tile<LO>(src, N, dst, K, (it % nkt) * 64, (it / nkt) * 128, N);
  }
  item_base = (item_base + total) % gridDim.x;
}

constexpr int G2_STAGE = 24576;
template <int NSEG, int AB = 0, class AF, class BF, class EF>
__device__ __forceinline__ void gemm2(char* smem_, int K, AF arow, BF brow, EF epi, int aseg1 = 0, int bseg1 = 0, int aseg2 = 0, int bseg2 = 0) {
  LAS char* smem = (LAS char*)smem_;
  const int tid = otid(), lane = tid & 63, wv = __builtin_amdgcn_readfirstlane(tid >> 6), wm = wv >> 1, wn = wv & 1;
  const int l15 = lane & 15, l4 = lane >> 4;
  const int row_l = lane >> 2, csrc = ((lane & 3) ^ (((row_l >> 3) & 1) * 3)) * 8;
  const bf16_t* ap[4]; const bf16_t* bp[2];
#pragma unroll
  for (int j = 0; j < 4; ++j) ap[j] = arow((wv + 4 * j) * 16 + row_l) + csrc;
#pragma unroll
  for (int j = 0; j < 2; ++j) bp[j] = brow((wv + 4 * j) * 16 + row_l) + csrc;
  const int nk1 = K / 32, nk = NSEG * nk1;
  auto issue = [&](int kt) {
    LAS char* st = smem + (kt % 3) * G2_STAGE;
    int ka = kt * 32, kb = kt * 32;
    if (NSEG > 1) { const int seg = kt / nk1, kk = (kt - seg * nk1) * 32; ka = kk + (seg == 1 ? aseg1 : (seg == 2 ? aseg2 : 0)); kb = kk + (seg == 1 ? bseg1 : (seg == 2 ? bseg2 : 0)); }
#pragma unroll
    for (int j = 0; j < 4; ++j) __builtin_amdgcn_global_load_lds((const unsigned*)(ap[j] + ka), (LAS unsigned*)(st + (wv + 4 * j) * 1024), 16, 0, 0);
#pragma unroll
    for (int j = 0; j < 2; ++j) __builtin_amdgcn_global_load_lds((const unsigned*)(bp[j] + kb), (LAS unsigned*)(st + 16384 + (wv + 4 * j) * 1024), 16, 0, 0);
  };
  f32x4 acc[8][4];
#pragma unroll
  for (int i = 0; i < 8; ++i)
#pragma unroll
    for (int j = 0; j < 4; ++j) acc[i][j] = (f32x4){0.f, 0.f, 0.f, 0.f};
  const int coff = (l4 ^ (((l15 >> 3) & 1) * 3)) << 4;
  const int aoff = (wm * 128 + l15) * 64 + coff, boff = 16384 + (wn * 64 + l15) * 64 + coff;
  asm volatile("s_waitcnt lgkmcnt(0)" ::: "memory");
  __builtin_amdgcn_s_barrier();
  asm volatile("" ::: "memory");
  issue(0);
  if (nk > 1) issue(1);
  for (int kt = 0; kt < nk; ++kt) {
    if (kt + 1 < nk) asm volatile("s_waitcnt vmcnt(6)" ::: "memory"); else asm volatile("s_waitcnt vmcnt(0)" ::: "memory");
    __builtin_amdgcn_s_barrier();
    asm volatile("" ::: "memory");
    if (AB != 2 && kt + 2 < nk) issue(kt + 2);
    const LAS char* st = smem + (kt % 3) * G2_STAGE;
    bf16x8 bfr[4], af[8];
    if (AB != 3) {
#pragma unroll
    for (int nt = 0; nt < 4; ++nt) bfr[nt] = *(const LAS bf16x8*)(st + boff + nt * 1024);
#pragma unroll
    for (int mt = 0; mt < 8; ++mt) af[mt] = *(const LAS bf16x8*)(st + aoff + mt * 1024);
    }
    __builtin_amdgcn_sched_barrier(0);
    if (AB == 1) {
#pragma unroll
      for (int nt = 0; nt < 4; ++nt) asm volatile("" :: "v"(bfr[nt]));
#pragma unroll
      for (int mt = 0; mt < 8; ++mt) asm volatile("" :: "v"(af[mt]));
    }
    if (AB == 0 || AB == 2) {
    __builtin_amdgcn_s_setprio(1);
#pragma unroll
    for (int mt = 0; mt < 8; ++mt)
#pragma unroll
      for (int nt = 0; nt < 4; ++nt) acc[mt][nt] = __builtin_amdgcn_mfma_f32_16x16x32_bf16(bfr[nt], af[mt], acc[mt][nt], 0, 0, 0);
    __builtin_amdgcn_s_setprio(0);
    }
    __builtin_amdgcn_sched_barrier(0);
  }
  epi(acc, wm * 128 + l15, wn * 64 + l4 * 4);
}

template <int NREP = 1, class AF, class BF, class EF>
__device__ __forceinline__ void gemm2q(char* smem_, int K, AF arow, BF brow, EF epi, size_t bstep = 0, bool half = false) {
  LAS char* smem = (LAS char*)smem_;
  const int tid = otid(), lane = tid & 63, wv = __builtin_amdgcn_readfirstlane(tid >> 6), wm = wv >> 1, wn = wv & 1;
  const int l15 = lane & 15, l4 = lane >> 4;
  const int row_l = lane >> 2, csrc = ((lane & 3) ^ ((row_l >> 2) & 3)) * 16;
  const unsigned char* ap[4]; const unsigned char* bp[2];
#pragma unroll
  for (int j = 0; j < 4; ++j) ap[j] = arow((wv + 4 * j) * 16 + row_l) + csrc;
#pragma unroll
  for (int j = 0; j < 2; ++j) bp[j] = brow((wv + 4 * j) * 16 + row_l) + csrc;
  const int nk1 = K / 64, nk = nk1 * NREP;
  auto issue = [&](int kt) {
    LAS char* st = smem + (kt % 3) * G2_STAGE;
    const int rp = NREP > 1 ? kt / nk1 : 0, kk = NREP > 1 ? kt - rp * nk1 : kt;
#pragma unroll
    for (int j = 0; j < 4; ++j) __builtin_amdgcn_global_load_lds((const unsigned*)(ap[j] + kk * 64), (LAS unsigned*)(st + (wv + 4 * j) * 1024), 16, 0, 0);
#pragma unroll
    for (int j = 0; j < 2; ++j) __builtin_amdgcn_global_load_lds((const unsigned*)(bp[j] + rp * bstep + kk * 64), (LAS unsigned*)(st + 16384 + (wv + 4 * j) * 1024), 16, 0, 0);
  };
  f32x4 acc[8][4];
#pragma unroll
  for (int i = 0; i < 8; ++i)
#pragma unroll
    for (int j = 0; j < 4; ++j) acc[i][j] = (f32x4){0.f, 0.f, 0.f, 0.f};
  const int sw = (l15 >> 2) & 3, sub = (l4 & 1) * 8, ch = l4 >> 1;
  const int aoff = (wm * 128 + l15) * 64 + sub, boff = 16384 + (wn * 64 + l15) * 64 + sub;
  asm volatile("s_waitcnt lgkmcnt(0)" ::: "memory");
  __builtin_amdgcn_s_barrier();
  asm volatile("" ::: "memory");
  issue(0);
  if (nk > 1) issue(1);
  for (int kt = 0; kt < nk; ++kt) {
    if (kt + 1 < nk) asm volatile("s_waitcnt vmcnt(6)" ::: "memory"); else asm volatile("s_waitcnt vmcnt(0)" ::: "memory");
    __builtin_amdgcn_s_barrier();
    asm volatile("" ::: "memory");
    if (kt + 2 < nk) issue(kt + 2);
    const LAS char* st = smem + (kt % 3) * G2_STAGE;
    if (!(half && wm == 1))
#pragma unroll
    for (int ks = 0; ks < 2; ++ks) {
      const int coff = ((2 * ks + ch) ^ sw) << 4;
      long bfr[4], af[8];
#pragma unroll
      for (int nt = 0; nt < 4; ++nt) bfr[nt] = *(const LAS long*)(st + boff + nt * 1024 + coff);
#pragma unroll
      for (int mt = 0; mt < 8; ++mt) af[mt] = *(const LAS long*)(st + aoff + mt * 1024 + coff);
      __builtin_amdgcn_s_setprio(1);
#pragma unroll
      for (int mt = 0; mt < 8; ++mt)
#pragma unroll
        for (int nt = 0; nt < 4; ++nt) acc[mt][nt] = __builtin_amdgcn_mfma_f32_16x16x32_fp8_fp8(bfr[nt], af[mt], acc[mt][nt], 0, 0, 0);
      __builtin_amdgcn_s_setprio(0);
    }
    __builtin_amdgcn_sched_barrier(0);
    if (NREP > 1 && (kt + 1) % nk1 == 0 && kt + 1 < nk) {
      epi(acc, wm * 128 + l15, wn * 64 + l4 * 4, kt / nk1);
#pragma unroll
      for (int i = 0; i < 8; ++i)
#pragma unroll
        for (int j = 0; j < 4; ++j) acc[i][j] = (f32x4){0.f, 0.f, 0.f, 0.f};
    }
  }
  epi(acc, wm * 128 + l15, wn * 64 + l4 * 4, NREP - 1);
}

template <class F>
__device__ __forceinline__ void gemm2_grid(int NT, F body) {
  const int xcd = blockIdx.x & 7, lb = blockIdx.x >> 3, nlb = gridDim.x >> 3;
  for (int i = lb; i < 8 * NT; i += nlb) body(xcd * 8 + (i & 7), i >> 3);
}

template <class F>
__device__ __forceinline__ void gemm_grid(int NT, F body) {
  const int xcd = blockIdx.x & 7, lb = blockIdx.x >> 3, nlb = gridDim.x >> 3;
  for (int i = lb; i < 16 * NT; i += nlb) {
    const int g = i / (8 * NT), rem = i % (8 * NT), nt = rem >> 3, mi = rem & 7;
    body(xcd * 16 + g * 8 + mi, nt);
  }
}

template <int MT>
__device__ __forceinline__ void proj_epi(const P& p, const f32x4 (&acc)[MT][4], int row_base, int ntile, int r0, int c0, float ascale = 1.f, const float* rope_tile = nullptr) {
  const int wn = c0 >> 6, l4 = (c0 & 63) >> 2;
  const int col0 = ntile * 128 + wn * 64;
  if (col0 >= INC) return;
  if (col0 == C_GB) {
#pragma unroll
    for (int mt = 0; mt < MT; ++mt) {
      const int m = row_base + r0 + mt * 16;
      f32x4 a = acc[mt][0] * ascale, g0 = {sigmoidf(a[0]), sigmoidf(a[1]), sigmoidf(a[2]), sigmoidf(a[3])};
      *(f32x4*)(p.GS + (size_t)m * 24 + 4 * l4) = g0;
      if (l4 < 2) { a = acc[mt][1] * ascale; f32x4 g1 = {sigmoidf(a[0]), sigmoidf(a[1]), sigmoidf(a[2]), sigmoidf(a[3])}; *(f32x4*)(p.GS + (size_t)m * 24 + 16 + 4 * l4) = g1; }
    }
    return;
  }
  const float* g = nullptr; bf16_t* dst; bf16_t* dst2 = nullptr; int hh, H; float qs = 1.f; bool dorope = false;
  if (col0 < 512) { g = p.g_q_dil; dst = p.QA; hh = col0 >> 6; H = 8; qs = 0.125f; dorope = true; }
  else if (col0 < 1024) { g = p.g_k_dil; dst = p.KA; hh = (col0 - 512) >> 6; H = 8; dorope = true; }
  else if (col0 < 1536) { dst = p.VA; hh = (col0 - 1024) >> 6; H = 8; }
  else if (col0 < 2048) { g = p.g_q_nsa; dst = p.QR; dst2 = p.QN; hh = (col0 - 1536) >> 6; H = 8; qs = 0.125f; dorope = true; }
  else {
    const int idx = (col0 - 2048) >> 6, which = idx >> 1; hh = idx & 1; H = 2;
    if (which == 0) dst = p.KC; else if (which == 1) dst = p.VC;
    else if (which == 2) { dst = p.KSL; g = p.g_k_slc; dorope = true; } else if (which == 3) dst = p.VSL;
    else if (which == 4) { dst = p.KW; g = p.g_k_win; dorope = true; } else dst = p.VW;
  }
  f32x4 gv[4];
  if (g) {
#pragma unroll
    for (int nt = 0; nt < 4; ++nt) gv[nt] = *(const f32x4*)(g + nt * 16 + 4 * l4);
  }
  const int bb = row_base / S;
#pragma unroll
  for (int mt = 0; mt < MT; ++mt) {
    const int m = row_base + r0 + mt * 16, s = m - bb * S;
    f32x4 v[4];
#pragma unroll
    for (int nt = 0; nt < 4; ++nt) v[nt] = acc[mt][nt] * ascale;
    if (g) {
      float ss = 0.f;
#pragma unroll
      for (int nt = 0; nt < 4; ++nt) ss += v[nt][0] * v[nt][0] + v[nt][1] * v[nt][1] + v[nt][2] * v[nt][2] + v[nt][3] * v[nt][3];
      ss += __shfl_xor(ss, 16); ss += __shfl_xor(ss, 32);
      const float r = rsqrtf(ss * (1.f / 64.f) + EPS) * qs;
#pragma unroll
      for (int nt = 0; nt < 4; ++nt) v[nt] = v[nt] * gv[nt] * r;
    }
    f32x4 vr = v[0];
    if (dorope) {
      const float* rp = rope_tile ? rope_tile + ((size_t)(m - row_base) * 8 + 4 * (l4 & 1)) * 2 : p.rope + ((size_t)s * 8 + 4 * (l4 & 1)) * 2;
      const f32x4 ra = *(const f32x4*)rp, rb = *(const f32x4*)(rp + 4);
      const float cs[4] = {ra[0], ra[2], rb[0], rb[2]}, sn[4] = {ra[1], ra[3], rb[1], rb[3]};
#pragma unroll
      for (int i = 0; i < 4; ++i) {
        const float pt = __shfl_xor(v[0][i], 32);
        vr[i] = (l4 < 2) ? (v[0][i] * cs[i] - pt * sn[i]) : (v[0][i] * cs[i] + pt * sn[i]);
      }
    }
    bf16_t* row = dst + ((size_t)(bb * H + hh) * S + s) * 64 + 16 * l4;
    unsigned dd[4][2] = {{pk_bf16(vr[0], vr[1]), pk_bf16(vr[2], vr[3])}, {pk_bf16(v[1][0], v[1][1]), pk_bf16(v[1][2], v[1][3])},
                         {pk_bf16(v[2][0], v[2][1]), pk_bf16(v[2][2], v[2][3])}, {pk_bf16(v[3][0], v[3][1]), pk_bf16(v[3][2], v[3][3])}};
    if (dst2) {
      unsigned d2[4][2] = {{pk_bf16(v[0][0], v[0][1]), pk_bf16(v[0][2], v[0][3])}, {dd[1][0], dd[1][1]}, {dd[2][0], dd[2][1]}, {dd[3][0], dd[3][1]}};
      xpose4(d2, l4);
      bf16_t* row2 = dst2 + ((size_t)(bb * H + hh) * S + s) * 64 + 16 * l4;
      *(u32x4*)row2 = (u32x4){d2[0][0], d2[0][1], d2[1][0], d2[1][1]};
      *(u32x4*)(row2 + 8) = (u32x4){d2[2][0], d2[2][1], d2[3][0], d2[3][1]};
    }
    xpose4(dd, l4);
    *(u32x4*)row = (u32x4){dd[0][0], dd[0][1], dd[1][0], dd[1][1]};
    *(u32x4*)(row + 8) = (u32x4){dd[2][0], dd[2][1], dd[3][0], dd[3][1]};
    asm volatile("" ::: "memory");
  }
}
__device__ __forceinline__ void ph_proj(const P& p, char* smem) {
  gemm2_grid(23, [&](int mtile, int ntile) {
    const unsigned char* A = p.h1q + (size_t)mtile * 256 * D; const unsigned char* W = p.Wq_in + (size_t)ntile * 128 * D; const unsigned char* Z = (const unsigned char*)p.zrow;
    const int nvalid = INC - ntile * 128;
    gemm2q<1>(smem, D, [=](int r) { return A + (size_t)r * D; }, [=](int n) { return n < nvalid ? W + (size_t)n * D : Z; },
              [&](const f32x4 (&acc)[8][4], int r0, int c0, int) {
                float* rl = (float*)smem;
                __syncthreads();
                { const int s0 = (mtile * 256) % S; const f32x4* srcp = (const f32x4*)(p.rope + (size_t)s0 * 16);
#pragma unroll
                  for (int i = 0; i < 4; ++i) ((f32x4*)rl)[threadIdx.x + 256 * i] = srcp[threadIdx.x + 256 * i]; }
                __syncthreads();
                proj_epi<8>(p, acc, mtile * 256, ntile, r0, c0, 1.f / WQ_SCALE, rl);
              });
  });
}
__device__ __forceinline__ void ph_outproj(const P& p, char* smem) {
  gemm2_grid(8, [&](int mtile, int ntile) {
    const bf16_t* A = p.mixinb + (size_t)mtile * 256 * D; const bf16_t* W = p.Wt_out + (size_t)ntile * 128 * D; bf16_t* C = (bf16_t*)p.x1; const float* x = p.x;
    const float* gt = p.mod + ((mtile * 256) / S) * 6 * D + 2 * D;
    gemm2<1>(smem, D, [=](int r) { return A + (size_t)r * D; }, [=](int n) { return W + (size_t)n * D; },
             [=](const f32x4 (&acc)[8][4], int r0, int c0) {
               const int l4 = (c0 & 63) >> 2;
#pragma unroll
               for (int mt = 0; mt < 8; ++mt) {
                 const int m = mtile * 256 + r0 + mt * 16;
                 f32x4 o[4];
#pragma unroll
                 for (int nt = 0; nt < 4; ++nt) {
                   const int n = ntile * 128 + c0 + nt * 16;
                   o[nt] = *(const f32x4*)(x + (size_t)m * D + n) + *(const f32x4*)(gt + n) * acc[mt][nt];
                 }
                 store_row64_bf16(o[0], o[1], o[2], o[3], l4, C + (size_t)m * D + ntile * 128 + (c0 & ~63), true);
                 asm volatile("" ::: "memory");
               }
             });
  });
}
template <int AB>
__device__ __forceinline__ void ph_outproj_abl(const P& p, char* smem) {
  gemm2_grid(8, [&](int mtile, int ntile) {
    const bf16_t* A = p.mixinb + (size_t)mtile * 256 * D; const bf16_t* W = p.Wt_out + (size_t)ntile * 128 * D; float* C = (float*)p.Ybuf;
    gemm2<1, AB>(smem, D, [=](int r) { return A + (size_t)r * D; }, [=](int n) { return W + (size_t)n * D; },
             [=](const f32x4 (&acc)[8][4], int r0, int c0) {
#pragma unroll
               for (int mt = 0; mt < 8; ++mt)
#pragma unroll
                 for (int nt = 0; nt < 4; ++nt) {
                   const int m = mtile * 256 + r0 + mt * 16, n = ntile * 128 + c0 + nt * 16;
                   *(f32x4*)(C + (size_t)m * D + n) = acc[mt][nt];
                 }
             });
  });
}
__device__ __forceinline__ void router_unit(const P& p, char* smem, int mtile, int j) {
  const int seg = j >> 1, ntile = j & 1;
  const bf16_t* A = p.h2s + (size_t)mtile * 256 * 2 * D + (seg == 2 ? D : 0);
  const bf16_t* W = (seg == 1 ? p.Wt_rtl : p.Wt_rth) + (size_t)ntile * 128 * D; float* C = p.logits + (size_t)seg * T * NE;
  gemm2<1>(smem, D, [=](int r) { return A + (size_t)r * 2 * D; }, [=](int n) { return W + (size_t)n * D; },
           [=](const f32x4 (&acc)[8][4], int r0, int c0) {
#pragma unroll
             for (int mt = 0; mt < 8; ++mt)
#pragma unroll
               for (int nt = 0; nt < 4; ++nt) {
                 const int m = mtile * 256 + r0 + mt * 16, n = ntile * 128 + c0 + nt * 16;
                 *(f32x4*)(C + (size_t)m * NE + n) = acc[mt][nt];
               }
           });
}
__device__ __forceinline__ const bf16_t* gu_row(const bf16_t* Wg, const bf16_t* Wu, int f0, int n) {
  const int wn = n >> 6, wi = n & 63;
  return (wi >= 32 ? Wu : Wg) + (size_t)(f0 + wn * 32 + (wi & 31)) * D;
}
template <int MT>
__device__ __forceinline__ void gu_store(const f32x4 (&acc)[MT][4], int mt, float scale, bf16_t* dstrow  ) {
#pragma unroll
  for (int q = 0; q < 2; ++q) {
    const f32x4 g = acc[mt][q], u = acc[mt][q + 2];
    float h[4];
#pragma unroll
    for (int i = 0; i < 4; ++i) h[i] = silu(g[i]) * u[i] * scale;
    u32x2 v = {pk_bf16(h[0], h[1]), pk_bf16(h[2], h[3])};
    *(u32x2*)(dstrow + q * 16) = v;
  }
}
__device__ __forceinline__ void shared_gu_unit(const P& p, char* smem, int mtile, int ntile) {
  const bf16_t* A = p.h2s + (size_t)mtile * 256 * 2 * D; const bf16_t* Wg = p.Wt_sg; const bf16_t* Wu = p.Wt_su; bf16_t* H = p.Hs;
  gemm2<1>(smem, D, [=](int r) { return A + (size_t)r * 2 * D; }, [=](int n) { return gu_row(Wg, Wu, ntile * 64, n); },
           [=](const f32x4 (&acc)[8][4], int r0, int c0) {
             const int wn = c0 >> 6, l4x4 = c0 & 63;
#pragma unroll
             for (int mt = 0; mt < 8; ++mt) gu_store<8>(acc, mt, 1.f, H + (size_t)(mtile * 256 + r0 + mt * 16) * FF + ntile * 64 + wn * 32 + l4x4);
           });
}
__device__ __forceinline__ void ph_router_shared_gu(const P& p, char* smem) {
  gemm2_grid(10, [&](int mtile, int j) { if (j < 6) router_unit(p, smem, mtile, j); else shared_gu_unit(p, smem, mtile, j - 6); });
}
__device__ __forceinline__ void ph_shared_d(const P& p, char* smem) {
  gemm2_grid(8, [&](int mtile, int ntile) {
    const bf16_t* A = p.Hs + (size_t)mtile * 256 * FF; const bf16_t* W = p.Wt_sd + (size_t)ntile * 128 * FF; bf16_t* Y = p.Ys;
    gemm2<1>(smem, FF, [=](int r) { return A + (size_t)r * FF; }, [=](int n) { return W + (size_t)n * FF; },
             [=](const f32x4 (&acc)[8][4], int r0, int c0) {
#pragma unroll
               for (int mt = 0; mt < 8; ++mt)
                 store_row64_bf16(acc[mt][0], acc[mt][1], acc[mt][2], acc[mt][3], (c0 & 63) >> 2, Y + (size_t)(mtile * 256 + r0 + mt * 16) * D + ntile * 128 + (c0 & ~63), true);
             });
  });
}
struct CvtQ { const float* src; unsigned char* dst; int ldn, ldk; };
__device__ __forceinline__ void cvtq_load(const CvtQ& d, f32x4 (&r)[16]) {
#pragma unroll
  for (int i = 0; i < 16; ++i) r[i] = __builtin_nontemporal_load((const f32x4*)(d.src + (size_t)i * d.ldn));
}
__device__ __forceinline__ void cvtq_store(const CvtQ& d, const f32x4 (&r)[16]) {
#pragma unroll
  for (int j = 0; j < 4; ++j) {
    u32x4 v = {pk4_fp8(r[0][j] * WQ_SCALE, r[1][j] * WQ_SCALE, r[2][j] * WQ_SCALE, r[3][j] * WQ_SCALE), pk4_fp8(r[4][j] * WQ_SCALE, r[5][j] * WQ_SCALE, r[6][j] * WQ_SCALE, r[7][j] * WQ_SCALE),
               pk4_fp8(r[8][j] * WQ_SCALE, r[9][j] * WQ_SCALE, r[10][j] * WQ_SCALE, r[11][j] * WQ_SCALE), pk4_fp8(r[12][j] * WQ_SCALE, r[13][j] * WQ_SCALE, r[14][j] * WQ_SCALE, r[15][j] * WQ_SCALE)};
    *(u32x4*)(d.dst + (size_t)j * d.ldk) = v;
  }
}
__device__ __forceinline__ CvtQ cvtq_desc(const float* src, int ldn, unsigned char* dst, int ldk, int k0, int n0) {
  const int kg = threadIdx.x & 7, n = n0 + (threadIdx.x >> 3) * 4;
  CvtQ d; d.src = src + (size_t)(k0 + kg * 16) * ldn + n; d.dst = dst + (size_t)n * ldk + k0 + kg * 16; d.ldn = ldn; d.ldk = ldk; return d;
}
__device__ __forceinline__ void cvtq_tile(const float* src, int ldn, unsigned char* dst, int ldk, int k0, int n0, int nmax = 1 << 30) {
  if (n0 + (int)(threadIdx.x >> 3) * 4 >= nmax) return;
  const CvtQ d = cvtq_desc(src, ldn, dst, ldk, k0, n0); f32x4 r[16]; cvtq_load(d, r); cvtq_store(d, r);
}
__device__ __forceinline__ CvtQ cvt_expert_desc(const P& p, int it) {
  const int e = it / 48, q = it - e * 48;
  if (q < 32) { const int up = q >> 4, qq = q & 15;
    return cvtq_desc((up ? p.w_up : p.w_gate) + (size_t)e * D * FF, FF, (up ? p.Wq_u : p.Wq_g) + (size_t)e * FF * D, D, (qq & 7) * 128, (qq >> 3) * 128);
  }
  const int qq = q - 32;
  return cvtq_desc(p.w_down + (size_t)e * FF * D, D, p.Wq_d + (size_t)e * D * FF, FF, (qq & 1) * 128, (qq >> 1) * 128);
}
__device__ __forceinline__ void cvt_expert_item(const P& p, int it) { const CvtQ d = cvt_expert_desc(p, it); f32x4 r[16]; cvtq_load(d, r); cvtq_store(d, r); }
__device__ __forceinline__ void ph_cvt_experts(const P& p) { WLOOP(w, NE * 48) cvt_expert_item(p, w); }

__device__ __forceinline__ bf16x8 pack8(const f32x16& x, int s) {
  u32x4 r = {pk_bf16(x[8 * s], x[8 * s + 1]), pk_bf16(x[8 * s + 2], x[8 * s + 3]), pk_bf16(x[8 * s + 4], x[8 * s + 5]), pk_bf16(x[8 * s + 6], x[8 * s + 7])};
  return __builtin_bit_cast(bf16x8, r);
}
__device__ __forceinline__ bf16x8 tr_pair(const LAS char* a) {
  const s16x4 lo = __builtin_amdgcn_ds_read_tr16_b64_v4i16((LAS s16x4*)a);
  const s16x4 hi = __builtin_amdgcn_ds_read_tr16_b64_v4i16((LAS s16x4*)(a + 8 * 128));
  return __builtin_shufflevector(lo, hi, 0, 1, 2, 3, 4, 5, 6, 7);
}
__device__ __forceinline__ int next_item(int* ctr, char* smem) {
  volatile int* slot = (volatile int*)(smem + SMEM_BYTES - 16);
  __syncthreads();
  if (threadIdx.x == 0) *slot = atomicAdd(ctr, 1);
  __syncthreads();
  return *slot;
}

__device__ __forceinline__ void compress_item(const P& p, char* smem, int item) {
  const int which = item >> 3, mtile = item & 7;
  const bf16_t* X = which ? p.VC : p.KC; const bf16_t* W1 = which ? p.Wt_c1v : p.Wt_c1k; const bf16_t* Z = p.zrow;
  const float* b1 = p.b1c + which * 128; bf16_t* hid = (bf16_t*)smem;
  gemm2<1>(smem, 2048,
           [=](int r) { const int R = mtile * 256 + r; if (R >= 2040) return Z; const int bg = R / 255, c = R - bg * 255; return X + ((size_t)bg * S + 16 * c) * 64; },
           [=](int n) { return W1 + (size_t)n * 2048; },
           [=](const f32x4 (&acc)[8][4], int r0, int c0) {
             __syncthreads();
#pragma unroll
             for (int nt = 0; nt < 4; ++nt) {
               const f32x4 bv = *(const f32x4*)(b1 + c0 + nt * 16);
#pragma unroll
               for (int mt = 0; mt < 8; ++mt) {
                 float h[4];
#pragma unroll
                 for (int i = 0; i < 4; ++i) { const float a = acc[mt][nt][i] + bv[i]; const float u = 0.7978845608028654f * (a + 0.044715f * a * a * a); h[i] = a - a / (1.f + __expf(2.f * u)); }
                 u32x2 w = {pk_bf16(h[0], h[1]), pk_bf16(h[2], h[3])};
                 *(u32x2*)(hid + (r0 + mt * 16) * 136 + c0 + nt * 16) = w;
               }
             }
           });
  __syncthreads();
  const float* W2 = which ? p.w2_v : p.w2_k;
  const int rl = threadIdx.x >> 3, pt = threadIdx.x & 7;
#pragma unroll 1
  for (int g = 0; g < 8; ++g) {
    const int row = g * 32 + rl, R = mtile * 256 + row;
    float o[8];
#pragma unroll
    for (int d = 0; d < 8; ++d) o[d] = 0.f;
#pragma unroll 2
    for (int n8 = 0; n8 < 16; ++n8) {
      const u32x4 hv4 = *(const u32x4*)(hid + row * 136 + n8 * 8);
#pragma unroll
      for (int k = 0; k < 8; ++k) {
        const float hv = (k & 1) ? __uint_as_float(hv4[k >> 1] & 0xffff0000u) : __uint_as_float(hv4[k >> 1] << 16);
        const f32x4 w0 = *(const f32x4*)(W2 + (n8 * 8 + k) * 64 + pt * 8), w1 = *(const f32x4*)(W2 + (n8 * 8 + k) * 64 + pt * 8 + 4);
        o[0] += hv * w0[0]; o[1] += hv * w0[1]; o[2] += hv * w0[2]; o[3] += hv * w0[3];
        o[4] += hv * w1[0]; o[5] += hv * w1[1]; o[6] += hv * w1[2]; o[7] += hv * w1[3];
      }
    }
    float rs = 1.f;
    if (!which) {
      float ss = 0.f;
#pragma unroll
      for (int d = 0; d < 8; ++d) ss += o[d] * o[d];
      ss += __shfl_xor(ss, 1); ss += __shfl_xor(ss, 2); ss += __shfl_xor(ss, 4);
      rs = rsqrtf(ss * (1.f / 64.f) + EPS);
    }
    if (R < 2040) {
      const int bg = R / 255, c = R - bg * 255;
      bf16_t* orow = (which ? p.vcb : p.kcb) + ((size_t)bg * 256 + c) * 64 + pt * 8;
      float gg[8];
      if (!which) { const f32x4 g0 = *(const f32x4*)(p.g_k_cmp + pt * 8), g1 = *(const f32x4*)(p.g_k_cmp + pt * 8 + 4); gg[0] = g0[0]; gg[1] = g0[1]; gg[2] = g0[2]; gg[3] = g0[3]; gg[4] = g1[0]; gg[5] = g1[1]; gg[6] = g1[2]; gg[7] = g1[3]; }
      else {
#pragma unroll
        for (int k = 0; k < 8; ++k) gg[k] = 1.f;
      }
      u32x4 w = {pk_bf16(o[0] * rs * gg[0], o[1] * rs * gg[1]), pk_bf16(o[2] * rs * gg[2], o[3] * rs * gg[3]), pk_bf16(o[4] * rs * gg[4], o[5] * rs * gg[5]), pk_bf16(o[6] * rs * gg[6], o[7] * rs * gg[7])};
      *(u32x4*)orow = w;
    }
  }
}

template <int MODE, int NSLOT>
__device__ __forceinline__ void nsa_pass(LAS char* kv, const bf16_t* Kg, const bf16_t* Vg, int t_lo, int t_hi, const bf16x8 (&qf)[4], float shf, int si,
                                         unsigned long long selm, f32x16& o0, f32x16& o1, float& l, LAS float* psl  ,
                                         int pos0 = 0, int pstride = 1, int kkmin = 0) {
  const int tid = otid(), lane = tid & 63, wv = __builtin_amdgcn_readfirstlane(tid >> 6), i = lane & 31, h5 = lane >> 5;
  const int ksw = (i >> 1) & 7;
  const int tq = (lane & 15) >> 2, tp = lane & 3, tds = (lane >> 4) & 1, vsw = ((tq >> 1) & 1) << 2;
  const int row_l = lane >> 3, cpos = lane & 7;
  const int kc8 = (cpos ^ ((wv & 1) * 4 + (row_l >> 1))) * 8, vc8 = (cpos ^ (((row_l >> 1) & 1) << 2)) * 8;
  const bf16_t* kgl = Kg + (size_t)(wv * 8 + row_l) * 64 + kc8;
  const bf16_t* vgl = Vg + (size_t)(wv * 8 + row_l) * 64 + vc8;
  auto stage = [&](int t, int buf) {
    LAS char* Ks = kv + buf * 16384 + wv * 1024; LAS char* Vs = Ks + 8192;
#pragma unroll
    for (int q = 0; q < 2; ++q) {
      if (MODE >= 3) {
        int pos = pos0 + pstride * (64 * t + 32 * q + wv * 8 + row_l);
        pos = pos < 0 ? 0 : (pos > S - 1 ? S - 1 : pos);
        __builtin_amdgcn_global_load_lds((const unsigned*)(Kg + (size_t)pos * 64 + kc8), (LAS unsigned*)(Ks + q * 4096), 16, 0, 0);
        __builtin_amdgcn_global_load_lds((const unsigned*)(Vg + (size_t)pos * 64 + vc8), (LAS unsigned*)(Vs + q * 4096), 16, 0, 0);
      } else {
        __builtin_amdgcn_global_load_lds((const unsigned*)(kgl + (size_t)(64 * t + 32 * q) * 64), (LAS unsigned*)(Ks + q * 4096), 16, 0, 0);
        __builtin_amdgcn_global_load_lds((const unsigned*)(vgl + (size_t)(64 * t + 32 * q) * 64), (LAS unsigned*)(Vs + q * 4096), 16, 0, 0);
      }
    }
  };
  float carry = 0.f;
  if (t_lo > t_hi) return;
  float dm16[4] = {0.f, 0.f, 0.f, 0.f}; int dmaxA = 0, dmaxB = 0; const int wq = wv & 3;
  if (MODE == 3) {
#pragma unroll
    for (int rg = 0; rg < 4; ++rg) dm16[rg] = (((wv - h5 - 2 * rg) & 3) == 0) ? 3.f : 2.f;
    dmaxA = si - kkmin < 128 ? si - kkmin : 128;
  }
  if (MODE == 4) { const int lim = si - kkmin; dmaxA = lim < 128 ? lim : 128; dmaxB = lim < 512 ? lim : 512; }
  asm volatile("s_waitcnt vmcnt(0) lgkmcnt(0)" ::: "memory");
  __builtin_amdgcn_s_barrier();
  asm volatile("" ::: "memory");
#pragma unroll
  for (int k = 0; k < NSLOT - 1; ++k) if (t_lo + k <= t_hi) stage(t_lo + k, k);
  for (int t = t_lo; t <= t_hi; ++t) {
    const int buf = (t - t_lo) % NSLOT;
    const int ahead = t_hi - t;
    if (NSLOT == 4 && ahead >= 2) asm volatile("s_waitcnt vmcnt(8)" ::: "memory");
    else if (NSLOT == 4 && ahead == 1) asm volatile("s_waitcnt vmcnt(4)" ::: "memory");
    else asm volatile("s_waitcnt vmcnt(0)" ::: "memory");
    __builtin_amdgcn_s_barrier();
    asm volatile("" ::: "memory");
    if (t + NSLOT - 1 <= t_hi) stage(t + NSLOT - 1, (t + NSLOT - 1 - t_lo) % NSLOT);
    const LAS char* Ks = kv + buf * 16384; const LAS char* Vs = Ks + 8192;
    const bool tsel = MODE == 1 ? ((selm >> t) & 1ull) != 0ull : true;
#pragma unroll
    for (int sub = 0; sub < 2; ++sub) {
      f32x16 sa;
#pragma unroll
      for (int q = 0; q < 16; ++q) sa[q] = 0.f;
      bf16x8 kf[4];
#pragma unroll
      for (int s4 = 0; s4 < 4; ++s4) kf[s4] = *(const LAS bf16x8*)(Ks + (32 * sub + i) * 128 + (((2 * s4 + h5) ^ ksw) << 4));
      __builtin_amdgcn_s_setprio(1);
#pragma unroll
      for (int s4 = 0; s4 < 4; ++s4) sa = MFMA32(kf[s4], qf[s4], sa);
      __builtin_amdgcn_s_setprio(0);
      const int k0 = 64 * t + 32 * sub + 4 * h5;
#pragma unroll
      for (int q = 0; q < 16; ++q) {
        const int kidx = k0 + (q & 3) + 8 * (q >> 2);
        float pv;
        if (MODE >= 3) {
          const int dl = si - kidx;
          const float e = __builtin_amdgcn_exp2f(sa[q] * LOG2E - shf);
          if (MODE == 3) {
            const float cw = (q & 3) ? 1.f : dm16[q >> 2];
            pv = (unsigned)dl <= (unsigned)dmaxA ? cw * e : 0.f;
          } else {
            const bool lo = dl >= 33;
            float cw = (lo && dl <= dmaxA) ? 1.f : 0.f;
            if ((q & 3) == wq) cw += (lo && dl <= dmaxB) ? 1.f : 0.f;
            pv = cw * e;
          }
        } else {
          bool valid;
          if (MODE == 0) valid = 16 * kidx + 31 <= si;
          else if (MODE == 1) valid = tsel && kidx <= si;
          else valid = (unsigned)(si - kidx) <= 511u;
          pv = valid ? __builtin_amdgcn_exp2f(sa[q] * LOG2E - shf) : 0.f;
        }
        l += pv; sa[q] = pv;
      }
      if (MODE == 0) {
#pragma unroll
        for (int rg = 0; rg < 4; ++rg) {
          const float a = 2.f * (sa[4 * rg] + sa[4 * rg + 1] + sa[4 * rg + 2]) + sa[4 * rg + 3];
          const float recv = __shfl_xor(sa[4 * rg + 3], 32);
          const float val = h5 ? a + recv : a + carry;
          carry = recv;
          psl[16 * t + 8 * sub + 2 * rg + h5] = val;
        }
      }
      const bf16x8 pf0 = pack8(sa, 0), pf1 = pack8(sa, 1);
      bf16x8 vf[2][2];
#pragma unroll
      for (int s2 = 0; s2 < 2; ++s2) {
        const LAS char* vb = Vs + (32 * sub + 16 * s2 + 4 * h5 + tq) * 128 + 8 * (tp & 1);
        vf[s2][0] = tr_pair(vb + (((tds * 2 + (tp >> 1)) ^ vsw) << 4));
        vf[s2][1] = tr_pair(vb + (((4 + tds * 2 + (tp >> 1)) ^ vsw) << 4));
      }
      __builtin_amdgcn_s_setprio(1);
#pragma unroll
      for (int s2 = 0; s2 < 2; ++s2) { o0 = MFMA32(vf[s2][0], s2 ? pf1 : pf0, o0); o1 = MFMA32(vf[s2][1], s2 ? pf1 : pf0, o1); }
      __builtin_amdgcn_s_setprio(0);
    }
    __builtin_amdgcn_sched_barrier(0);
  }
}

__device__ __forceinline__ void dilated_item(const P& p, char* smem_, int unit) {
  LAS char* kv = (LAS char*)smem_;
  const int tid = otid(), lane = tid & 63, wv = tid >> 6, i = lane & 31, h5 = lane >> 5;
  const int r4 = unit & 3, ti = (unit >> 2) & 7, hh = (unit >> 5) & 7, b = unit >> 8;
  const size_t hb = (size_t)(b * 8 + hh) * S * 64;
  const int si = ti * 512 + r4 + 4 * wv + 16 * i;
  bf16x8 qf[4];
#pragma unroll
  for (int s4 = 0; s4 < 4; ++s4) qf[s4] = *(const bf16x8*)(p.QA + hb + (size_t)si * 64 + 16 * s4 + 8 * h5);
  f32x16 o0, o1;
#pragma unroll
  for (int q = 0; q < 16; ++q) { o0[q] = 0.f; o1[q] = 0.f; }
  float l = 0.f;
  const float shf = p.smaxv[0] * LOG2E;
  const int pbase = ti * 512 + r4 - 128, ubase = ti * 128 - 512;
  nsa_pass<3, 4>(kv, p.KA + hb, p.VA + hb, 0, 9, qf, shf, 4 * wv + 16 * i + 128, 0ull, o0, o1, l, nullptr, pbase, 1, pbase < 0 ? -pbase : 0);
  nsa_pass<4, 4>(kv, p.KA + hb, p.VA + hb, 0, 9, qf, shf, wv + 4 * i + 512, 0ull, o0, o1, l, nullptr, r4 + 4 * ubase, 4, ubase < 0 ? -ubase : 0);
  l += __shfl_xor(l, 32);
  const float inv = 1.f / l;
  bf16_t* orow = p.mixinb + (size_t)(b * S + si) * D + hh * 64 + 4 * h5;
#pragma unroll
  for (int rg = 0; rg < 4; ++rg) {
    u32x2 w0 = {pk_bf16(o0[4 * rg] * inv, o0[4 * rg + 1] * inv), pk_bf16(o0[4 * rg + 2] * inv, o0[4 * rg + 3] * inv)};
    u32x2 w1 = {pk_bf16(o1[4 * rg] * inv, o1[4 * rg + 1] * inv), pk_bf16(o1[4 * rg + 2] * inv, o1[4 * rg + 3] * inv)};
    *(u32x2*)(orow + 8 * rg) = w0;
    *(u32x2*)(orow + 32 + 8 * rg) = w1;
  }
}

__device__ __forceinline__ void nsa_item(const P& p, char* smem_, int item) {
  LAS char* smem = (LAS char*)smem_;
  LAS char* kv = smem;
  LAS float* pslcw = (LAS float*)(smem + 32768);
  LAS float* invl = (LAS float*)(smem + 32768 + 33280);
  LAS unsigned* msk = (LAS unsigned*)(smem + 32768 + 33280 + 512);
  const int tid = otid(), lane = tid & 63, wv = tid >> 6, i = lane & 31, h5 = lane >> 5;
  const int qt = 127 - (item >> 3), bg = item & 7, b = bg >> 1, g = bg & 1, hq = g * 4 + wv;
  const int s0 = qt * 32, si = s0 + i, cur = s0 >> 6;
  const size_t qoff = ((size_t)(b * 8 + hq) * S + si) * 64 + 8 * h5;
  bf16x8 qf[4];
#pragma unroll
  for (int s4 = 0; s4 < 4; ++s4) qf[s4] = *(const bf16x8*)(p.QN + qoff + 16 * s4);
  const float* gs = p.GS + (size_t)(b * S + si) * 24 + hq * 3;
  const float g0 = gs[0], g1 = gs[1], g2 = gs[2];
  f32x16 oa0, oa1, o0, o1;
#pragma unroll
  for (int q = 0; q < 16; ++q) { o0[q] = 0.f; o1[q] = 0.f; }
  float l = 0.f;
  LAS float* psl = pslcw + (wv * 32 + i) * 65;
  const int ncv = (s0 + 31 - 31) >> 4;
  const int tc_hi = (ncv < 254 ? ncv : 254) >> 6;
#pragma unroll
  for (int k = 0; k < 32; ++k) psl[2 * k + h5] = 0.f;
  nsa_pass<0, 2>(kv, p.kcb + (size_t)bg * 256 * 64, p.vcb + (size_t)bg * 256 * 64, 0, tc_hi, qf, p.smaxv[1] * LOG2E, si, 0ull, o0, o1, l, psl);
  l += __shfl_xor(l, 32);
  {
    const float il = l > 0.f ? 1.f / l : 0.f;
    if (h5 == 0) invl[wv * 32 + i] = il;
    const float sc = g0 * il;
#pragma unroll
    for (int q = 0; q < 16; ++q) { oa0[q] = o0[q] * sc; oa1[q] = o1[q] * sc; o0[q] = 0.f; o1[q] = 0.f; }
  }
  __syncthreads();
  LAS float* scr = pslcw;
  {
    const int q = tid >> 3, jj = tid & 7;
    float tot[8];
#pragma unroll
    for (int k = 0; k < 8; ++k) {
      const int j = jj + 8 * k;
      float v = 0.f;
#pragma unroll
      for (int w4 = 0; w4 < 4; ++w4) v += pslcw[(w4 * 32 + q) * 65 + j] * invl[w4 * 32 + q];
      const bool forced = (j == 0) || (j == cur) || (j == cur - 1);
      tot[k] = forced ? INFINITY : (j <= cur ? v : -INFINITY);
    }
    __syncthreads();
#pragma unroll
    for (int k = 0; k < 8; ++k) scr[q * 65 + jj + 8 * k] = tot[k];
    if (tid < 64) msk[tid] = 0u;
    __syncthreads();
    unsigned lo = 0u, hi = 0u;
#pragma unroll
    for (int k = 0; k < 8; ++k) {
      const int j = jj + 8 * k; const float v = tot[k];
      int rank = 0;
      for (int c = 0; c < 64; ++c) { const float sv = scr[q * 65 + c]; rank += (sv > v) || (sv == v && c < j); }
      if (rank < 16 && j <= cur) { if (j < 32) lo |= 1u << j; else hi |= 1u << (j - 32); }
    }
    if (lo) atomicOr((unsigned*)&msk[q * 2], lo);
    if (hi) atomicOr((unsigned*)&msk[q * 2 + 1], hi);
    __syncthreads();
  }
  const unsigned long long selm = (unsigned long long)msk[i * 2] | ((unsigned long long)msk[i * 2 + 1] << 32);
#pragma unroll
  for (int s4 = 0; s4 < 4; ++s4) qf[s4] = *(const bf16x8*)(p.QR + qoff + 16 * s4);
  const size_t kvoff = (size_t)bg * S * 64;
  l = 0.f;
  nsa_pass<1, 4>(kv, p.KSL + kvoff, p.VSL + kvoff, 0, cur, qf, p.smaxv[2] * LOG2E, si, selm, o0, o1, l, nullptr);
  l += __shfl_xor(l, 32);
  {
    const float sc = g1 / l;
#pragma unroll
    for (int q = 0; q < 16; ++q) { oa0[q] += o0[q] * sc; oa1[q] += o1[q] * sc; o0[q] = 0.f; o1[q] = 0.f; }
  }
  l = 0.f;
  const int tw_lo = s0 >= 511 ? (s0 - 511) >> 6 : 0;
  nsa_pass<2, 4>(kv, p.KW + kvoff, p.VW + kvoff, tw_lo, cur, qf, p.smaxv[3] * LOG2E, si, 0ull, o0, o1, l, nullptr);
  l += __shfl_xor(l, 32);
  {
    const float sc = g2 / l;
#pragma unroll
    for (int q = 0; q < 16; ++q) { oa0[q] += o0[q] * sc; oa1[q] += o1[q] * sc; }
  }
  bf16_t* orow = p.mixinb + (size_t)(b * S + si) * D + 512 + hq * 64 + 4 * h5;
#pragma unroll
  for (int rg = 0; rg < 4; ++rg) {
    u32x2 w0 = {pk_bf16(oa0[4 * rg], oa0[4 * rg + 1]), pk_bf16(oa0[4 * rg + 2], oa0[4 * rg + 3])};
    u32x2 w1 = {pk_bf16(oa1[4 * rg], oa1[4 * rg + 1]), pk_bf16(oa1[4 * rg + 2], oa1[4 * rg + 3])};
    *(u32x2*)(orow + 8 * rg) = w0;
    *(u32x2*)(orow + 32 + 8 * rg) = w1;
  }
}
__device__ __forceinline__ void cvt_queue_item(const P& p, int ci) {
  f32x4 ra[16], rb[16];
  const CvtQ d0 = cvt_expert_desc(p, ci * 4), d1 = cvt_expert_desc(p, ci * 4 + 1), d2 = cvt_expert_desc(p, ci * 4 + 2), d3 = cvt_expert_desc(p, ci * 4 + 3);
  cvtq_load(d0, ra); cvtq_load(d1, rb);
  cvtq_store(d0, ra); cvtq_load(d2, ra);
  cvtq_store(d1, rb); cvtq_load(d3, rb);
  cvtq_store(d2, ra); cvtq_store(d3, rb);
}
__device__ __forceinline__ void ph_attn_a(const P& p, char* smem) {
  for (;;) {
    const int q = next_item(p.ctr + 0, smem);
    if (q >= 16 + 2560) break;
    if (q < 16) { compress_item(p, smem, q); continue; }
    const int j = q - 16, g = j / 5, r = j - g * 5;
    if (r == 0 || r == 3) dilated_item(p, smem, g * 2 + (r == 3)); else cvt_queue_item(p, g * 3 + (r == 1 ? 0 : (r == 2 ? 1 : 2)));
  }
}
__device__ __forceinline__ void ph_attn_b(const P& p, char* smem) {
  for (;;) {
    const int q = next_item(p.ctr + 1, smem);
    if (q >= 2560) break;
    const int g = q / 5, r = q - g * 5;
    if (r == 0 || r == 3) nsa_item(p, smem, g * 2 + (r == 3)); else cvt_queue_item(p, 1536 + g * 3 + (r == 1 ? 0 : (r == 2 ? 1 : 2)));
  }
}

__device__ __forceinline__ void ph_route(const P& p, char* smem) {
  const int lane = threadIdx.x & 63, wv = threadIdx.x >> 6;
  int* hist = (int*)smem;
  __syncthreads();
  hist[threadIdx.x] = 0;
  __syncthreads();
  const int tpb = T / gridDim.x, t0 = blockIdx.x * tpb;
  float bias[4];
#pragma unroll
  for (int i = 0; i < 4; ++i) bias[i] = p.r_bias[lane + 64 * i];
  for (int tt = wv; tt < tpb; tt += 4) {
    const int t = t0 + tt;
    float aff[4], bv[4], ta[4], tb[4];
#pragma unroll
    for (int i = 0; i < 4; ++i) { { const size_t li = (size_t)t * NE + lane + 64 * i; aff[i] = sigmoidf((p.logits[li] + p.logits[li + (size_t)T * NE]) + p.logits[li + (size_t)2 * T * NE]); } bv[i] = aff[i] + bias[i]; ta[i] = bv[i]; tb[i] = -INFINITY; }
#pragma unroll
    for (int o = 16; o; o >>= 1)
#pragma unroll
      for (int i = 0; i < 4; ++i) {
        const float a2 = __shfl_xor(ta[i], o), b2 = __shfl_xor(tb[i], o);
        const float na = fmaxf(ta[i], a2), nb = fmaxf(fminf(ta[i], a2), fmaxf(tb[i], b2));
        ta[i] = na; tb[i] = nb;
      }
    float gs[8];
#pragma unroll
    for (int i = 0; i < 4; ++i) { const float s2 = ta[i] + tb[i]; gs[2 * i] = __shfl(s2, 0); gs[2 * i + 1] = __shfl(s2, 32); }
    unsigned gmask = 0;
#pragma unroll
    for (int g = 0; g < 8; ++g) {
      int rank = 0;
#pragma unroll
      for (int i = 0; i < 8; ++i) rank += (gs[i] > gs[g]) || (gs[i] == gs[g] && i < g);
      if (rank < 4) gmask |= 1u << g;
    }
#pragma unroll
    for (int i = 0; i < 4; ++i) if (!((gmask >> (2 * i + (lane >> 5))) & 1u)) bv[i] = -INFINITY;
    unsigned key[4];
#pragma unroll
    for (int i = 0; i < 4; ++i) { const unsigned u = __float_as_uint(bv[i]); key[i] = (u & 0x80000000u) ? ~u : (u | 0x80000000u); }
    unsigned thr = 0u;
#pragma unroll 1
    for (int bit = 31; bit >= 0; --bit) {
      const unsigned trial = thr | (1u << bit);
      int c = 0;
#pragma unroll
      for (int i = 0; i < 4; ++i) c += __builtin_popcountll(__ballot(key[i] >= trial));
      if (c >= 8) thr = trial;
    }
    int ngt = 0;
#pragma unroll
    for (int i = 0; i < 4; ++i) ngt += __builtin_popcountll(__ballot(key[i] > thr));
    const int need = 8 - ngt;
    const unsigned long long ltmask = (1ull << lane) - 1ull;
    int eqbefore = 0, selbefore = 0;
    bool sel[4]; int slot[4];
#pragma unroll
    for (int i = 0; i < 4; ++i) {
      const unsigned long long eqm = __ballot(key[i] == thr);
      const bool s = key[i] > thr || (key[i] == thr && eqbefore + __builtin_popcountll(eqm & ltmask) < need);
      eqbefore += __builtin_popcountll(eqm);
      const unsigned long long sm = __ballot(s);
      sel[i] = s; slot[i] = selbefore + __builtin_popcountll(sm & ltmask);
      selbefore += __builtin_popcountll(sm);
    }
    float part = 0.f;
#pragma unroll
    for (int i = 0; i < 4; ++i) part += sel[i] ? aff[i] : 0.f;
    const float ssum = wave_sum(part);
#pragma unroll
    for (int i = 0; i < 4; ++i)
      if (sel[i]) {
        const int e = lane + 64 * i;
        p.eidx[t * 8 + slot[i]] = e;
        p.gates[t * 8 + slot[i]] = aff[i] / ssum * 2.5f;
        p.pos[t * 8 + slot[i]] = atomicAdd(&hist[e], 1);
      }
  }
  __syncthreads();
  p.bhist[(size_t)blockIdx.x * NE + threadIdx.x] = hist[threadIdx.x];
}
__device__ __forceinline__ void ph_fill(const P& p, char* smem) {
  int* soff = (int*)smem;
  int* wsum = soff + 260;
  int* sbase = soff + 272;
  const int tid = threadIdx.x, lane = tid & 63, wv = tid >> 6;
  __syncthreads();
  int c = 0, before = 0;
  for (int bb = 0; bb < (int)gridDim.x; ++bb) { const int v = p.bhist[(size_t)bb * NE + tid]; c += v; before += (bb < (int)blockIdx.x) ? v : 0; }
  int incl = c;
#pragma unroll
  for (int o = 1; o < 64; o <<= 1) { const int v = __shfl_up(incl, o); if (lane >= o) incl += v; }
  if (lane == 63) wsum[wv] = incl;
  __syncthreads();
  int base = 0;
  for (int i = 0; i < wv; ++i) base += wsum[i];
  soff[tid] = base + incl - c;
  sbase[tid] = base + incl - c + before;
  if (tid == 255) soff[256] = base + incl;
  __syncthreads();
  if (blockIdx.x == 0) {
    p.off[tid] = soff[tid]; p.cnt[tid] = c;
    if (tid == 255) p.off[256] = soff[256];
  }
  if (blockIdx.x == 1) {
    const int x = tid >> 5, i = tid & 31, e = x + 8 * i;
    const int tl = (soff[e + 1] - soff[e] + 255) >> 8;
    int inc2 = tl;
#pragma unroll
    for (int o = 1; o < 32; o <<= 1) { const int v = __shfl_up(inc2, o, 32); if (i >= o) inc2 += v; }
    p.tstart[x * 33 + i] = inc2 - tl;
    if (i == 31) p.tstart[x * 33 + 32] = inc2;
  }
  const int tpb = T / gridDim.x, a0 = blockIdx.x * tpb * 8;
  for (int a = a0 + tid; a < a0 + tpb * 8; a += 256) p.sorted[sbase[p.eidx[a]] + p.pos[a]] = a;
}

template <int NTL, class F>
__device__ __forceinline__ void moe_grid(const P& p, F body) {
  const int xcd = blockIdx.x & 7, lb = blockIdx.x >> 3, nlb = gridDim.x >> 3;
  const int* ts = p.tstart + xcd * 33;
  const int total = ts[32] * NTL;
  int i = 0;
  for (int j = lb; j < total; j += nlb) {
    while (ts[i + 1] * NTL <= j) ++i;
    const int tiles = ts[i + 1] - ts[i], rem = j - ts[i] * NTL;
    body(xcd + 8 * i, rem / tiles, rem % tiles);
  }
}
__device__ __forceinline__ const unsigned char* gu_rowq(const unsigned char* Wg, const unsigned char* Wu, int f0, int n) {
  const int wn = n >> 6, wi = n & 63;
  return (wi >= 32 ? Wu : Wg) + (size_t)(f0 + wn * 32 + (wi & 31)) * D;
}
__device__ __forceinline__ void ph_moe_gu(const P& p, char* smem) {
  moe_grid<4>(p, [&](int e, int ntile, int mtile) {
    const int cnt = p.cnt[e] - mtile * 256; const int* srt = p.sorted + p.off[e] + mtile * 256;
    const unsigned char* A = p.h2q; const unsigned char* Wg = p.Wq_g + (size_t)e * FF * D; const unsigned char* Wu = p.Wq_u + (size_t)e * FF * D; unsigned char* H = p.Hq;
    const float* gates = p.gates; const unsigned char* Z = (const unsigned char*)p.zrow;
    gemm2q(smem, D, [=](int r) { return r < cnt ? A + (size_t)(srt[r] >> 3) * D : Z; }, [=](int n) { return gu_rowq(Wg, Wu, ntile * 64, n); },
           [=](const f32x4 (&acc)[8][4], int r0, int c0, int) {
             const int wn = c0 >> 6, l4 = (c0 & 63) >> 2;
#pragma unroll
             for (int mt = 0; mt < 8; ++mt) {
               const int r = r0 + mt * 16; const bool ok = r < cnt; const int a = ok ? srt[r] : 0;
               const float sc = ok ? gates[a] * (HQ_SCALE / (WQ_SCALE * WQ_SCALE)) : 0.f;
               unsigned d[2];
#pragma unroll
               for (int q = 0; q < 2; ++q) {
                 const f32x4 g = acc[mt][q], u = acc[mt][q + 2];
                 float h[4];
#pragma unroll
                 for (int i = 0; i < 4; ++i) h[i] = clamp_e4m3(silu(g[i] * (1.f / WQ_SCALE)) * u[i] * (sc * WQ_SCALE));
                 d[q] = pk4_fp8(h[0], h[1], h[2], h[3]);
               }
               const bool b0 = l4 & 1;
               const unsigned send = b0 ? d[0] : d[1], recv = __shfl_xor(send, 16);
               u32x2 w = b0 ? (u32x2){recv, d[1]} : (u32x2){d[0], recv};
               if (ok) *(u32x2*)(H + (size_t)a * FF + ntile * 64 + wn * 32 + (b0 ? 16 + 4 * (l4 - 1) : 4 * l4)) = w;
             }
           }, 0, cnt <= 128);
  });
}
__device__ __forceinline__ void ph_moe_d(const P& p, char* smem) {
  moe_grid<4>(p, [&](int e, int ntp, int mtile) {
    const int cnt = p.cnt[e] - mtile * 256; const int* srt = p.sorted + p.off[e] + mtile * 256;
    const unsigned char* A = p.Hq; const unsigned char* W = p.Wq_d + (size_t)e * D * FF + (size_t)ntp * 256 * FF; unsigned char* Yq = p.Yq; const unsigned char* Z = (const unsigned char*)p.zrow;
    const int tid_ = otid(), lrow = ((tid_ >> 7) & 1) * 128 + (tid_ & 15);
    LAS int* ridt = (LAS int*)((LAS char*)smem + 3 * G2_STAGE);
    __syncthreads();
    ridt[tid_] = tid_ < cnt ? srt[tid_] : -1;
    gemm2q<2>(smem, FF, [=](int r) { return r < cnt ? A + (size_t)srt[r] * FF : Z; }, [=](int n) { return W + (size_t)n * FF; },
           [=](const f32x4 (&acc)[8][4], int r0, int c0, int rp) {
             const int wn64 = c0 & ~63, l4 = (c0 & 63) >> 2;
             const float s = YQ_SCALE / (WQ_SCALE * HQ_SCALE);
#pragma unroll
             for (int mt = 0; mt < 8; ++mt) {
               const int rd = ridt[lrow + mt * 16]; const bool ok = rd >= 0;
               unsigned dq[4];
#pragma unroll
               for (int nt = 0; nt < 4; ++nt) { const f32x4 a = acc[mt][nt] * s; dq[nt] = pk4_fp8(clamp_e4m3(a[0]), clamp_e4m3(a[1]), clamp_e4m3(a[2]), clamp_e4m3(a[3])); }
               { u32x2v r = __builtin_amdgcn_permlane16_swap(dq[0], dq[1], false, false); dq[0] = r.x; dq[1] = r.y; r = __builtin_amdgcn_permlane16_swap(dq[2], dq[3], false, false); dq[2] = r.x; dq[3] = r.y;
                 r = __builtin_amdgcn_permlane32_swap(dq[0], dq[2], false, false); dq[0] = r.x; dq[2] = r.y; r = __builtin_amdgcn_permlane32_swap(dq[1], dq[3], false, false); dq[1] = r.x; dq[3] = r.y; }
               if (ok) *(u32x4*)(Yq + (size_t)rd * D + (ntp * 2 + rp) * 128 + wn64 + 16 * l4) = (u32x4){dq[0], dq[1], dq[2], dq[3]};
               asm volatile("" ::: "memory");
             }
           }, (size_t)128 * FF, cnt <= 128);
  });
}
__device__ __forceinline__ void ph_combine(const P& p) {
  WLOOP(w, T / 4) {
    const int tid_ = otid(), t = w * 4 + (tid_ >> 6), c = (tid_ & 63) * 16, b = t / S;
    float acc[16];
#pragma unroll
    for (int i = 0; i < 16; ++i) acc[i] = 0.f;
#pragma unroll
    for (int k = 0; k < 8; ++k) {
      const u32x4 v = *(const u32x4*)(p.Yq + ((size_t)t * 8 + k) * D + c);
#pragma unroll
      for (int i = 0; i < 4; ++i) {
        const f32x2 lo = __builtin_amdgcn_cvt_pk_f32_fp8((int)v[i], false), hi = __builtin_amdgcn_cvt_pk_f32_fp8((int)v[i], true);
        acc[4 * i] += lo[0]; acc[4 * i + 1] += lo[1]; acc[4 * i + 2] += hi[0]; acc[4 * i + 3] += hi[1];
      }
    }
    const bf16_t* ys = p.Ys + (size_t)t * D + c; const float* gt = p.mod + b * 6 * D + 5 * D + c; const bf16_t* x1 = (const bf16_t*)p.x1 + (size_t)t * D + c; float* o = p.out + (size_t)t * D + c;
#pragma unroll
    for (int h = 0; h < 4; ++h) {
      const u32x2 sv = *(const u32x2*)(ys + 4 * h);
      const float s0 = __uint_as_float(sv.x << 16), s1 = __uint_as_float(sv.x & 0xffff0000u), s2 = __uint_as_float(sv.y << 16), s3 = __uint_as_float(sv.y & 0xffff0000u);
      const u32x2 xq = *(const u32x2*)(x1 + 4 * h);
      const f32x4 xv = {__uint_as_float(xq.x << 16), __uint_as_float(xq.x & 0xffff0000u), __uint_as_float(xq.y << 16), __uint_as_float(xq.y & 0xffff0000u)}, gv = *(const f32x4*)(gt + 4 * h);
      f32x4 r = {xv[0] + gv[0] * (s0 + acc[4 * h] * (1.f / YQ_SCALE)), xv[1] + gv[1] * (s1 + acc[4 * h + 1] * (1.f / YQ_SCALE)),
                 xv[2] + gv[2] * (s2 + acc[4 * h + 2] * (1.f / YQ_SCALE)), xv[3] + gv[3] * (s3 + acc[4 * h + 3] * (1.f / YQ_SCALE))};
      *(f32x4*)(o + 4 * h) = r;
    }
  }
}


#define XB_TMO      128
#define XB_XCNT(j)  (256  + 64 * (j))
#define XB_XSUB(j)  (1280 + 64 * (j))
#define XB_XGEN(j)  (2304 + 64 * (j))
#define XB_TOP      3328
#define XB_TOPGEN   3392
#define XCD_BAR_WORDS 3456
#define XB_SPIN_CAP (1u << 22)
__device__ __forceinline__ unsigned xb_ld(unsigned* p)              { return __hip_atomic_load(p, __ATOMIC_RELAXED, __HIP_MEMORY_SCOPE_AGENT); }
__device__ __forceinline__ unsigned xb_add(unsigned* p, unsigned v) { return __hip_atomic_fetch_add(p, v, __ATOMIC_RELAXED, __HIP_MEMORY_SCOPE_AGENT); }
__device__ __forceinline__ unsigned xb_xcc_id() { return (unsigned)__builtin_amdgcn_s_getreg((3 << 11) | 20) & 0xFu; }
#define XB_SPIN(cond, bar) do { unsigned _sp = 0; while (cond) { __builtin_amdgcn_s_sleep(1); \
    if ((++_sp & 255u) == 0u) { if (xb_ld(&(bar)[XB_TMO])) break; if (_sp > XB_SPIN_CAP) { atomicAdd(&(bar)[XB_TMO], 1u); break; } } } } while (0)
struct XcdBarrier { unsigned* bar; unsigned x; volatile LAS unsigned* st; };
__device__ __forceinline__ XcdBarrier xcd_barrier_post(unsigned* bar, volatile LAS unsigned* st) {
  XcdBarrier b; b.bar = bar; b.x = xb_xcc_id(); b.st = st;
  if (threadIdx.x == 0) (void)xb_add(&bar[XB_XCNT(b.x)], 1u);
  return b;
}
__device__ __forceinline__ void xcd_barrier_complete(unsigned* bar, unsigned x, unsigned& nloc, unsigned& nx) {
  const unsigned G = gridDim.x * gridDim.y * gridDim.z;
  unsigned sum, cnt, mine, sp = 0u;
  for (;;) {
    sum = 0u; cnt = 0u; mine = 0u;
#pragma unroll
    for (unsigned j = 0; j < 16; ++j) { const unsigned c = xb_ld(&bar[XB_XCNT(j)]); sum += c; cnt += (c > 0u) ? 1u : 0u; mine = (j == x) ? c : mine; }
    if (sum == G) break;
    __builtin_amdgcn_s_sleep(1);
    if ((++sp & 255u) == 0u) { if (xb_ld(&bar[XB_TMO])) break; if (sp > XB_SPIN_CAP) { atomicAdd(&bar[XB_TMO], 1u); break; } }
  }
  nloc = mine > 0u ? mine : 1u; nx = cnt > 0u ? cnt : 1u;
}
__device__ __forceinline__ void xcd_barrier(const XcdBarrier& b) {
  asm volatile("s_waitcnt vmcnt(0)" ::: "memory");
  __syncthreads();
  if (threadIdx.x == 0) {
    unsigned* bar = b.bar;
    __builtin_amdgcn_s_waitcnt(0);
    unsigned nloc = b.st[0], nx = b.st[1];
    if (nloc == 0u) { xcd_barrier_complete(bar, b.x, nloc, nx); b.st[0] = nloc; b.st[1] = nx; }
    const unsigned old = xb_add(&bar[XB_XSUB(b.x)], 1u);
    const unsigned gen = old / nloc;
    if (old + 1u == (gen + 1u) * nloc) {
      __builtin_amdgcn_fence(__ATOMIC_RELEASE, "agent");
      asm volatile("s_waitcnt vmcnt(0)" ::: "memory");
      const unsigned og = xb_add(&bar[XB_TOP], 1u);
      const unsigned tg = og / nx;
      if (og + 1u == (tg + 1u) * nx) xb_add(&bar[XB_TOPGEN], 1u);
      else XB_SPIN(xb_ld(&bar[XB_TOPGEN]) == tg, bar);
      __builtin_amdgcn_fence(__ATOMIC_ACQUIRE, "agent");
      xb_add(&bar[XB_XGEN(b.x)], 1u);
      asm volatile("s_waitcnt vmcnt(0)" ::: "memory");
    } else {
      XB_SPIN(xb_ld(&bar[XB_XGEN(b.x)]) == gen, bar);
      __builtin_amdgcn_fence(__ATOMIC_ACQUIRE, "agent");
      asm volatile("s_waitcnt vmcnt(0)" ::: "memory");
    }
  }
  __syncthreads();
}

__global__ void __launch_bounds__(256, 2) mega(P p) {
  extern __shared__ __attribute__((aligned(16))) char smem[];
  {
    volatile LAS unsigned* st0 = (volatile LAS unsigned*)((LAS char*)smem + SMEM_BYTES - 32);
    if (threadIdx.x == 0) { st0[0] = 0u; st0[1] = 0u; }
    __syncthreads();
  }
  const XcdBarrier xb = xcd_barrier_post(p.bar, (volatile LAS unsigned*)((LAS char*)smem + SMEM_BYTES - 32));
  ph_ada(p, smem); ph_rope_tab(p);
  { int ib = 0;
    for (int it = (int)blockIdx.x; it < 8 * 23; it += gridDim.x) cvtq_tile(p.w_in, INC, p.Wq_in, D, (it & 7) * 128, (it >> 3) * 128, INC);
    ib = (8 * 23) % gridDim.x; cvt_matrix<false>(p.w_out, p.Wt_out, D, D, ib);
    cvt_matrix<false>(p.w_router, p.Wt_rth, D, NE, ib); cvt_matrix<true>(p.w_router, p.Wt_rtl, D, NE, ib);
    cvt_matrix<false>(p.w1_k, p.Wt_c1k, 2048, 128, ib); cvt_matrix<false>(p.w1_v, p.Wt_c1v, 2048, 128, ib);
    cvt_matrix<false>(p.ws_gate, p.Wt_sg, D, FF, ib); cvt_matrix<false>(p.ws_up, p.Wt_su, D, FF, ib); cvt_matrix<false>(p.ws_down, p.Wt_sd, FF, D, ib); }
  if (blockIdx.x == gridDim.x - 4) { for (int i = threadIdx.x; i < 2048; i += 256) p.zrow[i] = 0; }
  if (blockIdx.x == gridDim.x - 1) {
    const int which = threadIdx.x >> 7, n = threadIdx.x & 127;
    const float* pe = which ? p.pe_v : p.pe_k; const float* w1 = which ? p.w1_v : p.w1_k;
    float a = 0.f;
    for (int k = 0; k < 2048; ++k) a += pe[k] * w1[(size_t)k * 128 + n];
    p.b1c[threadIdx.x] = a;
  }
  if (blockIdx.x == gridDim.x - 2) {
    for (int i = threadIdx.x; i < 8 * 64; i += 256) { p.kcb[((size_t)(i >> 6) * 256 + 255) * 64 + (i & 63)] = 0; p.vcb[((size_t)(i >> 6) * 256 + 255) * 64 + (i & 63)] = 0; }
  }
  if (blockIdx.x == gridDim.x - 3) {
    p.cnt[threadIdx.x] = 0;
    if (threadIdx.x < 8) p.ctr[threadIdx.x] = 0;
    if (threadIdx.x < 64) {
      const int ln = threadIdx.x;
      const float a = wave_max(fabsf(p.g_q_dil[ln])), bq = wave_max(fabsf(p.g_k_dil[ln])), c = wave_max(fabsf(p.g_q_nsa[ln]));
      const float d1 = wave_max(fabsf(p.g_k_cmp[ln])), d2 = wave_max(fabsf(p.g_k_slc[ln])), d3 = wave_max(fabsf(p.g_k_win[ln]));
      if (ln == 0) { p.smaxv[0] = 8.f * a * bq; p.smaxv[1] = 8.f * c * d1; p.smaxv[2] = 8.f * c * d2; p.smaxv[3] = 8.f * c * d3; }
    }
  }
  xcd_barrier(xb);
  ph_norm_mod<false>(p.x, p.g_mix, p.mod, 0, D, nullptr, p.h1q);
  xcd_barrier(xb);
  ph_proj(p, smem);
  xcd_barrier(xb);
  ph_attn_a(p, smem);
  xcd_barrier(xb);
  ph_attn_b(p, smem);
  xcd_barrier(xb);
  ph_outproj(p, smem);
  xcd_barrier(xb);
  if (DUP == 10) { ph_outproj_abl<0>(p, smem); xcd_barrier(xb); }
  if (DUP == 11) { ph_outproj_abl<1>(p, smem); xcd_barrier(xb); }
  if (DUP == 12) { ph_outproj_abl<2>(p, smem); xcd_barrier(xb); }
  if (DUP == 13) { ph_outproj_abl<3>(p, smem); xcd_barrier(xb); }
  ph_norm_mod<true, true>(p.x1, p.g_ffn, p.mod, 3 * D, 4 * D, p.h2s, p.h2q);
  xcd_barrier(xb);
  ph_router_shared_gu(p, smem);
  xcd_barrier(xb);
  ph_route(p, smem); ph_shared_d(p, smem);
  xcd_barrier(xb);
  ph_fill(p, smem);
  xcd_barrier(xb);
  ph_moe_gu(p, smem);
  xcd_barrier(xb);
  ph_moe_d(p, smem);
  xcd_barrier(xb);
  ph_combine(p);
}
}

extern "C" void kernel_launch(void* const* d_in, const int* in_sizes, int n_in, void* d_out, int out_size, void* d_ws, size_t ws_size,
                              hipStream_t stream) {
  P p{};
  const float** f = (const float**)d_in;
  p.x = f[0]; p.c = f[1]; p.w_ada = f[2]; p.b_ada = f[3]; p.g_mix = f[4]; p.g_ffn = f[5]; p.w_in = f[6]; p.g_q_dil = f[7]; p.g_k_dil = f[8];
  p.g_q_nsa = f[9]; p.g_k_cmp = f[10]; p.g_k_slc = f[11]; p.g_k_win = f[12]; p.pe_k = f[13]; p.w1_k = f[14]; p.w2_k = f[15]; p.pe_v = f[16];
  p.w1_v = f[17]; p.w2_v = f[18]; p.w_out = f[19]; p.w_router = f[20]; p.r_bias = f[21]; p.w_gate = f[22]; p.w_up = f[23]; p.w_down = f[24];
  p.ws_gate = f[25]; p.ws_up = f[26]; p.ws_down = f[27];
  p.out = (float*)d_out;
  char* w = (char*)d_ws; size_t o = 0;
  auto alloc = [&](size_t bytes) { void* r = w + o; o += (bytes + 255) & ~(size_t)255; return r; };
  p.mod = (float*)alloc(4 * 6 * D * 4);
  p.rope = (float*)alloc(S * 16 * 4);
  p.selmask = (unsigned long long*)alloc((size_t)T * 2 * 8);
  p.eidx = (int*)alloc(T * 8 * 4); p.gates = (float*)alloc(T * 8 * 4);
  p.cnt = (int*)alloc(NE * 4); p.off = (int*)alloc((NE + 1) * 4); p.pos = (int*)alloc(T * 8 * 4); p.sorted = (int*)alloc(T * 8 * 4);
  p.tstart = (int*)alloc(8 * 33 * 4);
  p.smaxv = (float*)alloc(64);
  p.b1c = (float*)alloc(256 * 4);
  p.ctr = (int*)alloc(64);
  p.kcb = (bf16_t*)alloc(8 * 256 * 64 * 2); p.vcb = (bf16_t*)alloc(8 * 256 * 64 * 2);
  p.GS = (float*)alloc((size_t)T * 24 * 4);
  p.QA = (bf16_t*)alloc((size_t)T * 512 * 2); p.KA = (bf16_t*)alloc((size_t)T * 512 * 2); p.VA = (bf16_t*)alloc((size_t)T * 512 * 2);
  p.QN = (bf16_t*)alloc((size_t)T * 512 * 2); p.QR = (bf16_t*)alloc((size_t)T * 512 * 2);
  p.KC = (bf16_t*)alloc((size_t)T * 128 * 2); p.VC = (bf16_t*)alloc((size_t)T * 128 * 2);
  p.KSL = (bf16_t*)alloc((size_t)T * 128 * 2); p.VSL = (bf16_t*)alloc((size_t)T * 128 * 2);
  p.KW = (bf16_t*)alloc((size_t)T * 128 * 2); p.VW = (bf16_t*)alloc((size_t)T * 128 * 2);
  p.logits = (float*)alloc((size_t)3 * T * NE * 4);
  p.x1 = (float*)alloc((size_t)T * D * 4);
  p.mixinb = (bf16_t*)alloc((size_t)T * D * 2);
  p.h1b = (bf16_t*)alloc((size_t)T * D * 2);
  p.h2s = (bf16_t*)alloc((size_t)T * 2 * D * 2);
  p.Hs = (bf16_t*)alloc((size_t)T * FF * 2);
  p.Ys = (bf16_t*)alloc((size_t)T * D * 2);
  p.bar = (unsigned*)alloc(XCD_BAR_WORDS * 4);
  p.bhist = (int*)alloc((size_t)2048 * NE * 4);
  p.Wt_c1k = (bf16_t*)alloc((size_t)128 * 2048 * 2); p.Wt_c1v = (bf16_t*)alloc((size_t)128 * 2048 * 2);
  p.zrow = (bf16_t*)alloc(2048 * 2);
  p.Wt_in = (bf16_t*)alloc((size_t)2944 * D * 2);
  p.Wt_out = (bf16_t*)alloc((size_t)D * D * 2);
  p.Wt_rth = (bf16_t*)alloc((size_t)NE * D * 2); p.Wt_rtl = (bf16_t*)alloc((size_t)NE * D * 2);
  p.Wt_sg = (bf16_t*)alloc((size_t)FF * D * 2); p.Wt_su = (bf16_t*)alloc((size_t)FF * D * 2); p.Wt_sd = (bf16_t*)alloc((size_t)D * FF * 2);
  p.Wq_g = (unsigned char*)alloc((size_t)NE * FF * D); p.Wq_u = (unsigned char*)alloc((size_t)NE * FF * D); p.Wq_d = (unsigned char*)alloc((size_t)NE * D * FF);
  p.h2q = (unsigned char*)alloc((size_t)T * D); p.h1q = (unsigned char*)alloc((size_t)T * D); p.Wq_in = (unsigned char*)alloc((size_t)2944 * D); p.Hq = (unsigned char*)alloc((size_t)T * 8 * FF);
  p.Yq = (unsigned char*)alloc((size_t)T * 8 * D);
  (void)hipMemsetAsync(p.bar, 0, XCD_BAR_WORDS * 4, stream);
  static int grid_blocks = 0;
  if (!grid_blocks) {
    int dev = 0, cus = 0, per_cu = 0;
    (void)hipGetDevice(&dev);
    (void)hipDeviceGetAttribute(&cus, hipDeviceAttributeMultiprocessorCount, dev);
    (void)hipOccupancyMaxActiveBlocksPerMultiprocessor(&per_cu, mega, 256, SMEM_BYTES);
    if (per_cu > 2) per_cu = 2;
    if (per_cu < 1) per_cu = 1;
    grid_blocks = cus * per_cu;
  }
  void* args[] = {&p};
  hipError_t e = hipLaunchCooperativeKernel((void*)mega, dim3(grid_blocks), dim3(256), args, SMEM_BYTES, stream);
  if (e != hipSuccess) fprintf(stderr, "cooperative launch failed: %s (grid %d)\n", hipGetErrorString(e), grid_blocks);
}
```

```cpp
#include <hip/hip_runtime.h>
#include <hip/hip_cooperative_groups.h>
#include <stdint.h>
#include <cstdio>
namespace cg = cooperative_groups;

namespace {
constexpr int D = 1024, NB = 4, S = 4096, T = NB * S, HD = 64;
constexpr int INC = 2840;
constexpr int C_QA = 0, C_KA = 512, C_VA = 1024, C_QB = 1536, C_KC = 2048, C_VC = 2176, C_KSL = 2304, C_VSL = 2432,
              C_KW = 2560, C_VW = 2688, C_GB = 2816;
constexpr int NC = 255, NE = 256, TOPK = 8, FF = 256;
constexpr float EPS = 1e-6f;
#ifndef DUP
#define DUP 0
#endif
constexpr int SMEM_BYTES = 74 * 1024;
typedef unsigned short bf16_t;
typedef short bf16x8 __attribute__((ext_vector_type(8)));
typedef float f32x4 __attribute__((ext_vector_type(4)));
typedef unsigned u32x4 __attribute__((ext_vector_type(4)));
typedef unsigned u32x2 __attribute__((ext_vector_type(2)));
typedef __bf16 bf2_t __attribute__((ext_vector_type(2)));
typedef float f32x2 __attribute__((ext_vector_type(2)));
typedef float f32x16 __attribute__((ext_vector_type(16)));
typedef short s16x4 __attribute__((ext_vector_type(4)));
#define LAS __attribute__((address_space(3)))
#define MFMA32(a, b, c) __builtin_amdgcn_mfma_f32_32x32x16_bf16((a), (b), (c), 0, 0, 0)
constexpr float LOG2E = 1.4426950408889634f;

struct P {
  const float *x, *c, *w_ada, *b_ada, *g_mix, *g_ffn, *w_in, *g_q_dil, *g_k_dil, *g_q_nsa, *g_k_cmp, *g_k_slc, *g_k_win;
  const float *pe_k, *w1_k, *w2_k, *pe_v, *w1_v, *w2_v, *w_out, *w_router, *r_bias, *w_gate, *w_up, *w_down, *ws_gate, *ws_up, *ws_down;
  float* out;
  float *mod, *rope, *h1, *proj, *qrope, *kcmp, *vcmp, *ocmp, *oslc, *owin, *mixin, *x1, *h2, *logits, *gates, *hs_g, *hs, *shared, *Hbuf;
  unsigned long long* selmask;
  int *eidx, *cnt, *off, *pos, *sorted, *tstart;
  bf16_t *h1b, *h2s, *mixinb, *Hb, *Hs, *Ybuf, *Ys;
  bf16_t *QA, *KA, *VA, *QN, *QR, *KC, *VC, *KSL, *VSL, *KW, *VW;
  float *GS, *smaxv, *b1c;
  bf16_t *kcb, *vcb;
  int* ctr;
  int* bhist;
  unsigned char *h2q, *Hq, *Wq_g, *Wq_u, *Wq_d, *h1q, *Wq_in, *Yq, *mixq, *Wq_out;
  unsigned* bar;
  bf16_t *zrow, *Wt_in, *Wt_out, *Wt_rth, *Wt_rtl, *Wt_sg, *Wt_su, *Wt_sd, *Wt_c1k, *Wt_c1v, *Wt_g, *Wt_u, *Wt_d;
};

#define WLOOP(w, n) for (int w = blockIdx.x; w < (n); w += gridDim.x)

__device__ __forceinline__ int otid() { int t = threadIdx.x; asm volatile("" : "+v"(t)); return t; }
__device__ __forceinline__ unsigned pk_bf16(float lo, float hi) {
  f32x2 v = {lo, hi};
  bf2_t r = __builtin_convertvector(v, bf2_t);
  return __builtin_bit_cast(unsigned, r);
}
__device__ __forceinline__ float clamp_e4m3(float v) { return __builtin_amdgcn_fmed3f(v, -448.f, 448.f); }
__device__ __forceinline__ unsigned pk4_fp8(float a, float b, float c, float d) {
  int t = __builtin_amdgcn_cvt_pk_fp8_f32(a, b, 0, false);
  t = __builtin_amdgcn_cvt_pk_fp8_f32(c, d, t, true);
  return (unsigned)t;
}
constexpr float WQ_SCALE = 64.f, HQ_SCALE = 8.f, YQ_SCALE = 16.f, MQ_SCALE = 16.f;
__device__ __forceinline__ float bf16_to_f32(unsigned short b) { return __uint_as_float((unsigned)b << 16); }
__device__ __forceinline__ float bf16_round(float v) { return __uint_as_float(pk_bf16(v, 0.f) << 16); }
__device__ __forceinline__ float silu(float v) { return v / (1.f + expf(-v)); }
__device__ __forceinline__ float sigmoidf(float v) { return 1.f / (1.f + expf(-v)); }
__device__ __forceinline__ float wave_sum(float v) { for (int o = 32; o; o >>= 1) v += __shfl_xor(v, o); return v; }
__device__ __forceinline__ float wave_max(float v) { for (int o = 32; o; o >>= 1) v = fmaxf(v, __shfl_xor(v, o)); return v; }

__device__ __forceinline__ void ph_ada(const P& p, char* smem) {
  float* sc = (float*)smem;
  f32x4* red = (f32x4*)(smem + 16384);
  bool loaded = false;
  WLOOP(w, 6 * D / 32) {
    const int tid = threadIdx.x, kg = tid >> 3, cl = tid & 7, j0 = w * 32 + cl * 4;
    __syncthreads();
    if (!loaded) { for (int i = tid; i < 4 * D; i += 256) sc[i] = silu(p.c[i]); loaded = true; __syncthreads(); }
    f32x4 acc[4];
#pragma unroll
    for (int b = 0; b < 4; ++b) acc[b] = (f32x4){0.f, 0.f, 0.f, 0.f};
#pragma unroll 8
    for (int it = 0; it < 32; ++it) {
      const int k = kg + 32 * it;
      const f32x4 wv = *(const f32x4*)(p.w_ada + (size_t)k * 6 * D + j0);
#pragma unroll
      for (int b = 0; b < 4; ++b) acc[b] += wv * sc[b * D + k];
    }
#pragma unroll
    for (int b = 0; b < 4; ++b) red[(kg * 8 + cl) * 4 + b] = acc[b];
    __syncthreads();
    if (tid < 128) {
      const int b = tid >> 5, c = tid & 31;
      float s = p.b_ada[w * 32 + c];
      for (int g = 0; g < 32; ++g) s += ((const float*)&red[(g * 8 + (c >> 2)) * 4 + b])[c & 3];
      p.mod[b * 6 * D + w * 32 + c] = s;
    }
  }
}
__device__ __forceinline__ void ph_rope_tab(const P& p) {
  WLOOP(w, S * 8 / 256) {
    int i = w * 256 + threadIdx.x;
    int pos = i >> 3, f = i & 7;
    double ang = (double)pos * pow(500000.0, -(double)f / 8.0);
    p.rope[i * 2] = (float)cos(ang);
    p.rope[i * 2 + 1] = (float)sin(ang);
  }
}
template <bool SPLIT, bool INBF = false>
__device__ __forceinline__ void ph_norm_mod(const float* in, const float* g, const float* mod, int shift_off, int scale_off, bf16_t* out, unsigned char* outq = nullptr) {
  const int lane = threadIdx.x & 63, wv = threadIdx.x >> 6;
  WLOOP(w, T / 4) {
    const int t = w * 4 + wv, b = t / S;
    f32x4 v[4];
    float ss = 0.f;
#pragma unroll
    for (int i = 0; i < 4; ++i) {
      if (INBF) { const u32x2 q = *(const u32x2*)((const bf16_t*)in + (size_t)t * D + i * 256 + lane * 4); v[i] = (f32x4){__uint_as_float(q.x << 16), __uint_as_float(q.x & 0xffff0000u), __uint_as_float(q.y << 16), __uint_as_float(q.y & 0xffff0000u)}; }
      else v[i] = *(const f32x4*)(in + (size_t)t * D + i * 256 + lane * 4);
      ss += v[i][0] * v[i][0] + v[i][1] * v[i][1] + v[i][2] * v[i][2] + v[i][3] * v[i][3]; }
    ss = wave_sum(ss);
    const float r = rsqrtf(ss * (1.f / D) + EPS);
    const int ld = SPLIT ? 2 * D : D;
#pragma unroll
    for (int i = 0; i < 4; ++i) {
      const int d = i * 256 + lane * 4;
      const f32x4 gg = *(const f32x4*)(g + d), sc = *(const f32x4*)(mod + b * 6 * D + scale_off + d), sh = *(const f32x4*)(mod + b * 6 * D + shift_off + d);
      const f32x4 o = v[i] * r * gg * (sc + 1.f) + sh;
      u32x2 hi = {pk_bf16(o[0], o[1]), pk_bf16(o[2], o[3])};
      if (out) *(u32x2*)(out + (size_t)t * ld + d) = hi;
      if (!SPLIT && outq) *(unsigned*)(outq + (size_t)t * D + d) = pk4_fp8(o[0], o[1], o[2], o[3]);
      if (SPLIT) {
        *(unsigned*)(outq + (size_t)t * D + d) = pk4_fp8(o[0], o[1], o[2], o[3]);
        const float l0 = o[0] - __uint_as_float(hi.x << 16), l1 = o[1] - __uint_as_float(hi.x & 0xffff0000u);
        const float l2 = o[2] - __uint_as_float(hi.y << 16), l3 = o[3] - __uint_as_float(hi.y & 0xffff0000u);
        u32x2 lo = {pk_bf16(l0, l1), pk_bf16(l2, l3)};
        *(u32x2*)(out + (size_t)t * ld + D + d) = lo;
      }
    }
  }
}

template <bool SPLIT3, class AF, class BF, class EF>
__device__ __forceinline__ void gemm128(char* smem, int K, int ldb, AF arow, BF bcol, EF epi) {
  const int tid = otid(), lane = tid & 63, wid = tid >> 6, wm = wid >> 1, wn = wid & 1;
  const int l15 = lane & 15, l4 = lane >> 4;
  char* As = smem; char* Bs = smem + 16384;
  const int ac = tid & 7, ar0 = tid >> 3;
  const bf16_t* ap[4];
#pragma unroll
  for (int i = 0; i < 4; ++i) ap[i] = arow(ar0 + 32 * i);
  const int kg = tid >> 5, ng = tid & 31;
  const float* bp = bcol(ng * 4);
  if (bp) bp += (size_t)(kg * 8) * ldb;
  u32x4 areg[4]; f32x4 breg[8];
  const int nk1 = K / 64, nk = SPLIT3 ? 3 * nk1 : nk1;
  auto gload = [&](int kt) {
    const int seg = SPLIT3 ? kt / nk1 : 0, k0 = (SPLIT3 ? kt % nk1 : kt) * 64;
    const int aoff = (seg == 2 ? K : 0) + k0 + ac * 8;
#pragma unroll
    for (int i = 0; i < 4; ++i) areg[i] = ap[i] ? *(const u32x4*)(ap[i] + aoff) : (u32x4){0u, 0u, 0u, 0u};
#pragma unroll
    for (int i = 0; i < 8; ++i) breg[i] = bp ? *(const f32x4*)(bp + (size_t)(k0 + i) * ldb) : (f32x4){0.f, 0.f, 0.f, 0.f};
    if (SPLIT3 && seg == 1) {
#pragma unroll
      for (int i = 0; i < 8; ++i)
#pragma unroll
        for (int j = 0; j < 4; ++j) breg[i][j] = breg[i][j] - bf16_round(breg[i][j]);
    }
  };
  auto lstore = [&]() {
#pragma unroll
    for (int i = 0; i < 4; ++i) { const int r = ar0 + 32 * i; *(u32x4*)(As + r * 128 + ((ac ^ ((r >> 1) & 7)) << 4)) = areg[i]; }
#pragma unroll
    for (int j = 0; j < 4; ++j) {
      const int n = ng * 4 + j;
      u32x4 v = {pk_bf16(breg[0][j], breg[1][j]), pk_bf16(breg[2][j], breg[3][j]), pk_bf16(breg[4][j], breg[5][j]), pk_bf16(breg[6][j], breg[7][j])};
      *(u32x4*)(Bs + n * 128 + ((kg ^ ((n >> 1) & 7)) << 4)) = v;
    }
  };
  f32x4 acc[4][4];
#pragma unroll
  for (int i = 0; i < 4; ++i)
#pragma unroll
    for (int j = 0; j < 4; ++j) acc[i][j] = (f32x4){0.f, 0.f, 0.f, 0.f};
  gload(0);
  const int sw = l15 >> 1;
  for (int kt = 0; kt < nk; ++kt) {
    __syncthreads();
    lstore();
    __syncthreads();
    if (kt + 1 < nk) gload(kt + 1);
#pragma unroll
    for (int ks = 0; ks < 2; ++ks) {
      const int coff = ((ks * 4 + l4) ^ sw) << 4;
      bf16x8 af[4], bfr[4];
#pragma unroll
      for (int mt = 0; mt < 4; ++mt) af[mt] = *(const bf16x8*)(As + (wm * 64 + mt * 16 + l15) * 128 + coff);
#pragma unroll
      for (int nt = 0; nt < 4; ++nt) bfr[nt] = *(const bf16x8*)(Bs + (wn * 64 + nt * 16 + l15) * 128 + coff);
#pragma unroll
      for (int mt = 0; mt < 4; ++mt)
#pragma unroll
        for (int nt = 0; nt < 4; ++nt) acc[mt][nt] = __builtin_amdgcn_mfma_f32_16x16x32_bf16(bfr[nt], af[mt], acc[mt][nt], 0, 0, 0);
    }
  }
  epi(acc, wm * 64 + l15, wn * 64 + l4 * 4);
}

typedef unsigned u32x2v __attribute__((ext_vector_type(2)));
__device__ __forceinline__ void xpose4(unsigned (&d)[4][2], int) {
#pragma unroll
  for (int a = 0; a < 2; ++a)
#pragma unroll
    for (int h = 0; h < 2; ++h) { const u32x2v r = __builtin_amdgcn_permlane16_swap(d[2 * a][h], d[2 * a + 1][h], false, false); d[2 * a][h] = r.x; d[2 * a + 1][h] = r.y; }
#pragma unroll
  for (int j = 0; j < 2; ++j)
#pragma unroll
    for (int h = 0; h < 2; ++h) { const u32x2v r = __builtin_amdgcn_permlane32_swap(d[j][h], d[2 + j][h], false, false); d[j][h] = r.x; d[2 + j][h] = r.y; }
}
__device__ __forceinline__ void store_row64_bf16(const f32x4& a0, const f32x4& a1, const f32x4& a2, const f32x4& a3, int l4, bf16_t* rowp, bool doit) {
  unsigned d[4][2] = {{pk_bf16(a0[0], a0[1]), pk_bf16(a0[2], a0[3])}, {pk_bf16(a1[0], a1[1]), pk_bf16(a1[2], a1[3])},
                      {pk_bf16(a2[0], a2[1]), pk_bf16(a2[2], a2[3])}, {pk_bf16(a3[0], a3[1]), pk_bf16(a3[2], a3[3])}};
  xpose4(d, l4);
  if (doit) {
    *(u32x4*)(rowp + 16 * l4) = (u32x4){d[0][0], d[0][1], d[1][0], d[1][1]};
    *(u32x4*)(rowp + 16 * l4 + 8) = (u32x4){d[2][0], d[2][1], d[3][0], d[3][1]};
  }
}

template <bool LO>
__device__ __forceinline__ void cvt_kn_tile(const float* src, int ldn, bf16_t* dst, int ldk, int k0, int n0, int nmax) {
  const int tid = threadIdx.x, kg = tid & 7, ng = tid >> 3, n = n0 + ng * 4;
  if (n >= nmax) return;
  f32x4 r[8];
#pragma unroll
  for (int i = 0; i < 8; ++i) r[i] = *(const f32x4*)(src + (size_t)(k0 + kg * 8 + i) * ldn + n);
  if (LO) {
#pragma unroll
    for (int i = 0; i < 8; ++i)
#pragma unroll
      for (int j = 0; j < 4; ++j) r[i][j] = r[i][j] - bf16_round(r[i][j]);
  }
#pragma unroll
  for (int j = 0; j < 4; ++j) {
    u32x4 v = {pk_bf16(r[0][j], r[1][j]), pk_bf16(r[2][j], r[3][j]), pk_bf16(r[4][j], r[5][j]), pk_bf16(r[6][j], r[7][j])};
    *(u32x4*)(dst + (size_t)(n + j) * ldk + k0 + kg * 8) = v;
  }
}
template <bool LO>
__device__ __forceinline__ void cvt_matrix(const float* src, bf16_t* dst, int K, int N, int& item_base) {
  const int nkt = K / 64, nnt = (N + 127) / 128, total = nkt * nnt;
  for (int it = (int)blockIdx.x - item_base; it < total; it += gridDim.x) {
    if (it < 0) continue;
    cvt_kn_tile<LO>(src, N, dst, K, (it % nkt) * 64, (it / nkt) * 128, N);
  }
  item_base = (item_base + total) % gridDim.x;
}

constexpr int G2_STAGE = 24576;
template <int NSEG, int AB = 0, class AF, class BF, class EF>
__device__ __forceinline__ void gemm2(char* smem_, int K, AF arow, BF brow, EF epi, int aseg1 = 0, int bseg1 = 0, int aseg2 = 0, int bseg2 = 0) {
  LAS char* smem = (LAS char*)smem_;
  const int tid = otid(), lane = tid & 63, wv = __builtin_amdgcn_readfirstlane(tid >> 6), wm = wv >> 1, wn = wv & 1;
  const int l15 = lane & 15, l4 = lane >> 4;
  const int row_l = lane >> 2, csrc = ((lane & 3) ^ (((row_l >> 3) & 1) * 3)) * 8;
  const bf16_t* ap[4]; const bf16_t* bp[2];
#pragma unroll
  for (int j = 0; j < 4; ++j) ap[j] = arow((wv + 4 * j) * 16 + row_l) + csrc;
#pragma unroll
  for (int j = 0; j < 2; ++j) bp[j] = brow((wv + 4 * j) * 16 + row_l) + csrc;
  const int nk1 = K / 32, nk = NSEG * nk1;
  auto issue = [&](int kt) {
    LAS char* st = smem + (kt % 3) * G2_STAGE;
    int ka = kt * 32, kb = kt * 32;
    if (NSEG > 1) { const int seg = kt / nk1, kk = (kt - seg * nk1) * 32; ka = kk + (seg == 1 ? aseg1 : (seg == 2 ? aseg2 : 0)); kb = kk + (seg == 1 ? bseg1 : (seg == 2 ? bseg2 : 0)); }
#pragma unroll
    for (int j = 0; j < 4; ++j) __builtin_amdgcn_global_load_lds((const unsigned*)(ap[j] + ka), (LAS unsigned*)(st + (wv + 4 * j) * 1024), 16, 0, 0);
#pragma unroll
    for (int j = 0; j < 2; ++j) __builtin_amdgcn_global_load_lds((const unsigned*)(bp[j] + kb), (LAS unsigned*)(st + 16384 + (wv + 4 * j) * 1024), 16, 0, 0);
  };
  f32x4 acc[8][4];
#pragma unroll
  for (int i = 0; i < 8; ++i)
#pragma unroll
    for (int j = 0; j < 4; ++j) acc[i][j] = (f32x4){0.f, 0.f, 0.f, 0.f};
  const int coff = (l4 ^ (((l15 >> 3) & 1) * 3)) << 4;
  const int aoff = (wm * 128 + l15) * 64 + coff, boff = 16384 + (wn * 64 + l15) * 64 + coff;
  asm volatile("s_waitcnt lgkmcnt(0)" ::: "memory");
  __builtin_amdgcn_s_barrier();
  asm volatile("" ::: "memory");
  issue(0);
  if (nk > 1) issue(1);
  for (int kt = 0; kt < nk; ++kt) {
    if (kt + 1 < nk) asm volatile("s_waitcnt vmcnt(6)" ::: "memory"); else asm volatile("s_waitcnt vmcnt(0)" ::: "memory");
    __builtin_amdgcn_s_barrier();
    asm volatile("" ::: "memory");
    if (AB != 2 && kt + 2 < nk) issue(kt + 2);
    const LAS char* st = smem + (kt % 3) * G2_STAGE;
    bf16x8 bfr[4], af[8];
    if (AB != 3) {
#pragma unroll
    for (int nt = 0; nt < 4; ++nt) bfr[nt] = *(const LAS bf16x8*)(st + boff + nt * 1024);
#pragma unroll
    for (int mt = 0; mt < 8; ++mt) af[mt] = *(const LAS bf16x8*)(st + aoff + mt * 1024);
    }
    __builtin_amdgcn_sched_barrier(0);
    if (AB == 1) {
#pragma unroll
      for (int nt = 0; nt < 4; ++nt) asm volatile("" :: "v"(bfr[nt]));
#pragma unroll
      for (int mt = 0; mt < 8; ++mt) asm volatile("" :: "v"(af[mt]));
    }
    if (AB == 0 || AB == 2) {
    __builtin_amdgcn_s_setprio(1);
#pragma unroll
    for (int mt = 0; mt < 8; ++mt)
#pragma unroll
      for (int nt = 0; nt < 4; ++nt) acc[mt][nt] = __builtin_amdgcn_mfma_f32_16x16x32_bf16(bfr[nt], af[mt], acc[mt][nt], 0, 0, 0);
    __builtin_amdgcn_s_setprio(0);
    }
    __builtin_amdgcn_sched_barrier(0);
  }
  epi(acc, wm * 128 + l15, wn * 64 + l4 * 4);
}

template <int NREP = 1, class AF, class BF, class EF>
__device__ __forceinline__ void gemm2q(char* smem_, int K, AF arow, BF brow, EF epi, size_t bstep = 0, bool half = false) {
  LAS char* smem = (LAS char*)smem_;
  const int tid = otid(), lane = tid & 63, wv = __builtin_amdgcn_readfirstlane(tid >> 6), wm = wv >> 1, wn = wv & 1;
  const int l15 = lane & 15, l4 = lane >> 4;
  const int row_l = lane >> 2, csrc = ((lane & 3) ^ ((row_l >> 2) & 3)) * 16;
  const unsigned char* ap[4]; const unsigned char* bp[2];
#pragma unroll
  for (int j = 0; j < 4; ++j) ap[j] = arow((wv + 4 * j) * 16 + row_l) + csrc;
#pragma unroll
  for (int j = 0; j < 2; ++j) bp[j] = brow((wv + 4 * j) * 16 + row_l) + csrc;
  const int nk1 = K / 64, nk = nk1 * NREP;
  auto issue = [&](int kt) {
    LAS char* st = smem + (kt % 3) * G2_STAGE;
    const int rp = NREP > 1 ? kt / nk1 : 0, kk = NREP > 1 ? kt - rp * nk1 : kt;
#pragma unroll
    for (int j = 0; j < 4; ++j) __builtin_amdgcn_global_load_lds((const unsigned*)(ap[j] + kk * 64), (LAS unsigned*)(st + (wv + 4 * j) * 1024), 16, 0, 0);
#pragma unroll
    for (int j = 0; j < 2; ++j) __builtin_amdgcn_global_load_lds((const unsigned*)(bp[j] + rp * bstep + kk * 64), (LAS unsigned*)(st + 16384 + (wv + 4 * j) * 1024), 16, 0, 0);
  };
  f32x4 acc[8][4];
#pragma unroll
  for (int i = 0; i < 8; ++i)
#pragma unroll
    for (int j = 0; j < 4; ++j) acc[i][j] = (f32x4){0.f, 0.f, 0.f, 0.f};
  const int sw = (l15 >> 2) & 3, sub = (l4 & 1) * 8, ch = l4 >> 1;
  const int aoff = (wm * 128 + l15) * 64 + sub, boff = 16384 + (wn * 64 + l15) * 64 + sub;
  asm volatile("s_waitcnt lgkmcnt(0)" ::: "memory");
  __builtin_amdgcn_s_barrier();
  asm volatile("" ::: "memory");
  issue(0);
  if (nk > 1) issue(1);
  for (int kt = 0; kt < nk; ++kt) {
    if (kt + 1 < nk) asm volatile("s_waitcnt vmcnt(6)" ::: "memory"); else asm volatile("s_waitcnt vmcnt(0)" ::: "memory");
    __builtin_amdgcn_s_barrier();
    asm volatile("" ::: "memory");
    if (kt + 2 < nk) issue(kt + 2);
    const LAS char* st = smem + (kt % 3) * G2_STAGE;
    if (!(half && wm == 1))
#pragma unroll
    for (int ks = 0; ks < 2; ++ks) {
      const int coff = ((2 * ks + ch) ^ sw) << 4;
      long bfr[4], af[8];
#pragma unroll
      for (int nt = 0; nt < 4; ++nt) bfr[nt] = *(const LAS long*)(st + boff + nt * 1024 + coff);
#pragma unroll
      for (int mt = 0; mt < 8; ++mt) af[mt] = *(const LAS long*)(st + aoff + mt * 1024 + coff);
      __builtin_amdgcn_s_setprio(1);
#pragma unroll
      for (int mt = 0; mt < 8; ++mt)
#pragma unroll
        for (int nt = 0; nt < 4; ++nt) acc[mt][nt] = __builtin_amdgcn_mfma_f32_16x16x32_fp8_fp8(bfr[nt], af[mt], acc[mt][nt], 0, 0, 0);
      __builtin_amdgcn_s_setprio(0);
    }
    __builtin_amdgcn_sched_barrier(0);
    if (NREP > 1 && (kt + 1) % nk1 == 0 && kt + 1 < nk) {
      epi(acc, wm * 128 + l15, wn * 64 + l4 * 4, kt / nk1);
#pragma unroll
      for (int i = 0; i < 8; ++i)
#pragma unroll
        for (int j = 0; j < 4; ++j) acc[i][j] = (f32x4){0.f, 0.f, 0.f, 0.f};
    }
  }
  epi(acc, wm * 128 + l15, wn * 64 + l4 * 4, NREP - 1);
}

template <class F>
__device__ __forceinline__ void gemm2_grid(int NT, F body) {
  const int xcd = blockIdx.x & 7, lb = blockIdx.x >> 3, nlb = gridDim.x >> 3;
  for (int i = lb; i < 8 * NT; i += nlb) body(xcd * 8 + (i & 7), i >> 3);
}

template <class F>
__device__ __forceinline__ void gemm_grid(int NT, F body) {
  const int xcd = blockIdx.x & 7, lb = blockIdx.x >> 3, nlb = gridDim.x >> 3;
  for (int i = lb; i < 16 * NT; i += nlb) {
    const int g = i / (8 * NT), rem = i % (8 * NT), nt = rem >> 3, mi = rem & 7;
    body(xcd * 16 + g * 8 + mi, nt);
  }
}

template <int MT>
__device__ __forceinline__ void proj_epi(const P& p, const f32x4 (&acc)[MT][4], int row_base, int ntile, int r0, int c0, float ascale = 1.f, const float* rope_tile = nullptr) {
  const int wn = c0 >> 6, l4 = (c0 & 63) >> 2;
  const int col0 = ntile * 128 + wn * 64;
  if (col0 >= INC) return;
  if (col0 == C_GB) {
#pragma unroll
    for (int mt = 0; mt < MT; ++mt) {
      const int m = row_base + r0 + mt * 16;
      f32x4 a = acc[mt][0] * ascale, g0 = {sigmoidf(a[0]), sigmoidf(a[1]), sigmoidf(a[2]), sigmoidf(a[3])};
      *(f32x4*)(p.GS + (size_t)m * 24 + 4 * l4) = g0;
      if (l4 < 2) { a = acc[mt][1] * ascale; f32x4 g1 = {sigmoidf(a[0]), sigmoidf(a[1]), sigmoidf(a[2]), sigmoidf(a[3])}; *(f32x4*)(p.GS + (size_t)m * 24 + 16 + 4 * l4) = g1; }
    }
    return;
  }
  const float* g = nullptr; bf16_t* dst; bf16_t* dst2 = nullptr; int hh, H; float qs = 1.f; bool dorope = false;
  if (col0 < 512) { g = p.g_q_dil; dst = p.QA; hh = col0 >> 6; H = 8; qs = 0.125f; dorope = true; }
  else if (col0 < 1024) { g = p.g_k_dil; dst = p.KA; hh = (col0 - 512) >> 6; H = 8; dorope = true; }
  else if (col0 < 1536) { dst = p.VA; hh = (col0 - 1024) >> 6; H = 8; }
  else if (col0 < 2048) { g = p.g_q_nsa; dst = p.QR; dst2 = p.QN; hh = (col0 - 1536) >> 6; H = 8; qs = 0.125f; dorope = true; }
  else {
    const int idx = (col0 - 2048) >> 6, which = idx >> 1; hh = idx & 1; H = 2;
    if (which == 0) dst = p.KC; else if (which == 1) dst = p.VC;
    else if (which == 2) { dst = p.KSL; g = p.g_k_slc; dorope = true; } else if (which == 3) dst = p.VSL;
    else if (which == 4) { dst = p.KW; g = p.g_k_win; dorope = true; } else dst = p.VW;
  }
  f32x4 gv[4];
  if (g) {
#pragma unroll
    for (int nt = 0; nt < 4; ++nt) gv[nt] = *(const f32x4*)(g + nt * 16 + 4 * l4);
  }
  const int bb = row_base / S;
#pragma unroll
  for (int mt = 0; mt < MT; ++mt) {
    const int m = row_base + r0 + mt * 16, s = m - bb * S;
    f32x4 v[4];
#pragma unroll
    for (int nt = 0; nt < 4; ++nt) v[nt] = acc[mt][nt] * ascale;
    if (g) {
      float ss = 0.f;
#pragma unroll
      for (int nt = 0; nt < 4; ++nt) ss += v[nt][0] * v[nt][0] + v[nt][1] * v[nt][1] + v[nt][2] * v[nt][2] + v[nt][3] * v[nt][3];
      ss += __shfl_xor(ss, 16); ss += __shfl_xor(ss, 32);
      const float r = rsqrtf(ss * (1.f / 64.f) + EPS) * qs;
#pragma unroll
      for (int nt = 0; nt < 4; ++nt) v[nt] = v[nt] * gv[nt] * r;
    }
    f32x4 vr = v[0];
    if (dorope) {
      const float* rp = rope_tile ? rope_tile + ((size_t)(m - row_base) * 8 + 4 * (l4 & 1)) * 2 : p.rope + ((size_t)s * 8 + 4 * (l4 & 1)) * 2;
      const f32x4 ra = *(const f32x4*)rp, rb = *(const f32x4*)(rp + 4);
      const float cs[4] = {ra[0], ra[2], rb[0], rb[2]}, sn[4] = {ra[1], ra[3], rb[1], rb[3]};
#pragma unroll
      for (int i = 0; i < 4; ++i) {
        const float pt = __shfl_xor(v[0][i], 32);
        vr[i] = (l4 < 2) ? (v[0][i] * cs[i] - pt * sn[i]) : (v[0][i] * cs[i] + pt * sn[i]);
      }
    }
    bf16_t* row = dst + ((size_t)(bb * H + hh) * S + s) * 64 + 16 * l4;
    unsigned dd[4][2] = {{pk_bf16(vr[0], vr[1]), pk_bf16(vr[2], vr[3])}, {pk_bf16(v[1][0], v[1][1]), pk_bf16(v[1][2], v[1][3])},
                         {pk_bf16(v[2][0], v[2][1]), pk_bf16(v[2][2], v[2][3])}, {pk_bf16(v[3][0], v[3][1]), pk_bf16(v[3][2], v[3][3])}};
    if (dst2) {
      unsigned d2[4][2] = {{pk_bf16(v[0][0], v[0][1]), pk_bf16(v[0][2], v[0][3])}, {dd[1][0], dd[1][1]}, {dd[2][0], dd[2][1]}, {dd[3][0], dd[3][1]}};
      xpose4(d2, l4);
      bf16_t* row2 = dst2 + ((size_t)(bb * H + hh) * S + s) * 64 + 16 * l4;
      *(u32x4*)row2 = (u32x4){d2[0][0], d2[0][1], d2[1][0], d2[1][1]};
      *(u32x4*)(row2 + 8) = (u32x4){d2[2][0], d2[2][1], d2[3][0], d2[3][1]};
    }
    xpose4(dd, l4);
    *(u32x4*)row = (u32x4){dd[0][0], dd[0][1], dd[1][0], dd[1][1]};
    *(u32x4*)(row + 8) = (u32x4){dd[2][0], dd[2][1], dd[3][0], dd[3][1]};
    asm volatile("" ::: "memory");
  }
}
__device__ __forceinline__ void ph_proj(const P& p, char* smem) {
  gemm2_grid(23, [&](int mtile, int ntile) {
    const unsigned char* A = p.h1q + (size_t)mtile * 256 * D; const unsigned char* W = p.Wq_in + (size_t)ntile * 128 * D; const unsigned char* Z = (const unsigned char*)p.zrow;
    const int nvalid = INC - ntile * 128;
    gemm2q<1>(smem, D, [=](int r) { return A + (size_t)r * D; }, [=](int n) { return n < nvalid ? W + (size_t)n * D : Z; },
              [&](const f32x4 (&acc)[8][4], int r0, int c0, int) {
                float* rl = (float*)smem;
                __syncthreads();
                { const int s0 = (mtile * 256) % S; const f32x4* srcp = (const f32x4*)(p.rope + (size_t)s0 * 16);
#pragma unroll
                  for (int i = 0; i < 4; ++i) ((f32x4*)rl)[threadIdx.x + 256 * i] = srcp[threadIdx.x + 256 * i]; }
                __syncthreads();
                proj_epi<8>(p, acc, mtile * 256, ntile, r0, c0, 1.f / WQ_SCALE, rl);
              });
  });
}
__device__ __forceinline__ void ph_outproj(const P& p, char* smem) {
  gemm2_grid(8, [&](int mtile, int ntile) {
    const unsigned char* A = p.mixq + (size_t)mtile * 256 * D; const unsigned char* W = p.Wq_out + (size_t)ntile * 128 * D; bf16_t* C = (bf16_t*)p.x1; const float* x = p.x;
    const float* gt = p.mod + ((mtile * 256) / S) * 6 * D + 2 * D;
    gemm2q<1>(smem, D, [=](int r) { return A + (size_t)r * D; }, [=](int n) { return W + (size_t)n * D; },
              [=](const f32x4 (&acc)[8][4], int r0, int c0, int) {
                const int l4 = (c0 & 63) >> 2;
                const float s = 1.f / (WQ_SCALE * MQ_SCALE);
#pragma unroll
                for (int mt = 0; mt < 8; ++mt) {
                  const int m = mtile * 256 + r0 + mt * 16;
                  f32x4 o[4];
#pragma unroll
                  for (int nt = 0; nt < 4; ++nt) {
                    const int n = ntile * 128 + c0 + nt * 16;
                    o[nt] = *(const f32x4*)(x + (size_t)m * D + n) + *(const f32x4*)(gt + n) * (acc[mt][nt] * s);
                  }
                  store_row64_bf16(o[0], o[1], o[2], o[3], l4, C + (size_t)m * D + ntile * 128 + (c0 & ~63), true);
                  asm volatile("" ::: "memory");
                }
              });
  });
}
template <int AB>
__device__ __forceinline__ void ph_outproj_abl(const P& p, char* smem) {
  gemm2_grid(8, [&](int mtile, int ntile) {
    const bf16_t* A = p.mixinb + (size_t)mtile * 256 * D; const bf16_t* W = p.Wt_out + (size_t)ntile * 128 * D; float* C = (float*)p.Ybuf;
    gemm2<1, AB>(smem, D, [=](int r) { return A + (size_t)r * D; }, [=](int n) { return W + (size_t)n * D; },
             [=](const f32x4 (&acc)[8][4], int r0, int c0) {
#pragma unroll
               for (int mt = 0; mt < 8; ++mt)
#pragma unroll
                 for (int nt = 0; nt < 4; ++nt) {
                   const int m = mtile * 256 + r0 + mt * 16, n = ntile * 128 + c0 + nt * 16;
                   *(f32x4*)(C + (size_t)m * D + n) = acc[mt][nt];
                 }
             });
  });
}
__device__ __forceinline__ void router_unit(const P& p, char* smem, int mtile, int j) {
  const int seg = j >> 1, ntile = j & 1;
  const bf16_t* A = p.h2s + (size_t)mtile * 256 * 2 * D + (seg == 2 ? D : 0);
  const bf16_t* W = (seg == 1 ? p.Wt_rtl : p.Wt_rth) + (size_t)ntile * 128 * D; float* C = p.logits + (size_t)seg * T * NE;
  gemm2<1>(smem, D, [=](int r) { return A + (size_t)r * 2 * D; }, [=](int n) { return W + (size_t)n * D; },
           [=](const f32x4 (&acc)[8][4], int r0, int c0) {
#pragma unroll
             for (int mt = 0; mt < 8; ++mt)
#pragma unroll
               for (int nt = 0; nt < 4; ++nt) {
                 const int m = mtile * 256 + r0 + mt * 16, n = ntile * 128 + c0 + nt * 16;
                 *(f32x4*)(C + (size_t)m * NE + n) = acc[mt][nt];
               }
           });
}
__device__ __forceinline__ const bf16_t* gu_row(const bf16_t* Wg, const bf16_t* Wu, int f0, int n) {
  const int wn = n >> 6, wi = n & 63;
  return (wi >= 32 ? Wu : Wg) + (size_t)(f0 + wn * 32 + (wi & 31)) * D;
}
template <int MT>
__device__ __forceinline__ void gu_store(const f32x4 (&acc)[MT][4], int mt, float scale, bf16_t* dstrow  ) {
#pragma unroll
  for (int q = 0; q < 2; ++q) {
    const f32x4 g = acc[mt][q], u = acc[mt][q + 2];
    float h[4];
#pragma unroll
    for (int i = 0; i < 4; ++i) h[i] = silu(g[i]) * u[i] * scale;
    u32x2 v = {pk_bf16(h[0], h[1]), pk_bf16(h[2], h[3])};
    *(u32x2*)(dstrow + q * 16) = v;
  }
}
__device__ __forceinline__ void shared_gu_unit(const P& p, char* smem, int mtile, int ntile) {
  const bf16_t* A = p.h2s + (size_t)mtile * 256 * 2 * D; const bf16_t* Wg = p.Wt_sg; const bf16_t* Wu = p.Wt_su; bf16_t* H = p.Hs;
  gemm2<1>(smem, D, [=](int r) { return A + (size_t)r * 2 * D; }, [=](int n) { return gu_row(Wg, Wu, ntile * 64, n); },
           [=](const f32x4 (&acc)[8][4], int r0, int c0) {
             const int wn = c0 >> 6, l4x4 = c0 & 63;
#pragma unroll
             for (int mt = 0; mt < 8; ++mt) gu_store<8>(acc, mt, 1.f, H + (size_t)(mtile * 256 + r0 + mt * 16) * FF + ntile * 64 + wn * 32 + l4x4);
           });
}
__device__ __forceinline__ void ph_router_shared_gu(const P& p, char* smem) {
  gemm2_grid(10, [&](int mtile, int j) { if (j < 6) router_unit(p, smem, mtile, j); else shared_gu_unit(p, smem, mtile, j - 6); });
}
__device__ __forceinline__ void ph_shared_d(const P& p, char* smem) {
  gemm2_grid(8, [&](int mtile, int ntile) {
    const bf16_t* A = p.Hs + (size_t)mtile * 256 * FF; const bf16_t* W = p.Wt_sd + (size_t)ntile * 128 * FF; bf16_t* Y = p.Ys;
    gemm2<1>(smem, FF, [=](int r) { return A + (size_t)r * FF; }, [=](int n) { return W + (size_t)n * FF; },
             [=](const f32x4 (&acc)[8][4], int r0, int c0) {
#pragma unroll
               for (int mt = 0; mt < 8; ++mt)
                 store_row64_bf16(acc[mt][0], acc[mt][1], acc[mt][2], acc[mt][3], (c0 & 63) >> 2, Y + (size_t)(mtile * 256 + r0 + mt * 16) * D + ntile * 128 + (c0 & ~63), true);
             });
  });
}
struct CvtQ { const float* src; unsigned char* dst; int ldn, ldk; };
__device__ __forceinline__ void cvtq_load(const CvtQ& d, f32x4 (&r)[16]) {
#pragma unroll
  for (int i = 0; i < 16; ++i) r[i] = __builtin_nontemporal_load((const f32x4*)(d.src + (size_t)i * d.ldn));
}
__device__ __forceinline__ void cvtq_store(const CvtQ& d, const f32x4 (&r)[16]) {
#pragma unroll
  for (int j = 0; j < 4; ++j) {
    u32x4 v = {pk4_fp8(r[0][j] * WQ_SCALE, r[1][j] * WQ_SCALE, r[2][j] * WQ_SCALE, r[3][j] * WQ_SCALE), pk4_fp8(r[4][j] * WQ_SCALE, r[5][j] * WQ_SCALE, r[6][j] * WQ_SCALE, r[7][j] * WQ_SCALE),
               pk4_fp8(r[8][j] * WQ_SCALE, r[9][j] * WQ_SCALE, r[10][j] * WQ_SCALE, r[11][j] * WQ_SCALE), pk4_fp8(r[12][j] * WQ_SCALE, r[13][j] * WQ_SCALE, r[14][j] * WQ_SCALE, r[15][j] * WQ_SCALE)};
    *(u32x4*)(d.dst + (size_t)j * d.ldk) = v;
  }
}
__device__ __forceinline__ CvtQ cvtq_desc(const float* src, int ldn, unsigned char* dst, int ldk, int k0, int n0) {
  const int kg = threadIdx.x & 7, n = n0 + (threadIdx.x >> 3) * 4;
  CvtQ d; d.src = src + (size_t)(k0 + kg * 16) * ldn + n; d.dst = dst + (size_t)n * ldk + k0 + kg * 16; d.ldn = ldn; d.ldk = ldk; return d;
}
__device__ __forceinline__ void cvtq_tile(const float* src, int ldn, unsigned char* dst, int ldk, int k0, int n0, int nmax = 1 << 30) {
  if (n0 + (int)(threadIdx.x >> 3) * 4 >= nmax) return;
  const CvtQ d = cvtq_desc(src, ldn, dst, ldk, k0, n0); f32x4 r[16]; cvtq_load(d, r); cvtq_store(d, r);
}
__device__ __forceinline__ CvtQ cvt_expert_desc(const P& p, int it) {
  const int e = it / 48, q = it - e * 48;
  if (q < 32) { const int up = q >> 4, qq = q & 15;
    return cvtq_desc((up ? p.w_up : p.w_gate) + (size_t)e * D * FF, FF, (up ? p.Wq_u : p.Wq_g) + (size_t)e * FF * D, D, (qq & 7) * 128, (qq >> 3) * 128);
  }
  const int qq = q - 32;
  return cvtq_desc(p.w_down + (size_t)e * FF * D, D, p.Wq_d + (size_t)e * D * FF, FF, (qq & 1) * 128, (qq >> 1) * 128);
}
__device__ __forceinline__ void cvt_expert_item(const P& p, int it) { const CvtQ d = cvt_expert_desc(p, it); f32x4 r[16]; cvtq_load(d, r); cvtq_store(d, r); }
__device__ __forceinline__ void ph_cvt_experts(const P& p) { WLOOP(w, NE * 48) cvt_expert_item(p, w); }

__device__ __forceinline__ bf16x8 pack8(const f32x16& x, int s) {
  u32x4 r = {pk_bf16(x[8 * s], x[8 * s + 1]), pk_bf16(x[8 * s + 2], x[8 * s + 3]), pk_bf16(x[8 * s + 4], x[8 * s + 5]), pk_bf16(x[8 * s + 6], x[8 * s + 7])};
  return __builtin_bit_cast(bf16x8, r);
}
__device__ __forceinline__ bf16x8 tr_pair(const LAS char* a) {
  const s16x4 lo = __builtin_amdgcn_ds_read_tr16_b64_v4i16((LAS s16x4*)a);
  const s16x4 hi = __builtin_amdgcn_ds_read_tr16_b64_v4i16((LAS s16x4*)(a + 8 * 128));
  return __builtin_shufflevector(lo, hi, 0, 1, 2, 3, 4, 5, 6, 7);
}
__device__ __forceinline__ int next_item(int* ctr, char* smem) {
  volatile int* slot = (volatile int*)(smem + SMEM_BYTES - 16);
  __syncthreads();
  if (threadIdx.x == 0) *slot = atomicAdd(ctr, 1);
  __syncthreads();
  return *slot;
}

__device__ __forceinline__ void compress_item(const P& p, char* smem, int item) {
  const int which = item >> 3, mtile = item & 7;
  const bf16_t* X = which ? p.VC : p.KC; const bf16_t* W1 = which ? p.Wt_c1v : p.Wt_c1k; const bf16_t* Z = p.zrow;
  const float* b1 = p.b1c + which * 128; bf16_t* hid = (bf16_t*)smem;
  gemm2<1>(smem, 2048,
           [=](int r) { const int R = mtile * 256 + r; if (R >= 2040) return Z; const int bg = R / 255, c = R - bg * 255; return X + ((size_t)bg * S + 16 * c) * 64; },
           [=](int n) { return W1 + (size_t)n * 2048; },
           [=](const f32x4 (&acc)[8][4], int r0, int c0) {
             __syncthreads();
#pragma unroll
             for (int nt = 0; nt < 4; ++nt) {
               const f32x4 bv = *(const f32x4*)(b1 + c0 + nt * 16);
#pragma unroll
               for (int mt = 0; mt < 8; ++mt) {
                 float h[4];
#pragma unroll
                 for (int i = 0; i < 4; ++i) { const float a = acc[mt][nt][i] + bv[i]; const float u = 0.7978845608028654f * (a + 0.044715f * a * a * a); h[i] = a - a / (1.f + __expf(2.f * u)); }
                 u32x2 w = {pk_bf16(h[0], h[1]), pk_bf16(h[2], h[3])};
                 *(u32x2*)(hid + (r0 + mt * 16) * 136 + c0 + nt * 16) = w;
               }
             }
           });
  __syncthreads();
  const float* W2 = which ? p.w2_v : p.w2_k;
  const int rl = threadIdx.x >> 3, pt = threadIdx.x & 7;
#pragma unroll 1
  for (int g = 0; g < 8; ++g) {
    const int row = g * 32 + rl, R = mtile * 256 + row;
    float o[8];
#pragma unroll
    for (int d = 0; d < 8; ++d) o[d] = 0.f;
#pragma unroll 2
    for (int n8 = 0; n8 < 16; ++n8) {
      const u32x4 hv4 = *(const u32x4*)(hid + row * 136 + n8 * 8);
#pragma unroll
      for (int k = 0; k < 8; ++k) {
        const float hv = (k & 1) ? __uint_as_float(hv4[k >> 1] & 0xffff0000u) : __uint_as_float(hv4[k >> 1] << 16);
        const f32x4 w0 = *(const f32x4*)(W2 + (n8 * 8 + k) * 64 + pt * 8), w1 = *(const f32x4*)(W2 + (n8 * 8 + k) * 64 + pt * 8 + 4);
        o[0] += hv * w0[0]; o[1] += hv * w0[1]; o[2] += hv * w0[2]; o[3] += hv * w0[3];
        o[4] += hv * w1[0]; o[5] += hv * w1[1]; o[6] += hv * w1[2]; o[7] += hv * w1[3];
      }
    }
    float rs = 1.f;
    if (!which) {
      float ss = 0.f;
#pragma unroll
      for (int d = 0; d < 8; ++d) ss += o[d] * o[d];
      ss += __shfl_xor(ss, 1); ss += __shfl_xor(ss, 2); ss += __shfl_xor(ss, 4);
      rs = rsqrtf(ss * (1.f / 64.f) + EPS);
    }
    if (R < 2040) {
      const int bg = R / 255, c = R - bg * 255;
      bf16_t* orow = (which ? p.vcb : p.kcb) + ((size_t)bg * 256 + c) * 64 + pt * 8;
      float gg[8];
      if (!which) { const f32x4 g0 = *(const f32x4*)(p.g_k_cmp + pt * 8), g1 = *(const f32x4*)(p.g_k_cmp + pt * 8 + 4); gg[0] = g0[0]; gg[1] = g0[1]; gg[2] = g0[2]; gg[3] = g0[3]; gg[4] = g1[0]; gg[5] = g1[1]; gg[6] = g1[2]; gg[7] = g1[3]; }
      else {
#pragma unroll
        for (int k = 0; k < 8; ++k) gg[k] = 1.f;
      }
      u32x4 w = {pk_bf16(o[0] * rs * gg[0], o[1] * rs * gg[1]), pk_bf16(o[2] * rs * gg[2], o[3] * rs * gg[3]), pk_bf16(o[4] * rs * gg[4], o[5] * rs * gg[5]), pk_bf16(o[6] * rs * gg[6], o[7] * rs * gg[7])};
      *(u32x4*)orow = w;
    }
  }
}

template <int MODE, int NSLOT>
__device__ __forceinline__ void nsa_pass(LAS char* kv, const bf16_t* Kg, const bf16_t* Vg, int t_lo, int t_hi, const bf16x8 (&qf)[4], float shf, int si,
                                         unsigned long long selm, f32x16& o0, f32x16& o1, float& l, LAS float* psl  ,
                                         int pos0 = 0, int pstride = 1, int kkmin = 0) {
  const int tid = otid(), lane = tid & 63, wv = __builtin_amdgcn_readfirstlane(tid >> 6), i = lane & 31, h5 = lane >> 5;
  const int ksw = (i >> 1) & 7;
  const int tq = (lane & 15) >> 2, tp = lane & 3, tds = (lane >> 4) & 1, vsw = ((tq >> 1) & 1) << 2;
  const int row_l = lane >> 3, cpos = lane & 7;
  const int kc8 = (cpos ^ ((wv & 1) * 4 + (row_l >> 1))) * 8, vc8 = (cpos ^ (((row_l >> 1) & 1) << 2)) * 8;
  const bf16_t* kgl = Kg + (size_t)(wv * 8 + row_l) * 64 + kc8;
  const bf16_t* vgl = Vg + (size_t)(wv * 8 + row_l) * 64 + vc8;
  auto stage = [&](int t, int buf) {
    LAS char* Ks = kv + buf * 16384 + wv * 1024; LAS char* Vs = Ks + 8192;
#pragma unroll
    for (int q = 0; q < 2; ++q) {
      if (MODE >= 3) {
        int pos = pos0 + pstride * (64 * t + 32 * q + wv * 8 + row_l);
        pos = pos < 0 ? 0 : (pos > S - 1 ? S - 1 : pos);
        __builtin_amdgcn_global_load_lds((const unsigned*)(Kg + (size_t)pos * 64 + kc8), (LAS unsigned*)(Ks + q * 4096), 16, 0, 0);
        __builtin_amdgcn_global_load_lds((const unsigned*)(Vg + (size_t)pos * 64 + vc8), (LAS unsigned*)(Vs + q * 4096), 16, 0, 0);
      } else {
        __builtin_amdgcn_global_load_lds((const unsigned*)(kgl + (size_t)(64 * t + 32 * q) * 64), (LAS unsigned*)(Ks + q * 4096), 16, 0, 0);
        __builtin_amdgcn_global_load_lds((const unsigned*)(vgl + (size_t)(64 * t + 32 * q) * 64), (LAS unsigned*)(Vs + q * 4096), 16, 0, 0);
      }
    }
  };
  float carry = 0.f;
  if (t_lo > t_hi) return;
  float dm16[4] = {0.f, 0.f, 0.f, 0.f}; int dmaxA = 0, dmaxB = 0; const int wq = wv & 3;
  if (MODE == 3) {
#pragma unroll
    for (int rg = 0; rg < 4; ++rg) dm16[rg] = (((wv - h5 - 2 * rg) & 3) == 0) ? 3.f : 2.f;
    dmaxA = si - kkmin < 128 ? si - kkmin : 128;
  }
  if (MODE == 4) { const int lim = si - kkmin; dmaxA = lim < 128 ? lim : 128; dmaxB = lim < 512 ? lim : 512; }
  asm volatile("s_waitcnt vmcnt(0) lgkmcnt(0)" ::: "memory");
  __builtin_amdgcn_s_barrier();
  asm volatile("" ::: "memory");
#pragma unroll
  for (int k = 0; k < NSLOT - 1; ++k) if (t_lo + k <= t_hi) stage(t_lo + k, k);
  for (int t = t_lo; t <= t_hi; ++t) {
    const int buf = (t - t_lo) % NSLOT;
    const int ahead = t_hi - t;
    if (NSLOT == 4 && ahead >= 2) asm volatile("s_waitcnt vmcnt(8)" ::: "memory");
    else if (NSLOT == 4 && ahead == 1) asm volatile("s_waitcnt vmcnt(4)" ::: "memory");
    else asm volatile("s_waitcnt vmcnt(0)" ::: "memory");
    __builtin_amdgcn_s_barrier();
    asm volatile("" ::: "memory");
    if (t + NSLOT - 1 <= t_hi) stage(t + NSLOT - 1, (t + NSLOT - 1 - t_lo) % NSLOT);
    const LAS char* Ks = kv + buf * 16384; const LAS char* Vs = Ks + 8192;
    const bool tsel = MODE == 1 ? ((selm >> t) & 1ull) != 0ull : true;
#pragma unroll
    for (int sub = 0; sub < 2; ++sub) {
      f32x16 sa;
#pragma unroll
      for (int q = 0; q < 16; ++q) sa[q] = 0.f;
      bf16x8 kf[4];
#pragma unroll
      for (int s4 = 0; s4 < 4; ++s4) kf[s4] = *(const LAS bf16x8*)(Ks + (32 * sub + i) * 128 + (((2 * s4 + h5) ^ ksw) << 4));
      __builtin_amdgcn_s_setprio(1);
#pragma unroll
      for (int s4 = 0; s4 < 4; ++s4) sa = MFMA32(kf[s4], qf[s4], sa);
      __builtin_amdgcn_s_setprio(0);
      const int k0 = 64 * t + 32 * sub + 4 * h5;
#pragma unroll
      for (int q = 0; q < 16; ++q) {
        const int kidx = k0 + (q & 3) + 8 * (q >> 2);
        float pv;
        if (MODE >= 3) {
          const int dl = si - kidx;
          const float e = __builtin_amdgcn_exp2f(sa[q] * LOG2E - shf);
          if (MODE == 3) {
            const float cw = (q & 3) ? 1.f : dm16[q >> 2];
            pv = (unsigned)dl <= (unsigned)dmaxA ? cw * e : 0.f;
          } else {
            const bool lo = dl >= 33;
            float cw = (lo && dl <= dmaxA) ? 1.f : 0.f;
            if ((q & 3) == wq) cw += (lo && dl <= dmaxB) ? 1.f : 0.f;
            pv = cw * e;
          }
        } else {
          bool valid;
          if (MODE == 0) valid = 16 * kidx + 31 <= si;
          else if (MODE == 1) valid = tsel && kidx <= si;
          else valid = (unsigned)(si - kidx) <= 511u;
          pv = valid ? __builtin_amdgcn_exp2f(sa[q] * LOG2E - shf) : 0.f;
        }
        l += pv; sa[q] = pv;
      }
      if (MODE == 0) {
#pragma unroll
        for (int rg = 0; rg < 4; ++rg) {
          const float a = 2.f * (sa[4 * rg] + sa[4 * rg + 1] + sa[4 * rg + 2]) + sa[4 * rg + 3];
          const float recv = __shfl_xor(sa[4 * rg + 3], 32);
          const float val = h5 ? a + recv : a + carry;
          carry = recv;
          psl[16 * t + 8 * sub + 2 * rg + h5] = val;
        }
      }
      const bf16x8 pf0 = pack8(sa, 0), pf1 = pack8(sa, 1);
      bf16x8 vf[2][2];
#pragma unroll
      for (int s2 = 0; s2 < 2; ++s2) {
        const LAS char* vb = Vs + (32 * sub + 16 * s2 + 4 * h5 + tq) * 128 + 8 * (tp & 1);
        vf[s2][0] = tr_pair(vb + (((tds * 2 + (tp >> 1)) ^ vsw) << 4));
        vf[s2][1] = tr_pair(vb + (((4 + tds * 2 + (tp >> 1)) ^ vsw) << 4));
      }
      __builtin_amdgcn_s_setprio(1);
#pragma unroll
      for (int s2 = 0; s2 < 2; ++s2) { o0 = MFMA32(vf[s2][0], s2 ? pf1 : pf0, o0); o1 = MFMA32(vf[s2][1], s2 ? pf1 : pf0, o1); }
      __builtin_amdgcn_s_setprio(0);
    }
    __builtin_amdgcn_sched_barrier(0);
  }
}

__device__ __forceinline__ void dilated_item(const P& p, char* smem_, int unit) {
  LAS char* kv = (LAS char*)smem_;
  const int tid = otid(), lane = tid & 63, wv = tid >> 6, i = lane & 31, h5 = lane >> 5;
  const int r4 = unit & 3, ti = (unit >> 2) & 7, hh = (unit >> 5) & 7, b = unit >> 8;
  const size_t hb = (size_t)(b * 8 + hh) * S * 64;
  const int si = ti * 512 + r4 + 4 * wv + 16 * i;
  bf16x8 qf[4];
#pragma unroll
  for (int s4 = 0; s4 < 4; ++s4) qf[s4] = *(const bf16x8*)(p.QA + hb + (size_t)si * 64 + 16 * s4 + 8 * h5);
  f32x16 o0, o1;
#pragma unroll
  for (int q = 0; q < 16; ++q) { o0[q] = 0.f; o1[q] = 0.f; }
  float l = 0.f;
  const float shf = p.smaxv[0] * LOG2E;
  const int pbase = ti * 512 + r4 - 128, ubase = ti * 128 - 512;
  nsa_pass<3, 4>(kv, p.KA + hb, p.VA + hb, 0, 9, qf, shf, 4 * wv + 16 * i + 128, 0ull, o0, o1, l, nullptr, pbase, 1, pbase < 0 ? -pbase : 0);
  nsa_pass<4, 4>(kv, p.KA + hb, p.VA + hb, 0, 9, qf, shf, wv + 4 * i + 512, 0ull, o0, o1, l, nullptr, r4 + 4 * ubase, 4, ubase < 0 ? -ubase : 0);
  l += __shfl_xor(l, 32);
  const float inv = 1.f / l;
  unsigned char* orow = p.mixq + (size_t)(b * S + si) * D + hh * 64 + 4 * h5;
  const float invq = inv * MQ_SCALE;
#pragma unroll
  for (int rg = 0; rg < 4; ++rg) {
    *(unsigned*)(orow + 8 * rg) = pk4_fp8(clamp_e4m3(o0[4 * rg] * invq), clamp_e4m3(o0[4 * rg + 1] * invq), clamp_e4m3(o0[4 * rg + 2] * invq), clamp_e4m3(o0[4 * rg + 3] * invq));
    *(unsigned*)(orow + 32 + 8 * rg) = pk4_fp8(clamp_e4m3(o1[4 * rg] * invq), clamp_e4m3(o1[4 * rg + 1] * invq), clamp_e4m3(o1[4 * rg + 2] * invq), clamp_e4m3(o1[4 * rg + 3] * invq));
  }
}

__device__ __forceinline__ void nsa_item(const P& p, char* smem_, int item) {
  LAS char* smem = (LAS char*)smem_;
  LAS char* kv = smem;
  LAS float* pslcw = (LAS float*)(smem + 32768);
  LAS float* invl = (LAS float*)(smem + 32768 + 33280);
  LAS unsigned* msk = (LAS unsigned*)(smem + 32768 + 33280 + 512);
  const int tid = otid(), lane = tid & 63, wv = tid >> 6, i = lane & 31, h5 = lane >> 5;
  const int qt = 127 - (item >> 3), bg = item & 7, b = bg >> 1, g = bg & 1, hq = g * 4 + wv;
  const int s0 = qt * 32, si = s0 + i, cur = s0 >> 6;
  const size_t qoff = ((size_t)(b * 8 + hq) * S + si) * 64 + 8 * h5;
  bf16x8 qf[4];
#pragma unroll
  for (int s4 = 0; s4 < 4; ++s4) qf[s4] = *(const bf16x8*)(p.QN + qoff + 16 * s4);
  const float* gs = p.GS + (size_t)(b * S + si) * 24 + hq * 3;
  const float g0 = gs[0], g1 = gs[1], g2 = gs[2];
  f32x16 oa0, oa1, o0, o1;
#pragma unroll
  for (int q = 0; q < 16; ++q) { o0[q] = 0.f; o1[q] = 0.f; }
  float l = 0.f;
  LAS float* psl = pslcw + (wv * 32 + i) * 65;
  const int ncv = (s0 + 31 - 31) >> 4;
  const int tc_hi = (ncv < 254 ? ncv : 254) >> 6;
#pragma unroll
  for (int k = 0; k < 32; ++k) psl[2 * k + h5] = 0.f;
  nsa_pass<0, 2>(kv, p.kcb + (size_t)bg * 256 * 64, p.vcb + (size_t)bg * 256 * 64, 0, tc_hi, qf, p.smaxv[1] * LOG2E, si, 0ull, o0, o1, l, psl);
  l += __shfl_xor(l, 32);
  {
    const float il = l > 0.f ? 1.f / l : 0.f;
    if (h5 == 0) invl[wv * 32 + i] = il;
    const float sc = g0 * il;
#pragma unroll
    for (int q = 0; q < 16; ++q) { oa0[q] = o0[q] * sc; oa1[q] = o1[q] * sc; o0[q] = 0.f; o1[q] = 0.f; }
  }
  __syncthreads();
  LAS float* scr = pslcw;
  {
    const int q = tid >> 3, jj = tid & 7;
    float tot[8];
#pragma unroll
    for (int k = 0; k < 8; ++k) {
      const int j = jj + 8 * k;
      float v = 0.f;
#pragma unroll
      for (int w4 = 0; w4 < 4; ++w4) v += pslcw[(w4 * 32 + q) * 65 + j] * invl[w4 * 32 + q];
      const bool forced = (j == 0) || (j == cur) || (j == cur - 1);
      tot[k] = forced ? INFINITY : (j <= cur ? v : -INFINITY);
    }
    __syncthreads();
#pragma unroll
    for (int k = 0; k < 8; ++k) scr[q * 65 + jj + 8 * k] = tot[k];
    if (tid < 64) msk[tid] = 0u;
    __syncthreads();
    unsigned lo = 0u, hi = 0u;
#pragma unroll
    for (int k = 0; k < 8; ++k) {
      const int j = jj + 8 * k; const float v = tot[k];
      int rank = 0;
      for (int c = 0; c < 64; ++c) { const float sv = scr[q * 65 + c]; rank += (sv > v) || (sv == v && c < j); }
      if (rank < 16 && j <= cur) { if (j < 32) lo |= 1u << j; else hi |= 1u << (j - 32); }
    }
    if (lo) atomicOr((unsigned*)&msk[q * 2], lo);
    if (hi) atomicOr((unsigned*)&msk[q * 2 + 1], hi);
    __syncthreads();
  }
  const unsigned long long selm = (unsigned long long)msk[i * 2] | ((unsigned long long)msk[i * 2 + 1] << 32);
#pragma unroll
  for (int s4 = 0; s4 < 4; ++s4) qf[s4] = *(const bf16x8*)(p.QR + qoff + 16 * s4);
  const size_t kvoff = (size_t)bg * S * 64;
  l = 0.f;
  nsa_pass<1, 4>(kv, p.KSL + kvoff, p.VSL + kvoff, 0, cur, qf, p.smaxv[2] * LOG2E, si, selm, o0, o1, l, nullptr);
  l += __shfl_xor(l, 32);
  {
    const float sc = g1 / l;
#pragma unroll
    for (int q = 0; q < 16; ++q) { oa0[q] += o0[q] * sc; oa1[q] += o1[q] * sc; o0[q] = 0.f; o1[q] = 0.f; }
  }
  l = 0.f;
  const int tw_lo = s0 >= 511 ? (s0 - 511) >> 6 : 0;
  nsa_pass<2, 4>(kv, p.KW + kvoff, p.VW + kvoff, tw_lo, cur, qf, p.smaxv[3] * LOG2E, si, 0ull, o0, o1, l, nullptr);
  l += __shfl_xor(l, 32);
  {
    const float sc = g2 / l;
#pragma unroll
    for (int q = 0; q < 16; ++q) { oa0[q] += o0[q] * sc; oa1[q] += o1[q] * sc; }
  }
  unsigned char* orow = p.mixq + (size_t)(b * S + si) * D + 512 + hq * 64 + 4 * h5;
#pragma unroll
  for (int rg = 0; rg < 4; ++rg) {
    *(unsigned*)(orow + 8 * rg) = pk4_fp8(clamp_e4m3(oa0[4 * rg] * MQ_SCALE), clamp_e4m3(oa0[4 * rg + 1] * MQ_SCALE), clamp_e4m3(oa0[4 * rg + 2] * MQ_SCALE), clamp_e4m3(oa0[4 * rg + 3] * MQ_SCALE));
    *(unsigned*)(orow + 32 + 8 * rg) = pk4_fp8(clamp_e4m3(oa1[4 * rg] * MQ_SCALE), clamp_e4m3(oa1[4 * rg + 1] * MQ_SCALE), clamp_e4m3(oa1[4 * rg + 2] * MQ_SCALE), clamp_e4m3(oa1[4 * rg + 3] * MQ_SCALE));
  }
}
__device__ __forceinline__ void cvt_queue_item(const P& p, int ci) {
  f32x4 ra[16], rb[16];
  const CvtQ d0 = cvt_expert_desc(p, ci * 4), d1 = cvt_expert_desc(p, ci * 4 + 1), d2 = cvt_expert_desc(p, ci * 4 + 2), d3 = cvt_expert_desc(p, ci * 4 + 3);
  cvtq_load(d0, ra); cvtq_load(d1, rb);
  cvtq_store(d0, ra); cvtq_load(d2, ra);
  cvtq_store(d1, rb); cvtq_load(d3, rb);
  cvtq_store(d2, ra); cvtq_store(d3, rb);
}
__device__ __forceinline__ void ph_attn_a(const P& p, char* smem) {
  for (;;) {
    const int q = next_item(p.ctr + 0, smem);
    if (q >= 16 + 2560) break;
    if (q < 16) { compress_item(p, smem, q); continue; }
    const int j = q - 16, g = j / 5, r = j - g * 5;
    if (r == 0 || r == 3) dilated_item(p, smem, g * 2 + (r == 3)); else cvt_queue_item(p, g * 3 + (r == 1 ? 0 : (r == 2 ? 1 : 2)));
  }
}
__device__ __forceinline__ void ph_attn_b(const P& p, char* smem) {
  for (;;) {
    const int q = next_item(p.ctr + 1, smem);
    if (q >= 2560) break;
    const int g = q / 5, r = q - g * 5;
    if (r == 0 || r == 3) nsa_item(p, smem, g * 2 + (r == 3)); else cvt_queue_item(p, 1536 + g * 3 + (r == 1 ? 0 : (r == 2 ? 1 : 2)));
  }
}

__device__ __forceinline__ void ph_route(const P& p, char* smem) {
  const int lane = threadIdx.x & 63, wv = threadIdx.x >> 6;
  int* hist = (int*)smem;
  __syncthreads();
  hist[threadIdx.x] = 0;
  __syncthreads();
  const int tpb = T / gridDim.x, t0 = blockIdx.x * tpb;
  float bias[4];
#pragma unroll
  for (int i = 0; i < 4; ++i) bias[i] = p.r_bias[lane + 64 * i];
  for (int tt = wv; tt < tpb; tt += 4) {
    const int t = t0 + tt;
    float aff[4], bv[4], ta[4], tb[4];
#pragma unroll
    for (int i = 0; i < 4; ++i) { { const size_t li = (size_t)t * NE + lane + 64 * i; aff[i] = sigmoidf((p.logits[li] + p.logits[li + (size_t)T * NE]) + p.logits[li + (size_t)2 * T * NE]); } bv[i] = aff[i] + bias[i]; ta[i] = bv[i]; tb[i] = -INFINITY; }
#pragma unroll
    for (int o = 16; o; o >>= 1)
#pragma unroll
      for (int i = 0; i < 4; ++i) {
        const float a2 = __shfl_xor(ta[i], o), b2 = __shfl_xor(tb[i], o);
        const float na = fmaxf(ta[i], a2), nb = fmaxf(fminf(ta[i], a2), fmaxf(tb[i], b2));
        ta[i] = na; tb[i] = nb;
      }
    float gs[8];
#pragma unroll
    for (int i = 0; i < 4; ++i) { const float s2 = ta[i] + tb[i]; gs[2 * i] = __shfl(s2, 0); gs[2 * i + 1] = __shfl(s2, 32); }
    unsigned gmask = 0;
#pragma unroll
    for (int g = 0; g < 8; ++g) {
      int rank = 0;
#pragma unroll
      for (int i = 0; i < 8; ++i) rank += (gs[i] > gs[g]) || (gs[i] == gs[g] && i < g);
      if (rank < 4) gmask |= 1u << g;
    }
#pragma unroll
    for (int i = 0; i < 4; ++i) if (!((gmask >> (2 * i + (lane >> 5))) & 1u)) bv[i] = -INFINITY;
    unsigned key[4];
#pragma unroll
    for (int i = 0; i < 4; ++i) { const unsigned u = __float_as_uint(bv[i]); key[i] = (u & 0x80000000u) ? ~u : (u | 0x80000000u); }
    unsigned thr = 0u;
#pragma unroll 1
    for (int bit = 31; bit >= 0; --bit) {
      const unsigned trial = thr | (1u << bit);
      int c = 0;
#pragma unroll
      for (int i = 0; i < 4; ++i) c += __builtin_popcountll(__ballot(key[i] >= trial));
      if (c >= 8) thr = trial;
    }
    int ngt = 0;
#pragma unroll
    for (int i = 0; i < 4; ++i) ngt += __builtin_popcountll(__ballot(key[i] > thr));
    const int need = 8 - ngt;
    const unsigned long long ltmask = (1ull << lane) - 1ull;
    int eqbefore = 0, selbefore = 0;
    bool sel[4]; int slot[4];
#pragma unroll
    for (int i = 0; i < 4; ++i) {
      const unsigned long long eqm = __ballot(key[i] == thr);
      const bool s = key[i] > thr || (key[i] == thr && eqbefore + __builtin_popcountll(eqm & ltmask) < need);
      eqbefore += __builtin_popcountll(eqm);
      const unsigned long long sm = __ballot(s);
      sel[i] = s; slot[i] = selbefore + __builtin_popcountll(sm & ltmask);
      selbefore += __builtin_popcountll(sm);
    }
    float part = 0.f;
#pragma unroll
    for (int i = 0; i < 4; ++i) part += sel[i] ? aff[i] : 0.f;
    const float ssum = wave_sum(part);
#pragma unroll
    for (int i = 0; i < 4; ++i)
      if (sel[i]) {
        const int e = lane + 64 * i;
        p.eidx[t * 8 + slot[i]] = e;
        p.gates[t * 8 + slot[i]] = aff[i] / ssum * 2.5f;
        p.pos[t * 8 + slot[i]] = atomicAdd(&hist[e], 1);
      }
  }
  __syncthreads();
  p.bhist[(size_t)blockIdx.x * NE + threadIdx.x] = hist[threadIdx.x];
}
__device__ __forceinline__ void ph_fill(const P& p, char* smem) {
  int* soff = (int*)smem;
  int* wsum = soff + 260;
  int* sbase = soff + 272;
  const int tid = threadIdx.x, lane = tid & 63, wv = tid >> 6;
  __syncthreads();
  int c = 0, before = 0;
  for (int bb = 0; bb < (int)gridDim.x; ++bb) { const int v = p.bhist[(size_t)bb * NE + tid]; c += v; before += (bb < (int)blockIdx.x) ? v : 0; }
  int incl = c;
#pragma unroll
  for (int o = 1; o < 64; o <<= 1) { const int v = __shfl_up(incl, o); if (lane >= o) incl += v; }
  if (lane == 63) wsum[wv] = incl;
  __syncthreads();
  int base = 0;
  for (int i = 0; i < wv; ++i) base += wsum[i];
  soff[tid] = base + incl - c;
  sbase[tid] = base + incl - c + before;
  if (tid == 255) soff[256] = base + incl;
  __syncthreads();
  if (blockIdx.x == 0) {
    p.off[tid] = soff[tid]; p.cnt[tid] = c;
    if (tid == 255) p.off[256] = soff[256];
  }
  if (blockIdx.x == 1) {
    const int x = tid >> 5, i = tid & 31, e = x + 8 * i;
    const int tl = (soff[e + 1] - soff[e] + 255) >> 8;
    int inc2 = tl;
#pragma unroll
    for (int o = 1; o < 32; o <<= 1) { const int v = __shfl_up(inc2, o, 32); if (i >= o) inc2 += v; }
    p.tstart[x * 33 + i] = inc2 - tl;
    if (i == 31) p.tstart[x * 33 + 32] = inc2;
  }
  const int tpb = T / gridDim.x, a0 = blockIdx.x * tpb * 8;
  for (int a = a0 + tid; a < a0 + tpb * 8; a += 256) p.sorted[sbase[p.eidx[a]] + p.pos[a]] = a;
}

template <int NTL, class F>
__device__ __forceinline__ void moe_grid(const P& p, F body) {
  const int xcd = blockIdx.x & 7, lb = blockIdx.x >> 3, nlb = gridDim.x >> 3;
  const int* ts = p.tstart + xcd * 33;
  const int total = ts[32] * NTL;
  int i = 0;
  for (int j = lb; j < total; j += nlb) {
    while (ts[i + 1] * NTL <= j) ++i;
    const int tiles = ts[i + 1] - ts[i], rem = j - ts[i] * NTL;
    body(xcd + 8 * i, rem / tiles, rem % tiles);
  }
}
__device__ __forceinline__ const unsigned char* gu_rowq(const unsigned char* Wg, const unsigned char* Wu, int f0, int n) {
  const int wn = n >> 6, wi = n & 63;
  return (wi >= 32 ? Wu : Wg) + (size_t)(f0 + wn * 32 + (wi & 31)) * D;
}
__device__ __forceinline__ void ph_moe_gu(const P& p, char* smem) {
  moe_grid<4>(p, [&](int e, int ntile, int mtile) {
    const int cnt = p.cnt[e] - mtile * 256; const int* srt = p.sorted + p.off[e] + mtile * 256;
    const unsigned char* A = p.h2q; const unsigned char* Wg = p.Wq_g + (size_t)e * FF * D; const unsigned char* Wu = p.Wq_u + (size_t)e * FF * D; unsigned char* H = p.Hq;
    const float* gates = p.gates; const unsigned char* Z = (const unsigned char*)p.zrow;
    gemm2q(smem, D, [=](int r) { return r < cnt ? A + (size_t)(srt[r] >> 3) * D : Z; }, [=](int n) { return gu_rowq(Wg, Wu, ntile * 64, n); },
           [=](const f32x4 (&acc)[8][4], int r0, int c0, int) {
             const int wn = c0 >> 6, l4 = (c0 & 63) >> 2;
#pragma unroll
             for (int mt = 0; mt < 8; ++mt) {
               const int r = r0 + mt * 16; const bool ok = r < cnt; const int a = ok ? srt[r] : 0;
               const float sc = ok ? gates[a] * (HQ_SCALE / (WQ_SCALE * WQ_SCALE)) : 0.f;
               unsigned d[2];
#pragma unroll
               for (int q = 0; q < 2; ++q) {
                 const f32x4 g = acc[mt][q], u = acc[mt][q + 2];
                 float h[4];
#pragma unroll
                 for (int i = 0; i < 4; ++i) h[i] = clamp_e4m3(silu(g[i] * (1.f / WQ_SCALE)) * u[i] * (sc * WQ_SCALE));
                 d[q] = pk4_fp8(h[0], h[1], h[2], h[3]);
               }
               const bool b0 = l4 & 1;
               const unsigned send = b0 ? d[0] : d[1], recv = __shfl_xor(send, 16);
               u32x2 w = b0 ? (u32x2){recv, d[1]} : (u32x2){d[0], recv};
               if (ok) *(u32x2*)(H + (size_t)a * FF + ntile * 64 + wn * 32 + (b0 ? 16 + 4 * (l4 - 1) : 4 * l4)) = w;
             }
           }, 0, cnt <= 128);
  });
}
__device__ __forceinline__ void ph_moe_d(const P& p, char* smem) {
  moe_grid<4>(p, [&](int e, int ntp, int mtile) {
    const int cnt = p.cnt[e] - mtile * 256; const int* srt = p.sorted + p.off[e] + mtile * 256;
    const unsigned char* A = p.Hq; const unsigned char* W = p.Wq_d + (size_t)e * D * FF + (size_t)ntp * 256 * FF; unsigned char* Yq = p.Yq; const unsigned char* Z = (const unsigned char*)p.zrow;
    const int tid_ = otid(), lrow = ((tid_ >> 7) & 1) * 128 + (tid_ & 15);
    LAS int* ridt = (LAS int*)((LAS char*)smem + 3 * G2_STAGE);
    __syncthreads();
    ridt[tid_] = tid_ < cnt ? srt[tid_] : -1;
    gemm2q<2>(smem, FF, [=](int r) { return r < cnt ? A + (size_t)srt[r] * FF : Z; }, [=](int n) { return W + (size_t)n * FF; },
           [=](const f32x4 (&acc)[8][4], int r0, int c0, int rp) {
             const int wn64 = c0 & ~63, l4 = (c0 & 63) >> 2;
             const float s = YQ_SCALE / (WQ_SCALE * HQ_SCALE);
#pragma unroll
             for (int mt = 0; mt < 8; ++mt) {
               const int rd = ridt[lrow + mt * 16]; const bool ok = rd >= 0;
               unsigned dq[4];
#pragma unroll
               for (int nt = 0; nt < 4; ++nt) { const f32x4 a = acc[mt][nt] * s; dq[nt] = pk4_fp8(clamp_e4m3(a[0]), clamp_e4m3(a[1]), clamp_e4m3(a[2]), clamp_e4m3(a[3])); }
               { u32x2v r = __builtin_amdgcn_permlane16_swap(dq[0], dq[1], false, false); dq[0] = r.x; dq[1] = r.y; r = __builtin_amdgcn_permlane16_swap(dq[2], dq[3], false, false); dq[2] = r.x; dq[3] = r.y;
                 r = __builtin_amdgcn_permlane32_swap(dq[0], dq[2], false, false); dq[0] = r.x; dq[2] = r.y; r = __builtin_amdgcn_permlane32_swap(dq[1], dq[3], false, false); dq[1] = r.x; dq[3] = r.y; }
               if (ok) *(u32x4*)(Yq + (size_t)rd * D + (ntp * 2 + rp) * 128 + wn64 + 16 * l4) = (u32x4){dq[0], dq[1], dq[2], dq[3]};
               asm volatile("" ::: "memory");
             }
           }, (size_t)128 * FF, cnt <= 128);
  });
}
__device__ __forceinline__ void ph_combine(const P& p) {
  WLOOP(w, T / 4) {
    const int tid_ = otid(), t = w * 4 + (tid_ >> 6), c = (tid_ & 63) * 16, b = t / S;
    float acc[16];
#pragma unroll
    for (int i = 0; i < 16; ++i) acc[i] = 0.f;
#pragma unroll
    for (int k = 0; k < 8; ++k) {
      const u32x4 v = *(const u32x4*)(p.Yq + ((size_t)t * 8 + k) * D + c);
#pragma unroll
      for (int i = 0; i < 4; ++i) {
        const f32x2 lo = __builtin_amdgcn_cvt_pk_f32_fp8((int)v[i], false), hi = __builtin_amdgcn_cvt_pk_f32_fp8((int)v[i], true);
        acc[4 * i] += lo[0]; acc[4 * i + 1] += lo[1]; acc[4 * i + 2] += hi[0]; acc[4 * i + 3] += hi[1];
      }
    }
    const bf16_t* ys = p.Ys + (size_t)t * D + c; const float* gt = p.mod + b * 6 * D + 5 * D + c; const bf16_t* x1 = (const bf16_t*)p.x1 + (size_t)t * D + c; float* o = p.out + (size_t)t * D + c;
#pragma unroll
    for (int h = 0; h < 4; ++h) {
      const u32x2 sv = *(const u32x2*)(ys + 4 * h);
      const float s0 = __uint_as_float(sv.x << 16), s1 = __uint_as_float(sv.x & 0xffff0000u), s2 = __uint_as_float(sv.y << 16), s3 = __uint_as_float(sv.y & 0xffff0000u);
      const u32x2 xq = *(const u32x2*)(x1 + 4 * h);
      const f32x4 xv = {__uint_as_float(xq.x << 16), __uint_as_float(xq.x & 0xffff0000u), __uint_as_float(xq.y << 16), __uint_as_float(xq.y & 0xffff0000u)}, gv = *(const f32x4*)(gt + 4 * h);
      f32x4 r = {xv[0] + gv[0] * (s0 + acc[4 * h] * (1.f / YQ_SCALE)), xv[1] + gv[1] * (s1 + acc[4 * h + 1] * (1.f / YQ_SCALE)),
                 xv[2] + gv[2] * (s2 + acc[4 * h + 2] * (1.f / YQ_SCALE)), xv[3] + gv[3] * (s3 + acc[4 * h + 3] * (1.f / YQ_SCALE))};
      *(f32x4*)(o + 4 * h) = r;
    }
  }
}


#define XB_TMO      128
#define XB_XCNT(j)  (256  + 64 * (j))
#define XB_XSUB(j)  (1280 + 64 * (j))
#define XB_XGEN(j)  (2304 + 64 * (j))
#define XB_TOP      3328
#define XB_TOPGEN   3392
#define XCD_BAR_WORDS 3456
#define XB_SPIN_CAP (1u << 22)
__device__ __forceinline__ unsigned xb_ld(unsigned* p)              { return __hip_atomic_load(p, __ATOMIC_RELAXED, __HIP_MEMORY_SCOPE_AGENT); }
__device__ __forceinline__ unsigned xb_add(unsigned* p, unsigned v) { return __hip_atomic_fetch_add(p, v, __ATOMIC_RELAXED, __HIP_MEMORY_SCOPE_AGENT); }
__device__ __forceinline__ unsigned xb_xcc_id() { return (unsigned)__builtin_amdgcn_s_getreg((3 << 11) | 20) & 0xFu; }
#define XB_SPIN(cond, bar) do { unsigned _sp = 0; while (cond) { __builtin_amdgcn_s_sleep(1); \
    if ((++_sp & 255u) == 0u) { if (xb_ld(&(bar)[XB_TMO])) break; if (_sp > XB_SPIN_CAP) { atomicAdd(&(bar)[XB_TMO], 1u); break; } } } } while (0)
struct XcdBarrier { unsigned* bar; unsigned x; volatile LAS unsigned* st; };
__device__ __forceinline__ XcdBarrier xcd_barrier_post(unsigned* bar, volatile LAS unsigned* st) {
  XcdBarrier b; b.bar = bar; b.x = xb_xcc_id(); b.st = st;
  if (threadIdx.x == 0) (void)xb_add(&bar[XB_XCNT(b.x)], 1u);
  return b;
}
__device__ __forceinline__ void xcd_barrier_complete(unsigned* bar, unsigned x, unsigned& nloc, unsigned& nx) {
  const unsigned G = gridDim.x * gridDim.y * gridDim.z;
  unsigned sum, cnt, mine, sp = 0u;
  for (;;) {
    sum = 0u; cnt = 0u; mine = 0u;
#pragma unroll
    for (unsigned j = 0; j < 16; ++j) { const unsigned c = xb_ld(&bar[XB_XCNT(j)]); sum += c; cnt += (c > 0u) ? 1u : 0u; mine = (j == x) ? c : mine; }
    if (sum == G) break;
    __builtin_amdgcn_s_sleep(1);
    if ((++sp & 255u) == 0u) { if (xb_ld(&bar[XB_TMO])) break; if (sp > XB_SPIN_CAP) { atomicAdd(&bar[XB_TMO], 1u); break; } }
  }
  nloc = mine > 0u ? mine : 1u; nx = cnt > 0u ? cnt : 1u;
}
__device__ __forceinline__ void xcd_barrier(const XcdBarrier& b) {
  asm volatile("s_waitcnt vmcnt(0)" ::: "memory");
  __syncthreads();
  if (threadIdx.x == 0) {
    unsigned* bar = b.bar;
    __builtin_amdgcn_s_waitcnt(0);
    unsigned nloc = b.st[0], nx = b.st[1];
    if (nloc == 0u) { xcd_barrier_complete(bar, b.x, nloc, nx); b.st[0] = nloc; b.st[1] = nx; }
    const unsigned old = xb_add(&bar[XB_XSUB(b.x)], 1u);
    const unsigned gen = old / nloc;
    if (old + 1u == (gen + 1u) * nloc) {
      __builtin_amdgcn_fence(__ATOMIC_RELEASE, "agent");
      asm volatile("s_waitcnt vmcnt(0)" ::: "memory");
      const unsigned og = xb_add(&bar[XB_TOP], 1u);
      const unsigned tg = og / nx;
      if (og + 1u == (tg + 1u) * nx) xb_add(&bar[XB_TOPGEN], 1u);
      else XB_SPIN(xb_ld(&bar[XB_TOPGEN]) == tg, bar);
      __builtin_amdgcn_fence(__ATOMIC_ACQUIRE, "agent");
      xb_add(&bar[XB_XGEN(b.x)], 1u);
      asm volatile("s_waitcnt vmcnt(0)" ::: "memory");
    } else {
      XB_SPIN(xb_ld(&bar[XB_XGEN(b.x)]) == gen, bar);
      __builtin_amdgcn_fence(__ATOMIC_ACQUIRE, "agent");
      asm volatile("s_waitcnt vmcnt(0)" ::: "memory");
    }
  }
  __syncthreads();
}

__global__ void __launch_bounds__(256, 2) mega(P p) {
  extern __shared__ __attribute__((aligned(16))) char smem[];
  {
    volatile LAS unsigned* st0 = (volatile LAS unsigned*)((LAS char*)smem + SMEM_BYTES - 32);
    if (threadIdx.x == 0) { st0[0] = 0u; st0[1] = 0u; }
    __syncthreads();
  }
  const XcdBarrier xb = xcd_barrier_post(p.bar, (volatile LAS unsigned*)((LAS char*)smem + SMEM_BYTES - 32));
  ph_ada(p, smem); ph_rope_tab(p);
  { int ib = 0;
    for (int it = (int)blockIdx.x; it < 8 * 23; it += gridDim.x) cvtq_tile(p.w_in, INC, p.Wq_in, D, (it & 7) * 128, (it >> 3) * 128, INC);
    ib = (8 * 23) % gridDim.x; for (int it = (int)blockIdx.x - ib; it < 64; it += gridDim.x) if (it >= 0) cvtq_tile(p.w_out, D, p.Wq_out, D, (it & 7) * 128, (it >> 3) * 128);
    ib = (ib + 64) % gridDim.x;
    cvt_matrix<false>(p.w_router, p.Wt_rth, D, NE, ib); cvt_matrix<true>(p.w_router, p.Wt_rtl, D, NE, ib);
    cvt_matrix<false>(p.w1_k, p.Wt_c1k, 2048, 128, ib); cvt_matrix<false>(p.w1_v, p.Wt_c1v, 2048, 128, ib);
    cvt_matrix<false>(p.ws_gate, p.Wt_sg, D, FF, ib); cvt_matrix<false>(p.ws_up, p.Wt_su, D, FF, ib); cvt_matrix<false>(p.ws_down, p.Wt_sd, FF, D, ib); }
  if (blockIdx.x == gridDim.x - 4) { for (int i = threadIdx.x; i < 2048; i += 256) p.zrow[i] = 0; }
  if (blockIdx.x == gridDim.x - 1) {
    const int which = threadIdx.x >> 7, n = threadIdx.x & 127;
    const float* pe = which ? p.pe_v : p.pe_k; const float* w1 = which ? p.w1_v : p.w1_k;
    float a = 0.f;
    for (int k = 0; k < 2048; ++k) a += pe[k] * w1[(size_t)k * 128 + n];
    p.b1c[threadIdx.x] = a;
  }
  if (blockIdx.x == gridDim.x - 2) {
    for (int i = threadIdx.x; i < 8 * 64; i += 256) { p.kcb[((size_t)(i >> 6) * 256 + 255) * 64 + (i & 63)] = 0; p.vcb[((size_t)(i >> 6) * 256 + 255) * 64 + (i & 63)] = 0; }
  }
  if (blockIdx.x == gridDim.x - 3) {
    p.cnt[threadIdx.x] = 0;
    if (threadIdx.x < 8) p.ctr[threadIdx.x] = 0;
    if (threadIdx.x < 64) {
      const int ln = threadIdx.x;
      const float a = wave_max(fabsf(p.g_q_dil[ln])), bq = wave_max(fabsf(p.g_k_dil[ln])), c = wave_max(fabsf(p.g_q_nsa[ln]));
      const float d1 = wave_max(fabsf(p.g_k_cmp[ln])), d2 = wave_max(fabsf(p.g_k_slc[ln])), d3 = wave_max(fabsf(p.g_k_win[ln]));
      if (ln == 0) { p.smaxv[0] = 8.f * a * bq; p.smaxv[1] = 8.f * c * d1; p.smaxv[2] = 8.f * c * d2; p.smaxv[3] = 8.f * c * d3; }
    }
  }
  xcd_barrier(xb);
  ph_norm_mod<false>(p.x, p.g_mix, p.mod, 0, D, nullptr, p.h1q);
  xcd_barrier(xb);
  ph_proj(p, smem);
  xcd_barrier(xb);
  ph_attn_a(p, smem);
  xcd_barrier(xb);
  ph_attn_b(p, smem);
  xcd_barrier(xb);
  ph_outproj(p, smem);
  xcd_barrier(xb);
  if (DUP == 10) { ph_outproj_abl<0>(p, smem); xcd_barrier(xb); }
  if (DUP == 11) { ph_outproj_abl<1>(p, smem); xcd_barrier(xb); }
  if (DUP == 12) { ph_outproj_abl<2>(p, smem); xcd_barrier(xb); }
  if (DUP == 13) { ph_outproj_abl<3>(p, smem); xcd_barrier(xb); }
  ph_norm_mod<true, true>(p.x1, p.g_ffn, p.mod, 3 * D, 4 * D, p.h2s, p.h2q);
  xcd_barrier(xb);
  ph_router_shared_gu(p, smem);
  xcd_barrier(xb);
  ph_route(p, smem); ph_shared_d(p, smem);
  xcd_barrier(xb);
  ph_fill(p, smem);
  xcd_barrier(xb);
  ph_moe_gu(p, smem);
  xcd_barrier(xb);
  ph_moe_d(p, smem);
  xcd_barrier(xb);
  ph_combine(p);
}
}

extern "C" void kernel_launch(void* const* d_in, const int* in_sizes, int n_in, void* d_out, int out_size, void* d_ws, size_t ws_size,
                              hipStream_t stream) {
  P p{};
  const float** f = (const float**)d_in;
  p.x = f[0]; p.c = f[1]; p.w_ada = f[2]; p.b_ada = f[3]; p.g_mix = f[4]; p.g_ffn = f[5]; p.w_in = f[6]; p.g_q_dil = f[7]; p.g_k_dil = f[8];
  p.g_q_nsa = f[9]; p.g_k_cmp = f[10]; p.g_k_slc = f[11]; p.g_k_win = f[12]; p.pe_k = f[13]; p.w1_k = f[14]; p.w2_k = f[15]; p.pe_v = f[16];
  p.w1_v = f[17]; p.w2_v = f[18]; p.w_out = f[19]; p.w_router = f[20]; p.r_bias = f[21]; p.w_gate = f[22]; p.w_up = f[23]; p.w_down = f[24];
  p.ws_gate = f[25]; p.ws_up = f[26]; p.ws_down = f[27];
  p.out = (float*)d_out;
  char* w = (char*)d_ws; size_t o = 0;
  auto alloc = [&](size_t bytes) { void* r = w + o; o += (bytes + 255) & ~(size_t)255; return r; };
  p.mod = (float*)alloc(4 * 6 * D * 4);
  p.rope = (float*)alloc(S * 16 * 4);
  p.selmask = (unsigned long long*)alloc((size_t)T * 2 * 8);
  p.eidx = (int*)alloc(T * 8 * 4); p.gates = (float*)alloc(T * 8 * 4);
  p.cnt = (int*)alloc(NE * 4); p.off = (int*)alloc((NE + 1) * 4); p.pos = (int*)alloc(T * 8 * 4); p.sorted = (int*)alloc(T * 8 * 4);
  p.tstart = (int*)alloc(8 * 33 * 4);
  p.smaxv = (float*)alloc(64);
  p.b1c = (float*)alloc(256 * 4);
  p.ctr = (int*)alloc(64);
  p.kcb = (bf16_t*)alloc(8 * 256 * 64 * 2); p.vcb = (bf16_t*)alloc(8 * 256 * 64 * 2);
  p.GS = (float*)alloc((size_t)T * 24 * 4);
  p.QA = (bf16_t*)alloc((size_t)T * 512 * 2); p.KA = (bf16_t*)alloc((size_t)T * 512 * 2); p.VA = (bf16_t*)alloc((size_t)T * 512 * 2);
  p.QN = (bf16_t*)alloc((size_t)T * 512 * 2); p.QR = (bf16_t*)alloc((size_t)T * 512 * 2);
  p.KC = (bf16_t*)alloc((size_t)T * 128 * 2); p.VC = (bf16_t*)alloc((size_t)T * 128 * 2);
  p.KSL = (bf16_t*)alloc((size_t)T * 128 * 2); p.VSL = (bf16_t*)alloc((size_t)T * 128 * 2);
  p.KW = (bf16_t*)alloc((size_t)T * 128 * 2); p.VW = (bf16_t*)alloc((size_t)T * 128 * 2);
  p.logits = (float*)alloc((size_t)3 * T * NE * 4);
  p.x1 = (float*)alloc((size_t)T * D * 4);
  p.mixinb = (bf16_t*)alloc((size_t)T * D * 2);
  p.h1b = (bf16_t*)alloc((size_t)T * D * 2);
  p.h2s = (bf16_t*)alloc((size_t)T * 2 * D * 2);
  p.Hs = (bf16_t*)alloc((size_t)T * FF * 2);
  p.Ys = (bf16_t*)alloc((size_t)T * D * 2);
  p.bar = (unsigned*)alloc(XCD_BAR_WORDS * 4);
  p.bhist = (int*)alloc((size_t)2048 * NE * 4);
  p.Wt_c1k = (bf16_t*)alloc((size_t)128 * 2048 * 2); p.Wt_c1v = (bf16_t*)alloc((size_t)128 * 2048 * 2);
  p.zrow = (bf16_t*)alloc(2048 * 2);
  p.Wt_in = (bf16_t*)alloc((size_t)2944 * D * 2);
  p.Wt_out = (bf16_t*)alloc((size_t)D * D * 2);
  p.Wt_rth = (bf16_t*)alloc((size_t)NE * D * 2); p.Wt_rtl = (bf16_t*)alloc((size_t)NE * D * 2);
  p.Wt_sg = (bf16_t*)alloc((size_t)FF * D * 2); p.Wt_su = (bf16_t*)alloc((size_t)FF * D * 2); p.Wt_sd = (bf16_t*)alloc((size_t)D * FF * 2);
  p.Wq_g = (unsigned char*)alloc((size_t)NE * FF * D); p.Wq_u = (unsigned char*)alloc((size_t)NE * FF * D); p.Wq_d = (unsigned char*)alloc((size_t)NE * D * FF);
  p.h2q = (unsigned char*)alloc((size_t)T * D); p.h1q = (unsigned char*)alloc((size_t)T * D); p.Wq_in = (unsigned char*)alloc((size_t)2944 * D); p.Hq = (unsigned char*)alloc((size_t)T * 8 * FF);
  p.Yq = (unsigned char*)alloc((size_t)T * 8 * D);
  p.mixq = (unsigned char*)alloc((size_t)T * D); p.Wq_out = (unsigned char*)alloc((size_t)D * D);
  (void)hipMemsetAsync(p.bar, 0, XCD_BAR_WORDS * 4, stream);
  static int grid_blocks = 0;
  if (!grid_blocks) {
    int dev = 0, cus = 0, per_cu = 0;
    (void)hipGetDevice(&dev);
    (void)hipDeviceGetAttribute(&cus, hipDeviceAttributeMultiprocessorCount, dev);
    (void)hipOccupancyMaxActiveBlocksPerMultiprocessor(&per_cu, mega, 256, SMEM_BYTES);
    if (per_cu > 2) per_cu = 2;
    if (per_cu < 1) per_cu = 1;
    grid_blocks = cus * per_cu;
  }
  void* args[] = {&p};
  hipError_t e = hipLaunchCooperativeKernel((void*)mega, dim3(grid_blocks), dim3(256), args, SMEM_BYTES, stream);
  if (e != hipSuccess) fprintf(stderr, "cooperative launch failed: %s (grid %d)\n", hipGetErrorString(e), grid_blocks);
}
```

```cpp
#include <hip/hip_runtime.h>
#include <hip/hip_cooperative_groups.h>
#include <stdint.h>
#include <cstdio>
namespace cg = cooperative_groups;

namespace {
constexpr int D = 1024, NB = 4, S = 4096, T = NB * S, HD = 64;
constexpr int INC = 2840;
constexpr int C_QA = 0, C_KA = 512, C_VA = 1024, C_QB = 1536, C_KC = 2048, C_VC = 2176, C_KSL = 2304, C_VSL = 2432,
              C_KW = 2560, C_VW = 2688, C_GB = 2816;
constexpr int NC = 255, NE = 256, TOPK = 8, FF = 256;
constexpr float EPS = 1e-6f;
#ifndef DUP
#define DUP 0
#endif
constexpr int SMEM_BYTES = 74 * 1024;
typedef unsigned short bf16_t;
typedef short bf16x8 __attribute__((ext_vector_type(8)));
typedef float f32x4 __attribute__((ext_vector_type(4)));
typedef unsigned u32x4 __attribute__((ext_vector_type(4)));
typedef unsigned u32x2 __attribute__((ext_vector_type(2)));
typedef __bf16 bf2_t __attribute__((ext_vector_type(2)));
typedef float f32x2 __attribute__((ext_vector_type(2)));
typedef float f32x16 __attribute__((ext_vector_type(16)));
typedef short s16x4 __attribute__((ext_vector_type(4)));
#define LAS __attribute__((address_space(3)))
#define MFMA32(a, b, c) __builtin_amdgcn_mfma_f32_32x32x16_bf16((a), (b), (c), 0, 0, 0)
constexpr float LOG2E = 1.4426950408889634f;

struct P {
  const float *x, *c, *w_ada, *b_ada, *g_mix, *g_ffn, *w_in, *g_q_dil, *g_k_dil, *g_q_nsa, *g_k_cmp, *g_k_slc, *g_k_win;
  const float *pe_k, *w1_k, *w2_k, *pe_v, *w1_v, *w2_v, *w_out, *w_router, *r_bias, *w_gate, *w_up, *w_down, *ws_gate, *ws_up, *ws_down;
  float* out;
  float *mod, *rope, *h1, *proj, *qrope, *kcmp, *vcmp, *ocmp, *oslc, *owin, *mixin, *x1, *h2, *logits, *gates, *hs_g, *hs, *shared, *Hbuf;
  unsigned long long* selmask;
  int *eidx, *cnt, *off, *pos, *sorted, *tstart;
  bf16_t *h1b, *h2s, *mixinb, *Hb, *Hs, *Ybuf, *Ys;
  bf16_t *QA, *KA, *VA, *QN, *QR, *KC, *VC, *KSL, *VSL, *KW, *VW;
  float *GS, *smaxv, *b1c;
  bf16_t *kcb, *vcb;
  int* ctr;
  int* bhist;
  unsigned char *h2q, *Hq, *Wq_g, *Wq_u, *Wq_d, *h1q, *Wq_in, *Yq, *mixq, *Wq_out, *Wq_sg, *Wq_su;
  unsigned* bar;
  bf16_t *zrow, *Wt_in, *Wt_out, *Wt_rth, *Wt_rtl, *Wt_sg, *Wt_su, *Wt_sd, *Wt_c1k, *Wt_c1v, *Wt_g, *Wt_u, *Wt_d;
};

#define WLOOP(w, n) for (int w = blockIdx.x; w < (n); w += gridDim.x)

__device__ __forceinline__ int otid() { int t = threadIdx.x; asm volatile("" : "+v"(t)); return t; }
__device__ __forceinline__ unsigned pk_bf16(float lo, float hi) {
  f32x2 v = {lo, hi};
  bf2_t r = __builtin_convertvector(v, bf2_t);
  return __builtin_bit_cast(unsigned, r);
}
__device__ __forceinline__ float clamp_e4m3(float v) { return __builtin_amdgcn_fmed3f(v, -448.f, 448.f); }
__device__ __forceinline__ unsigned pk4_fp8(float a, float b, float c, float d) {
  int t = __builtin_amdgcn_cvt_pk_fp8_f32(a, b, 0, false);
  t = __builtin_amdgcn_cvt_pk_fp8_f32(c, d, t, true);
  return (unsigned)t;
}
constexpr float WQ_SCALE = 64.f, HQ_SCALE = 8.f, YQ_SCALE = 16.f, MQ_SCALE = 16.f;
__device__ __forceinline__ float bf16_to_f32(unsigned short b) { return __uint_as_float((unsigned)b << 16); }
__device__ __forceinline__ float bf16_round(float v) { return __uint_as_float(pk_bf16(v, 0.f) << 16); }
__device__ __forceinline__ float silu(float v) { return v / (1.f + expf(-v)); }
__device__ __forceinline__ float sigmoidf(float v) { return 1.f / (1.f + expf(-v)); }
__device__ __forceinline__ float wave_sum(float v) { for (int o = 32; o; o >>= 1) v += __shfl_xor(v, o); return v; }
__device__ __forceinline__ float wave_max(float v) { for (int o = 32; o; o >>= 1) v = fmaxf(v, __shfl_xor(v, o)); return v; }

__device__ __forceinline__ void ph_ada(const P& p, char* smem) {
  float* sc = (float*)smem;
  f32x4* red = (f32x4*)(smem + 16384);
  bool loaded = false;
  WLOOP(w, 6 * D / 32) {
    const int tid = threadIdx.x, kg = tid >> 3, cl = tid & 7, j0 = w * 32 + cl * 4;
    __syncthreads();
    if (!loaded) { for (int i = tid; i < 4 * D; i += 256) sc[i] = silu(p.c[i]); loaded = true; __syncthreads(); }
    f32x4 acc[4];
#pragma unroll
    for (int b = 0; b < 4; ++b) acc[b] = (f32x4){0.f, 0.f, 0.f, 0.f};
#pragma unroll 8
    for (int it = 0; it < 32; ++it) {
      const int k = kg + 32 * it;
      const f32x4 wv = *(const f32x4*)(p.w_ada + (size_t)k * 6 * D + j0);
#pragma unroll
      for (int b = 0; b < 4; ++b) acc[b] += wv * sc[b * D + k];
    }
#pragma unroll
    for (int b = 0; b < 4; ++b) red[(kg * 8 + cl) * 4 + b] = acc[b];
    __syncthreads();
    if (tid < 128) {
      const int b = tid >> 5, c = tid & 31;
      float s = p.b_ada[w * 32 + c];
      for (int g = 0; g < 32; ++g) s += ((const float*)&red[(g * 8 + (c >> 2)) * 4 + b])[c & 3];
      p.mod[b * 6 * D + w * 32 + c] = s;
    }
  }
}
__device__ __forceinline__ void ph_rope_tab(const P& p) {
  WLOOP(w, S * 8 / 256) {
    int i = w * 256 + threadIdx.x;
    int pos = i >> 3, f = i & 7;
    double ang = (double)pos * pow(500000.0, -(double)f / 8.0);
    p.rope[i * 2] = (float)cos(ang);
    p.rope[i * 2 + 1] = (float)sin(ang);
  }
}
template <bool SPLIT, bool INBF = false>
__device__ __forceinline__ void ph_norm_mod(const float* in, const float* g, const float* mod, int shift_off, int scale_off, bf16_t* out, unsigned char* outq = nullptr) {
  const int lane = threadIdx.x & 63, wv = threadIdx.x >> 6;
  WLOOP(w, T / 4) {
    const int t = w * 4 + wv, b = t / S;
    f32x4 v[4];
    float ss = 0.f;
#pragma unroll
    for (int i = 0; i < 4; ++i) {
      if (INBF) { const u32x2 q = *(const u32x2*)((const bf16_t*)in + (size_t)t * D + i * 256 + lane * 4); v[i] = (f32x4){__uint_as_float(q.x << 16), __uint_as_float(q.x & 0xffff0000u), __uint_as_float(q.y << 16), __uint_as_float(q.y & 0xffff0000u)}; }
      else v[i] = *(const f32x4*)(in + (size_t)t * D + i * 256 + lane * 4);
      ss += v[i][0] * v[i][0] + v[i][1] * v[i][1] + v[i][2] * v[i][2] + v[i][3] * v[i][3]; }
    ss = wave_sum(ss);
    const float r = rsqrtf(ss * (1.f / D) + EPS);
    const int ld = SPLIT ? 2 * D : D;
#pragma unroll
    for (int i = 0; i < 4; ++i) {
      const int d = i * 256 + lane * 4;
      const f32x4 gg = *(const f32x4*)(g + d), sc = *(const f32x4*)(mod + b * 6 * D + scale_off + d), sh = *(const f32x4*)(mod + b * 6 * D + shift_off + d);
      const f32x4 o = v[i] * r * gg * (sc + 1.f) + sh;
      u32x2 hi = {pk_bf16(o[0], o[1]), pk_bf16(o[2], o[3])};
      if (out) *(u32x2*)(out + (size_t)t * ld + d) = hi;
      if (!SPLIT && outq) *(unsigned*)(outq + (size_t)t * D + d) = pk4_fp8(o[0], o[1], o[2], o[3]);
      if (SPLIT) {
        *(unsigned*)(outq + (size_t)t * D + d) = pk4_fp8(o[0], o[1], o[2], o[3]);
        const float l0 = o[0] - __uint_as_float(hi.x << 16), l1 = o[1] - __uint_as_float(hi.x & 0xffff0000u);
        const float l2 = o[2] - __uint_as_float(hi.y << 16), l3 = o[3] - __uint_as_float(hi.y & 0xffff0000u);
        u32x2 lo = {pk_bf16(l0, l1), pk_bf16(l2, l3)};
        *(u32x2*)(out + (size_t)t * ld + D + d) = lo;
      }
    }
  }
}

template <bool SPLIT3, class AF, class BF, class EF>
__device__ __forceinline__ void gemm128(char* smem, int K, int ldb, AF arow, BF bcol, EF epi) {
  const int tid = otid(), lane = tid & 63, wid = tid >> 6, wm = wid >> 1, wn = wid & 1;
  const int l15 = lane & 15, l4 = lane >> 4;
  char* As = smem; char* Bs = smem + 16384;
  const int ac = tid & 7, ar0 = tid >> 3;
  const bf16_t* ap[4];
#pragma unroll
  for (int i = 0; i < 4; ++i) ap[i] = arow(ar0 + 32 * i);
  const int kg = tid >> 5, ng = tid & 31;
  const float* bp = bcol(ng * 4);
  if (bp) bp += (size_t)(kg * 8) * ldb;
  u32x4 areg[4]; f32x4 breg[8];
  const int nk1 = K / 64, nk = SPLIT3 ? 3 * nk1 : nk1;
  auto gload = [&](int kt) {
    const int seg = SPLIT3 ? kt / nk1 : 0, k0 = (SPLIT3 ? kt % nk1 : kt) * 64;
    const int aoff = (seg == 2 ? K : 0) + k0 + ac * 8;
#pragma unroll
    for (int i = 0; i < 4; ++i) areg[i] = ap[i] ? *(const u32x4*)(ap[i] + aoff) : (u32x4){0u, 0u, 0u, 0u};
#pragma unroll
    for (int i = 0; i < 8; ++i) breg[i] = bp ? *(const f32x4*)(bp + (size_t)(k0 + i) * ldb) : (f32x4){0.f, 0.f, 0.f, 0.f};
    if (SPLIT3 && seg == 1) {
#pragma unroll
      for (int i = 0; i < 8; ++i)
#pragma unroll
        for (int j = 0; j < 4; ++j) breg[i][j] = breg[i][j] - bf16_round(breg[i][j]);
    }
  };
  auto lstore = [&]() {
#pragma unroll
    for (int i = 0; i < 4; ++i) { const int r = ar0 + 32 * i; *(u32x4*)(As + r * 128 + ((ac ^ ((r >> 1) & 7)) << 4)) = areg[i]; }
#pragma unroll
    for (int j = 0; j < 4; ++j) {
      const int n = ng * 4 + j;
      u32x4 v = {pk_bf16(breg[0][j], breg[1][j]), pk_bf16(breg[2][j], breg[3][j]), pk_bf16(breg[4][j], breg[5][j]), pk_bf16(breg[6][j], breg[7][j])};
      *(u32x4*)(Bs + n * 128 + ((kg ^ ((n >> 1) & 7)) << 4)) = v;
    }
  };
  f32x4 acc[4][4];
#pragma unroll
  for (int i = 0; i < 4; ++i)
#pragma unroll
    for (int j = 0; j < 4; ++j) acc[i][j] = (f32x4){0.f, 0.f, 0.f, 0.f};
  gload(0);
  const int sw = l15 >> 1;
  for (int kt = 0; kt < nk; ++kt) {
    __syncthreads();
    lstore();
    __syncthreads();
    if (kt + 1 < nk) gload(kt + 1);
#pragma unroll
    for (int ks = 0; ks < 2; ++ks) {
      const int coff = ((ks * 4 + l4) ^ sw) << 4;
      bf16x8 af[4], bfr[4];
#pragma unroll
      for (int mt = 0; mt < 4; ++mt) af[mt] = *(const bf16x8*)(As + (wm * 64 + mt * 16 + l15) * 128 + coff);
#pragma unroll
      for (int nt = 0; nt < 4; ++nt) bfr[nt] = *(const bf16x8*)(Bs + (wn * 64 + nt * 16 + l15) * 128 + coff);
#pragma unroll
      for (int mt = 0; mt < 4; ++mt)
#pragma unroll
        for (int nt = 0; nt < 4; ++nt) acc[mt][nt] = __builtin_amdgcn_mfma_f32_16x16x32_bf16(bfr[nt], af[mt], acc[mt][nt], 0, 0, 0);
    }
  }
  epi(acc, wm * 64 + l15, wn * 64 + l4 * 4);
}

typedef unsigned u32x2v __attribute__((ext_vector_type(2)));
__device__ __forceinline__ void xpose4(unsigned (&d)[4][2], int) {
#pragma unroll
  for (int a = 0; a < 2; ++a)
#pragma unroll
    for (int h = 0; h < 2; ++h) { const u32x2v r = __builtin_amdgcn_permlane16_swap(d[2 * a][h], d[2 * a + 1][h], false, false); d[2 * a][h] = r.x; d[2 * a + 1][h] = r.y; }
#pragma unroll
  for (int j = 0; j < 2; ++j)
#pragma unroll
    for (int h = 0; h < 2; ++h) { const u32x2v r = __builtin_amdgcn_permlane32_swap(d[j][h], d[2 + j][h], false, false); d[j][h] = r.x; d[2 + j][h] = r.y; }
}
__device__ __forceinline__ void store_row64_bf16(const f32x4& a0, const f32x4& a1, const f32x4& a2, const f32x4& a3, int l4, bf16_t* rowp, bool doit) {
  unsigned d[4][2] = {{pk_bf16(a0[0], a0[1]), pk_bf16(a0[2], a0[3])}, {pk_bf16(a1[0], a1[1]), pk_bf16(a1[2], a1[3])},
                      {pk_bf16(a2[0], a2[1]), pk_bf16(a2[2], a2[3])}, {pk_bf16(a3[0], a3[1]), pk_bf16(a3[2], a3[3])}};
  xpose4(d, l4);
  if (doit) {
    *(u32x4*)(rowp + 16 * l4) = (u32x4){d[0][0], d[0][1], d[1][0], d[1][1]};
    *(u32x4*)(rowp + 16 * l4 + 8) = (u32x4){d[2][0], d[2][1], d[3][0], d[3][1]};
  }
}

template <bool LO>
__device__ __forceinline__ void cvt_kn_tile(const float* src, int ldn, bf16_t* dst, int ldk, int k0, int n0, int nmax) {
  const int tid = threadIdx.x, kg = tid & 7, ng = tid >> 3, n = n0 + ng * 4;
  if (n >= nmax) return;
  f32x4 r[8];
#pragma unroll
  for (int i = 0; i < 8; ++i) r[i] = *(const f32x4*)(src + (size_t)(k0 + kg * 8 + i) * ldn + n);
  if (LO) {
#pragma unroll
    for (int i = 0; i < 8; ++i)
#pragma unroll
      for (int j = 0; j < 4; ++j) r[i][j] = r[i][j] - bf16_round(r[i][j]);
  }
#pragma unroll
  for (int j = 0; j < 4; ++j) {
    u32x4 v = {pk_bf16(r[0][j], r[1][j]), pk_bf16(r[2][j], r[3][j]), pk_bf16(r[4][j], r[5][j]), pk_bf16(r[6][j], r[7][j])};
    *(u32x4*)(dst + (size_t)(n + j) * ldk + k0 + kg * 8) = v;
  }
}
template <bool LO>
__device__ __forceinline__ void cvt_matrix(const float* src, bf16_t* dst, int K, int N, int& item_base) {
  const int nkt = K / 64, nnt = (N + 127) / 128, total = nkt * nnt;
  for (int it = (int)blockIdx.x - item_base; it < total; it += gridDim.x) {
    if (it < 0) continue;
    cvt_kn_tile<LO>(src, N, dst, K, (it % nkt) * 64, (it / nkt) * 128, N);
  }
  item_base = (item_base + total) % gridDim.x;
}

constexpr int G2_STAGE = 24576;
template <int NSEG, int AB = 0, class AF, class BF, class EF>
__device__ __forceinline__ void gemm2(char* smem_, int K, AF arow, BF brow, EF epi, int aseg1 = 0, int bseg1 = 0, int aseg2 = 0, int bseg2 = 0) {
  LAS char* smem = (LAS char*)smem_;
  const int tid = otid(), lane = tid & 63, wv = __builtin_amdgcn_readfirstlane(tid >> 6), wm = wv >> 1, wn = wv & 1;
  const int l15 = lane & 15, l4 = lane >> 4;
  const int row_l = lane >> 2, csrc = ((lane & 3) ^ (((row_l >> 3) & 1) * 3)) * 8;
  const bf16_t* ap[4]; const bf16_t* bp[2];
#pragma unroll
  for (int j = 0; j < 4; ++j) ap[j] = arow((wv + 4 * j) * 16 + row_l) + csrc;
#pragma unroll
  for (int j = 0; j < 2; ++j) bp[j] = brow((wv + 4 * j) * 16 + row_l) + csrc;
  const int nk1 = K / 32, nk = NSEG * nk1;
  auto issue = [&](int kt) {
    LAS char* st = smem + (kt % 3) * G2_STAGE;
    int ka = kt * 32, kb = kt * 32;
    if (NSEG > 1) { const int seg = kt / nk1, kk = (kt - seg * nk1) * 32; ka = kk + (seg == 1 ? aseg1 : (seg == 2 ? aseg2 : 0)); kb = kk + (seg == 1 ? bseg1 : (seg == 2 ? bseg2 : 0)); }
#pragma unroll
    for (int j = 0; j < 4; ++j) __builtin_amdgcn_global_load_lds((const unsigned*)(ap[j] + ka), (LAS unsigned*)(st + (wv + 4 * j) * 1024), 16, 0, 0);
#pragma unroll
    for (int j = 0; j < 2; ++j) __builtin_amdgcn_global_load_lds((const unsigned*)(bp[j] + kb), (LAS unsigned*)(st + 16384 + (wv + 4 * j) * 1024), 16, 0, 0);
  };
  f32x4 acc[8][4];
#pragma unroll
  for (int i = 0; i < 8; ++i)
#pragma unroll
    for (int j = 0; j < 4; ++j) acc[i][j] = (f32x4){0.f, 0.f, 0.f, 0.f};
  const int coff = (l4 ^ (((l15 >> 3) & 1) * 3)) << 4;
  const int aoff = (wm * 128 + l15) * 64 + coff, boff = 16384 + (wn * 64 + l15) * 64 + coff;
  asm volatile("s_waitcnt lgkmcnt(0)" ::: "memory");
  __builtin_amdgcn_s_barrier();
  asm volatile("" ::: "memory");
  issue(0);
  if (nk > 1) issue(1);
  for (int kt = 0; kt < nk; ++kt) {
    if (kt + 1 < nk) asm volatile("s_waitcnt vmcnt(6)" ::: "memory"); else asm volatile("s_waitcnt vmcnt(0)" ::: "memory");
    __builtin_amdgcn_s_barrier();
    asm volatile("" ::: "memory");
    if (AB != 2 && kt + 2 < nk) issue(kt + 2);
    const LAS char* st = smem + (kt % 3) * G2_STAGE;
    bf16x8 bfr[4], af[8];
    if (AB != 3) {
#pragma unroll
    for (int nt = 0; nt < 4; ++nt) bfr[nt] = *(const LAS bf16x8*)(st + boff + nt * 1024);
#pragma unroll
    for (int mt = 0; mt < 8; ++mt) af[mt] = *(const LAS bf16x8*)(st + aoff + mt * 1024);
    }
    __builtin_amdgcn_sched_barrier(0);
    if (AB == 1) {
#pragma unroll
      for (int nt = 0; nt < 4; ++nt) asm volatile("" :: "v"(bfr[nt]));
#pragma unroll
      for (int mt = 0; mt < 8; ++mt) asm volatile("" :: "v"(af[mt]));
    }
    if (AB == 0 || AB == 2) {
    __builtin_amdgcn_s_setprio(1);
#pragma unroll
    for (int mt = 0; mt < 8; ++mt)
#pragma unroll
      for (int nt = 0; nt < 4; ++nt) acc[mt][nt] = __builtin_amdgcn_mfma_f32_16x16x32_bf16(bfr[nt], af[mt], acc[mt][nt], 0, 0, 0);
    __builtin_amdgcn_s_setprio(0);
    }
    __builtin_amdgcn_sched_barrier(0);
  }
  epi(acc, wm * 128 + l15, wn * 64 + l4 * 4);
}

template <int NREP = 1, class AF, class BF, class EF>
__device__ __forceinline__ void gemm2q(char* smem_, int K, AF arow, BF brow, EF epi, size_t bstep = 0, bool half = false) {
  LAS char* smem = (LAS char*)smem_;
  const int tid = otid(), lane = tid & 63, wv = __builtin_amdgcn_readfirstlane(tid >> 6), wm = wv >> 1, wn = wv & 1;
  const int l15 = lane & 15, l4 = lane >> 4;
  const int row_l = lane >> 2, csrc = ((lane & 3) ^ ((row_l >> 2) & 3)) * 16;
  const unsigned char* ap[4]; const unsigned char* bp[2];
#pragma unroll
  for (int j = 0; j < 4; ++j) ap[j] = arow((wv + 4 * j) * 16 + row_l) + csrc;
#pragma unroll
  for (int j = 0; j < 2; ++j) bp[j] = brow((wv + 4 * j) * 16 + row_l) + csrc;
  const int nk1 = K / 64, nk = nk1 * NREP;
  auto issue = [&](int kt) {
    LAS char* st = smem + (kt % 3) * G2_STAGE;
    const int rp = NREP > 1 ? kt / nk1 : 0, kk = NREP > 1 ? kt - rp * nk1 : kt;
#pragma unroll
    for (int j = 0; j < 4; ++j) __builtin_amdgcn_global_load_lds((const unsigned*)(ap[j] + kk * 64), (LAS unsigned*)(st + (wv + 4 * j) * 1024), 16, 0, 0);
#pragma unroll
    for (int j = 0; j < 2; ++j) __builtin_amdgcn_global_load_lds((const unsigned*)(bp[j] + rp * bstep + kk * 64), (LAS unsigned*)(st + 16384 + (wv + 4 * j) * 1024), 16, 0, 0);
  };
  f32x4 acc[8][4];
#pragma unroll
  for (int i = 0; i < 8; ++i)
#pragma unroll
    for (int j = 0; j < 4; ++j) acc[i][j] = (f32x4){0.f, 0.f, 0.f, 0.f};
  const int sw = (l15 >> 2) & 3, sub = (l4 & 1) * 8, ch = l4 >> 1;
  const int aoff = (wm * 128 + l15) * 64 + sub, boff = 16384 + (wn * 64 + l15) * 64 + sub;
  asm volatile("s_waitcnt lgkmcnt(0)" ::: "memory");
  __builtin_amdgcn_s_barrier();
  asm volatile("" ::: "memory");
  issue(0);
  if (nk > 1) issue(1);
  for (int kt = 0; kt < nk; ++kt) {
    if (kt + 1 < nk) asm volatile("s_waitcnt vmcnt(6)" ::: "memory"); else asm volatile("s_waitcnt vmcnt(0)" ::: "memory");
    __builtin_amdgcn_s_barrier();
    asm volatile("" ::: "memory");
    if (kt + 2 < nk) issue(kt + 2);
    const LAS char* st = smem + (kt % 3) * G2_STAGE;
    if (!(half && wm == 1))
#pragma unroll
    for (int ks = 0; ks < 2; ++ks) {
      const int coff = ((2 * ks + ch) ^ sw) << 4;
      long bfr[4], af[8];
#pragma unroll
      for (int nt = 0; nt < 4; ++nt) bfr[nt] = *(const LAS long*)(st + boff + nt * 1024 + coff);
#pragma unroll
      for (int mt = 0; mt < 8; ++mt) af[mt] = *(const LAS long*)(st + aoff + mt * 1024 + coff);
      __builtin_amdgcn_s_setprio(1);
#pragma unroll
      for (int mt = 0; mt < 8; ++mt)
#pragma unroll
        for (int nt = 0; nt < 4; ++nt) acc[mt][nt] = __builtin_amdgcn_mfma_f32_16x16x32_fp8_fp8(bfr[nt], af[mt], acc[mt][nt], 0, 0, 0);
      __builtin_amdgcn_s_setprio(0);
    }
    __builtin_amdgcn_sched_barrier(0);
    if (NREP > 1 && (kt + 1) % nk1 == 0 && kt + 1 < nk) {
      epi(acc, wm * 128 + l15, wn * 64 + l4 * 4, kt / nk1);
#pragma unroll
      for (int i = 0; i < 8; ++i)
#pragma unroll
        for (int j = 0; j < 4; ++j) acc[i][j] = (f32x4){0.f, 0.f, 0.f, 0.f};
    }
  }
  epi(acc, wm * 128 + l15, wn * 64 + l4 * 4, NREP - 1);
}

template <class F>
__device__ __forceinline__ void gemm2_grid(int NT, F body) {
  const int xcd = blockIdx.x & 7, lb = blockIdx.x >> 3, nlb = gridDim.x >> 3;
  for (int i = lb; i < 8 * NT; i += nlb) body(xcd * 8 + (i & 7), i >> 3);
}

template <class F>
__device__ __forceinline__ void gemm_grid(int NT, F body) {
  const int xcd = blockIdx.x & 7, lb = blockIdx.x >> 3, nlb = gridDim.x >> 3;
  for (int i = lb; i < 16 * NT; i += nlb) {
    const int g = i / (8 * NT), rem = i % (8 * NT), nt = rem >> 3, mi = rem & 7;
    body(xcd * 16 + g * 8 + mi, nt);
  }
}

template <int MT>
__device__ __forceinline__ void proj_epi(const P& p, const f32x4 (&acc)[MT][4], int row_base, int ntile, int r0, int c0, float ascale = 1.f, const float* rope_tile = nullptr) {
  const int wn = c0 >> 6, l4 = (c0 & 63) >> 2;
  const int col0 = ntile * 128 + wn * 64;
  if (col0 >= INC) return;
  if (col0 == C_GB) {
#pragma unroll
    for (int mt = 0; mt < MT; ++mt) {
      const int m = row_base + r0 + mt * 16;
      f32x4 a = acc[mt][0] * ascale, g0 = {sigmoidf(a[0]), sigmoidf(a[1]), sigmoidf(a[2]), sigmoidf(a[3])};
      *(f32x4*)(p.GS + (size_t)m * 24 + 4 * l4) = g0;
      if (l4 < 2) { a = acc[mt][1] * ascale; f32x4 g1 = {sigmoidf(a[0]), sigmoidf(a[1]), sigmoidf(a[2]), sigmoidf(a[3])}; *(f32x4*)(p.GS + (size_t)m * 24 + 16 + 4 * l4) = g1; }
    }
    return;
  }
  const float* g = nullptr; bf16_t* dst; bf16_t* dst2 = nullptr; int hh, H; float qs = 1.f; bool dorope = false;
  if (col0 < 512) { g = p.g_q_dil; dst = p.QA; hh = col0 >> 6; H = 8; qs = 0.125f; dorope = true; }
  else if (col0 < 1024) { g = p.g_k_dil; dst = p.KA; hh = (col0 - 512) >> 6; H = 8; dorope = true; }
  else if (col0 < 1536) { dst = p.VA; hh = (col0 - 1024) >> 6; H = 8; }
  else if (col0 < 2048) { g = p.g_q_nsa; dst = p.QR; dst2 = p.QN; hh = (col0 - 1536) >> 6; H = 8; qs = 0.125f; dorope = true; }
  else {
    const int idx = (col0 - 2048) >> 6, which = idx >> 1; hh = idx & 1; H = 2;
    if (which == 0) dst = p.KC; else if (which == 1) dst = p.VC;
    else if (which == 2) { dst = p.KSL; g = p.g_k_slc; dorope = true; } else if (which == 3) dst = p.VSL;
    else if (which == 4) { dst = p.KW; g = p.g_k_win; dorope = true; } else dst = p.VW;
  }
  f32x4 gv[4];
  if (g) {
#pragma unroll
    for (int nt = 0; nt < 4; ++nt) gv[nt] = *(const f32x4*)(g + nt * 16 + 4 * l4);
  }
  const int bb = row_base / S;
#pragma unroll
  for (int mt = 0; mt < MT; ++mt) {
    const int m = row_base + r0 + mt * 16, s = m - bb * S;
    f32x4 v[4];
#pragma unroll
    for (int nt = 0; nt < 4; ++nt) v[nt] = acc[mt][nt] * ascale;
    if (g) {
      float ss = 0.f;
#pragma unroll
      for (int nt = 0; nt < 4; ++nt) ss += v[nt][0] * v[nt][0] + v[nt][1] * v[nt][1] + v[nt][2] * v[nt][2] + v[nt][3] * v[nt][3];
      ss += __shfl_xor(ss, 16); ss += __shfl_xor(ss, 32);
      const float r = rsqrtf(ss * (1.f / 64.f) + EPS) * qs;
#pragma unroll
      for (int nt = 0; nt < 4; ++nt) v[nt] = v[nt] * gv[nt] * r;
    }
    f32x4 vr = v[0];
    if (dorope) {
      const float* rp = rope_tile ? rope_tile + ((size_t)(m - row_base) * 8 + 4 * (l4 & 1)) * 2 : p.rope + ((size_t)s * 8 + 4 * (l4 & 1)) * 2;
      const f32x4 ra = *(const f32x4*)rp, rb = *(const f32x4*)(rp + 4);
      const float cs[4] = {ra[0], ra[2], rb[0], rb[2]}, sn[4] = {ra[1], ra[3], rb[1], rb[3]};
#pragma unroll
      for (int i = 0; i < 4; ++i) {
        const float pt = __shfl_xor(v[0][i], 32);
        vr[i] = (l4 < 2) ? (v[0][i] * cs[i] - pt * sn[i]) : (v[0][i] * cs[i] + pt * sn[i]);
      }
    }
    bf16_t* row = dst + ((size_t)(bb * H + hh) * S + s) * 64 + 16 * l4;
    unsigned dd[4][2] = {{pk_bf16(vr[0], vr[1]), pk_bf16(vr[2], vr[3])}, {pk_bf16(v[1][0], v[1][1]), pk_bf16(v[1][2], v[1][3])},
                         {pk_bf16(v[2][0], v[2][1]), pk_bf16(v[2][2], v[2][3])}, {pk_bf16(v[3][0], v[3][1]), pk_bf16(v[3][2], v[3][3])}};
    if (dst2) {
      unsigned d2[4][2] = {{pk_bf16(v[0][0], v[0][1]), pk_bf16(v[0][2], v[0][3])}, {dd[1][0], dd[1][1]}, {dd[2][0], dd[2][1]}, {dd[3][0], dd[3][1]}};
      xpose4(d2, l4);
      bf16_t* row2 = dst2 + ((size_t)(bb * H + hh) * S + s) * 64 + 16 * l4;
      *(u32x4*)row2 = (u32x4){d2[0][0], d2[0][1], d2[1][0], d2[1][1]};
      *(u32x4*)(row2 + 8) = (u32x4){d2[2][0], d2[2][1], d2[3][0], d2[3][1]};
    }
    xpose4(dd, l4);
    *(u32x4*)row = (u32x4){dd[0][0], dd[0][1], dd[1][0], dd[1][1]};
    *(u32x4*)(row + 8) = (u32x4){dd[2][0], dd[2][1], dd[3][0], dd[3][1]};
    asm volatile("" ::: "memory");
  }
}
__device__ __forceinline__ void ph_proj(const P& p, char* smem) {
  gemm2_grid(23, [&](int mtile, int ntile) {
    const unsigned char* A = p.h1q + (size_t)mtile * 256 * D; const unsigned char* W = p.Wq_in + (size_t)ntile * 128 * D; const unsigned char* Z = (const unsigned char*)p.zrow;
    const int nvalid = INC - ntile * 128;
    gemm2q<1>(smem, D, [=](int r) { return A + (size_t)r * D; }, [=](int n) { return n < nvalid ? W + (size_t)n * D : Z; },
              [&](const f32x4 (&acc)[8][4], int r0, int c0, int) {
                float* rl = (float*)smem;
                __syncthreads();
                { const int s0 = (mtile * 256) % S; const f32x4* srcp = (const f32x4*)(p.rope + (size_t)s0 * 16);
#pragma unroll
                  for (int i = 0; i < 4; ++i) ((f32x4*)rl)[threadIdx.x + 256 * i] = srcp[threadIdx.x + 256 * i]; }
                __syncthreads();
                proj_epi<8>(p, acc, mtile * 256, ntile, r0, c0, 1.f / WQ_SCALE, rl);
              });
  });
}
__device__ __forceinline__ void ph_outproj(const P& p, char* smem) {
  gemm2_grid(8, [&](int mtile, int ntile) {
    const unsigned char* A = p.mixq + (size_t)mtile * 256 * D; const unsigned char* W = p.Wq_out + (size_t)ntile * 128 * D; bf16_t* C = (bf16_t*)p.x1; const float* x = p.x;
    const float* gt = p.mod + ((mtile * 256) / S) * 6 * D + 2 * D;
    gemm2q<1>(smem, D, [=](int r) { return A + (size_t)r * D; }, [=](int n) { return W + (size_t)n * D; },
              [=](const f32x4 (&acc)[8][4], int r0, int c0, int) {
                const int l4 = (c0 & 63) >> 2;
                const float s = 1.f / (WQ_SCALE * MQ_SCALE);
#pragma unroll
                for (int mt = 0; mt < 8; ++mt) {
                  const int m = mtile * 256 + r0 + mt * 16;
                  f32x4 o[4];
#pragma unroll
                  for (int nt = 0; nt < 4; ++nt) {
                    const int n = ntile * 128 + c0 + nt * 16;
                    o[nt] = *(const f32x4*)(x + (size_t)m * D + n) + *(const f32x4*)(gt + n) * (acc[mt][nt] * s);
                  }
                  store_row64_bf16(o[0], o[1], o[2], o[3], l4, C + (size_t)m * D + ntile * 128 + (c0 & ~63), true);
                  asm volatile("" ::: "memory");
                }
              });
  });
}
template <int AB>
__device__ __forceinline__ void ph_outproj_abl(const P& p, char* smem) {
  gemm2_grid(8, [&](int mtile, int ntile) {
    const bf16_t* A = p.mixinb + (size_t)mtile * 256 * D; const bf16_t* W = p.Wt_out + (size_t)ntile * 128 * D; float* C = (float*)p.Ybuf;
    gemm2<1, AB>(smem, D, [=](int r) { return A + (size_t)r * D; }, [=](int n) { return W + (size_t)n * D; },
             [=](const f32x4 (&acc)[8][4], int r0, int c0) {
#pragma unroll
               for (int mt = 0; mt < 8; ++mt)
#pragma unroll
                 for (int nt = 0; nt < 4; ++nt) {
                   const int m = mtile * 256 + r0 + mt * 16, n = ntile * 128 + c0 + nt * 16;
                   *(f32x4*)(C + (size_t)m * D + n) = acc[mt][nt];
                 }
             });
  });
}
__device__ __forceinline__ void router_unit(const P& p, char* smem, int mtile, int j) {
  const int seg = j >> 1, ntile = j & 1;
  const bf16_t* A = p.h2s + (size_t)mtile * 256 * 2 * D + (seg == 2 ? D : 0);
  const bf16_t* W = (seg == 1 ? p.Wt_rtl : p.Wt_rth) + (size_t)ntile * 128 * D; float* C = p.logits + (size_t)seg * T * NE;
  gemm2<1>(smem, D, [=](int r) { return A + (size_t)r * 2 * D; }, [=](int n) { return W + (size_t)n * D; },
           [=](const f32x4 (&acc)[8][4], int r0, int c0) {
#pragma unroll
             for (int mt = 0; mt < 8; ++mt)
#pragma unroll
               for (int nt = 0; nt < 4; ++nt) {
                 const int m = mtile * 256 + r0 + mt * 16, n = ntile * 128 + c0 + nt * 16;
                 *(f32x4*)(C + (size_t)m * NE + n) = acc[mt][nt];
               }
           });
}
__device__ __forceinline__ const bf16_t* gu_row(const bf16_t* Wg, const bf16_t* Wu, int f0, int n) {
  const int wn = n >> 6, wi = n & 63;
  return (wi >= 32 ? Wu : Wg) + (size_t)(f0 + wn * 32 + (wi & 31)) * D;
}
template <int MT>
__device__ __forceinline__ void gu_store(const f32x4 (&acc)[MT][4], int mt, float scale, bf16_t* dstrow  ) {
#pragma unroll
  for (int q = 0; q < 2; ++q) {
    const f32x4 g = acc[mt][q], u = acc[mt][q + 2];
    float h[4];
#pragma unroll
    for (int i = 0; i < 4; ++i) h[i] = silu(g[i]) * u[i] * scale;
    u32x2 v = {pk_bf16(h[0], h[1]), pk_bf16(h[2], h[3])};
    *(u32x2*)(dstrow + q * 16) = v;
  }
}
__device__ __forceinline__ const unsigned char* gu_rowq(const unsigned char* Wg, const unsigned char* Wu, int f0, int n);
__device__ __forceinline__ void shared_gu_unit(const P& p, char* smem, int mtile, int ntile) {
  const unsigned char* A = p.h2q + (size_t)mtile * 256 * D; const unsigned char* Wg = p.Wq_sg; const unsigned char* Wu = p.Wq_su; bf16_t* H = p.Hs;
  gemm2q<1>(smem, D, [=](int r) { return A + (size_t)r * D; }, [=](int n) { return gu_rowq(Wg, Wu, ntile * 64, n); },
            [=](const f32x4 (&acc)[8][4], int r0, int c0, int) {
              const int wn = c0 >> 6, l4x4 = c0 & 63;
#pragma unroll
              for (int mt = 0; mt < 8; ++mt) {
                bf16_t* dstrow = H + (size_t)(mtile * 256 + r0 + mt * 16) * FF + ntile * 64 + wn * 32 + l4x4;
#pragma unroll
                for (int q = 0; q < 2; ++q) {
                  const f32x4 g = acc[mt][q], u = acc[mt][q + 2];
                  float h[4];
#pragma unroll
                  for (int i = 0; i < 4; ++i) h[i] = silu(g[i] * (1.f / WQ_SCALE)) * u[i] * (1.f / WQ_SCALE);
                  u32x2 v = {pk_bf16(h[0], h[1]), pk_bf16(h[2], h[3])};
                  *(u32x2*)(dstrow + q * 16) = v;
                }
              }
            });
}
__device__ __forceinline__ void ph_router_shared_gu(const P& p, char* smem) {
  const int xcd = blockIdx.x & 7, lb = blockIdx.x >> 3, nlb = gridDim.x >> 3;
  if (nlb == 64) {
    if (lb < 48) router_unit(p, smem, xcd * 8 + (lb & 7), lb >> 3);
    else for (int i = lb - 48; i < 32; i += 16) shared_gu_unit(p, smem, xcd * 8 + (i & 7), i >> 3);
  } else {
    gemm2_grid(10, [&](int mtile, int j) { if (j < 6) router_unit(p, smem, mtile, j); else shared_gu_unit(p, smem, mtile, j - 6); });
  }
}
__device__ __forceinline__ void ph_shared_d(const P& p, char* smem) {
  gemm2_grid(8, [&](int mtile, int ntile) {
    const bf16_t* A = p.Hs + (size_t)mtile * 256 * FF; const bf16_t* W = p.Wt_sd + (size_t)ntile * 128 * FF; bf16_t* Y = p.Ys;
    gemm2<1>(smem, FF, [=](int r) { return A + (size_t)r * FF; }, [=](int n) { return W + (size_t)n * FF; },
             [=](const f32x4 (&acc)[8][4], int r0, int c0) {
#pragma unroll
               for (int mt = 0; mt < 8; ++mt)
                 store_row64_bf16(acc[mt][0], acc[mt][1], acc[mt][2], acc[mt][3], (c0 & 63) >> 2, Y + (size_t)(mtile * 256 + r0 + mt * 16) * D + ntile * 128 + (c0 & ~63), true);
             });
  });
}
struct CvtQ { const float* src; unsigned char* dst; int ldn, ldk; };
__device__ __forceinline__ void cvtq_load(const CvtQ& d, f32x4 (&r)[16]) {
#pragma unroll
  for (int i = 0; i < 16; ++i) r[i] = __builtin_nontemporal_load((const f32x4*)(d.src + (size_t)i * d.ldn));
}
__device__ __forceinline__ void cvtq_store(const CvtQ& d, const f32x4 (&r)[16]) {
#pragma unroll
  for (int j = 0; j < 4; ++j) {
    u32x4 v = {pk4_fp8(r[0][j] * WQ_SCALE, r[1][j] * WQ_SCALE, r[2][j] * WQ_SCALE, r[3][j] * WQ_SCALE), pk4_fp8(r[4][j] * WQ_SCALE, r[5][j] * WQ_SCALE, r[6][j] * WQ_SCALE, r[7][j] * WQ_SCALE),
               pk4_fp8(r[8][j] * WQ_SCALE, r[9][j] * WQ_SCALE, r[10][j] * WQ_SCALE, r[11][j] * WQ_SCALE), pk4_fp8(r[12][j] * WQ_SCALE, r[13][j] * WQ_SCALE, r[14][j] * WQ_SCALE, r[15][j] * WQ_SCALE)};
    *(u32x4*)(d.dst + (size_t)j * d.ldk) = v;
  }
}
__device__ __forceinline__ CvtQ cvtq_desc(const float* src, int ldn, unsigned char* dst, int ldk, int k0, int n0) {
  const int kg = threadIdx.x & 7, n = n0 + (threadIdx.x >> 3) * 4;
  CvtQ d; d.src = src + (size_t)(k0 + kg * 16) * ldn + n; d.dst = dst + (size_t)n * ldk + k0 + kg * 16; d.ldn = ldn; d.ldk = ldk; return d;
}
__device__ __forceinline__ void cvtq_tile(const float* src, int ldn, unsigned char* dst, int ldk, int k0, int n0, int nmax = 1 << 30) {
  if (n0 + (int)(threadIdx.x >> 3) * 4 >= nmax) return;
  const CvtQ d = cvtq_desc(src, ldn, dst, ldk, k0, n0); f32x4 r[16]; cvtq_load(d, r); cvtq_store(d, r);
}
__device__ __forceinline__ CvtQ cvt_expert_desc(const P& p, int it) {
  const int e = it / 48, q = it - e * 48;
  if (q < 32) { const int up = q >> 4, qq = q & 15;
    return cvtq_desc((up ? p.w_up : p.w_gate) + (size_t)e * D * FF, FF, (up ? p.Wq_u : p.Wq_g) + (size_t)e * FF * D, D, (qq & 7) * 128, (qq >> 3) * 128);
  }
  const int qq = q - 32;
  return cvtq_desc(p.w_down + (size_t)e * FF * D, D, p.Wq_d + (size_t)e * D * FF, FF, (qq & 1) * 128, (qq >> 1) * 128);
}
__device__ __forceinline__ void cvt_expert_item(const P& p, int it) { const CvtQ d = cvt_expert_desc(p, it); f32x4 r[16]; cvtq_load(d, r); cvtq_store(d, r); }
__device__ __forceinline__ void ph_cvt_experts(const P& p) { WLOOP(w, NE * 48) cvt_expert_item(p, w); }

__device__ __forceinline__ bf16x8 pack8(const f32x16& x, int s) {
  u32x4 r = {pk_bf16(x[8 * s], x[8 * s + 1]), pk_bf16(x[8 * s + 2], x[8 * s + 3]), pk_bf16(x[8 * s + 4], x[8 * s + 5]), pk_bf16(x[8 * s + 6], x[8 * s + 7])};
  return __builtin_bit_cast(bf16x8, r);
}
__device__ __forceinline__ bf16x8 tr_pair(const LAS char* a) {
  const s16x4 lo = __builtin_amdgcn_ds_read_tr16_b64_v4i16((LAS s16x4*)a);
  const s16x4 hi = __builtin_amdgcn_ds_read_tr16_b64_v4i16((LAS s16x4*)(a + 8 * 128));
  return __builtin_shufflevector(lo, hi, 0, 1, 2, 3, 4, 5, 6, 7);
}
__device__ __forceinline__ int next_item(int* ctr, char* smem) {
  volatile int* slot = (volatile int*)(smem + SMEM_BYTES - 16);
  __syncthreads();
  if (threadIdx.x == 0) *slot = atomicAdd(ctr, 1);
  __syncthreads();
  return *slot;
}

__device__ __forceinline__ void compress_item(const P& p, char* smem, int item) {
  const int which = item >> 3, mtile = item & 7;
  const bf16_t* X = which ? p.VC : p.KC; const bf16_t* W1 = which ? p.Wt_c1v : p.Wt_c1k; const bf16_t* Z = p.zrow;
  const float* b1 = p.b1c + which * 128; bf16_t* hid = (bf16_t*)smem;
  gemm2<1>(smem, 2048,
           [=](int r) { const int R = mtile * 256 + r; if (R >= 2040) return Z; const int bg = R / 255, c = R - bg * 255; return X + ((size_t)bg * S + 16 * c) * 64; },
           [=](int n) { return W1 + (size_t)n * 2048; },
           [=](const f32x4 (&acc)[8][4], int r0, int c0) {
             __syncthreads();
#pragma unroll
             for (int nt = 0; nt < 4; ++nt) {
               const f32x4 bv = *(const f32x4*)(b1 + c0 + nt * 16);
#pragma unroll
               for (int mt = 0; mt < 8; ++mt) {
                 float h[4];
#pragma unroll
                 for (int i = 0; i < 4; ++i) { const float a = acc[mt][nt][i] + bv[i]; const float u = 0.7978845608028654f * (a + 0.044715f * a * a * a); h[i] = a - a / (1.f + __expf(2.f * u)); }
                 u32x2 w = {pk_bf16(h[0], h[1]), pk_bf16(h[2], h[3])};
                 *(u32x2*)(hid + (r0 + mt * 16) * 136 + c0 + nt * 16) = w;
               }
             }
           });
  __syncthreads();
  const float* W2 = which ? p.w2_v : p.w2_k;
  const int rl = threadIdx.x >> 3, pt = threadIdx.x & 7;
#pragma unroll 1
  for (int g = 0; g < 8; ++g) {
    const int row = g * 32 + rl, R = mtile * 256 + row;
    float o[8];
#pragma unroll
    for (int d = 0; d < 8; ++d) o[d] = 0.f;
#pragma unroll 2
    for (int n8 = 0; n8 < 16; ++n8) {
      const u32x4 hv4 = *(const u32x4*)(hid + row * 136 + n8 * 8);
#pragma unroll
      for (int k = 0; k < 8; ++k) {
        const float hv = (k & 1) ? __uint_as_float(hv4[k >> 1] & 0xffff0000u) : __uint_as_float(hv4[k >> 1] << 16);
        const f32x4 w0 = *(const f32x4*)(W2 + (n8 * 8 + k) * 64 + pt * 8), w1 = *(const f32x4*)(W2 + (n8 * 8 + k) * 64 + pt * 8 + 4);
        o[0] += hv * w0[0]; o[1] += hv * w0[1]; o[2] += hv * w0[2]; o[3] += hv * w0[3];
        o[4] += hv * w1[0]; o[5] += hv * w1[1]; o[6] += hv * w1[2]; o[7] += hv * w1[3];
      }
    }
    float rs = 1.f;
    if (!which) {
      float ss = 0.f;
#pragma unroll
      for (int d = 0; d < 8; ++d) ss += o[d] * o[d];
      ss += __shfl_xor(ss, 1); ss += __shfl_xor(ss, 2); ss += __shfl_xor(ss, 4);
      rs = rsqrtf(ss * (1.f / 64.f) + EPS);
    }
    if (R < 2040) {
      const int bg = R / 255, c = R - bg * 255;
      bf16_t* orow = (which ? p.vcb : p.kcb) + ((size_t)bg * 256 + c) * 64 + pt * 8;
      float gg[8];
      if (!which) { const f32x4 g0 = *(const f32x4*)(p.g_k_cmp + pt * 8), g1 = *(const f32x4*)(p.g_k_cmp + pt * 8 + 4); gg[0] = g0[0]; gg[1] = g0[1]; gg[2] = g0[2]; gg[3] = g0[3]; gg[4] = g1[0]; gg[5] = g1[1]; gg[6] = g1[2]; gg[7] = g1[3]; }
      else {
#pragma unroll
        for (int k = 0; k < 8; ++k) gg[k] = 1.f;
      }
      u32x4 w = {pk_bf16(o[0] * rs * gg[0], o[1] * rs * gg[1]), pk_bf16(o[2] * rs * gg[2], o[3] * rs * gg[3]), pk_bf16(o[4] * rs * gg[4], o[5] * rs * gg[5]), pk_bf16(o[6] * rs * gg[6], o[7] * rs * gg[7])};
      *(u32x4*)orow = w;
    }
  }
}

template <int MODE, int NSLOT>
__device__ __forceinline__ void nsa_pass(LAS char* kv, const bf16_t* Kg, const bf16_t* Vg, int t_lo, int t_hi, const bf16x8 (&qf)[4], float shf, int si,
                                         unsigned long long selm, f32x16& o0, f32x16& o1, float& l, LAS float* psl  ,
                                         int pos0 = 0, int pstride = 1, int kkmin = 0) {
  const int tid = otid(), lane = tid & 63, wv = __builtin_amdgcn_readfirstlane(tid >> 6), i = lane & 31, h5 = lane >> 5;
  const int ksw = (i >> 1) & 7;
  const int tq = (lane & 15) >> 2, tp = lane & 3, tds = (lane >> 4) & 1, vsw = ((tq >> 1) & 1) << 2;
  const int row_l = lane >> 3, cpos = lane & 7;
  const int kc8 = (cpos ^ ((wv & 1) * 4 + (row_l >> 1))) * 8, vc8 = (cpos ^ (((row_l >> 1) & 1) << 2)) * 8;
  const bf16_t* kgl = Kg + (size_t)(wv * 8 + row_l) * 64 + kc8;
  const bf16_t* vgl = Vg + (size_t)(wv * 8 + row_l) * 64 + vc8;
  auto stage = [&](int t, int buf) {
    LAS char* Ks = kv + buf * 16384 + wv * 1024; LAS char* Vs = Ks + 8192;
#pragma unroll
    for (int q = 0; q < 2; ++q) {
      if (MODE >= 3) {
        int pos = pos0 + pstride * (64 * t + 32 * q + wv * 8 + row_l);
        pos = pos < 0 ? 0 : (pos > S - 1 ? S - 1 : pos);
        __builtin_amdgcn_global_load_lds((const unsigned*)(Kg + (size_t)pos * 64 + kc8), (LAS unsigned*)(Ks + q * 4096), 16, 0, 0);
        __builtin_amdgcn_global_load_lds((const unsigned*)(Vg + (size_t)pos * 64 + vc8), (LAS unsigned*)(Vs + q * 4096), 16, 0, 0);
      } else {
        __builtin_amdgcn_global_load_lds((const unsigned*)(kgl + (size_t)(64 * t + 32 * q) * 64), (LAS unsigned*)(Ks + q * 4096), 16, 0, 0);
        __builtin_amdgcn_global_load_lds((const unsigned*)(vgl + (size_t)(64 * t + 32 * q) * 64), (LAS unsigned*)(Vs + q * 4096), 16, 0, 0);
      }
    }
  };
  float carry = 0.f;
  if (t_lo > t_hi) return;
  float dm16[4] = {0.f, 0.f, 0.f, 0.f}; int dmaxA = 0, dmaxB = 0; const int wq = wv & 3;
  if (MODE == 3) {
#pragma unroll
    for (int rg = 0; rg < 4; ++rg) dm16[rg] = (((wv - h5 - 2 * rg) & 3) == 0) ? 3.f : 2.f;
    dmaxA = si - kkmin < 128 ? si - kkmin : 128;
  }
  if (MODE == 4) { const int lim = si - kkmin; dmaxA = lim < 128 ? lim : 128; dmaxB = lim < 512 ? lim : 512; }
  asm volatile("s_waitcnt vmcnt(0) lgkmcnt(0)" ::: "memory");
  __builtin_amdgcn_s_barrier();
  asm volatile("" ::: "memory");
#pragma unroll
  for (int k = 0; k < NSLOT - 1; ++k) if (t_lo + k <= t_hi) stage(t_lo + k, k);
  for (int t = t_lo; t <= t_hi; ++t) {
    const int buf = (t - t_lo) % NSLOT;
    const int ahead = t_hi - t;
    if (NSLOT == 4 && ahead >= 2) asm volatile("s_waitcnt vmcnt(8)" ::: "memory");
    else if (NSLOT == 4 && ahead == 1) asm volatile("s_waitcnt vmcnt(4)" ::: "memory");
    else asm volatile("s_waitcnt vmcnt(0)" ::: "memory");
    __builtin_amdgcn_s_barrier();
    asm volatile("" ::: "memory");
    if (t + NSLOT - 1 <= t_hi) stage(t + NSLOT - 1, (t + NSLOT - 1 - t_lo) % NSLOT);
    const LAS char* Ks = kv + buf * 16384; const LAS char* Vs = Ks + 8192;
    const bool tsel = MODE == 1 ? ((selm >> t) & 1ull) != 0ull : true;
#pragma unroll
    for (int sub = 0; sub < 2; ++sub) {
      f32x16 sa;
#pragma unroll
      for (int q = 0; q < 16; ++q) sa[q] = 0.f;
      bf16x8 kf[4];
#pragma unroll
      for (int s4 = 0; s4 < 4; ++s4) kf[s4] = *(const LAS bf16x8*)(Ks + (32 * sub + i) * 128 + (((2 * s4 + h5) ^ ksw) << 4));
      __builtin_amdgcn_s_setprio(1);
#pragma unroll
      for (int s4 = 0; s4 < 4; ++s4) sa = MFMA32(kf[s4], qf[s4], sa);
      __builtin_amdgcn_s_setprio(0);
      const int k0 = 64 * t + 32 * sub + 4 * h5;
#pragma unroll
      for (int q = 0; q < 16; ++q) {
        const int kidx = k0 + (q & 3) + 8 * (q >> 2);
        float pv;
        if (MODE >= 3) {
          const int dl = si - kidx;
          const float e = __builtin_amdgcn_exp2f(sa[q] * LOG2E - shf);
          if (MODE == 3) {
            const float cw = (q & 3) ? 1.f : dm16[q >> 2];
            pv = (unsigned)dl <= (unsigned)dmaxA ? cw * e : 0.f;
          } else {
            const bool lo = dl >= 33;
            float cw = (lo && dl <= dmaxA) ? 1.f : 0.f;
            if ((q & 3) == wq) cw += (lo && dl <= dmaxB) ? 1.f : 0.f;
            pv = cw * e;
          }
        } else {
          bool valid;
          if (MODE == 0) valid = 16 * kidx + 31 <= si;
          else if (MODE == 1) valid = tsel && kidx <= si;
          else valid = (unsigned)(si - kidx) <= 511u;
          pv = valid ? __builtin_amdgcn_exp2f(sa[q] * LOG2E - shf) : 0.f;
        }
        l += pv; sa[q] = pv;
      }
      if (MODE == 0) {
#pragma unroll
        for (int rg = 0; rg < 4; ++rg) {
          const float a = 2.f * (sa[4 * rg] + sa[4 * rg + 1] + sa[4 * rg + 2]) + sa[4 * rg + 3];
          const float recv = __shfl_xor(sa[4 * rg + 3], 32);
          const float val = h5 ? a + recv : a + carry;
          carry = recv;
          psl[16 * t + 8 * sub + 2 * rg + h5] = val;
        }
      }
      const bf16x8 pf0 = pack8(sa, 0), pf1 = pack8(sa, 1);
      bf16x8 vf[2][2];
#pragma unroll
      for (int s2 = 0; s2 < 2; ++s2) {
        const LAS char* vb = Vs + (32 * sub + 16 * s2 + 4 * h5 + tq) * 128 + 8 * (tp & 1);
        vf[s2][0] = tr_pair(vb + (((tds * 2 + (tp >> 1)) ^ vsw) << 4));
        vf[s2][1] = tr_pair(vb + (((4 + tds * 2 + (tp >> 1)) ^ vsw) << 4));
      }
      __builtin_amdgcn_s_setprio(1);
#pragma unroll
      for (int s2 = 0; s2 < 2; ++s2) { o0 = MFMA32(vf[s2][0], s2 ? pf1 : pf0, o0); o1 = MFMA32(vf[s2][1], s2 ? pf1 : pf0, o1); }
      __builtin_amdgcn_s_setprio(0);
    }
    __builtin_amdgcn_sched_barrier(0);
  }
}

__device__ __forceinline__ void dilated_item(const P& p, char* smem_, int unit) {
  LAS char* kv = (LAS char*)smem_;
  const int tid = otid(), lane = tid & 63, wv = tid >> 6, i = lane & 31, h5 = lane >> 5;
  const int r4 = unit & 3, ti = (unit >> 2) & 7, hh = (unit >> 5) & 7, b = unit >> 8;
  const size_t hb = (size_t)(b * 8 + hh) * S * 64;
  const int si = ti * 512 + r4 + 4 * wv + 16 * i;
  bf16x8 qf[4];
#pragma unroll
  for (int s4 = 0; s4 < 4; ++s4) qf[s4] = *(const bf16x8*)(p.QA + hb + (size_t)si * 64 + 16 * s4 + 8 * h5);
  f32x16 o0, o1;
#pragma unroll
  for (int q = 0; q < 16; ++q) { o0[q] = 0.f; o1[q] = 0.f; }
  float l = 0.f;
  const float shf = p.smaxv[0] * LOG2E;
  const int pbase = ti * 512 + r4 - 128, ubase = ti * 128 - 512;
  nsa_pass<3, 4>(kv, p.KA + hb, p.VA + hb, 0, 9, qf, shf, 4 * wv + 16 * i + 128, 0ull, o0, o1, l, nullptr, pbase, 1, pbase < 0 ? -pbase : 0);
  nsa_pass<4, 4>(kv, p.KA + hb, p.VA + hb, 0, 9, qf, shf, wv + 4 * i + 512, 0ull, o0, o1, l, nullptr, r4 + 4 * ubase, 4, ubase < 0 ? -ubase : 0);
  l += __shfl_xor(l, 32);
  const float inv = 1.f / l;
  unsigned char* orow = p.mixq + (size_t)(b * S + si) * D + hh * 64 + 4 * h5;
  const float invq = inv * MQ_SCALE;
#pragma unroll
  for (int rg = 0; rg < 4; ++rg) {
    *(unsigned*)(orow + 8 * rg) = pk4_fp8(clamp_e4m3(o0[4 * rg] * invq), clamp_e4m3(o0[4 * rg + 1] * invq), clamp_e4m3(o0[4 * rg + 2] * invq), clamp_e4m3(o0[4 * rg + 3] * invq));
    *(unsigned*)(orow + 32 + 8 * rg) = pk4_fp8(clamp_e4m3(o1[4 * rg] * invq), clamp_e4m3(o1[4 * rg + 1] * invq), clamp_e4m3(o1[4 * rg + 2] * invq), clamp_e4m3(o1[4 * rg + 3] * invq));
  }
}

__device__ __forceinline__ void nsa_item(const P& p, char* smem_, int item) {
  LAS char* smem = (LAS char*)smem_;
  LAS char* kv = smem;
  LAS float* pslcw = (LAS float*)(smem + 32768);
  LAS float* invl = (LAS float*)(smem + 32768 + 33280);
  LAS unsigned* msk = (LAS unsigned*)(smem + 32768 + 33280 + 512);
  const int tid = otid(), lane = tid & 63, wv = tid >> 6, i = lane & 31, h5 = lane >> 5;
  const int qt = 127 - (item >> 3), bg = item & 7, b = bg >> 1, g = bg & 1, hq = g * 4 + wv;
  const int s0 = qt * 32, si = s0 + i, cur = s0 >> 6;
  const size_t qoff = ((size_t)(b * 8 + hq) * S + si) * 64 + 8 * h5;
  bf16x8 qf[4];
#pragma unroll
  for (int s4 = 0; s4 < 4; ++s4) qf[s4] = *(const bf16x8*)(p.QN + qoff + 16 * s4);
  const float* gs = p.GS + (size_t)(b * S + si) * 24 + hq * 3;
  const float g0 = gs[0], g1 = gs[1], g2 = gs[2];
  f32x16 oa0, oa1, o0, o1;
#pragma unroll
  for (int q = 0; q < 16; ++q) { o0[q] = 0.f; o1[q] = 0.f; }
  float l = 0.f;
  LAS float* psl = pslcw + (wv * 32 + i) * 65;
  const int ncv = (s0 + 31 - 31) >> 4;
  const int tc_hi = (ncv < 254 ? ncv : 254) >> 6;
#pragma unroll
  for (int k = 0; k < 32; ++k) psl[2 * k + h5] = 0.f;
  nsa_pass<0, 2>(kv, p.kcb + (size_t)bg * 256 * 64, p.vcb + (size_t)bg * 256 * 64, 0, tc_hi, qf, p.smaxv[1] * LOG2E, si, 0ull, o0, o1, l, psl);
  l += __shfl_xor(l, 32);
  {
    const float il = l > 0.f ? 1.f / l : 0.f;
    if (h5 == 0) invl[wv * 32 + i] = il;
    const float sc = g0 * il;
#pragma unroll
    for (int q = 0; q < 16; ++q) { oa0[q] = o0[q] * sc; oa1[q] = o1[q] * sc; o0[q] = 0.f; o1[q] = 0.f; }
  }
  __syncthreads();
  LAS float* scr = pslcw;
  {
    const int q = tid >> 3, jj = tid & 7;
    float tot[8];
#pragma unroll
    for (int k = 0; k < 8; ++k) {
      const int j = jj + 8 * k;
      float v = 0.f;
#pragma unroll
      for (int w4 = 0; w4 < 4; ++w4) v += pslcw[(w4 * 32 + q) * 65 + j] * invl[w4 * 32 + q];
      const bool forced = (j == 0) || (j == cur) || (j == cur - 1);
      tot[k] = forced ? INFINITY : (j <= cur ? v : -INFINITY);
    }
    __syncthreads();
#pragma unroll
    for (int k = 0; k < 8; ++k) scr[q * 65 + jj + 8 * k] = tot[k];
    if (tid < 64) msk[tid] = 0u;
    __syncthreads();
    unsigned lo = 0u, hi = 0u;
#pragma unroll
    for (int k = 0; k < 8; ++k) {
      const int j = jj + 8 * k; const float v = tot[k];
      int rank = 0;
      for (int c = 0; c < 64; ++c) { const float sv = scr[q * 65 + c]; rank += (sv > v) || (sv == v && c < j); }
      if (rank < 16 && j <= cur) { if (j < 32) lo |= 1u << j; else hi |= 1u << (j - 32); }
    }
    if (lo) atomicOr((unsigned*)&msk[q * 2], lo);
    if (hi) atomicOr((unsigned*)&msk[q * 2 + 1], hi);
    __syncthreads();
  }
  const unsigned long long selm = (unsigned long long)msk[i * 2] | ((unsigned long long)msk[i * 2 + 1] << 32);
#pragma unroll
  for (int s4 = 0; s4 < 4; ++s4) qf[s4] = *(const bf16x8*)(p.QR + qoff + 16 * s4);
  const size_t kvoff = (size_t)bg * S * 64;
  l = 0.f;
  nsa_pass<1, 4>(kv, p.KSL + kvoff, p.VSL + kvoff, 0, cur, qf, p.smaxv[2] * LOG2E, si, selm, o0, o1, l, nullptr);
  l += __shfl_xor(l, 32);
  {
    const float sc = g1 / l;
#pragma unroll
    for (int q = 0; q < 16; ++q) { oa0[q] += o0[q] * sc; oa1[q] += o1[q] * sc; o0[q] = 0.f; o1[q] = 0.f; }
  }
  l = 0.f;
  const int tw_lo = s0 >= 511 ? (s0 - 511) >> 6 : 0;
  nsa_pass<2, 4>(kv, p.KW + kvoff, p.VW + kvoff, tw_lo, cur, qf, p.smaxv[3] * LOG2E, si, 0ull, o0, o1, l, nullptr);
  l += __shfl_xor(l, 32);
  {
    const float sc = g2 / l;
#pragma unroll
    for (int q = 0; q < 16; ++q) { oa0[q] += o0[q] * sc; oa1[q] += o1[q] * sc; }
  }
  unsigned char* orow = p.mixq + (size_t)(b * S + si) * D + 512 + hq * 64 + 4 * h5;
#pragma unroll
  for (int rg = 0; rg < 4; ++rg) {
    *(unsigned*)(orow + 8 * rg) = pk4_fp8(clamp_e4m3(oa0[4 * rg] * MQ_SCALE), clamp_e4m3(oa0[4 * rg + 1] * MQ_SCALE), clamp_e4m3(oa0[4 * rg + 2] * MQ_SCALE), clamp_e4m3(oa0[4 * rg + 3] * MQ_SCALE));
    *(unsigned*)(orow + 32 + 8 * rg) = pk4_fp8(clamp_e4m3(oa1[4 * rg] * MQ_SCALE), clamp_e4m3(oa1[4 * rg + 1] * MQ_SCALE), clamp_e4m3(oa1[4 * rg + 2] * MQ_SCALE), clamp_e4m3(oa1[4 * rg + 3] * MQ_SCALE));
  }
}
__device__ __forceinline__ void cvt_queue_item(const P& p, int ci) {
  f32x4 ra[16], rb[16];
  const CvtQ d0 = cvt_expert_desc(p, ci * 4), d1 = cvt_expert_desc(p, ci * 4 + 1), d2 = cvt_expert_desc(p, ci * 4 + 2), d3 = cvt_expert_desc(p, ci * 4 + 3);
  cvtq_load(d0, ra); cvtq_load(d1, rb);
  cvtq_store(d0, ra); cvtq_load(d2, ra);
  cvtq_store(d1, rb); cvtq_load(d3, rb);
  cvtq_store(d2, ra); cvtq_store(d3, rb);
}
__device__ __forceinline__ void ph_attn_a(const P& p, char* smem) {
  for (;;) {
    const int q = next_item(p.ctr + 0, smem);
    if (q >= 16 + 2560) break;
    if (q < 16) { compress_item(p, smem, q); continue; }
    const int j = q - 16, g = j / 5, r = j - g * 5;
    if (r == 0 || r == 3) dilated_item(p, smem, g * 2 + (r == 3)); else cvt_queue_item(p, g * 3 + (r == 1 ? 0 : (r == 2 ? 1 : 2)));
  }
}
__device__ __forceinline__ void ph_attn_b(const P& p, char* smem) {
  for (;;) {
    const int q = next_item(p.ctr + 1, smem);
    if (q >= 2560) break;
    const int g = q / 5, r = q - g * 5;
    if (r == 0 || r == 3) nsa_item(p, smem, g * 2 + (r == 3)); else cvt_queue_item(p, 1536 + g * 3 + (r == 1 ? 0 : (r == 2 ? 1 : 2)));
  }
}

__device__ __forceinline__ void ph_route(const P& p, char* smem) {
  const int lane = threadIdx.x & 63, wv = threadIdx.x >> 6;
  int* hist = (int*)smem;
  __syncthreads();
  hist[threadIdx.x] = 0;
  __syncthreads();
  const int tpb = T / gridDim.x, t0 = blockIdx.x * tpb;
  float bias[4];
#pragma unroll
  for (int i = 0; i < 4; ++i) bias[i] = p.r_bias[lane + 64 * i];
  for (int tt = wv; tt < tpb; tt += 4) {
    const int t = t0 + tt;
    float aff[4], bv[4], ta[4], tb[4];
#pragma unroll
    for (int i = 0; i < 4; ++i) { { const size_t li = (size_t)t * NE + lane + 64 * i; aff[i] = sigmoidf((p.logits[li] + p.logits[li + (size_t)T * NE]) + p.logits[li + (size_t)2 * T * NE]); } bv[i] = aff[i] + bias[i]; ta[i] = bv[i]; tb[i] = -INFINITY; }
#pragma unroll
    for (int o = 16; o; o >>= 1)
#pragma unroll
      for (int i = 0; i < 4; ++i) {
        const float a2 = __shfl_xor(ta[i], o), b2 = __shfl_xor(tb[i], o);
        const float na = fmaxf(ta[i], a2), nb = fmaxf(fminf(ta[i], a2), fmaxf(tb[i], b2));
        ta[i] = na; tb[i] = nb;
      }
    float gs[8];
#pragma unroll
    for (int i = 0; i < 4; ++i) { const float s2 = ta[i] + tb[i]; gs[2 * i] = __shfl(s2, 0); gs[2 * i + 1] = __shfl(s2, 32); }
    unsigned gmask = 0;
#pragma unroll
    for (int g = 0; g < 8; ++g) {
      int rank = 0;
#pragma unroll
      for (int i = 0; i < 8; ++i) rank += (gs[i] > gs[g]) || (gs[i] == gs[g] && i < g);
      if (rank < 4) gmask |= 1u << g;
    }
#pragma unroll
    for (int i = 0; i < 4; ++i) if (!((gmask >> (2 * i + (lane >> 5))) & 1u)) bv[i] = -INFINITY;
    unsigned key[4];
#pragma unroll
    for (int i = 0; i < 4; ++i) { const unsigned u = __float_as_uint(bv[i]); key[i] = (u & 0x80000000u) ? ~u : (u | 0x80000000u); }
    unsigned thr = 0u;
#pragma unroll 1
    for (int bit = 31; bit >= 0; --bit) {
      const unsigned trial = thr | (1u << bit);
      int c = 0;
#pragma unroll
      for (int i = 0; i < 4; ++i) c += __builtin_popcountll(__ballot(key[i] >= trial));
      if (c >= 8) thr = trial;
    }
    int ngt = 0;
#pragma unroll
    for (int i = 0; i < 4; ++i) ngt += __builtin_popcountll(__ballot(key[i] > thr));
    const int need = 8 - ngt;
    const unsigned long long ltmask = (1ull << lane) - 1ull;
    int eqbefore = 0, selbefore = 0;
    bool sel[4]; int slot[4];
#pragma unroll
    for (int i = 0; i < 4; ++i) {
      const unsigned long long eqm = __ballot(key[i] == thr);
      const bool s = key[i] > thr || (key[i] == thr && eqbefore + __builtin_popcountll(eqm & ltmask) < need);
      eqbefore += __builtin_popcountll(eqm);
      const unsigned long long sm = __ballot(s);
      sel[i] = s; slot[i] = selbefore + __builtin_popcountll(sm & ltmask);
      selbefore += __builtin_popcountll(sm);
    }
    float part = 0.f;
#pragma unroll
    for (int i = 0; i < 4; ++i) part += sel[i] ? aff[i] : 0.f;
    const float ssum = wave_sum(part);
#pragma unroll
    for (int i = 0; i < 4; ++i)
      if (sel[i]) {
        const int e = lane + 64 * i;
        p.eidx[t * 8 + slot[i]] = e;
        p.gates[t * 8 + slot[i]] = aff[i] / ssum * 2.5f;
        p.pos[t * 8 + slot[i]] = atomicAdd(&hist[e], 1);
      }
  }
  __syncthreads();
  p.bhist[(size_t)blockIdx.x * NE + threadIdx.x] = hist[threadIdx.x];
}
__device__ __forceinline__ void ph_fill(const P& p, char* smem) {
  int* soff = (int*)smem;
  int* wsum = soff + 260;
  int* sbase = soff + 272;
  const int tid = threadIdx.x, lane = tid & 63, wv = tid >> 6;
  __syncthreads();
  int c = 0, before = 0;
  for (int bb = 0; bb < (int)gridDim.x; ++bb) { const int v = p.bhist[(size_t)bb * NE + tid]; c += v; before += (bb < (int)blockIdx.x) ? v : 0; }
  int incl = c;
#pragma unroll
  for (int o = 1; o < 64; o <<= 1) { const int v = __shfl_up(incl, o); if (lane >= o) incl += v; }
  if (lane == 63) wsum[wv] = incl;
  __syncthreads();
  int base = 0;
  for (int i = 0; i < wv; ++i) base += wsum[i];
  soff[tid] = base + incl - c;
  sbase[tid] = base + incl - c + before;
  if (tid == 255) soff[256] = base + incl;
  __syncthreads();
  if (blockIdx.x == 0) {
    p.off[tid] = soff[tid]; p.cnt[tid] = c;
    if (tid == 255) p.off[256] = soff[256];
  }
  if (blockIdx.x == 1) {
    const int x = tid >> 5, i = tid & 31, e = x + 8 * i;
    const int tl = (soff[e + 1] - soff[e] + 255) >> 8;
    int inc2 = tl;
#pragma unroll
    for (int o = 1; o < 32; o <<= 1) { const int v = __shfl_up(inc2, o, 32); if (i >= o) inc2 += v; }
    p.tstart[x * 33 + i] = inc2 - tl;
    if (i == 31) p.tstart[x * 33 + 32] = inc2;
  }
  const int tpb = T / gridDim.x, a0 = blockIdx.x * tpb * 8;
  for (int a = a0 + tid; a < a0 + tpb * 8; a += 256) p.sorted[sbase[p.eidx[a]] + p.pos[a]] = a;
}

template <int NTL, class F>
__device__ __forceinline__ void moe_grid(const P& p, F body) {
  const int xcd = blockIdx.x & 7, lb = blockIdx.x >> 3, nlb = gridDim.x >> 3;
  const int* ts = p.tstart + xcd * 33;
  const int total = ts[32] * NTL;
  int i = 0;
  for (int j = lb; j < total; j += nlb) {
    while (ts[i + 1] * NTL <= j) ++i;
    const int tiles = ts[i + 1] - ts[i], rem = j - ts[i] * NTL;
    body(xcd + 8 * i, rem / tiles, rem % tiles);
  }
}
__device__ __forceinline__ const unsigned char* gu_rowq(const unsigned char* Wg, const unsigned char* Wu, int f0, int n) {
  const int wn = n >> 6, wi = n & 63;
  return (wi >= 32 ? Wu : Wg) + (size_t)(f0 + wn * 32 + (wi & 31)) * D;
}
__device__ __forceinline__ void ph_moe_gu(const P& p, char* smem) {
  moe_grid<4>(p, [&](int e, int ntile, int mtile) {
    const int cnt = p.cnt[e] - mtile * 256; const int* srt = p.sorted + p.off[e] + mtile * 256;
    const unsigned char* A = p.h2q; const unsigned char* Wg = p.Wq_g + (size_t)e * FF * D; const unsigned char* Wu = p.Wq_u + (size_t)e * FF * D; unsigned char* H = p.Hq;
    const float* gates = p.gates; const unsigned char* Z = (const unsigned char*)p.zrow;
    gemm2q(smem, D, [=](int r) { return r < cnt ? A + (size_t)(srt[r] >> 3) * D : Z; }, [=](int n) { return gu_rowq(Wg, Wu, ntile * 64, n); },
           [=](const f32x4 (&acc)[8][4], int r0, int c0, int) {
             const int wn = c0 >> 6, l4 = (c0 & 63) >> 2;
#pragma unroll
             for (int mt = 0; mt < 8; ++mt) {
               const int r = r0 + mt * 16; const bool ok = r < cnt; const int a = ok ? srt[r] : 0;
               const float sc = ok ? gates[a] * (HQ_SCALE / (WQ_SCALE * WQ_SCALE)) : 0.f;
               unsigned d[2];
#pragma unroll
               for (int q = 0; q < 2; ++q) {
                 const f32x4 g = acc[mt][q], u = acc[mt][q + 2];
                 float h[4];
#pragma unroll
                 for (int i = 0; i < 4; ++i) h[i] = clamp_e4m3(silu(g[i] * (1.f / WQ_SCALE)) * u[i] * (sc * WQ_SCALE));
                 d[q] = pk4_fp8(h[0], h[1], h[2], h[3]);
               }
               const bool b0 = l4 & 1;
               const unsigned send = b0 ? d[0] : d[1], recv = __shfl_xor(send, 16);
               u32x2 w = b0 ? (u32x2){recv, d[1]} : (u32x2){d[0], recv};
               if (ok) *(u32x2*)(H + (size_t)a * FF + ntile * 64 + wn * 32 + (b0 ? 16 + 4 * (l4 - 1) : 4 * l4)) = w;
             }
           }, 0, cnt <= 128);
  });
}
__device__ __forceinline__ void ph_moe_d(const P& p, char* smem) {
  moe_grid<4>(p, [&](int e, int ntp, int mtile) {
    const int cnt = p.cnt[e] - mtile * 256; const int* srt = p.sorted + p.off[e] + mtile * 256;
    const unsigned char* A = p.Hq; const unsigned char* W = p.Wq_d + (size_t)e * D * FF + (size_t)ntp * 256 * FF; unsigned char* Yq = p.Yq; const unsigned char* Z = (const unsigned char*)p.zrow;
    const int tid_ = otid(), lrow = ((tid_ >> 7) & 1) * 128 + (tid_ & 15);
    LAS int* ridt = (LAS int*)((LAS char*)smem + 3 * G2_STAGE);
    __syncthreads();
    ridt[tid_] = tid_ < cnt ? srt[tid_] : -1;
    gemm2q<2>(smem, FF, [=](int r) { return r < cnt ? A + (size_t)srt[r] * FF : Z; }, [=](int n) { return W + (size_t)n * FF; },
           [=](const f32x4 (&acc)[8][4], int r0, int c0, int rp) {
             const int wn64 = c0 & ~63, l4 = (c0 & 63) >> 2;
             const float s = YQ_SCALE / (WQ_SCALE * HQ_SCALE);
#pragma unroll
             for (int mt = 0; mt < 8; ++mt) {
               const int rd = ridt[lrow + mt * 16]; const bool ok = rd >= 0;
               unsigned dq[4];
#pragma unroll
               for (int nt = 0; nt < 4; ++nt) { const f32x4 a = acc[mt][nt] * s; dq[nt] = pk4_fp8(clamp_e4m3(a[0]), clamp_e4m3(a[1]), clamp_e4m3(a[2]), clamp_e4m3(a[3])); }
               { u32x2v r = __builtin_amdgcn_permlane16_swap(dq[0], dq[1], false, false); dq[0] = r.x; dq[1] = r.y; r = __builtin_amdgcn_permlane16_swap(dq[2], dq[3], false, false); dq[2] = r.x; dq[3] = r.y;
                 r = __builtin_amdgcn_permlane32_swap(dq[0], dq[2], false, false); dq[0] = r.x; dq[2] = r.y; r = __builtin_amdgcn_permlane32_swap(dq[1], dq[3], false, false); dq[1] = r.x; dq[3] = r.y; }
               if (ok) *(u32x4*)(Yq + (size_t)rd * D + (ntp * 2 + rp) * 128 + wn64 + 16 * l4) = (u32x4){dq[0], dq[1], dq[2], dq[3]};
               asm volatile("" ::: "memory");
             }
           }, (size_t)128 * FF, cnt <= 128);
  });
}
__device__ __forceinline__ void ph_combine(const P& p) {
  WLOOP(w, T / 4) {
    const int tid_ = otid(), t = w * 4 + (tid_ >> 6), c = (tid_ & 63) * 16, b = t / S;
    float acc[16];
#pragma unroll
    for (int i = 0; i < 16; ++i) acc[i] = 0.f;
#pragma unroll
    for (int k = 0; k < 8; ++k) {
      const u32x4 v = *(const u32x4*)(p.Yq + ((size_t)t * 8 + k) * D + c);
#pragma unroll
      for (int i = 0; i < 4; ++i) {
        const f32x2 lo = __builtin_amdgcn_cvt_pk_f32_fp8((int)v[i], false), hi = __builtin_amdgcn_cvt_pk_f32_fp8((int)v[i], true);
        acc[4 * i] += lo[0]; acc[4 * i + 1] += lo[1]; acc[4 * i + 2] += hi[0]; acc[4 * i + 3] += hi[1];
      }
    }
    const bf16_t* ys = p.Ys + (size_t)t * D + c; const float* gt = p.mod + b * 6 * D + 5 * D + c; const bf16_t* x1 = (const bf16_t*)p.x1 + (size_t)t * D + c; float* o = p.out + (size_t)t * D + c;
#pragma unroll
    for (int h = 0; h < 4; ++h) {
      const u32x2 sv = *(const u32x2*)(ys + 4 * h);
      const float s0 = __uint_as_float(sv.x << 16), s1 = __uint_as_float(sv.x & 0xffff0000u), s2 = __uint_as_float(sv.y << 16), s3 = __uint_as_float(sv.y & 0xffff0000u);
      const u32x2 xq = *(const u32x2*)(x1 + 4 * h);
      const f32x4 xv = {__uint_as_float(xq.x << 16), __uint_as_float(xq.x & 0xffff0000u), __uint_as_float(xq.y << 16), __uint_as_float(xq.y & 0xffff0000u)}, gv = *(const f32x4*)(gt + 4 * h);
      f32x4 r = {xv[0] + gv[0] * (s0 + acc[4 * h] * (1.f / YQ_SCALE)), xv[1] + gv[1] * (s1 + acc[4 * h + 1] * (1.f / YQ_SCALE)),
                 xv[2] + gv[2] * (s2 + acc[4 * h + 2] * (1.f / YQ_SCALE)), xv[3] + gv[3] * (s3 + acc[4 * h + 3] * (1.f / YQ_SCALE))};
      *(f32x4*)(o + 4 * h) = r;
    }
  }
}


#define XB_TMO      128
#define XB_XCNT(j)  (256  + 64 * (j))
#define XB_XSUB(j)  (1280 + 64 * (j))
#define XB_XGEN(j)  (2304 + 64 * (j))
#define XB_TOP      3328
#define XB_TOPGEN   3392
#define XCD_BAR_WORDS 3456
#define XB_SPIN_CAP (1u << 22)
__device__ __forceinline__ unsigned xb_ld(unsigned* p)              { return __hip_atomic_load(p, __ATOMIC_RELAXED, __HIP_MEMORY_SCOPE_AGENT); }
__device__ __forceinline__ unsigned xb_add(unsigned* p, unsigned v) { return __hip_atomic_fetch_add(p, v, __ATOMIC_RELAXED, __HIP_MEMORY_SCOPE_AGENT); }
__device__ __forceinline__ unsigned xb_xcc_id() { return (unsigned)__builtin_amdgcn_s_getreg((3 << 11) | 20) & 0xFu; }
#define XB_SPIN(cond, bar) do { unsigned _sp = 0; while (cond) { __builtin_amdgcn_s_sleep(1); \
    if ((++_sp & 255u) == 0u) { if (xb_ld(&(bar)[XB_TMO])) break; if (_sp > XB_SPIN_CAP) { atomicAdd(&(bar)[XB_TMO], 1u); break; } } } } while (0)
struct XcdBarrier { unsigned* bar; unsigned x; volatile LAS unsigned* st; };
__device__ __forceinline__ XcdBarrier xcd_barrier_post(unsigned* bar, volatile LAS unsigned* st) {
  XcdBarrier b; b.bar = bar; b.x = xb_xcc_id(); b.st = st;
  if (threadIdx.x == 0) (void)xb_add(&bar[XB_XCNT(b.x)], 1u);
  return b;
}
__device__ __forceinline__ void xcd_barrier_complete(unsigned* bar, unsigned x, unsigned& nloc, unsigned& nx) {
  const unsigned G = gridDim.x * gridDim.y * gridDim.z;
  unsigned sum, cnt, mine, sp = 0u;
  for (;;) {
    sum = 0u; cnt = 0u; mine = 0u;
#pragma unroll
    for (unsigned j = 0; j < 16; ++j) { const unsigned c = xb_ld(&bar[XB_XCNT(j)]); sum += c; cnt += (c > 0u) ? 1u : 0u; mine = (j == x) ? c : mine; }
    if (sum == G) break;
    __builtin_amdgcn_s_sleep(1);
    if ((++sp & 255u) == 0u) { if (xb_ld(&bar[XB_TMO])) break; if (sp > XB_SPIN_CAP) { atomicAdd(&bar[XB_TMO], 1u); break; } }
  }
  nloc = mine > 0u ? mine : 1u; nx = cnt > 0u ? cnt : 1u;
}
__device__ __forceinline__ void xcd_barrier(const XcdBarrier& b) {
  asm volatile("s_waitcnt vmcnt(0)" ::: "memory");
  __syncthreads();
  if (threadIdx.x == 0) {
    unsigned* bar = b.bar;
    __builtin_amdgcn_s_waitcnt(0);
    unsigned nloc = b.st[0], nx = b.st[1];
    if (nloc == 0u) { xcd_barrier_complete(bar, b.x, nloc, nx); b.st[0] = nloc; b.st[1] = nx; }
    const unsigned old = xb_add(&bar[XB_XSUB(b.x)], 1u);
    const unsigned gen = old / nloc;
    if (old + 1u == (gen + 1u) * nloc) {
      __builtin_amdgcn_fence(__ATOMIC_RELEASE, "agent");
      asm volatile("s_waitcnt vmcnt(0)" ::: "memory");
      const unsigned og = xb_add(&bar[XB_TOP], 1u);
      const unsigned tg = og / nx;
      if (og + 1u == (tg + 1u) * nx) xb_add(&bar[XB_TOPGEN], 1u);
      else XB_SPIN(xb_ld(&bar[XB_TOPGEN]) == tg, bar);
      __builtin_amdgcn_fence(__ATOMIC_ACQUIRE, "agent");
      xb_add(&bar[XB_XGEN(b.x)], 1u);
      asm volatile("s_waitcnt vmcnt(0)" ::: "memory");
    } else {
      XB_SPIN(xb_ld(&bar[XB_XGEN(b.x)]) == gen, bar);
      __builtin_amdgcn_fence(__ATOMIC_ACQUIRE, "agent");
      asm volatile("s_waitcnt vmcnt(0)" ::: "memory");
    }
  }
  __syncthreads();
}

__global__ void __launch_bounds__(256, 2) mega(P p) {
  extern __shared__ __attribute__((aligned(16))) char smem[];
  {
    volatile LAS unsigned* st0 = (volatile LAS unsigned*)((LAS char*)smem + SMEM_BYTES - 32);
    if (threadIdx.x == 0) { st0[0] = 0u; st0[1] = 0u; }
    __syncthreads();
  }
  const XcdBarrier xb = xcd_barrier_post(p.bar, (volatile LAS unsigned*)((LAS char*)smem + SMEM_BYTES - 32));
  ph_ada(p, smem); ph_rope_tab(p);
  { int ib = 0;
    for (int it = (int)blockIdx.x; it < 8 * 23; it += gridDim.x) cvtq_tile(p.w_in, INC, p.Wq_in, D, (it & 7) * 128, (it >> 3) * 128, INC);
    ib = (8 * 23) % gridDim.x; for (int it = (int)blockIdx.x - ib; it < 64; it += gridDim.x) if (it >= 0) cvtq_tile(p.w_out, D, p.Wq_out, D, (it & 7) * 128, (it >> 3) * 128);
    ib = (ib + 64) % gridDim.x;
    cvt_matrix<false>(p.w_router, p.Wt_rth, D, NE, ib); cvt_matrix<true>(p.w_router, p.Wt_rtl, D, NE, ib);
    cvt_matrix<false>(p.w1_k, p.Wt_c1k, 2048, 128, ib); cvt_matrix<false>(p.w1_v, p.Wt_c1v, 2048, 128, ib);
    for (int it = (int)blockIdx.x - ib; it < 32; it += gridDim.x) if (it >= 0) cvtq_tile(it < 16 ? p.ws_gate : p.ws_up, FF, it < 16 ? p.Wq_sg : p.Wq_su, D, (it & 7) * 128, ((it >> 3) & 1) * 128);
    ib = (ib + 32) % gridDim.x; cvt_matrix<false>(p.ws_down, p.Wt_sd, FF, D, ib); }
  if (blockIdx.x == gridDim.x - 4) { for (int i = threadIdx.x; i < 2048; i += 256) p.zrow[i] = 0; }
  if (blockIdx.x == gridDim.x - 1) {
    const int which = threadIdx.x >> 7, n = threadIdx.x & 127;
    const float* pe = which ? p.pe_v : p.pe_k; const float* w1 = which ? p.w1_v : p.w1_k;
    float a = 0.f;
    for (int k = 0; k < 2048; ++k) a += pe[k] * w1[(size_t)k * 128 + n];
    p.b1c[threadIdx.x] = a;
  }
  if (blockIdx.x == gridDim.x - 2) {
    for (int i = threadIdx.x; i < 8 * 64; i += 256) { p.kcb[((size_t)(i >> 6) * 256 + 255) * 64 + (i & 63)] = 0; p.vcb[((size_t)(i >> 6) * 256 + 255) * 64 + (i & 63)] = 0; }
  }
  if (blockIdx.x == gridDim.x - 3) {
    p.cnt[threadIdx.x] = 0;
    if (threadIdx.x < 8) p.ctr[threadIdx.x] = 0;
    if (threadIdx.x < 64) {
      const int ln = threadIdx.x;
      const float a = wave_max(fabsf(p.g_q_dil[ln])), bq = wave_max(fabsf(p.g_k_dil[ln])), c = wave_max(fabsf(p.g_q_nsa[ln]));
      const float d1 = wave_max(fabsf(p.g_k_cmp[ln])), d2 = wave_max(fabsf(p.g_k_slc[ln])), d3 = wave_max(fabsf(p.g_k_win[ln]));
      if (ln == 0) { p.smaxv[0] = 8.f * a * bq; p.smaxv[1] = 8.f * c * d1; p.smaxv[2] = 8.f * c * d2; p.smaxv[3] = 8.f * c * d3; }
    }
  }
  xcd_barrier(xb);
  ph_norm_mod<false>(p.x, p.g_mix, p.mod, 0, D, nullptr, p.h1q);
  xcd_barrier(xb);
  ph_proj(p, smem);
  xcd_barrier(xb);
  ph_attn_a(p, smem);
  xcd_barrier(xb);
  ph_attn_b(p, smem);
  xcd_barrier(xb);
  ph_outproj(p, smem);
  xcd_barrier(xb);
  if (DUP == 10) { ph_outproj_abl<0>(p, smem); xcd_barrier(xb); }
  if (DUP == 11) { ph_outproj_abl<1>(p, smem); xcd_barrier(xb); }
  if (DUP == 12) { ph_outproj_abl<2>(p, smem); xcd_barrier(xb); }
  if (DUP == 13) { ph_outproj_abl<3>(p, smem); xcd_barrier(xb); }
  ph_norm_mod<true, true>(p.x1, p.g_ffn, p.mod, 3 * D, 4 * D, p.h2s, p.h2q);
  xcd_barrier(xb);
  ph_router_shared_gu(p, smem);
  xcd_barrier(xb);
  ph_route(p, smem); ph_shared_d(p, smem);
  xcd_barrier(xb);
  ph_fill(p, smem);
  xcd_barrier(xb);
  ph_moe_gu(p, smem);
  xcd_barrier(xb);
  ph_moe_d(p, smem);
  xcd_barrier(xb);
  ph_combine(p);
}
}

extern "C" void kernel_launch(void* const* d_in, const int* in_sizes, int n_in, void* d_out, int out_size, void* d_ws, size_t ws_size,
                              hipStream_t stream) {
  P p{};
  const float** f = (const float**)d_in;
  p.x = f[0]; p.c = f[1]; p.w_ada = f[2]; p.b_ada = f[3]; p.g_mix = f[4]; p.g_ffn = f[5]; p.w_in = f[6]; p.g_q_dil = f[7]; p.g_k_dil = f[8];
  p.g_q_nsa = f[9]; p.g_k_cmp = f[10]; p.g_k_slc = f[11]; p.g_k_win = f[12]; p.pe_k = f[13]; p.w1_k = f[14]; p.w2_k = f[15]; p.pe_v = f[16];
  p.w1_v = f[17]; p.w2_v = f[18]; p.w_out = f[19]; p.w_router = f[20]; p.r_bias = f[21]; p.w_gate = f[22]; p.w_up = f[23]; p.w_down = f[24];
  p.ws_gate = f[25]; p.ws_up = f[26]; p.ws_down = f[27];
  p.out = (float*)d_out;
  char* w = (char*)d_ws; size_t o = 0;
  auto alloc = [&](size_t bytes) { void* r = w + o; o += (bytes + 255) & ~(size_t)255; return r; };
  p.mod = (float*)alloc(4 * 6 * D * 4);
  p.rope = (float*)alloc(S * 16 * 4);
  p.selmask = (unsigned long long*)alloc((size_t)T * 2 * 8);
  p.eidx = (int*)alloc(T * 8 * 4); p.gates = (float*)alloc(T * 8 * 4);
  p.cnt = (int*)alloc(NE * 4); p.off = (int*)alloc((NE + 1) * 4); p.pos = (int*)alloc(T * 8 * 4); p.sorted = (int*)alloc(T * 8 * 4);
  p.tstart = (int*)alloc(8 * 33 * 4);
  p.smaxv = (float*)alloc(64);
  p.b1c = (float*)alloc(256 * 4);
  p.ctr = (int*)alloc(64);
  p.kcb = (bf16_t*)alloc(8 * 256 * 64 * 2); p.vcb = (bf16_t*)alloc(8 * 256 * 64 * 2);
  p.GS = (float*)alloc((size_t)T * 24 * 4);
  p.QA = (bf16_t*)alloc((size_t)T * 512 * 2); p.KA = (bf16_t*)alloc((size_t)T * 512 * 2); p.VA = (bf16_t*)alloc((size_t)T * 512 * 2);
  p.QN = (bf16_t*)alloc((size_t)T * 512 * 2); p.QR = (bf16_t*)alloc((size_t)T * 512 * 2);
  p.KC = (bf16_t*)alloc((size_t)T * 128 * 2); p.VC = (bf16_t*)alloc((size_t)T * 128 * 2);
  p.KSL = (bf16_t*)alloc((size_t)T * 128 * 2); p.VSL = (bf16_t*)alloc((size_t)T * 128 * 2);
  p.KW = (bf16_t*)alloc((size_t)T * 128 * 2); p.VW = (bf16_t*)alloc((size_t)T * 128 * 2);
  p.logits = (float*)alloc((size_t)3 * T * NE * 4);
  p.x1 = (float*)alloc((size_t)T * D * 4);
  p.mixinb = (bf16_t*)alloc((size_t)T * D * 2);
  p.h1b = (bf16_t*)alloc((size_t)T * D * 2);
  p.h2s = (bf16_t*)alloc((size_t)T * 2 * D * 2);
  p.Hs = (bf16_t*)alloc((size_t)T * FF * 2);
  p.Ys = (bf16_t*)alloc((size_t)T * D * 2);
  p.bar = (unsigned*)alloc(XCD_BAR_WORDS * 4);
  p.bhist = (int*)alloc((size_t)2048 * NE * 4);
  p.Wt_c1k = (bf16_t*)alloc((size_t)128 * 2048 * 2); p.Wt_c1v = (bf16_t*)alloc((size_t)128 * 2048 * 2);
  p.zrow = (bf16_t*)alloc(2048 * 2);
  p.Wt_in = (bf16_t*)alloc((size_t)2944 * D * 2);
  p.Wt_out = (bf16_t*)alloc((size_t)D * D * 2);
  p.Wt_rth = (bf16_t*)alloc((size_t)NE * D * 2); p.Wt_rtl = (bf16_t*)alloc((size_t)NE * D * 2);
  p.Wt_sg = (bf16_t*)alloc((size_t)FF * D * 2); p.Wt_su = (bf16_t*)alloc((size_t)FF * D * 2); p.Wt_sd = (bf16_t*)alloc((size_t)D * FF * 2);
  p.Wq_g = (unsigned char*)alloc((size_t)NE * FF * D); p.Wq_u = (unsigned char*)alloc((size_t)NE * FF * D); p.Wq_d = (unsigned char*)alloc((size_t)NE * D * FF);
  p.h2q = (unsigned char*)alloc((size_t)T * D); p.h1q = (unsigned char*)alloc((size_t)T * D); p.Wq_in = (unsigned char*)alloc((size_t)2944 * D); p.Hq = (unsigned char*)alloc((size_t)T * 8 * FF);
  p.Yq = (unsigned char*)alloc((size_t)T * 8 * D);
  p.Wq_sg = (unsigned char*)alloc((size_t)FF * D); p.Wq_su = (unsigned char*)alloc((size_t)FF * D);
  p.mixq = (unsigned char*)alloc((size_t)T * D); p.Wq_out = (unsigned char*)alloc((size_t)D * D);
  (void)hipMemsetAsync(p.bar, 0, XCD_BAR_WORDS * 4, stream);
  static int grid_blocks = 0;
  if (!grid_blocks) {
    int dev = 0, cus = 0, per_cu = 0;
    (void)hipGetDevice(&dev);
    (void)hipDeviceGetAttribute(&cus, hipDeviceAttributeMultiprocessorCount, dev);
    (void)hipOccupancyMaxActiveBlocksPerMultiprocessor(&per_cu, mega, 256, SMEM_BYTES);
    if (per_cu > 2) per_cu = 2;
    if (per_cu < 1) per_cu = 1;
    grid_blocks = cus * per_cu;
  }
  void* args[] = {&p};
  hipError_t e = hipLaunchCooperativeKernel((void*)mega, dim3(grid_blocks), dim3(256), args, SMEM_BYTES, stream);
  if (e != hipSuccess) fprintf(stderr, "cooperative launch failed: %s (grid %d)\n", hipGetErrorString(e), grid_blocks);
}
```

```cpp
#include <hip/hip_runtime.h>
#include <hip/hip_cooperative_groups.h>
#include <stdint.h>
#include <cstdio>
namespace cg = cooperative_groups;

namespace {
constexpr int D = 1024, NB = 4, S = 4096, T = NB * S, HD = 64;
constexpr int INC = 2840;
constexpr int C_QA = 0, C_KA = 512, C_VA = 1024, C_QB = 1536, C_KC = 2048, C_VC = 2176, C_KSL = 2304, C_VSL = 2432,
              C_KW = 2560, C_VW = 2688, C_GB = 2816;
constexpr int NC = 255, NE = 256, TOPK = 8, FF = 256;
constexpr float EPS = 1e-6f;
#ifndef DUP
#define DUP 0
#endif
constexpr int SMEM_BYTES = 74 * 1024;
typedef unsigned short bf16_t;
typedef short bf16x8 __attribute__((ext_vector_type(8)));
typedef float f32x4 __attribute__((ext_vector_type(4)));
typedef unsigned u32x4 __attribute__((ext_vector_type(4)));
typedef unsigned u32x2 __attribute__((ext_vector_type(2)));
typedef __bf16 bf2_t __attribute__((ext_vector_type(2)));
typedef float f32x2 __attribute__((ext_vector_type(2)));
typedef float f32x16 __attribute__((ext_vector_type(16)));
typedef short s16x4 __attribute__((ext_vector_type(4)));
#define LAS __attribute__((address_space(3)))
#define MFMA32(a, b, c) __builtin_amdgcn_mfma_f32_32x32x16_bf16((a), (b), (c), 0, 0, 0)
constexpr float LOG2E = 1.4426950408889634f;

struct P {
  const float *x, *c, *w_ada, *b_ada, *g_mix, *g_ffn, *w_in, *g_q_dil, *g_k_dil, *g_q_nsa, *g_k_cmp, *g_k_slc, *g_k_win;
  const float *pe_k, *w1_k, *w2_k, *pe_v, *w1_v, *w2_v, *w_out, *w_router, *r_bias, *w_gate, *w_up, *w_down, *ws_gate, *ws_up, *ws_down;
  float* out;
  float *mod, *rope, *h1, *proj, *qrope, *kcmp, *vcmp, *ocmp, *oslc, *owin, *mixin, *x1, *h2, *logits, *gates, *hs_g, *hs, *shared, *Hbuf;
  unsigned long long* selmask;
  int *eidx, *cnt, *off, *pos, *sorted, *tstart;
  bf16_t *h1b, *h2s, *mixinb, *Hb, *Hs, *Ybuf, *Ys;
  bf16_t *QA, *KA, *VA, *QN, *QR, *KC, *VC, *KSL, *VSL, *KW, *VW;
  float *GS, *smaxv, *b1c;
  bf16_t *kcb, *vcb;
  int* ctr;
  int* bhist;
  unsigned char *h2q, *Hq, *Wq_g, *Wq_u, *Wq_d, *h1q, *Wq_in, *Yq, *mixq, *Wq_out, *Wq_sg, *Wq_su;
  unsigned* bar;
  bf16_t *zrow, *Wt_in, *Wt_out, *Wt_rth, *Wt_rtl, *Wt_sg, *Wt_su, *Wt_sd, *Wt_c1k, *Wt_c1v, *Wt_g, *Wt_u, *Wt_d;
};

#define WLOOP(w, n) for (int w = blockIdx.x; w < (n); w += gridDim.x)

__device__ __forceinline__ int otid() { int t = threadIdx.x; asm volatile("" : "+v"(t)); return t; }
__device__ __forceinline__ unsigned pk_bf16(float lo, float hi) {
  f32x2 v = {lo, hi};
  bf2_t r = __builtin_convertvector(v, bf2_t);
  return __builtin_bit_cast(unsigned, r);
}
__device__ __forceinline__ float clamp_e4m3(float v) { return __builtin_amdgcn_fmed3f(v, -448.f, 448.f); }
__device__ __forceinline__ unsigned pk4_fp8(float a, float b, float c, float d) {
  int t = __builtin_amdgcn_cvt_pk_fp8_f32(a, b, 0, false);
  t = __builtin_amdgcn_cvt_pk_fp8_f32(c, d, t, true);
  return (unsigned)t;
}
constexpr float WQ_SCALE = 64.f, HQ_SCALE = 8.f, YQ_SCALE = 16.f, MQ_SCALE = 16.f;
__device__ __forceinline__ float bf16_to_f32(unsigned short b) { return __uint_as_float((unsigned)b << 16); }
__device__ __forceinline__ float bf16_round(float v) { return __uint_as_float(pk_bf16(v, 0.f) << 16); }
__device__ __forceinline__ float silu(float v) { return v / (1.f + expf(-v)); }
__device__ __forceinline__ float sigmoidf(float v) { return 1.f / (1.f + expf(-v)); }
__device__ __forceinline__ float wave_sum(float v) { for (int o = 32; o; o >>= 1) v += __shfl_xor(v, o); return v; }
__device__ __forceinline__ float wave_max(float v) { for (int o = 32; o; o >>= 1) v = fmaxf(v, __shfl_xor(v, o)); return v; }

__device__ __forceinline__ void ph_ada(const P& p, char* smem) {
  float* sc = (float*)smem;
  f32x4* red = (f32x4*)(smem + 16384);
  bool loaded = false;
  WLOOP(w, 6 * D / 32) {
    const int tid = threadIdx.x, kg = tid >> 3, cl = tid & 7, j0 = w * 32 + cl * 4;
    __syncthreads();
    if (!loaded) { for (int i = tid; i < 4 * D; i += 256) sc[i] = silu(p.c[i]); loaded = true; __syncthreads(); }
    f32x4 acc[4];
#pragma unroll
    for (int b = 0; b < 4; ++b) acc[b] = (f32x4){0.f, 0.f, 0.f, 0.f};
#pragma unroll 8
    for (int it = 0; it < 32; ++it) {
      const int k = kg + 32 * it;
      const f32x4 wv = *(const f32x4*)(p.w_ada + (size_t)k * 6 * D + j0);
#pragma unroll
      for (int b = 0; b < 4; ++b) acc[b] += wv * sc[b * D + k];
    }
#pragma unroll
    for (int b = 0; b < 4; ++b) red[(kg * 8 + cl) * 4 + b] = acc[b];
    __syncthreads();
    if (tid < 128) {
      const int b = tid >> 5, c = tid & 31;
      float s = p.b_ada[w * 32 + c];
      for (int g = 0; g < 32; ++g) s += ((const float*)&red[(g * 8 + (c >> 2)) * 4 + b])[c & 3];
      p.mod[b * 6 * D + w * 32 + c] = s;
    }
  }
}
__device__ __forceinline__ void ph_rope_tab(const P& p) {
  WLOOP(w, S * 8 / 256) {
    int i = w * 256 + threadIdx.x;
    int pos = i >> 3, f = i & 7;
    double ang = (double)pos * pow(500000.0, -(double)f / 8.0);
    p.rope[i * 2] = (float)cos(ang);
    p.rope[i * 2 + 1] = (float)sin(ang);
  }
}
template <bool SPLIT, bool INBF = false>
__device__ __forceinline__ void ph_norm_mod(const float* in, const float* g, const float* mod, int shift_off, int scale_off, bf16_t* out, unsigned char* outq = nullptr) {
  const int lane = threadIdx.x & 63, wv = threadIdx.x >> 6;
  WLOOP(w, T / 4) {
    const int t = w * 4 + wv, b = t / S;
    f32x4 v[4];
    float ss = 0.f;
#pragma unroll
    for (int i = 0; i < 4; ++i) {
      if (INBF) { const u32x2 q = *(const u32x2*)((const bf16_t*)in + (size_t)t * D + i * 256 + lane * 4); v[i] = (f32x4){__uint_as_float(q.x << 16), __uint_as_float(q.x & 0xffff0000u), __uint_as_float(q.y << 16), __uint_as_float(q.y & 0xffff0000u)}; }
      else v[i] = *(const f32x4*)(in + (size_t)t * D + i * 256 + lane * 4);
      ss += v[i][0] * v[i][0] + v[i][1] * v[i][1] + v[i][2] * v[i][2] + v[i][3] * v[i][3]; }
    ss = wave_sum(ss);
    const float r = rsqrtf(ss * (1.f / D) + EPS);
    const int ld = SPLIT ? 2 * D : D;
#pragma unroll
    for (int i = 0; i < 4; ++i) {
      const int d = i * 256 + lane * 4;
      const f32x4 gg = *(const f32x4*)(g + d), sc = *(const f32x4*)(mod + b * 6 * D + scale_off + d), sh = *(const f32x4*)(mod + b * 6 * D + shift_off + d);
      const f32x4 o = v[i] * r * gg * (sc + 1.f) + sh;
      u32x2 hi = {pk_bf16(o[0], o[1]), pk_bf16(o[2], o[3])};
      if (out) *(u32x2*)(out + (size_t)t * ld + d) = hi;
      if (!SPLIT && outq) *(unsigned*)(outq + (size_t)t * D + d) = pk4_fp8(o[0], o[1], o[2], o[3]);
      if (SPLIT) {
        *(unsigned*)(outq + (size_t)t * D + d) = pk4_fp8(o[0], o[1], o[2], o[3]);
        const float l0 = o[0] - __uint_as_float(hi.x << 16), l1 = o[1] - __uint_as_float(hi.x & 0xffff0000u);
        const float l2 = o[2] - __uint_as_float(hi.y << 16), l3 = o[3] - __uint_as_float(hi.y & 0xffff0000u);
        u32x2 lo = {pk_bf16(l0, l1), pk_bf16(l2, l3)};
        *(u32x2*)(out + (size_t)t * ld + D + d) = lo;
      }
    }
  }
}

template <bool SPLIT3, class AF, class BF, class EF>
__device__ __forceinline__ void gemm128(char* smem, int K, int ldb, AF arow, BF bcol, EF epi) {
  const int tid = otid(), lane = tid & 63, wid = tid >> 6, wm = wid >> 1, wn = wid & 1;
  const int l15 = lane & 15, l4 = lane >> 4;
  char* As = smem; char* Bs = smem + 16384;
  const int ac = tid & 7, ar0 = tid >> 3;
  const bf16_t* ap[4];
#pragma unroll
  for (int i = 0; i < 4; ++i) ap[i] = arow(ar0 + 32 * i);
  const int kg = tid >> 5, ng = tid & 31;
  const float* bp = bcol(ng * 4);
  if (bp) bp += (size_t)(kg * 8) * ldb;
  u32x4 areg[4]; f32x4 breg[8];
  const int nk1 = K / 64, nk = SPLIT3 ? 3 * nk1 : nk1;
  auto gload = [&](int kt) {
    const int seg = SPLIT3 ? kt / nk1 : 0, k0 = (SPLIT3 ? kt % nk1 : kt) * 64;
    const int aoff = (seg == 2 ? K : 0) + k0 + ac * 8;
#pragma unroll
    for (int i = 0; i < 4; ++i) areg[i] = ap[i] ? *(const u32x4*)(ap[i] + aoff) : (u32x4){0u, 0u, 0u, 0u};
#pragma unroll
    for (int i = 0; i < 8; ++i) breg[i] = bp ? *(const f32x4*)(bp + (size_t)(k0 + i) * ldb) : (f32x4){0.f, 0.f, 0.f, 0.f};
    if (SPLIT3 && seg == 1) {
#pragma unroll
      for (int i = 0; i < 8; ++i)
#pragma unroll
        for (int j = 0; j < 4; ++j) breg[i][j] = breg[i][j] - bf16_round(breg[i][j]);
    }
  };
  auto lstore = [&]() {
#pragma unroll
    for (int i = 0; i < 4; ++i) { const int r = ar0 + 32 * i; *(u32x4*)(As + r * 128 + ((ac ^ ((r >> 1) & 7)) << 4)) = areg[i]; }
#pragma unroll
    for (int j = 0; j < 4; ++j) {
      const int n = ng * 4 + j;
      u32x4 v = {pk_bf16(breg[0][j], breg[1][j]), pk_bf16(breg[2][j], breg[3][j]), pk_bf16(breg[4][j], breg[5][j]), pk_bf16(breg[6][j], breg[7][j])};
      *(u32x4*)(Bs + n * 128 + ((kg ^ ((n >> 1) & 7)) << 4)) = v;
    }
  };
  f32x4 acc[4][4];
#pragma unroll
  for (int i = 0; i < 4; ++i)
#pragma unroll
    for (int j = 0; j < 4; ++j) acc[i][j] = (f32x4){0.f, 0.f, 0.f, 0.f};
  gload(0);
  const int sw = l15 >> 1;
  for (int kt = 0; kt < nk; ++kt) {
    __syncthreads();
    lstore();
    __syncthreads();
    if (kt + 1 < nk) gload(kt + 1);
#pragma unroll
    for (int ks = 0; ks < 2; ++ks) {
      const int coff = ((ks * 4 + l4) ^ sw) << 4;
      bf16x8 af[4], bfr[4];
#pragma unroll
      for (int mt = 0; mt < 4; ++mt) af[mt] = *(const bf16x8*)(As + (wm * 64 + mt * 16 + l15) * 128 + coff);
#pragma unroll
      for (int nt = 0; nt < 4; ++nt) bfr[nt] = *(const bf16x8*)(Bs + (wn * 64 + nt * 16 + l15) * 128 + coff);
#pragma unroll
      for (int mt = 0; mt < 4; ++mt)
#pragma unroll
        for (int nt = 0; nt < 4; ++nt) acc[mt][nt] = __builtin_amdgcn_mfma_f32_16x16x32_bf16(bfr[nt], af[mt], acc[mt][nt], 0, 0, 0);
    }
  }
  epi(acc, wm * 64 + l15, wn * 64 + l4 * 4);
}

typedef unsigned u32x2v __attribute__((ext_vector_type(2)));
__device__ __forceinline__ void xpose4(unsigned (&d)[4][2], int) {
#pragma unroll
  for (int a = 0; a < 2; ++a)
#pragma unroll
    for (int h = 0; h < 2; ++h) { const u32x2v r = __builtin_amdgcn_permlane16_swap(d[2 * a][h], d[2 * a + 1][h], false, false); d[2 * a][h] = r.x; d[2 * a + 1][h] = r.y; }
#pragma unroll
  for (int j = 0; j < 2; ++j)
#pragma unroll
    for (int h = 0; h < 2; ++h) { const u32x2v r = __builtin_amdgcn_permlane32_swap(d[j][h], d[2 + j][h], false, false); d[j][h] = r.x; d[2 + j][h] = r.y; }
}
__device__ __forceinline__ void store_row64_bf16(const f32x4& a0, const f32x4& a1, const f32x4& a2, const f32x4& a3, int l4, bf16_t* rowp, bool doit) {
  unsigned d[4][2] = {{pk_bf16(a0[0], a0[1]), pk_bf16(a0[2], a0[3])}, {pk_bf16(a1[0], a1[1]), pk_bf16(a1[2], a1[3])},
                      {pk_bf16(a2[0], a2[1]), pk_bf16(a2[2], a2[3])}, {pk_bf16(a3[0], a3[1]), pk_bf16(a3[2], a3[3])}};
  xpose4(d, l4);
  if (doit) {
    *(u32x4*)(rowp + 16 * l4) = (u32x4){d[0][0], d[0][1], d[1][0], d[1][1]};
    *(u32x4*)(rowp + 16 * l4 + 8) = (u32x4){d[2][0], d[2][1], d[3][0], d[3][1]};
  }
}

template <bool LO>
__device__ __forceinline__ void cvt_kn_tile(const float* src, int ldn, bf16_t* dst, int ldk, int k0, int n0, int nmax) {
  const int tid = threadIdx.x, kg = tid & 7, ng = tid >> 3, n = n0 + ng * 4;
  if (n >= nmax) return;
  f32x4 r[8];
#pragma unroll
  for (int i = 0; i < 8; ++i) r[i] = *(const f32x4*)(src + (size_t)(k0 + kg * 8 + i) * ldn + n);
  if (LO) {
#pragma unroll
    for (int i = 0; i < 8; ++i)
#pragma unroll
      for (int j = 0; j < 4; ++j) r[i][j] = r[i][j] - bf16_round(r[i][j]);
  }
#pragma unroll
  for (int j = 0; j < 4; ++j) {
    u32x4 v = {pk_bf16(r[0][j], r[1][j]), pk_bf16(r[2][j], r[3][j]), pk_bf16(r[4][j], r[5][j]), pk_bf16(r[6][j], r[7][j])};
    *(u32x4*)(dst + (size_t)(n + j) * ldk + k0 + kg * 8) = v;
  }
}
template <bool LO>
__device__ __forceinline__ void cvt_matrix(const float* src, bf16_t* dst, int K, int N, int& item_base) {
  const int nkt = K / 64, nnt = (N + 127) / 128, total = nkt * nnt;
  for (int it = (int)blockIdx.x - item_base; it < total; it += gridDim.x) {
    if (it < 0) continue;
    cvt_kn_tile<LO>(src, N, dst, K, (it % nkt) * 64, (it / nkt) * 128, N);
  }
  item_base = (item_base + total) % gridDim.x;
}

constexpr int G2_STAGE = 24576;
template <int NSEG, int AB = 0, class AF, class BF, class EF>
__device__ __forceinline__ void gemm2(char* smem_, int K, AF arow, BF brow, EF epi, int aseg1 = 0, int bseg1 = 0, int aseg2 = 0, int bseg2 = 0) {
  LAS char* smem = (LAS char*)smem_;
  const int tid = otid(), lane = tid & 63, wv = __builtin_amdgcn_readfirstlane(tid >> 6), wm = wv >> 1, wn = wv & 1;
  const int l15 = lane & 15, l4 = lane >> 4;
  const int row_l = lane >> 2, csrc = ((lane & 3) ^ (((row_l >> 3) & 1) * 3)) * 8;
  const bf16_t* ap[4]; const bf16_t* bp[2];
#pragma unroll
  for (int j = 0; j < 4; ++j) ap[j] = arow((wv + 4 * j) * 16 + row_l) + csrc;
#pragma unroll
  for (int j = 0; j < 2; ++j) bp[j] = brow((wv + 4 * j) * 16 + row_l) + csrc;
  const int nk1 = K / 32, nk = NSEG * nk1;
  auto issue = [&](int kt) {
    LAS char* st = smem + (kt % 3) * G2_STAGE;
    int ka = kt * 32, kb = kt * 32;
    if (NSEG > 1) { const int seg = kt / nk1, kk = (kt - seg * nk1) * 32; ka = kk + (seg == 1 ? aseg1 : (seg == 2 ? aseg2 : 0)); kb = kk + (seg == 1 ? bseg1 : (seg == 2 ? bseg2 : 0)); }
#pragma unroll
    for (int j = 0; j < 4; ++j) __builtin_amdgcn_global_load_lds((const unsigned*)(ap[j] + ka), (LAS unsigned*)(st + (wv + 4 * j) * 1024), 16, 0, 0);
#pragma unroll
    for (int j = 0; j < 2; ++j) __builtin_amdgcn_global_load_lds((const unsigned*)(bp[j] + kb), (LAS unsigned*)(st + 16384 + (wv + 4 * j) * 1024), 16, 0, 0);
  };
  f32x4 acc[8][4];
#pragma unroll
  for (int i = 0; i < 8; ++i)
#pragma unroll
    for (int j = 0; j < 4; ++j) acc[i][j] = (f32x4){0.f, 0.f, 0.f, 0.f};
  const int coff = (l4 ^ (((l15 >> 3) & 1) * 3)) << 4;
  const int aoff = (wm * 128 + l15) * 64 + coff, boff = 16384 + (wn * 64 + l15) * 64 + coff;
  asm volatile("s_waitcnt lgkmcnt(0)" ::: "memory");
  __builtin_amdgcn_s_barrier();
  asm volatile("" ::: "memory");
  issue(0);
  if (nk > 1) issue(1);
  for (int kt = 0; kt < nk; ++kt) {
    if (kt + 1 < nk) asm volatile("s_waitcnt vmcnt(6)" ::: "memory"); else asm volatile("s_waitcnt vmcnt(0)" ::: "memory");
    __builtin_amdgcn_s_barrier();
    asm volatile("" ::: "memory");
    if (AB != 2 && kt + 2 < nk) issue(kt + 2);
    const LAS char* st = smem + (kt % 3) * G2_STAGE;
    bf16x8 bfr[4], af[8];
    if (AB != 3) {
#pragma unroll
    for (int nt = 0; nt < 4; ++nt) bfr[nt] = *(const LAS bf16x8*)(st + boff + nt * 1024);
#pragma unroll
    for (int mt = 0; mt < 8; ++mt) af[mt] = *(const LAS bf16x8*)(st + aoff + mt * 1024);
    }
    __builtin_amdgcn_sched_barrier(0);
    if (AB == 1) {
#pragma unroll
      for (int nt = 0; nt < 4; ++nt) asm volatile("" :: "v"(bfr[nt]));
#pragma unroll
      for (int mt = 0; mt < 8; ++mt) asm volatile("" :: "v"(af[mt]));
    }
    if (AB == 0 || AB == 2) {
    __builtin_amdgcn_s_setprio(1);
#pragma unroll
    for (int mt = 0; mt < 8; ++mt)
#pragma unroll
      for (int nt = 0; nt < 4; ++nt) acc[mt][nt] = __builtin_amdgcn_mfma_f32_16x16x32_bf16(bfr[nt], af[mt], acc[mt][nt], 0, 0, 0);
    __builtin_amdgcn_s_setprio(0);
    }
    __builtin_amdgcn_sched_barrier(0);
  }
  epi(acc, wm * 128 + l15, wn * 64 + l4 * 4);
}

template <int NREP = 1, class AF, class BF, class EF>
__device__ __forceinline__ void gemm2q(char* smem_, int K, AF arow, BF brow, EF epi, size_t bstep = 0, bool half = false) {
  LAS char* smem = (LAS char*)smem_;
  const int tid = otid(), lane = tid & 63, wv = __builtin_amdgcn_readfirstlane(tid >> 6), wm = wv >> 1, wn = wv & 1;
  const int l15 = lane & 15, l4 = lane >> 4;
  const int row_l = lane >> 2, csrc = ((lane & 3) ^ ((row_l >> 2) & 3)) * 16;
  const unsigned char* ap[4]; const unsigned char* bp[2];
#pragma unroll
  for (int j = 0; j < 4; ++j) ap[j] = arow((wv + 4 * j) * 16 + row_l) + csrc;
#pragma unroll
  for (int j = 0; j < 2; ++j) bp[j] = brow((wv + 4 * j) * 16 + row_l) + csrc;
  const int nk1 = K / 64, nk = nk1 * NREP;
  auto issue = [&](int kt) {
    LAS char* st = smem + (kt % 3) * G2_STAGE;
    const int rp = NREP > 1 ? kt / nk1 : 0, kk = NREP > 1 ? kt - rp * nk1 : kt;
#pragma unroll
    for (int j = 0; j < 4; ++j) __builtin_amdgcn_global_load_lds((const unsigned*)(ap[j] + kk * 64), (LAS unsigned*)(st + (wv + 4 * j) * 1024), 16, 0, 0);
#pragma unroll
    for (int j = 0; j < 2; ++j) __builtin_amdgcn_global_load_lds((const unsigned*)(bp[j] + rp * bstep + kk * 64), (LAS unsigned*)(st + 16384 + (wv + 4 * j) * 1024), 16, 0, 0);
  };
  f32x4 acc[8][4];
#pragma unroll
  for (int i = 0; i < 8; ++i)
#pragma unroll
    for (int j = 0; j < 4; ++j) acc[i][j] = (f32x4){0.f, 0.f, 0.f, 0.f};
  const int sw = (l15 >> 2) & 3, sub = (l4 & 1) * 8, ch = l4 >> 1;
  const int aoff = (wm * 128 + l15) * 64 + sub, boff = 16384 + (wn * 64 + l15) * 64 + sub;
  asm volatile("s_waitcnt lgkmcnt(0)" ::: "memory");
  __builtin_amdgcn_s_barrier();
  asm volatile("" ::: "memory");
  issue(0);
  if (nk > 1) issue(1);
  for (int kt = 0; kt < nk; ++kt) {
    if (kt + 1 < nk) asm volatile("s_waitcnt vmcnt(6)" ::: "memory"); else asm volatile("s_waitcnt vmcnt(0)" ::: "memory");
    __builtin_amdgcn_s_barrier();
    asm volatile("" ::: "memory");
    if (kt + 2 < nk) issue(kt + 2);
    const LAS char* st = smem + (kt % 3) * G2_STAGE;
    if (!(half && wm == 1))
#pragma unroll
    for (int ks = 0; ks < 2; ++ks) {
      const int coff = ((2 * ks + ch) ^ sw) << 4;
      long bfr[4], af[8];
#pragma unroll
      for (int nt = 0; nt < 4; ++nt) bfr[nt] = *(const LAS long*)(st + boff + nt * 1024 + coff);
#pragma unroll
      for (int mt = 0; mt < 8; ++mt) af[mt] = *(const LAS long*)(st + aoff + mt * 1024 + coff);
      __builtin_amdgcn_s_setprio(1);
#pragma unroll
      for (int mt = 0; mt < 8; ++mt)
#pragma unroll
        for (int nt = 0; nt < 4; ++nt) acc[mt][nt] = __builtin_amdgcn_mfma_f32_16x16x32_fp8_fp8(bfr[nt], af[mt], acc[mt][nt], 0, 0, 0);
      __builtin_amdgcn_s_setprio(0);
    }
    __builtin_amdgcn_sched_barrier(0);
    if (NREP > 1 && (kt + 1) % nk1 == 0 && kt + 1 < nk) {
      epi(acc, wm * 128 + l15, wn * 64 + l4 * 4, kt / nk1);
#pragma unroll
      for (int i = 0; i < 8; ++i)
#pragma unroll
        for (int j = 0; j < 4; ++j) acc[i][j] = (f32x4){0.f, 0.f, 0.f, 0.f};
    }
  }
  epi(acc, wm * 128 + l15, wn * 64 + l4 * 4, NREP - 1);
}


typedef int i32x8 __attribute__((ext_vector_type(8)));
typedef float f32x16 __attribute__((ext_vector_type(16)));
template <int NREP = 1, class AF, class BF, class EF>
__device__ __forceinline__ void gemm2x(char* smem_, int K, AF arow, BF brow, EF epi, size_t bstep = 0, bool half = false) {
  LAS char* smem = (LAS char*)smem_;
  const int tid = otid(), lane = tid & 63, wv = __builtin_amdgcn_readfirstlane(tid >> 6), wm = wv >> 1, wn = wv & 1;
  const int l31 = lane & 31, hh = lane >> 5;
  const int row_l = lane >> 2, csrc = ((lane & 3) ^ ((row_l >> 1) & 3)) * 16;
  const unsigned char* ap[4]; const unsigned char* bp[2];
#pragma unroll
  for (int j = 0; j < 4; ++j) ap[j] = arow((wv + 4 * j) * 16 + row_l) + csrc;
#pragma unroll
  for (int j = 0; j < 2; ++j) bp[j] = brow((wv + 4 * j) * 16 + row_l) + csrc;
  const int nk1 = K / 64, nk = nk1 * NREP;
  auto issue = [&](int kt) {
    LAS char* st = smem + (kt % 3) * G2_STAGE;
    const int rp = NREP > 1 ? kt / nk1 : 0, kk = NREP > 1 ? kt - rp * nk1 : kt;
#pragma unroll
    for (int j = 0; j < 4; ++j) __builtin_amdgcn_global_load_lds((const unsigned*)(ap[j] + kk * 64), (LAS unsigned*)(st + (wv + 4 * j) * 1024), 16, 0, 0);
#pragma unroll
    for (int j = 0; j < 2; ++j) __builtin_amdgcn_global_load_lds((const unsigned*)(bp[j] + rp * bstep + kk * 64), (LAS unsigned*)(st + 16384 + (wv + 4 * j) * 1024), 16, 0, 0);
  };
  f32x16 acc[4][2];
#pragma unroll
  for (int i = 0; i < 4; ++i)
#pragma unroll
    for (int j = 0; j < 2; ++j)
#pragma unroll
      for (int e = 0; e < 16; ++e) acc[i][j][e] = 0.f;
  const int sw = (l31 >> 1) & 3, c0 = ((2 * hh) ^ sw) << 4, c1 = c0 ^ 16;
  const int aoff = (wm * 128 + l31) * 64, boff = 16384 + (wn * 64 + l31) * 64;
  asm volatile("s_waitcnt lgkmcnt(0)" ::: "memory");
  __builtin_amdgcn_s_barrier();
  asm volatile("" ::: "memory");
  issue(0);
  if (nk > 1) issue(1);
  for (int kt = 0; kt < nk; ++kt) {
    if (kt + 1 < nk) asm volatile("s_waitcnt vmcnt(6)" ::: "memory"); else asm volatile("s_waitcnt vmcnt(0)" ::: "memory");
    __builtin_amdgcn_s_barrier();
    asm volatile("" ::: "memory");
    if (kt + 2 < nk) issue(kt + 2);
    const LAS char* st = smem + (kt % 3) * G2_STAGE;
    if (!(half && wm == 1)) {
      i32x8 bfr[2], af[4];
#pragma unroll
      for (int nt = 0; nt < 2; ++nt) {
        const u32x4 lo = *(const LAS u32x4*)(st + boff + nt * 2048 + c0), hi = *(const LAS u32x4*)(st + boff + nt * 2048 + c1);
        bfr[nt] = (i32x8){(int)lo.x, (int)lo.y, (int)lo.z, (int)lo.w, (int)hi.x, (int)hi.y, (int)hi.z, (int)hi.w};
      }
#pragma unroll
      for (int mt = 0; mt < 4; ++mt) {
        const u32x4 lo = *(const LAS u32x4*)(st + aoff + mt * 2048 + c0), hi = *(const LAS u32x4*)(st + aoff + mt * 2048 + c1);
        af[mt] = (i32x8){(int)lo.x, (int)lo.y, (int)lo.z, (int)lo.w, (int)hi.x, (int)hi.y, (int)hi.z, (int)hi.w};
      }
      __builtin_amdgcn_s_setprio(1);
#pragma unroll
      for (int mt = 0; mt < 4; ++mt)
#pragma unroll
        for (int nt = 0; nt < 2; ++nt)
          acc[mt][nt] = __builtin_amdgcn_mfma_scale_f32_32x32x64_f8f6f4(bfr[nt], af[mt], acc[mt][nt], 0, 0, 0, 0x7F7F7F7F, 0, 0x7F7F7F7F);
      __builtin_amdgcn_s_setprio(0);
    }
    __builtin_amdgcn_sched_barrier(0);
    if (NREP > 1 && (kt + 1) % nk1 == 0 && kt + 1 < nk) {
      epi(acc, wm * 128 + l31, wn * 64 + 4 * hh, kt / nk1);
#pragma unroll
      for (int i = 0; i < 4; ++i)
#pragma unroll
        for (int j = 0; j < 2; ++j)
#pragma unroll
          for (int e = 0; e < 16; ++e) acc[i][j][e] = 0.f;
    }
  }
  epi(acc, wm * 128 + l31, wn * 64 + 4 * hh, NREP - 1);
}

template <class F>
__device__ __forceinline__ void gemm2_grid(int NT, F body) {
  const int xcd = blockIdx.x & 7, lb = blockIdx.x >> 3, nlb = gridDim.x >> 3;
  for (int i = lb; i < 8 * NT; i += nlb) body(xcd * 8 + (i & 7), i >> 3);
}

template <class F>
__device__ __forceinline__ void gemm_grid(int NT, F body) {
  const int xcd = blockIdx.x & 7, lb = blockIdx.x >> 3, nlb = gridDim.x >> 3;
  for (int i = lb; i < 16 * NT; i += nlb) {
    const int g = i / (8 * NT), rem = i % (8 * NT), nt = rem >> 3, mi = rem & 7;
    body(xcd * 16 + g * 8 + mi, nt);
  }
}

template <int MT>
__device__ __forceinline__ void proj_epi(const P& p, const f32x4 (&acc)[MT][4], int row_base, int ntile, int r0, int c0, float ascale = 1.f, const float* rope_tile = nullptr) {
  const int wn = c0 >> 6, l4 = (c0 & 63) >> 2;
  const int col0 = ntile * 128 + wn * 64;
  if (col0 >= INC) return;
  if (col0 == C_GB) {
#pragma unroll
    for (int mt = 0; mt < MT; ++mt) {
      const int m = row_base + r0 + mt * 16;
      f32x4 a = acc[mt][0] * ascale, g0 = {sigmoidf(a[0]), sigmoidf(a[1]), sigmoidf(a[2]), sigmoidf(a[3])};
      *(f32x4*)(p.GS + (size_t)m * 24 + 4 * l4) = g0;
      if (l4 < 2) { a = acc[mt][1] * ascale; f32x4 g1 = {sigmoidf(a[0]), sigmoidf(a[1]), sigmoidf(a[2]), sigmoidf(a[3])}; *(f32x4*)(p.GS + (size_t)m * 24 + 16 + 4 * l4) = g1; }
    }
    return;
  }
  const float* g = nullptr; bf16_t* dst; bf16_t* dst2 = nullptr; int hh, H; float qs = 1.f; bool dorope = false;
  if (col0 < 512) { g = p.g_q_dil; dst = p.QA; hh = col0 >> 6; H = 8; qs = 0.125f; dorope = true; }
  else if (col0 < 1024) { g = p.g_k_dil; dst = p.KA; hh = (col0 - 512) >> 6; H = 8; dorope = true; }
  else if (col0 < 1536) { dst = p.VA; hh = (col0 - 1024) >> 6; H = 8; }
  else if (col0 < 2048) { g = p.g_q_nsa; dst = p.QR; dst2 = p.QN; hh = (col0 - 1536) >> 6; H = 8; qs = 0.125f; dorope = true; }
  else {
    const int idx = (col0 - 2048) >> 6, which = idx >> 1; hh = idx & 1; H = 2;
    if (which == 0) dst = p.KC; else if (which == 1) dst = p.VC;
    else if (which == 2) { dst = p.KSL; g = p.g_k_slc; dorope = true; } else if (which == 3) dst = p.VSL;
    else if (which == 4) { dst = p.KW; g = p.g_k_win; dorope = true; } else dst = p.VW;
  }
  f32x4 gv[4];
  if (g) {
#pragma unroll
    for (int nt = 0; nt < 4; ++nt) gv[nt] = *(const f32x4*)(g + nt * 16 + 4 * l4);
  }
  const int bb = row_base / S;
#pragma unroll
  for (int mt = 0; mt < MT; ++mt) {
    const int m = row_base + r0 + mt * 16, s = m - bb * S;
    f32x4 v[4];
#pragma unroll
    for (int nt = 0; nt < 4; ++nt) v[nt] = acc[mt][nt] * ascale;
    if (g) {
      float ss = 0.f;
#pragma unroll
      for (int nt = 0; nt < 4; ++nt) ss += v[nt][0] * v[nt][0] + v[nt][1] * v[nt][1] + v[nt][2] * v[nt][2] + v[nt][3] * v[nt][3];
      ss += __shfl_xor(ss, 16); ss += __shfl_xor(ss, 32);
      const float r = rsqrtf(ss * (1.f / 64.f) + EPS) * qs;
#pragma unroll
      for (int nt = 0; nt < 4; ++nt) v[nt] = v[nt] * gv[nt] * r;
    }
    f32x4 vr = v[0];
    if (dorope) {
      const float* rp = rope_tile ? rope_tile + ((size_t)(m - row_base) * 8 + 4 * (l4 & 1)) * 2 : p.rope + ((size_t)s * 8 + 4 * (l4 & 1)) * 2;
      const f32x4 ra = *(const f32x4*)rp, rb = *(const f32x4*)(rp + 4);
      const float cs[4] = {ra[0], ra[2], rb[0], rb[2]}, sn[4] = {ra[1], ra[3], rb[1], rb[3]};
#pragma unroll
      for (int i = 0; i < 4; ++i) {
        const float pt = __shfl_xor(v[0][i], 32);
        vr[i] = (l4 < 2) ? (v[0][i] * cs[i] - pt * sn[i]) : (v[0][i] * cs[i] + pt * sn[i]);
      }
    }
    bf16_t* row = dst + ((size_t)(bb * H + hh) * S + s) * 64 + 16 * l4;
    unsigned dd[4][2] = {{pk_bf16(vr[0], vr[1]), pk_bf16(vr[2], vr[3])}, {pk_bf16(v[1][0], v[1][1]), pk_bf16(v[1][2], v[1][3])},
                         {pk_bf16(v[2][0], v[2][1]), pk_bf16(v[2][2], v[2][3])}, {pk_bf16(v[3][0], v[3][1]), pk_bf16(v[3][2], v[3][3])}};
    if (dst2) {
      unsigned d2[4][2] = {{pk_bf16(v[0][0], v[0][1]), pk_bf16(v[0][2], v[0][3])}, {dd[1][0], dd[1][1]}, {dd[2][0], dd[2][1]}, {dd[3][0], dd[3][1]}};
      xpose4(d2, l4);
      bf16_t* row2 = dst2 + ((size_t)(bb * H + hh) * S + s) * 64 + 16 * l4;
      *(u32x4*)row2 = (u32x4){d2[0][0], d2[0][1], d2[1][0], d2[1][1]};
      *(u32x4*)(row2 + 8) = (u32x4){d2[2][0], d2[2][1], d2[3][0], d2[3][1]};
    }
    xpose4(dd, l4);
    *(u32x4*)row = (u32x4){dd[0][0], dd[0][1], dd[1][0], dd[1][1]};
    *(u32x4*)(row + 8) = (u32x4){dd[2][0], dd[2][1], dd[3][0], dd[3][1]};
    asm volatile("" ::: "memory");
  }
}
__device__ __forceinline__ void ph_proj(const P& p, char* smem) {
  gemm2_grid(23, [&](int mtile, int ntile) {
    const unsigned char* A = p.h1q + (size_t)mtile * 256 * D; const unsigned char* W = p.Wq_in + (size_t)ntile * 128 * D; const unsigned char* Z = (const unsigned char*)p.zrow;
    const int nvalid = INC - ntile * 128;
    gemm2q<1>(smem, D, [=](int r) { return A + (size_t)r * D; }, [=](int n) { return n < nvalid ? W + (size_t)n * D : Z; },
              [&](const f32x4 (&acc)[8][4], int r0, int c0, int) {
                float* rl = (float*)smem;
                __syncthreads();
                { const int s0 = (mtile * 256) % S; const f32x4* srcp = (const f32x4*)(p.rope + (size_t)s0 * 16);
#pragma unroll
                  for (int i = 0; i < 4; ++i) ((f32x4*)rl)[threadIdx.x + 256 * i] = srcp[threadIdx.x + 256 * i]; }
                __syncthreads();
                proj_epi<8>(p, acc, mtile * 256, ntile, r0, c0, 1.f / WQ_SCALE, rl);
              });
  });
}
__device__ __forceinline__ void ph_outproj(const P& p, char* smem) {
  gemm2_grid(8, [&](int mtile, int ntile) {
    const unsigned char* A = p.mixq + (size_t)mtile * 256 * D; const unsigned char* W = p.Wq_out + (size_t)ntile * 128 * D; bf16_t* C = (bf16_t*)p.x1; const float* x = p.x;
    const float* gt = p.mod + ((mtile * 256) / S) * 6 * D + 2 * D;
    gemm2q<1>(smem, D, [=](int r) { return A + (size_t)r * D; }, [=](int n) { return W + (size_t)n * D; },
              [=](const f32x4 (&acc)[8][4], int r0, int c0, int) {
                const int l4 = (c0 & 63) >> 2;
                const float s = 1.f / (WQ_SCALE * MQ_SCALE);
#pragma unroll
                for (int mt = 0; mt < 8; ++mt) {
                  const int m = mtile * 256 + r0 + mt * 16;
                  f32x4 o[4];
#pragma unroll
                  for (int nt = 0; nt < 4; ++nt) {
                    const int n = ntile * 128 + c0 + nt * 16;
                    o[nt] = *(const f32x4*)(x + (size_t)m * D + n) + *(const f32x4*)(gt + n) * (acc[mt][nt] * s);
                  }
                  store_row64_bf16(o[0], o[1], o[2], o[3], l4, C + (size_t)m * D + ntile * 128 + (c0 & ~63), true);
                  asm volatile("" ::: "memory");
                }
              });
  });
}
template <int AB>
__device__ __forceinline__ void ph_outproj_abl(const P& p, char* smem) {
  gemm2_grid(8, [&](int mtile, int ntile) {
    const bf16_t* A = p.mixinb + (size_t)mtile * 256 * D; const bf16_t* W = p.Wt_out + (size_t)ntile * 128 * D; float* C = (float*)p.Ybuf;
    gemm2<1, AB>(smem, D, [=](int r) { return A + (size_t)r * D; }, [=](int n) { return W + (size_t)n * D; },
             [=](const f32x4 (&acc)[8][4], int r0, int c0) {
#pragma unroll
               for (int mt = 0; mt < 8; ++mt)
#pragma unroll
                 for (int nt = 0; nt < 4; ++nt) {
                   const int m = mtile * 256 + r0 + mt * 16, n = ntile * 128 + c0 + nt * 16;
                   *(f32x4*)(C + (size_t)m * D + n) = acc[mt][nt];
                 }
             });
  });
}
__device__ __forceinline__ void router_unit(const P& p, char* smem, int mtile, int j) {
  const int seg = j >> 1, ntile = j & 1;
  const bf16_t* A = p.h2s + (size_t)mtile * 256 * 2 * D + (seg == 2 ? D : 0);
  const bf16_t* W = (seg == 1 ? p.Wt_rtl : p.Wt_rth) + (size_t)ntile * 128 * D; float* C = p.logits + (size_t)seg * T * NE;
  gemm2<1>(smem, D, [=](int r) { return A + (size_t)r * 2 * D; }, [=](int n) { return W + (size_t)n * D; },
           [=](const f32x4 (&acc)[8][4], int r0, int c0) {
#pragma unroll
             for (int mt = 0; mt < 8; ++mt)
#pragma unroll
               for (int nt = 0; nt < 4; ++nt) {
                 const int m = mtile * 256 + r0 + mt * 16, n = ntile * 128 + c0 + nt * 16;
                 *(f32x4*)(C + (size_t)m * NE + n) = acc[mt][nt];
               }
           });
}
__device__ __forceinline__ const bf16_t* gu_row(const bf16_t* Wg, const bf16_t* Wu, int f0, int n) {
  const int wn = n >> 6, wi = n & 63;
  return (wi >= 32 ? Wu : Wg) + (size_t)(f0 + wn * 32 + (wi & 31)) * D;
}
template <int MT>
__device__ __forceinline__ void gu_store(const f32x4 (&acc)[MT][4], int mt, float scale, bf16_t* dstrow  ) {
#pragma unroll
  for (int q = 0; q < 2; ++q) {
    const f32x4 g = acc[mt][q], u = acc[mt][q + 2];
    float h[4];
#pragma unroll
    for (int i = 0; i < 4; ++i) h[i] = silu(g[i]) * u[i] * scale;
    u32x2 v = {pk_bf16(h[0], h[1]), pk_bf16(h[2], h[3])};
    *(u32x2*)(dstrow + q * 16) = v;
  }
}
__device__ __forceinline__ const unsigned char* gu_rowq(const unsigned char* Wg, const unsigned char* Wu, int f0, int n);
__device__ __forceinline__ void shared_gu_unit(const P& p, char* smem, int mtile, int ntile) {
  const unsigned char* A = p.h2q + (size_t)mtile * 256 * D; const unsigned char* Wg = p.Wq_sg; const unsigned char* Wu = p.Wq_su; bf16_t* H = p.Hs;
  gemm2q<1>(smem, D, [=](int r) { return A + (size_t)r * D; }, [=](int n) { return gu_rowq(Wg, Wu, ntile * 64, n); },
            [=](const f32x4 (&acc)[8][4], int r0, int c0, int) {
              const int wn = c0 >> 6, l4x4 = c0 & 63;
#pragma unroll
              for (int mt = 0; mt < 8; ++mt) {
                bf16_t* dstrow = H + (size_t)(mtile * 256 + r0 + mt * 16) * FF + ntile * 64 + wn * 32 + l4x4;
#pragma unroll
                for (int q = 0; q < 2; ++q) {
                  const f32x4 g = acc[mt][q], u = acc[mt][q + 2];
                  float h[4];
#pragma unroll
                  for (int i = 0; i < 4; ++i) h[i] = silu(g[i] * (1.f / WQ_SCALE)) * u[i] * (1.f / WQ_SCALE);
                  u32x2 v = {pk_bf16(h[0], h[1]), pk_bf16(h[2], h[3])};
                  *(u32x2*)(dstrow + q * 16) = v;
                }
              }
            });
}
__device__ __forceinline__ void ph_router_shared_gu(const P& p, char* smem) {
  const int xcd = blockIdx.x & 7, lb = blockIdx.x >> 3, nlb = gridDim.x >> 3;
  if (nlb == 64) {
    if (lb < 48) router_unit(p, smem, xcd * 8 + (lb & 7), lb >> 3);
    else for (int i = lb - 48; i < 32; i += 16) shared_gu_unit(p, smem, xcd * 8 + (i & 7), i >> 3);
  } else {
    gemm2_grid(10, [&](int mtile, int j) { if (j < 6) router_unit(p, smem, mtile, j); else shared_gu_unit(p, smem, mtile, j - 6); });
  }
}
__device__ __forceinline__ void ph_shared_d(const P& p, char* smem) {
  gemm2_grid(8, [&](int mtile, int ntile) {
    const bf16_t* A = p.Hs + (size_t)mtile * 256 * FF; const bf16_t* W = p.Wt_sd + (size_t)ntile * 128 * FF; bf16_t* Y = p.Ys;
    gemm2<1>(smem, FF, [=](int r) { return A + (size_t)r * FF; }, [=](int n) { return W + (size_t)n * FF; },
             [=](const f32x4 (&acc)[8][4], int r0, int c0) {
#pragma unroll
               for (int mt = 0; mt < 8; ++mt)
                 store_row64_bf16(acc[mt][0], acc[mt][1], acc[mt][2], acc[mt][3], (c0 & 63) >> 2, Y + (size_t)(mtile * 256 + r0 + mt * 16) * D + ntile * 128 + (c0 & ~63), true);
             });
  });
}
struct CvtQ { const float* src; unsigned char* dst; int ldn, ldk; };
__device__ __forceinline__ void cvtq_load(const CvtQ& d, f32x4 (&r)[16]) {
#pragma unroll
  for (int i = 0; i < 16; ++i) r[i] = __builtin_nontemporal_load((const f32x4*)(d.src + (size_t)i * d.ldn));
}
__device__ __forceinline__ void cvtq_store(const CvtQ& d, const f32x4 (&r)[16]) {
#pragma unroll
  for (int j = 0; j < 4; ++j) {
    u32x4 v = {pk4_fp8(r[0][j] * WQ_SCALE, r[1][j] * WQ_SCALE, r[2][j] * WQ_SCALE, r[3][j] * WQ_SCALE), pk4_fp8(r[4][j] * WQ_SCALE, r[5][j] * WQ_SCALE, r[6][j] * WQ_SCALE, r[7][j] * WQ_SCALE),
               pk4_fp8(r[8][j] * WQ_SCALE, r[9][j] * WQ_SCALE, r[10][j] * WQ_SCALE, r[11][j] * WQ_SCALE), pk4_fp8(r[12][j] * WQ_SCALE, r[13][j] * WQ_SCALE, r[14][j] * WQ_SCALE, r[15][j] * WQ_SCALE)};
    *(u32x4*)(d.dst + (size_t)j * d.ldk) = v;
  }
}
__device__ __forceinline__ CvtQ cvtq_desc(const float* src, int ldn, unsigned char* dst, int ldk, int k0, int n0) {
  const int kg = threadIdx.x & 7, n = n0 + (threadIdx.x >> 3) * 4;
  CvtQ d; d.src = src + (size_t)(k0 + kg * 16) * ldn + n; d.dst = dst + (size_t)n * ldk + k0 + kg * 16; d.ldn = ldn; d.ldk = ldk; return d;
}
__device__ __forceinline__ void cvtq_tile(const float* src, int ldn, unsigned char* dst, int ldk, int k0, int n0, int nmax = 1 << 30) {
  if (n0 + (int)(threadIdx.x >> 3) * 4 >= nmax) return;
  const CvtQ d = cvtq_desc(src, ldn, dst, ldk, k0, n0); f32x4 r[16]; cvtq_load(d, r); cvtq_store(d, r);
}
__device__ __forceinline__ CvtQ cvt_expert_desc(const P& p, int it) {
  const int e = it / 48, q = it - e * 48;
  if (q < 32) { const int up = q >> 4, qq = q & 15;
    return cvtq_desc((up ? p.w_up : p.w_gate) + (size_t)e * D * FF, FF, (up ? p.Wq_u : p.Wq_g) + (size_t)e * FF * D, D, (qq & 7) * 128, (qq >> 3) * 128);
  }
  const int qq = q - 32;
  return cvtq_desc(p.w_down + (size_t)e * FF * D, D, p.Wq_d + (size_t)e * D * FF, FF, (qq & 1) * 128, (qq >> 1) * 128);
}
__device__ __forceinline__ void cvt_expert_item(const P& p, int it) { const CvtQ d = cvt_expert_desc(p, it); f32x4 r[16]; cvtq_load(d, r); cvtq_store(d, r); }
__device__ __forceinline__ void ph_cvt_experts(const P& p) { WLOOP(w, NE * 48) cvt_expert_item(p, w); }

__device__ __forceinline__ bf16x8 pack8(const f32x16& x, int s) {
  u32x4 r = {pk_bf16(x[8 * s], x[8 * s + 1]), pk_bf16(x[8 * s + 2], x[8 * s + 3]), pk_bf16(x[8 * s + 4], x[8 * s + 5]), pk_bf16(x[8 * s + 6], x[8 * s + 7])};
  return __builtin_bit_cast(bf16x8, r);
}
__device__ __forceinline__ bf16x8 tr_pair(const LAS char* a) {
  const s16x4 lo = __builtin_amdgcn_ds_read_tr16_b64_v4i16((LAS s16x4*)a);
  const s16x4 hi = __builtin_amdgcn_ds_read_tr16_b64_v4i16((LAS s16x4*)(a + 8 * 128));
  return __builtin_shufflevector(lo, hi, 0, 1, 2, 3, 4, 5, 6, 7);
}
__device__ __forceinline__ int next_item(int* ctr, char* smem) {
  volatile int* slot = (volatile int*)(smem + SMEM_BYTES - 16);
  __syncthreads();
  if (threadIdx.x == 0) *slot = atomicAdd(ctr, 1);
  __syncthreads();
  return *slot;
}

__device__ __forceinline__ void compress_item(const P& p, char* smem, int item) {
  const int which = item >> 3, mtile = item & 7;
  const bf16_t* X = which ? p.VC : p.KC; const bf16_t* W1 = which ? p.Wt_c1v : p.Wt_c1k; const bf16_t* Z = p.zrow;
  const float* b1 = p.b1c + which * 128; bf16_t* hid = (bf16_t*)smem;
  gemm2<1>(smem, 2048,
           [=](int r) { const int R = mtile * 256 + r; if (R >= 2040) return Z; const int bg = R / 255, c = R - bg * 255; return X + ((size_t)bg * S + 16 * c) * 64; },
           [=](int n) { return W1 + (size_t)n * 2048; },
           [=](const f32x4 (&acc)[8][4], int r0, int c0) {
             __syncthreads();
#pragma unroll
             for (int nt = 0; nt < 4; ++nt) {
               const f32x4 bv = *(const f32x4*)(b1 + c0 + nt * 16);
#pragma unroll
               for (int mt = 0; mt < 8; ++mt) {
                 float h[4];
#pragma unroll
                 for (int i = 0; i < 4; ++i) { const float a = acc[mt][nt][i] + bv[i]; const float u = 0.7978845608028654f * (a + 0.044715f * a * a * a); h[i] = a - a / (1.f + __expf(2.f * u)); }
                 u32x2 w = {pk_bf16(h[0], h[1]), pk_bf16(h[2], h[3])};
                 *(u32x2*)(hid + (r0 + mt * 16) * 136 + c0 + nt * 16) = w;
               }
             }
           });
  __syncthreads();
  const float* W2 = which ? p.w2_v : p.w2_k;
  const int rl = threadIdx.x >> 3, pt = threadIdx.x & 7;
#pragma unroll 1
  for (int g = 0; g < 8; ++g) {
    const int row = g * 32 + rl, R = mtile * 256 + row;
    float o[8];
#pragma unroll
    for (int d = 0; d < 8; ++d) o[d] = 0.f;
#pragma unroll 2
    for (int n8 = 0; n8 < 16; ++n8) {
      const u32x4 hv4 = *(const u32x4*)(hid + row * 136 + n8 * 8);
#pragma unroll
      for (int k = 0; k < 8; ++k) {
        const float hv = (k & 1) ? __uint_as_float(hv4[k >> 1] & 0xffff0000u) : __uint_as_float(hv4[k >> 1] << 16);
        const f32x4 w0 = *(const f32x4*)(W2 + (n8 * 8 + k) * 64 + pt * 8), w1 = *(const f32x4*)(W2 + (n8 * 8 + k) * 64 + pt * 8 + 4);
        o[0] += hv * w0[0]; o[1] += hv * w0[1]; o[2] += hv * w0[2]; o[3] += hv * w0[3];
        o[4] += hv * w1[0]; o[5] += hv * w1[1]; o[6] += hv * w1[2]; o[7] += hv * w1[3];
      }
    }
    float rs = 1.f;
    if (!which) {
      float ss = 0.f;
#pragma unroll
      for (int d = 0; d < 8; ++d) ss += o[d] * o[d];
      ss += __shfl_xor(ss, 1); ss += __shfl_xor(ss, 2); ss += __shfl_xor(ss, 4);
      rs = rsqrtf(ss * (1.f / 64.f) + EPS);
    }
    if (R < 2040) {
      const int bg = R / 255, c = R - bg * 255;
      bf16_t* orow = (which ? p.vcb : p.kcb) + ((size_t)bg * 256 + c) * 64 + pt * 8;
      float gg[8];
      if (!which) { const f32x4 g0 = *(const f32x4*)(p.g_k_cmp + pt * 8), g1 = *(const f32x4*)(p.g_k_cmp + pt * 8 + 4); gg[0] = g0[0]; gg[1] = g0[1]; gg[2] = g0[2]; gg[3] = g0[3]; gg[4] = g1[0]; gg[5] = g1[1]; gg[6] = g1[2]; gg[7] = g1[3]; }
      else {
#pragma unroll
        for (int k = 0; k < 8; ++k) gg[k] = 1.f;
      }
      u32x4 w = {pk_bf16(o[0] * rs * gg[0], o[1] * rs * gg[1]), pk_bf16(o[2] * rs * gg[2], o[3] * rs * gg[3]), pk_bf16(o[4] * rs * gg[4], o[5] * rs * gg[5]), pk_bf16(o[6] * rs * gg[6], o[7] * rs * gg[7])};
      *(u32x4*)orow = w;
    }
  }
}

template <int MODE, int NSLOT>
__device__ __forceinline__ void nsa_pass(LAS char* kv, const bf16_t* Kg, const bf16_t* Vg, int t_lo, int t_hi, const bf16x8 (&qf)[4], float shf, int si,
                                         unsigned long long selm, f32x16& o0, f32x16& o1, float& l, LAS float* psl  ,
                                         int pos0 = 0, int pstride = 1, int kkmin = 0) {
  const int tid = otid(), lane = tid & 63, wv = __builtin_amdgcn_readfirstlane(tid >> 6), i = lane & 31, h5 = lane >> 5;
  const int ksw = (i >> 1) & 7;
  const int tq = (lane & 15) >> 2, tp = lane & 3, tds = (lane >> 4) & 1, vsw = ((tq >> 1) & 1) << 2;
  const int row_l = lane >> 3, cpos = lane & 7;
  const int kc8 = (cpos ^ ((wv & 1) * 4 + (row_l >> 1))) * 8, vc8 = (cpos ^ (((row_l >> 1) & 1) << 2)) * 8;
  const bf16_t* kgl = Kg + (size_t)(wv * 8 + row_l) * 64 + kc8;
  const bf16_t* vgl = Vg + (size_t)(wv * 8 + row_l) * 64 + vc8;
  auto stage = [&](int t, int buf) {
    LAS char* Ks = kv + buf * 16384 + wv * 1024; LAS char* Vs = Ks + 8192;
#pragma unroll
    for (int q = 0; q < 2; ++q) {
      if (MODE >= 3) {
        int pos = pos0 + pstride * (64 * t + 32 * q + wv * 8 + row_l);
        pos = pos < 0 ? 0 : (pos > S - 1 ? S - 1 : pos);
        __builtin_amdgcn_global_load_lds((const unsigned*)(Kg + (size_t)pos * 64 + kc8), (LAS unsigned*)(Ks + q * 4096), 16, 0, 0);
        __builtin_amdgcn_global_load_lds((const unsigned*)(Vg + (size_t)pos * 64 + vc8), (LAS unsigned*)(Vs + q * 4096), 16, 0, 0);
      } else {
        __builtin_amdgcn_global_load_lds((const unsigned*)(kgl + (size_t)(64 * t + 32 * q) * 64), (LAS unsigned*)(Ks + q * 4096), 16, 0, 0);
        __builtin_amdgcn_global_load_lds((const unsigned*)(vgl + (size_t)(64 * t + 32 * q) * 64), (LAS unsigned*)(Vs + q * 4096), 16, 0, 0);
      }
    }
  };
  float carry = 0.f;
  if (t_lo > t_hi) return;
  float dm16[4] = {0.f, 0.f, 0.f, 0.f}; int dmaxA = 0, dmaxB = 0; const int wq = wv & 3;
  if (MODE == 3) {
#pragma unroll
    for (int rg = 0; rg < 4; ++rg) dm16[rg] = (((wv - h5 - 2 * rg) & 3) == 0) ? 3.f : 2.f;
    dmaxA = si - kkmin < 128 ? si - kkmin : 128;
  }
  if (MODE == 4) { const int lim = si - kkmin; dmaxA = lim < 128 ? lim : 128; dmaxB = lim < 512 ? lim : 512; }
  asm volatile("s_waitcnt vmcnt(0) lgkmcnt(0)" ::: "memory");
  __builtin_amdgcn_s_barrier();
  asm volatile("" ::: "memory");
#pragma unroll
  for (int k = 0; k < NSLOT - 1; ++k) if (t_lo + k <= t_hi) stage(t_lo + k, k);
  for (int t = t_lo; t <= t_hi; ++t) {
    const int buf = (t - t_lo) % NSLOT;
    const int ahead = t_hi - t;
    if (NSLOT == 4 && ahead >= 2) asm volatile("s_waitcnt vmcnt(8)" ::: "memory");
    else if (NSLOT == 4 && ahead == 1) asm volatile("s_waitcnt vmcnt(4)" ::: "memory");
    else asm volatile("s_waitcnt vmcnt(0)" ::: "memory");
    __builtin_amdgcn_s_barrier();
    asm volatile("" ::: "memory");
    if (t + NSLOT - 1 <= t_hi) stage(t + NSLOT - 1, (t + NSLOT - 1 - t_lo) % NSLOT);
    const LAS char* Ks = kv + buf * 16384; const LAS char* Vs = Ks + 8192;
    const bool tsel = MODE == 1 ? ((selm >> t) & 1ull) != 0ull : true;
#pragma unroll
    for (int sub = 0; sub < 2; ++sub) {
      f32x16 sa;
#pragma unroll
      for (int q = 0; q < 16; ++q) sa[q] = 0.f;
      bf16x8 kf[4];
#pragma unroll
      for (int s4 = 0; s4 < 4; ++s4) kf[s4] = *(const LAS bf16x8*)(Ks + (32 * sub + i) * 128 + (((2 * s4 + h5) ^ ksw) << 4));
      __builtin_amdgcn_s_setprio(1);
#pragma unroll
      for (int s4 = 0; s4 < 4; ++s4) sa = MFMA32(kf[s4], qf[s4], sa);
      __builtin_amdgcn_s_setprio(0);
      const int k0 = 64 * t + 32 * sub + 4 * h5;
#pragma unroll
      for (int q = 0; q < 16; ++q) {
        const int kidx = k0 + (q & 3) + 8 * (q >> 2);
        float pv;
        if (MODE >= 3) {
          const int dl = si - kidx;
          const float e = __builtin_amdgcn_exp2f(sa[q] * LOG2E - shf);
          if (MODE == 3) {
            const float cw = (q & 3) ? 1.f : dm16[q >> 2];
            pv = (unsigned)dl <= (unsigned)dmaxA ? cw * e : 0.f;
          } else {
            const bool lo = dl >= 33;
            float cw = (lo && dl <= dmaxA) ? 1.f : 0.f;
            if ((q & 3) == wq) cw += (lo && dl <= dmaxB) ? 1.f : 0.f;
            pv = cw * e;
          }
        } else {
          bool valid;
          if (MODE == 0) valid = 16 * kidx + 31 <= si;
          else if (MODE == 1) valid = tsel && kidx <= si;
          else valid = (unsigned)(si - kidx) <= 511u;
          pv = valid ? __builtin_amdgcn_exp2f(sa[q] * LOG2E - shf) : 0.f;
        }
        l += pv; sa[q] = pv;
      }
      if (MODE == 0) {
#pragma unroll
        for (int rg = 0; rg < 4; ++rg) {
          const float a = 2.f * (sa[4 * rg] + sa[4 * rg + 1] + sa[4 * rg + 2]) + sa[4 * rg + 3];
          const float recv = __shfl_xor(sa[4 * rg + 3], 32);
          const float val = h5 ? a + recv : a + carry;
          carry = recv;
          psl[16 * t + 8 * sub + 2 * rg + h5] = val;
        }
      }
      const bf16x8 pf0 = pack8(sa, 0), pf1 = pack8(sa, 1);
      bf16x8 vf[2][2];
#pragma unroll
      for (int s2 = 0; s2 < 2; ++s2) {
        const LAS char* vb = Vs + (32 * sub + 16 * s2 + 4 * h5 + tq) * 128 + 8 * (tp & 1);
        vf[s2][0] = tr_pair(vb + (((tds * 2 + (tp >> 1)) ^ vsw) << 4));
        vf[s2][1] = tr_pair(vb + (((4 + tds * 2 + (tp >> 1)) ^ vsw) << 4));
      }
      __builtin_amdgcn_s_setprio(1);
#pragma unroll
      for (int s2 = 0; s2 < 2; ++s2) { o0 = MFMA32(vf[s2][0], s2 ? pf1 : pf0, o0); o1 = MFMA32(vf[s2][1], s2 ? pf1 : pf0, o1); }
      __builtin_amdgcn_s_setprio(0);
    }
    __builtin_amdgcn_sched_barrier(0);
  }
}

__device__ __forceinline__ void dilated_item(const P& p, char* smem_, int unit) {
  LAS char* kv = (LAS char*)smem_;
  const int tid = otid(), lane = tid & 63, wv = tid >> 6, i = lane & 31, h5 = lane >> 5;
  const int r4 = unit & 3, ti = (unit >> 2) & 7, hh = (unit >> 5) & 7, b = unit >> 8;
  const size_t hb = (size_t)(b * 8 + hh) * S * 64;
  const int si = ti * 512 + r4 + 4 * wv + 16 * i;
  bf16x8 qf[4];
#pragma unroll
  for (int s4 = 0; s4 < 4; ++s4) qf[s4] = *(const bf16x8*)(p.QA + hb + (size_t)si * 64 + 16 * s4 + 8 * h5);
  f32x16 o0, o1;
#pragma unroll
  for (int q = 0; q < 16; ++q) { o0[q] = 0.f; o1[q] = 0.f; }
  float l = 0.f;
  const float shf = p.smaxv[0] * LOG2E;
  const int pbase = ti * 512 + r4 - 128, ubase = ti * 128 - 512;
  nsa_pass<3, 4>(kv, p.KA + hb, p.VA + hb, 0, 9, qf, shf, 4 * wv + 16 * i + 128, 0ull, o0, o1, l, nullptr, pbase, 1, pbase < 0 ? -pbase : 0);
  nsa_pass<4, 4>(kv, p.KA + hb, p.VA + hb, 0, 9, qf, shf, wv + 4 * i + 512, 0ull, o0, o1, l, nullptr, r4 + 4 * ubase, 4, ubase < 0 ? -ubase : 0);
  l += __shfl_xor(l, 32);
  const float inv = 1.f / l;
  unsigned char* orow = p.mixq + (size_t)(b * S + si) * D + hh * 64 + 4 * h5;
  const float invq = inv * MQ_SCALE;
#pragma unroll
  for (int rg = 0; rg < 4; ++rg) {
    *(unsigned*)(orow + 8 * rg) = pk4_fp8(clamp_e4m3(o0[4 * rg] * invq), clamp_e4m3(o0[4 * rg + 1] * invq), clamp_e4m3(o0[4 * rg + 2] * invq), clamp_e4m3(o0[4 * rg + 3] * invq));
    *(unsigned*)(orow + 32 + 8 * rg) = pk4_fp8(clamp_e4m3(o1[4 * rg] * invq), clamp_e4m3(o1[4 * rg + 1] * invq), clamp_e4m3(o1[4 * rg + 2] * invq), clamp_e4m3(o1[4 * rg + 3] * invq));
  }
}

__device__ __forceinline__ void nsa_item(const P& p, char* smem_, int item) {
  LAS char* smem = (LAS char*)smem_;
  LAS char* kv = smem;
  LAS float* pslcw = (LAS float*)(smem + 32768);
  LAS float* invl = (LAS float*)(smem + 32768 + 33280);
  LAS unsigned* msk = (LAS unsigned*)(smem + 32768 + 33280 + 512);
  const int tid = otid(), lane = tid & 63, wv = tid >> 6, i = lane & 31, h5 = lane >> 5;
  const int qt = 127 - (item >> 3), bg = item & 7, b = bg >> 1, g = bg & 1, hq = g * 4 + wv;
  const int s0 = qt * 32, si = s0 + i, cur = s0 >> 6;
  const size_t qoff = ((size_t)(b * 8 + hq) * S + si) * 64 + 8 * h5;
  bf16x8 qf[4];
#pragma unroll
  for (int s4 = 0; s4 < 4; ++s4) qf[s4] = *(const bf16x8*)(p.QN + qoff + 16 * s4);
  const float* gs = p.GS + (size_t)(b * S + si) * 24 + hq * 3;
  const float g0 = gs[0], g1 = gs[1], g2 = gs[2];
  f32x16 oa0, oa1, o0, o1;
#pragma unroll
  for (int q = 0; q < 16; ++q) { o0[q] = 0.f; o1[q] = 0.f; }
  float l = 0.f;
  LAS float* psl = pslcw + (wv * 32 + i) * 65;
  const int ncv = (s0 + 31 - 31) >> 4;
  const int tc_hi = (ncv < 254 ? ncv : 254) >> 6;
#pragma unroll
  for (int k = 0; k < 32; ++k) psl[2 * k + h5] = 0.f;
  nsa_pass<0, 2>(kv, p.kcb + (size_t)bg * 256 * 64, p.vcb + (size_t)bg * 256 * 64, 0, tc_hi, qf, p.smaxv[1] * LOG2E, si, 0ull, o0, o1, l, psl);
  l += __shfl_xor(l, 32);
  {
    const float il = l > 0.f ? 1.f / l : 0.f;
    if (h5 == 0) invl[wv * 32 + i] = il;
    const float sc = g0 * il;
#pragma unroll
    for (int q = 0; q < 16; ++q) { oa0[q] = o0[q] * sc; oa1[q] = o1[q] * sc; o0[q] = 0.f; o1[q] = 0.f; }
  }
  __syncthreads();
  LAS float* scr = pslcw;
  {
    const int q = tid >> 3, jj = tid & 7;
    float tot[8];
#pragma unroll
    for (int k = 0; k < 8; ++k) {
      const int j = jj + 8 * k;
      float v = 0.f;
#pragma unroll
      for (int w4 = 0; w4 < 4; ++w4) v += pslcw[(w4 * 32 + q) * 65 + j] * invl[w4 * 32 + q];
      const bool forced = (j == 0) || (j == cur) || (j == cur - 1);
      tot[k] = forced ? INFINITY : (j <= cur ? v : -INFINITY);
    }
    __syncthreads();
#pragma unroll
    for (int k = 0; k < 8; ++k) scr[q * 65 + jj + 8 * k] = tot[k];
    if (tid < 64) msk[tid] = 0u;
    __syncthreads();
    unsigned lo = 0u, hi = 0u;
#pragma unroll
    for (int k = 0; k < 8; ++k) {
      const int j = jj + 8 * k; const float v = tot[k];
      int rank = 0;
      for (int c = 0; c < 64; ++c) { const float sv = scr[q * 65 + c]; rank += (sv > v) || (sv == v && c < j); }
      if (rank < 16 && j <= cur) { if (j < 32) lo |= 1u << j; else hi |= 1u << (j - 32); }
    }
    if (lo) atomicOr((unsigned*)&msk[q * 2], lo);
    if (hi) atomicOr((unsigned*)&msk[q * 2 + 1], hi);
    __syncthreads();
  }
  const unsigned long long selm = (unsigned long long)msk[i * 2] | ((unsigned long long)msk[i * 2 + 1] << 32);
#pragma unroll
  for (int s4 = 0; s4 < 4; ++s4) qf[s4] = *(const bf16x8*)(p.QR + qoff + 16 * s4);
  const size_t kvoff = (size_t)bg * S * 64;
  l = 0.f;
  nsa_pass<1, 4>(kv, p.KSL + kvoff, p.VSL + kvoff, 0, cur, qf, p.smaxv[2] * LOG2E, si, selm, o0, o1, l, nullptr);
  l += __shfl_xor(l, 32);
  {
    const float sc = g1 / l;
#pragma unroll
    for (int q = 0; q < 16; ++q) { oa0[q] += o0[q] * sc; oa1[q] += o1[q] * sc; o0[q] = 0.f; o1[q] = 0.f; }
  }
  l = 0.f;
  const int tw_lo = s0 >= 511 ? (s0 - 511) >> 6 : 0;
  nsa_pass<2, 4>(kv, p.KW + kvoff, p.VW + kvoff, tw_lo, cur, qf, p.smaxv[3] * LOG2E, si, 0ull, o0, o1, l, nullptr);
  l += __shfl_xor(l, 32);
  {
    const float sc = g2 / l;
#pragma unroll
    for (int q = 0; q < 16; ++q) { oa0[q] += o0[q] * sc; oa1[q] += o1[q] * sc; }
  }
  unsigned char* orow = p.mixq + (size_t)(b * S + si) * D + 512 + hq * 64 + 4 * h5;
#pragma unroll
  for (int rg = 0; rg < 4; ++rg) {
    *(unsigned*)(orow + 8 * rg) = pk4_fp8(clamp_e4m3(oa0[4 * rg] * MQ_SCALE), clamp_e4m3(oa0[4 * rg + 1] * MQ_SCALE), clamp_e4m3(oa0[4 * rg + 2] * MQ_SCALE), clamp_e4m3(oa0[4 * rg + 3] * MQ_SCALE));
    *(unsigned*)(orow + 32 + 8 * rg) = pk4_fp8(clamp_e4m3(oa1[4 * rg] * MQ_SCALE), clamp_e4m3(oa1[4 * rg + 1] * MQ_SCALE), clamp_e4m3(oa1[4 * rg + 2] * MQ_SCALE), clamp_e4m3(oa1[4 * rg + 3] * MQ_SCALE));
  }
}
__device__ __forceinline__ void cvt_queue_item(const P& p, int ci) {
  f32x4 ra[16], rb[16];
  const CvtQ d0 = cvt_expert_desc(p, ci * 4), d1 = cvt_expert_desc(p, ci * 4 + 1), d2 = cvt_expert_desc(p, ci * 4 + 2), d3 = cvt_expert_desc(p, ci * 4 + 3);
  cvtq_load(d0, ra); cvtq_load(d1, rb);
  cvtq_store(d0, ra); cvtq_load(d2, ra);
  cvtq_store(d1, rb); cvtq_load(d3, rb);
  cvtq_store(d2, ra); cvtq_store(d3, rb);
}
__device__ __forceinline__ void ph_attn_a(const P& p, char* smem) {
  for (;;) {
    const int q = next_item(p.ctr + 0, smem);
    if (q >= 16 + 2560) break;
    if (q < 16) { compress_item(p, smem, q); continue; }
    const int j = q - 16, g = j / 5, r = j - g * 5;
    if (r == 0 || r == 3) dilated_item(p, smem, g * 2 + (r == 3)); else cvt_queue_item(p, g * 3 + (r == 1 ? 0 : (r == 2 ? 1 : 2)));
  }
}
__device__ __forceinline__ void ph_attn_b(const P& p, char* smem) {
  for (;;) {
    const int q = next_item(p.ctr + 1, smem);
    if (q >= 2560) break;
    const int g = q / 5, r = q - g * 5;
    if (r == 0 || r == 3) nsa_item(p, smem, g * 2 + (r == 3)); else cvt_queue_item(p, 1536 + g * 3 + (r == 1 ? 0 : (r == 2 ? 1 : 2)));
  }
}

__device__ __forceinline__ void ph_route(const P& p, char* smem) {
  const int lane = threadIdx.x & 63, wv = threadIdx.x >> 6;
  int* hist = (int*)smem;
  __syncthreads();
  hist[threadIdx.x] = 0;
  __syncthreads();
  const int tpb = T / gridDim.x, t0 = blockIdx.x * tpb;
  float bias[4];
#pragma unroll
  for (int i = 0; i < 4; ++i) bias[i] = p.r_bias[lane + 64 * i];
  for (int tt = wv; tt < tpb; tt += 4) {
    const int t = t0 + tt;
    float aff[4], bv[4], ta[4], tb[4];
#pragma unroll
    for (int i = 0; i < 4; ++i) { { const size_t li = (size_t)t * NE + lane + 64 * i; aff[i] = sigmoidf((p.logits[li] + p.logits[li + (size_t)T * NE]) + p.logits[li + (size_t)2 * T * NE]); } bv[i] = aff[i] + bias[i]; ta[i] = bv[i]; tb[i] = -INFINITY; }
#pragma unroll
    for (int o = 16; o; o >>= 1)
#pragma unroll
      for (int i = 0; i < 4; ++i) {
        const float a2 = __shfl_xor(ta[i], o), b2 = __shfl_xor(tb[i], o);
        const float na = fmaxf(ta[i], a2), nb = fmaxf(fminf(ta[i], a2), fmaxf(tb[i], b2));
        ta[i] = na; tb[i] = nb;
      }
    float gs[8];
#pragma unroll
    for (int i = 0; i < 4; ++i) { const float s2 = ta[i] + tb[i]; gs[2 * i] = __shfl(s2, 0); gs[2 * i + 1] = __shfl(s2, 32); }
    unsigned gmask = 0;
#pragma unroll
    for (int g = 0; g < 8; ++g) {
      int rank = 0;
#pragma unroll
      for (int i = 0; i < 8; ++i) rank += (gs[i] > gs[g]) || (gs[i] == gs[g] && i < g);
      if (rank < 4) gmask |= 1u << g;
    }
#pragma unroll
    for (int i = 0; i < 4; ++i) if (!((gmask >> (2 * i + (lane >> 5))) & 1u)) bv[i] = -INFINITY;
    unsigned key[4];
#pragma unroll
    for (int i = 0; i < 4; ++i) { const unsigned u = __float_as_uint(bv[i]); key[i] = (u & 0x80000000u) ? ~u : (u | 0x80000000u); }
    unsigned thr = 0u;
#pragma unroll 1
    for (int bit = 31; bit >= 0; --bit) {
      const unsigned trial = thr | (1u << bit);
      int c = 0;
#pragma unroll
      for (int i = 0; i < 4; ++i) c += __builtin_popcountll(__ballot(key[i] >= trial));
      if (c >= 8) thr = trial;
    }
    int ngt = 0;
#pragma unroll
    for (int i = 0; i < 4; ++i) ngt += __builtin_popcountll(__ballot(key[i] > thr));
    const int need = 8 - ngt;
    const unsigned long long ltmask = (1ull << lane) - 1ull;
    int eqbefore = 0, selbefore = 0;
    bool sel[4]; int slot[4];
#pragma unroll
    for (int i = 0; i < 4; ++i) {
      const unsigned long long eqm = __ballot(key[i] == thr);
      const bool s = key[i] > thr || (key[i] == thr && eqbefore + __builtin_popcountll(eqm & ltmask) < need);
      eqbefore += __builtin_popcountll(eqm);
      const unsigned long long sm = __ballot(s);
      sel[i] = s; slot[i] = selbefore + __builtin_popcountll(sm & ltmask);
      selbefore += __builtin_popcountll(sm);
    }
    float part = 0.f;
#pragma unroll
    for (int i = 0; i < 4; ++i) part += sel[i] ? aff[i] : 0.f;
    const float ssum = wave_sum(part);
#pragma unroll
    for (int i = 0; i < 4; ++i)
      if (sel[i]) {
        const int e = lane + 64 * i;
        p.eidx[t * 8 + slot[i]] = e;
        p.gates[t * 8 + slot[i]] = aff[i] / ssum * 2.5f;
        p.pos[t * 8 + slot[i]] = atomicAdd(&hist[e], 1);
      }
  }
  __syncthreads();
  p.bhist[(size_t)blockIdx.x * NE + threadIdx.x] = hist[threadIdx.x];
}
__device__ __forceinline__ void ph_fill(const P& p, char* smem) {
  int* soff = (int*)smem;
  int* wsum = soff + 260;
  int* sbase = soff + 272;
  const int tid = threadIdx.x, lane = tid & 63, wv = tid >> 6;
  __syncthreads();
  int c = 0, before = 0;
  for (int bb = 0; bb < (int)gridDim.x; ++bb) { const int v = p.bhist[(size_t)bb * NE + tid]; c += v; before += (bb < (int)blockIdx.x) ? v : 0; }
  int incl = c;
#pragma unroll
  for (int o = 1; o < 64; o <<= 1) { const int v = __shfl_up(incl, o); if (lane >= o) incl += v; }
  if (lane == 63) wsum[wv] = incl;
  __syncthreads();
  int base = 0;
  for (int i = 0; i < wv; ++i) base += wsum[i];
  soff[tid] = base + incl - c;
  sbase[tid] = base + incl - c + before;
  if (tid == 255) soff[256] = base + incl;
  __syncthreads();
  if (blockIdx.x == 0) {
    p.off[tid] = soff[tid]; p.cnt[tid] = c;
    if (tid == 255) p.off[256] = soff[256];
  }
  if (blockIdx.x == 1) {
    const int x = tid >> 5, i = tid & 31, e = x + 8 * i;
    const int tl = (soff[e + 1] - soff[e] + 255) >> 8;
    int inc2 = tl;
#pragma unroll
    for (int o = 1; o < 32; o <<= 1) { const int v = __shfl_up(inc2, o, 32); if (i >= o) inc2 += v; }
    p.tstart[x * 33 + i] = inc2 - tl;
    if (i == 31) p.tstart[x * 33 + 32] = inc2;
  }
  const int tpb = T / gridDim.x, a0 = blockIdx.x * tpb * 8;
  for (int a = a0 + tid; a < a0 + tpb * 8; a += 256) p.sorted[sbase[p.eidx[a]] + p.pos[a]] = a;
}

template <int NTL, class F>
__device__ __forceinline__ void moe_grid(const P& p, F body) {
  const int xcd = blockIdx.x & 7, lb = blockIdx.x >> 3, nlb = gridDim.x >> 3;
  const int* ts = p.tstart + xcd * 33;
  const int total = ts[32] * NTL;
  int i = 0;
  for (int j = lb; j < total; j += nlb) {
    while (ts[i + 1] * NTL <= j) ++i;
    const int tiles = ts[i + 1] - ts[i], rem = j - ts[i] * NTL;
    body(xcd + 8 * i, rem / tiles, rem % tiles);
  }
}
__device__ __forceinline__ const unsigned char* gu_rowq(const unsigned char* Wg, const unsigned char* Wu, int f0, int n) {
  const int wn = n >> 6, wi = n & 63;
  return (wi >= 32 ? Wu : Wg) + (size_t)(f0 + wn * 32 + (wi & 31)) * D;
}
__device__ __forceinline__ void ph_moe_gu(const P& p, char* smem) {
  moe_grid<4>(p, [&](int e, int ntile, int mtile) {
    const int cnt = p.cnt[e] - mtile * 256; const int* srt = p.sorted + p.off[e] + mtile * 256;
    const unsigned char* A = p.h2q; const unsigned char* Wg = p.Wq_g + (size_t)e * FF * D; const unsigned char* Wu = p.Wq_u + (size_t)e * FF * D; unsigned char* H = p.Hq;
    const float* gates = p.gates; const unsigned char* Z = (const unsigned char*)p.zrow;
    gemm2x(smem, D, [=](int r) { return r < cnt ? A + (size_t)(srt[r] >> 3) * D : Z; }, [=](int n) { return gu_rowq(Wg, Wu, ntile * 64, n); },
           [=](const f32x16 (&acc)[4][2], int r0, int c0, int) {
             const int wn = c0 >> 6, hh = (c0 >> 2) & 1;
#pragma unroll
             for (int mt = 0; mt < 4; ++mt) {
               const int r = r0 + mt * 32; const bool ok = r < cnt; const int a = ok ? srt[r] : 0;
               const float sc = ok ? gates[a] * (HQ_SCALE / WQ_SCALE) : 0.f;
               unsigned d[4];
#pragma unroll
               for (int g = 0; g < 4; ++g) {
                 float h[4];
#pragma unroll
                 for (int i = 0; i < 4; ++i) h[i] = clamp_e4m3(silu(acc[mt][0][4 * g + i] * (1.f / WQ_SCALE)) * acc[mt][1][4 * g + i] * sc);
                 d[g] = pk4_fp8(h[0], h[1], h[2], h[3]);
               }
               const u32x2v p01 = __builtin_amdgcn_permlane32_swap(d[0], d[1], false, false), p23 = __builtin_amdgcn_permlane32_swap(d[2], d[3], false, false);
               if (ok) {
                 unsigned char* dst = H + (size_t)a * FF + ntile * 64 + wn * 32 + 8 * hh;
                 *(u32x2*)dst = (u32x2){p01.x, p01.y};
                 *(u32x2*)(dst + 16) = (u32x2){p23.x, p23.y};
               }
             }
           }, 0, cnt <= 128);
  });
}
__device__ __forceinline__ void ph_moe_d(const P& p, char* smem) {
  moe_grid<4>(p, [&](int e, int ntp, int mtile) {
    const int cnt = p.cnt[e] - mtile * 256; const int* srt = p.sorted + p.off[e] + mtile * 256;
    const unsigned char* A = p.Hq; const unsigned char* W = p.Wq_d + (size_t)e * D * FF + (size_t)ntp * 256 * FF; unsigned char* Yq = p.Yq; const unsigned char* Z = (const unsigned char*)p.zrow;
    const int tid_ = otid(), lrow = ((tid_ >> 7) & 1) * 128 + (tid_ & 31);
    LAS int* ridt = (LAS int*)((LAS char*)smem + 3 * G2_STAGE);
    __syncthreads();
    ridt[tid_] = tid_ < cnt ? srt[tid_] : -1;
    gemm2x<2>(smem, FF, [=](int r) { return r < cnt ? A + (size_t)srt[r] * FF : Z; }, [=](int n) { return W + (size_t)n * FF; },
           [=](const f32x16 (&acc)[4][2], int r0, int c0, int rp) {
             const int wn64 = c0 & ~63, hh = (c0 >> 2) & 1;
             const float s = YQ_SCALE / (WQ_SCALE * HQ_SCALE);
#pragma unroll
             for (int mt = 0; mt < 4; ++mt) {
               const int rd = ridt[lrow + mt * 32]; const bool ok = rd >= 0;
               unsigned char* dst = Yq + (size_t)rd * D + (ntp * 2 + rp) * 128 + wn64 + 8 * hh;
#pragma unroll
               for (int nt = 0; nt < 2; ++nt) {
                 unsigned d[4];
#pragma unroll
                 for (int g = 0; g < 4; ++g) d[g] = pk4_fp8(clamp_e4m3(acc[mt][nt][4 * g] * s), clamp_e4m3(acc[mt][nt][4 * g + 1] * s), clamp_e4m3(acc[mt][nt][4 * g + 2] * s), clamp_e4m3(acc[mt][nt][4 * g + 3] * s));
                 const u32x2v p01 = __builtin_amdgcn_permlane32_swap(d[0], d[1], false, false), p23 = __builtin_amdgcn_permlane32_swap(d[2], d[3], false, false);
                 if (ok) { *(u32x2*)(dst + nt * 32) = (u32x2){p01.x, p01.y}; *(u32x2*)(dst + nt * 32 + 16) = (u32x2){p23.x, p23.y}; }
               }
               asm volatile("" ::: "memory");
             }
           }, (size_t)128 * FF, cnt <= 128);
  });
}
__device__ __forceinline__ void ph_combine(const P& p) {
  WLOOP(w, T / 4) {
    const int tid_ = otid(), t = w * 4 + (tid_ >> 6), c = (tid_ & 63) * 16, b = t / S;
    float acc[16];
#pragma unroll
    for (int i = 0; i < 16; ++i) acc[i] = 0.f;
#pragma unroll
    for (int k = 0; k < 8; ++k) {
      const u32x4 v = *(const u32x4*)(p.Yq + ((size_t)t * 8 + k) * D + c);
#pragma unroll
      for (int i = 0; i < 4; ++i) {
        const f32x2 lo = __builtin_amdgcn_cvt_pk_f32_fp8((int)v[i], false), hi = __builtin_amdgcn_cvt_pk_f32_fp8((int)v[i], true);
        acc[4 * i] += lo[0]; acc[4 * i + 1] += lo[1]; acc[4 * i + 2] += hi[0]; acc[4 * i + 3] += hi[1];
      }
    }
    const bf16_t* ys = p.Ys + (size_t)t * D + c; const float* gt = p.mod + b * 6 * D + 5 * D + c; const bf16_t* x1 = (const bf16_t*)p.x1 + (size_t)t * D + c; float* o = p.out + (size_t)t * D + c;
#pragma unroll
    for (int h = 0; h < 4; ++h) {
      const u32x2 sv = *(const u32x2*)(ys + 4 * h);
      const float s0 = __uint_as_float(sv.x << 16), s1 = __uint_as_float(sv.x & 0xffff0000u), s2 = __uint_as_float(sv.y << 16), s3 = __uint_as_float(sv.y & 0xffff0000u);
      const u32x2 xq = *(const u32x2*)(x1 + 4 * h);
      const f32x4 xv = {__uint_as_float(xq.x << 16), __uint_as_float(xq.x & 0xffff0000u), __uint_as_float(xq.y << 16), __uint_as_float(xq.y & 0xffff0000u)}, gv = *(const f32x4*)(gt + 4 * h);
      f32x4 r = {xv[0] + gv[0] * (s0 + acc[4 * h] * (1.f / YQ_SCALE)), xv[1] + gv[1] * (s1 + acc[4 * h + 1] * (1.f / YQ_SCALE)),
                 xv[2] + gv[2] * (s2 + acc[4 * h + 2] * (1.f / YQ_SCALE)), xv[3] + gv[3] * (s3 + acc[4 * h + 3] * (1.f / YQ_SCALE))};
      *(f32x4*)(o + 4 * h) = r;
    }
  }
}


#define XB_TMO      128
#define XB_XCNT(j)  (256  + 64 * (j))
#define XB_XSUB(j)  (1280 + 64 * (j))
#define XB_XGEN(j)  (2304 + 64 * (j))
#define XB_TOP      3328
#define XB_TOPGEN   3392
#define XCD_BAR_WORDS 3456
#define XB_SPIN_CAP (1u << 22)
__device__ __forceinline__ unsigned xb_ld(unsigned* p)              { return __hip_atomic_load(p, __ATOMIC_RELAXED, __HIP_MEMORY_SCOPE_AGENT); }
__device__ __forceinline__ unsigned xb_add(unsigned* p, unsigned v) { return __hip_atomic_fetch_add(p, v, __ATOMIC_RELAXED, __HIP_MEMORY_SCOPE_AGENT); }
__device__ __forceinline__ unsigned xb_xcc_id() { return (unsigned)__builtin_amdgcn_s_getreg((3 << 11) | 20) & 0xFu; }
#define XB_SPIN(cond, bar) do { unsigned _sp = 0; while (cond) { __builtin_amdgcn_s_sleep(1); \
    if ((++_sp & 255u) == 0u) { if (xb_ld(&(bar)[XB_TMO])) break; if (_sp > XB_SPIN_CAP) { atomicAdd(&(bar)[XB_TMO], 1u); break; } } } } while (0)
struct XcdBarrier { unsigned* bar; unsigned x; volatile LAS unsigned* st; };
__device__ __forceinline__ XcdBarrier xcd_barrier_post(unsigned* bar, volatile LAS unsigned* st) {
  XcdBarrier b; b.bar = bar; b.x = xb_xcc_id(); b.st = st;
  if (threadIdx.x == 0) (void)xb_add(&bar[XB_XCNT(b.x)], 1u);
  return b;
}
__device__ __forceinline__ void xcd_barrier_complete(unsigned* bar, unsigned x, unsigned& nloc, unsigned& nx) {
  const unsigned G = gridDim.x * gridDim.y * gridDim.z;
  unsigned sum, cnt, mine, sp = 0u;
  for (;;) {
    sum = 0u; cnt = 0u; mine = 0u;
#pragma unroll
    for (unsigned j = 0; j < 16; ++j) { const unsigned c = xb_ld(&bar[XB_XCNT(j)]); sum += c; cnt += (c > 0u) ? 1u : 0u; mine = (j == x) ? c : mine; }
    if (sum == G) break;
    __builtin_amdgcn_s_sleep(1);
    if ((++sp & 255u) == 0u) { if (xb_ld(&bar[XB_TMO])) break; if (sp > XB_SPIN_CAP) { atomicAdd(&bar[XB_TMO], 1u); break; } }
  }
  nloc = mine > 0u ? mine : 1u; nx = cnt > 0u ? cnt : 1u;
}
__device__ __forceinline__ void xcd_barrier(const XcdBarrier& b) {
  asm volatile("s_waitcnt vmcnt(0)" ::: "memory");
  __syncthreads();
  if (threadIdx.x == 0) {
    unsigned* bar = b.bar;
    __builtin_amdgcn_s_waitcnt(0);
    unsigned nloc = b.st[0], nx = b.st[1];
    if (nloc == 0u) { xcd_barrier_complete(bar, b.x, nloc, nx); b.st[0] = nloc; b.st[1] = nx; }
    const unsigned old = xb_add(&bar[XB_XSUB(b.x)], 1u);
    const unsigned gen = old / nloc;
    if (old + 1u == (gen + 1u) * nloc) {
      __builtin_amdgcn_fence(__ATOMIC_RELEASE, "agent");
      asm volatile("s_waitcnt vmcnt(0)" ::: "memory");
      const unsigned og = xb_add(&bar[XB_TOP], 1u);
      const unsigned tg = og / nx;
      if (og + 1u == (tg + 1u) * nx) xb_add(&bar[XB_TOPGEN], 1u);
      else XB_SPIN(xb_ld(&bar[XB_TOPGEN]) == tg, bar);
      __builtin_amdgcn_fence(__ATOMIC_ACQUIRE, "agent");
      xb_add(&bar[XB_XGEN(b.x)], 1u);
      asm volatile("s_waitcnt vmcnt(0)" ::: "memory");
    } else {
      XB_SPIN(xb_ld(&bar[XB_XGEN(b.x)]) == gen, bar);
      __builtin_amdgcn_fence(__ATOMIC_ACQUIRE, "agent");
      asm volatile("s_waitcnt vmcnt(0)" ::: "memory");
    }
  }
  __syncthreads();
}

__global__ void __launch_bounds__(256, 2) mega(P p) {
  extern __shared__ __attribute__((aligned(16))) char smem[];
  {
    volatile LAS unsigned* st0 = (volatile LAS unsigned*)((LAS char*)smem + SMEM_BYTES - 32);
    if (threadIdx.x == 0) { st0[0] = 0u; st0[1] = 0u; }
    __syncthreads();
  }
  const XcdBarrier xb = xcd_barrier_post(p.bar, (volatile LAS unsigned*)((LAS char*)smem + SMEM_BYTES - 32));
  ph_ada(p, smem); ph_rope_tab(p);
  { int ib = 0;
    for (int it = (int)blockIdx.x; it < 8 * 23; it += gridDim.x) cvtq_tile(p.w_in, INC, p.Wq_in, D, (it & 7) * 128, (it >> 3) * 128, INC);
    ib = (8 * 23) % gridDim.x; for (int it = (int)blockIdx.x - ib; it < 64; it += gridDim.x) if (it >= 0) cvtq_tile(p.w_out, D, p.Wq_out, D, (it & 7) * 128, (it >> 3) * 128);
    ib = (ib + 64) % gridDim.x;
    cvt_matrix<false>(p.w_router, p.Wt_rth, D, NE, ib); cvt_matrix<true>(p.w_router, p.Wt_rtl, D, NE, ib);
    cvt_matrix<false>(p.w1_k, p.Wt_c1k, 2048, 128, ib); cvt_matrix<false>(p.w1_v, p.Wt_c1v, 2048, 128, ib);
    for (int it = (int)blockIdx.x - ib; it < 32; it += gridDim.x) if (it >= 0) cvtq_tile(it < 16 ? p.ws_gate : p.ws_up, FF, it < 16 ? p.Wq_sg : p.Wq_su, D, (it & 7) * 128, ((it >> 3) & 1) * 128);
    ib = (ib + 32) % gridDim.x; cvt_matrix<false>(p.ws_down, p.Wt_sd, FF, D, ib); }
  if (blockIdx.x == gridDim.x - 4) { for (int i = threadIdx.x; i < 2048; i += 256) p.zrow[i] = 0; }
  if (blockIdx.x == gridDim.x - 1) {
    const int which = threadIdx.x >> 7, n = threadIdx.x & 127;
    const float* pe = which ? p.pe_v : p.pe_k; const float* w1 = which ? p.w1_v : p.w1_k;
    float a = 0.f;
    for (int k = 0; k < 2048; ++k) a += pe[k] * w1[(size_t)k * 128 + n];
    p.b1c[threadIdx.x] = a;
  }
  if (blockIdx.x == gridDim.x - 2) {
    for (int i = threadIdx.x; i < 8 * 64; i += 256) { p.kcb[((size_t)(i >> 6) * 256 + 255) * 64 + (i & 63)] = 0; p.vcb[((size_t)(i >> 6) * 256 + 255) * 64 + (i & 63)] = 0; }
  }
  if (blockIdx.x == gridDim.x - 3) {
    p.cnt[threadIdx.x] = 0;
    if (threadIdx.x < 8) p.ctr[threadIdx.x] = 0;
    if (threadIdx.x < 64) {
      const int ln = threadIdx.x;
      const float a = wave_max(fabsf(p.g_q_dil[ln])), bq = wave_max(fabsf(p.g_k_dil[ln])), c = wave_max(fabsf(p.g_q_nsa[ln]));
      const float d1 = wave_max(fabsf(p.g_k_cmp[ln])), d2 = wave_max(fabsf(p.g_k_slc[ln])), d3 = wave_max(fabsf(p.g_k_win[ln]));
      if (ln == 0) { p.smaxv[0] = 8.f * a * bq; p.smaxv[1] = 8.f * c * d1; p.smaxv[2] = 8.f * c * d2; p.smaxv[3] = 8.f * c * d3; }
    }
  }
  xcd_barrier(xb);
  ph_norm_mod<false>(p.x, p.g_mix, p.mod, 0, D, nullptr, p.h1q);
  xcd_barrier(xb);
  ph_proj(p, smem);
  xcd_barrier(xb);
  ph_attn_a(p, smem);
  xcd_barrier(xb);
  ph_attn_b(p, smem);
  xcd_barrier(xb);
  ph_outproj(p, smem);
  xcd_barrier(xb);
  if (DUP == 10) { ph_outproj_abl<0>(p, smem); xcd_barrier(xb); }
  if (DUP == 11) { ph_outproj_abl<1>(p, smem); xcd_barrier(xb); }
  if (DUP == 12) { ph_outproj_abl<2>(p, smem); xcd_barrier(xb); }
  if (DUP == 13) { ph_outproj_abl<3>(p, smem); xcd_barrier(xb); }
  ph_norm_mod<true, true>(p.x1, p.g_ffn, p.mod, 3 * D, 4 * D, p.h2s, p.h2q);
  xcd_barrier(xb);
  ph_router_shared_gu(p, smem);
  xcd_barrier(xb);
  ph_route(p, smem); ph_shared_d(p, smem);
  xcd_barrier(xb);
  ph_fill(p, smem);
  xcd_barrier(xb);
  ph_moe_gu(p, smem);
  xcd_barrier(xb);
  ph_moe_d(p, smem);
  xcd_barrier(xb);
  ph_combine(p);
}
}

extern "C" void kernel_launch(void* const* d_in, const int* in_sizes, int n_in, void* d_out, int out_size, void* d_ws, size_t ws_size,
                              hipStream_t stream) {
  P p{};
  const float** f = (const float**)d_in;
  p.x = f[0]; p.c = f[1]; p.w_ada = f[2]; p.b_ada = f[3]; p.g_mix = f[4]; p.g_ffn = f[5]; p.w_in = f[6]; p.g_q_dil = f[7]; p.g_k_dil = f[8];
  p.g_q_nsa = f[9]; p.g_k_cmp = f[10]; p.g_k_slc = f[11]; p.g_k_win = f[12]; p.pe_k = f[13]; p.w1_k = f[14]; p.w2_k = f[15]; p.pe_v = f[16];
  p.w1_v = f[17]; p.w2_v = f[18]; p.w_out = f[19]; p.w_router = f[20]; p.r_bias = f[21]; p.w_gate = f[22]; p.w_up = f[23]; p.w_down = f[24];
  p.ws_gate = f[25]; p.ws_up = f[26]; p.ws_down = f[27];
  p.out = (float*)d_out;
  char* w = (char*)d_ws; size_t o = 0;
  auto alloc = [&](size_t bytes) { void* r = w + o; o += (bytes + 255) & ~(size_t)255; return r; };
  p.mod = (float*)alloc(4 * 6 * D * 4);
  p.rope = (float*)alloc(S * 16 * 4);
  p.selmask = (unsigned long long*)alloc((size_t)T * 2 * 8);
  p.eidx = (int*)alloc(T * 8 * 4); p.gates = (float*)alloc(T * 8 * 4);
  p.cnt = (int*)alloc(NE * 4); p.off = (int*)alloc((NE + 1) * 4); p.pos = (int*)alloc(T * 8 * 4); p.sorted = (int*)alloc(T * 8 * 4);
  p.tstart = (int*)alloc(8 * 33 * 4);
  p.smaxv = (float*)alloc(64);
  p.b1c = (float*)alloc(256 * 4);
  p.ctr = (int*)alloc(64);
  p.kcb = (bf16_t*)alloc(8 * 256 * 64 * 2); p.vcb = (bf16_t*)alloc(8 * 256 * 64 * 2);
  p.GS = (float*)alloc((size_t)T * 24 * 4);
  p.QA = (bf16_t*)alloc((size_t)T * 512 * 2); p.KA = (bf16_t*)alloc((size_t)T * 512 * 2); p.VA = (bf16_t*)alloc((size_t)T * 512 * 2);
  p.QN = (bf16_t*)alloc((size_t)T * 512 * 2); p.QR = (bf16_t*)alloc((size_t)T * 512 * 2);
  p.KC = (bf16_t*)alloc((size_t)T * 128 * 2); p.VC = (bf16_t*)alloc((size_t)T * 128 * 2);
  p.KSL = (bf16_t*)alloc((size_t)T * 128 * 2); p.VSL = (bf16_t*)alloc((size_t)T * 128 * 2);
  p.KW = (bf16_t*)alloc((size_t)T * 128 * 2); p.VW = (bf16_t*)alloc((size_t)T * 128 * 2);
  p.logits = (float*)alloc((size_t)3 * T * NE * 4);
  p.x1 = (float*)alloc((size_t)T * D * 4);
  p.mixinb = (bf16_t*)alloc((size_t)T * D * 2);
  p.h1b = (bf16_t*)alloc((size_t)T * D * 2);
  p.h2s = (bf16_t*)alloc((size_t)T * 2 * D * 2);
  p.Hs = (bf16_t*)alloc((size_t)T * FF * 2);
  p.Ys = (bf16_t*)alloc((size_t)T * D * 2);
  p.bar = (unsigned*)alloc(XCD_BAR_WORDS * 4);
  p.bhist = (int*)alloc((size_t)2048 * NE * 4);
  p.Wt_c1k = (bf16_t*)alloc((size_t)128 * 2048 * 2); p.Wt_c1v = (bf16_t*)alloc((size_t)128 * 2048 * 2);
  p.zrow = (bf16_t*)alloc(2048 * 2);
  p.Wt_in = (bf16_t*)alloc((size_t)2944 * D * 2);
  p.Wt_out = (bf16_t*)alloc((size_t)D * D * 2);
  p.Wt_rth = (bf16_t*)alloc((size_t)NE * D * 2); p.Wt_rtl = (bf16_t*)alloc((size_t)NE * D * 2);
  p.Wt_sg = (bf16_t*)alloc((size_t)FF * D * 2); p.Wt_su = (bf16_t*)alloc((size_t)FF * D * 2); p.Wt_sd = (bf16_t*)alloc((size_t)D * FF * 2);
  p.Wq_g = (unsigned char*)alloc((size_t)NE * FF * D); p.Wq_u = (unsigned char*)alloc((size_t)NE * FF * D); p.Wq_d = (unsigned char*)alloc((size_t)NE * D * FF);
  p.h2q = (unsigned char*)alloc((size_t)T * D); p.h1q = (unsigned char*)alloc((size_t)T * D); p.Wq_in = (unsigned char*)alloc((size_t)2944 * D); p.Hq = (unsigned char*)alloc((size_t)T * 8 * FF);
  p.Yq = (unsigned char*)alloc((size_t)T * 8 * D);
  p.Wq_sg = (unsigned char*)alloc((size_t)FF * D); p.Wq_su = (unsigned char*)alloc((size_t)FF * D);
  p.mixq = (unsigned char*)alloc((size_t)T * D); p.Wq_out = (unsigned char*)alloc((size_t)D * D);
  (void)hipMemsetAsync(p.bar, 0, XCD_BAR_WORDS * 4, stream);
  static int grid_blocks = 0;
  if (!grid_blocks) {
    int dev = 0, cus = 0, per_cu = 0;
    (void)hipGetDevice(&dev);
    (void)hipDeviceGetAttribute(&cus, hipDeviceAttributeMultiprocessorCount, dev);
    (void)hipOccupancyMaxActiveBlocksPerMultiprocessor(&per_cu, mega, 256, SMEM_BYTES);
    if (per_cu > 2) per_cu = 2;
    if (per_cu < 1) per_cu = 1;
    grid_blocks = cus * per_cu;
  }
  void* args[] = {&p};
  hipError_t e = hipLaunchCooperativeKernel((void*)mega, dim3(grid_blocks), dim3(256), args, SMEM_BYTES, stream);
  if (e != hipSuccess) fprintf(stderr, "cooperative launch failed: %s (grid %d)\n", hipGetErrorString(e), grid_blocks);
}
```

```cpp
#include <hip/hip_runtime.h>
#include <hip/hip_cooperative_groups.h>
#include <stdint.h>
#include <cstdio>
namespace cg = cooperative_groups;

namespace {
constexpr int D = 1024, NB = 4, S = 4096, T = NB * S, HD = 64;
constexpr int INC = 2840;
constexpr int C_QA = 0, C_KA = 512, C_VA = 1024, C_QB = 1536, C_KC = 2048, C_VC = 2176, C_KSL = 2304, C_VSL = 2432,
              C_KW = 2560, C_VW = 2688, C_GB = 2816;
constexpr int NC = 255, NE = 256, TOPK = 8, FF = 256;
constexpr float EPS = 1e-6f;
#ifndef DUP
#define DUP 0
#endif
constexpr int SMEM_BYTES = 74 * 1024;
typedef unsigned short bf16_t;
typedef short bf16x8 __attribute__((ext_vector_type(8)));
typedef float f32x4 __attribute__((ext_vector_type(4)));
typedef unsigned u32x4 __attribute__((ext_vector_type(4)));
typedef unsigned u32x2 __attribute__((ext_vector_type(2)));
typedef __bf16 bf2_t __attribute__((ext_vector_type(2)));
typedef float f32x2 __attribute__((ext_vector_type(2)));
typedef float f32x16 __attribute__((ext_vector_type(16)));
typedef short s16x4 __attribute__((ext_vector_type(4)));
#define LAS __attribute__((address_space(3)))
#define MFMA32(a, b, c) __builtin_amdgcn_mfma_f32_32x32x16_bf16((a), (b), (c), 0, 0, 0)
constexpr float LOG2E = 1.4426950408889634f;

struct P {
  const float *x, *c, *w_ada, *b_ada, *g_mix, *g_ffn, *w_in, *g_q_dil, *g_k_dil, *g_q_nsa, *g_k_cmp, *g_k_slc, *g_k_win;
  const float *pe_k, *w1_k, *w2_k, *pe_v, *w1_v, *w2_v, *w_out, *w_router, *r_bias, *w_gate, *w_up, *w_down, *ws_gate, *ws_up, *ws_down;
  float* out;
  float *mod, *rope, *h1, *proj, *qrope, *kcmp, *vcmp, *ocmp, *oslc, *owin, *mixin, *x1, *h2, *logits, *gates, *hs_g, *hs, *shared, *Hbuf;
  unsigned long long* selmask;
  int *eidx, *cnt, *off, *pos, *sorted, *tstart;
  bf16_t *h1b, *h2s, *mixinb, *Hb, *Hs, *Ybuf, *Ys;
  bf16_t *QA, *KA, *VA, *QN, *QR, *KC, *VC, *KSL, *VSL, *KW, *VW;
  float *GS, *smaxv, *b1c;
  bf16_t *kcb, *vcb;
  int* ctr;
  int* bhist;
  unsigned char *h2q, *Hq, *Wq_g, *Wq_u, *Wq_d, *h1q, *Wq_in, *Yq, *mixq, *Wq_out, *Wq_sg, *Wq_su;
  unsigned* bar;
  bf16_t *zrow, *Wt_in, *Wt_out, *Wt_rth, *Wt_rtl, *Wt_sg, *Wt_su, *Wt_sd, *Wt_c1k, *Wt_c1v, *Wt_g, *Wt_u, *Wt_d;
};

#define WLOOP(w, n) for (int w = blockIdx.x; w < (n); w += gridDim.x)

__device__ __forceinline__ int otid() { int t = threadIdx.x; asm volatile("" : "+v"(t)); return t; }
__device__ __forceinline__ unsigned pk_bf16(float lo, float hi) {
  f32x2 v = {lo, hi};
  bf2_t r = __builtin_convertvector(v, bf2_t);
  return __builtin_bit_cast(unsigned, r);
}
__device__ __forceinline__ float clamp_e4m3(float v) { return __builtin_amdgcn_fmed3f(v, -448.f, 448.f); }
__device__ __forceinline__ unsigned pk4_fp8(float a, float b, float c, float d) {
  int t = __builtin_amdgcn_cvt_pk_fp8_f32(a, b, 0, false);
  t = __builtin_amdgcn_cvt_pk_fp8_f32(c, d, t, true);
  return (unsigned)t;
}
constexpr float WQ_SCALE = 64.f, HQ_SCALE = 8.f, YQ_SCALE = 16.f, MQ_SCALE = 16.f;
__device__ __forceinline__ float bf16_to_f32(unsigned short b) { return __uint_as_float((unsigned)b << 16); }
__device__ __forceinline__ float bf16_round(float v) { return __uint_as_float(pk_bf16(v, 0.f) << 16); }
__device__ __forceinline__ float silu(float v) { return v / (1.f + expf(-v)); }
__device__ __forceinline__ float sigmoidf(float v) { return 1.f / (1.f + expf(-v)); }
__device__ __forceinline__ float wave_sum(float v) { for (int o = 32; o; o >>= 1) v += __shfl_xor(v, o); return v; }
__device__ __forceinline__ float wave_max(float v) { for (int o = 32; o; o >>= 1) v = fmaxf(v, __shfl_xor(v, o)); return v; }

__device__ __forceinline__ void ph_ada(const P& p, char* smem) {
  float* sc = (float*)smem;
  f32x4* red = (f32x4*)(smem + 16384);
  bool loaded = false;
  WLOOP(w, 6 * D / 32) {
    const int tid = threadIdx.x, kg = tid >> 3, cl = tid & 7, j0 = w * 32 + cl * 4;
    __syncthreads();
    if (!loaded) { for (int i = tid; i < 4 * D; i += 256) sc[i] = silu(p.c[i]); loaded = true; __syncthreads(); }
    f32x4 acc[4];
#pragma unroll
    for (int b = 0; b < 4; ++b) acc[b] = (f32x4){0.f, 0.f, 0.f, 0.f};
#pragma unroll 8
    for (int it = 0; it < 32; ++it) {
      const int k = kg + 32 * it;
      const f32x4 wv = *(const f32x4*)(p.w_ada + (size_t)k * 6 * D + j0);
#pragma unroll
      for (int b = 0; b < 4; ++b) acc[b] += wv * sc[b * D + k];
    }
#pragma unroll
    for (int b = 0; b < 4; ++b) red[(kg * 8 + cl) * 4 + b] = acc[b];
    __syncthreads();
    if (tid < 128) {
      const int b = tid >> 5, c = tid & 31;
      float s = p.b_ada[w * 32 + c];
      for (int g = 0; g < 32; ++g) s += ((const float*)&red[(g * 8 + (c >> 2)) * 4 + b])[c & 3];
      p.mod[b * 6 * D + w * 32 + c] = s;
    }
  }
}
__device__ __forceinline__ void ph_rope_tab(const P& p) {
  WLOOP(w, S * 8 / 256) {
    int i = w * 256 + threadIdx.x;
    int pos = i >> 3, f = i & 7;
    double ang = (double)pos * pow(500000.0, -(double)f / 8.0);
    p.rope[i * 2] = (float)cos(ang);
    p.rope[i * 2 + 1] = (float)sin(ang);
  }
}
template <bool SPLIT, bool INBF = false>
__device__ __forceinline__ void ph_norm_mod(const float* in, const float* g, const float* mod, int shift_off, int scale_off, bf16_t* out, unsigned char* outq = nullptr) {
  const int lane = threadIdx.x & 63, wv = threadIdx.x >> 6;
  WLOOP(w, T / 4) {
    const int t = w * 4 + wv, b = t / S;
    f32x4 v[4];
    float ss = 0.f;
#pragma unroll
    for (int i = 0; i < 4; ++i) {
      if (INBF) { const u32x2 q = *(const u32x2*)((const bf16_t*)in + (size_t)t * D + i * 256 + lane * 4); v[i] = (f32x4){__uint_as_float(q.x << 16), __uint_as_float(q.x & 0xffff0000u), __uint_as_float(q.y << 16), __uint_as_float(q.y & 0xffff0000u)}; }
      else v[i] = *(const f32x4*)(in + (size_t)t * D + i * 256 + lane * 4);
      ss += v[i][0] * v[i][0] + v[i][1] * v[i][1] + v[i][2] * v[i][2] + v[i][3] * v[i][3]; }
    ss = wave_sum(ss);
    const float r = rsqrtf(ss * (1.f / D) + EPS);
    const int ld = SPLIT ? 2 * D : D;
#pragma unroll
    for (int i = 0; i < 4; ++i) {
      const int d = i * 256 + lane * 4;
      const f32x4 gg = *(const f32x4*)(g + d), sc = *(const f32x4*)(mod + b * 6 * D + scale_off + d), sh = *(const f32x4*)(mod + b * 6 * D + shift_off + d);
      const f32x4 o = v[i] * r * gg * (sc + 1.f) + sh;
      u32x2 hi = {pk_bf16(o[0], o[1]), pk_bf16(o[2], o[3])};
      if (out) *(u32x2*)(out + (size_t)t * ld + d) = hi;
      if (!SPLIT && outq) *(unsigned*)(outq + (size_t)t * D + d) = pk4_fp8(o[0], o[1], o[2], o[3]);
      if (SPLIT) {
        *(unsigned*)(outq + (size_t)t * D + d) = pk4_fp8(o[0], o[1], o[2], o[3]);
        const float l0 = o[0] - __uint_as_float(hi.x << 16), l1 = o[1] - __uint_as_float(hi.x & 0xffff0000u);
        const float l2 = o[2] - __uint_as_float(hi.y << 16), l3 = o[3] - __uint_as_float(hi.y & 0xffff0000u);
        u32x2 lo = {pk_bf16(l0, l1), pk_bf16(l2, l3)};
        *(u32x2*)(out + (size_t)t * ld + D + d) = lo;
      }
    }
  }
}

template <bool SPLIT3, class AF, class BF, class EF>
__device__ __forceinline__ void gemm128(char* smem, int K, int ldb, AF arow, BF bcol, EF epi) {
  const int tid = otid(), lane = tid & 63, wid = tid >> 6, wm = wid >> 1, wn = wid & 1;
  const int l15 = lane & 15, l4 = lane >> 4;
  char* As = smem; char* Bs = smem + 16384;
  const int ac = tid & 7, ar0 = tid >> 3;
  const bf16_t* ap[4];
#pragma unroll
  for (int i = 0; i < 4; ++i) ap[i] = arow(ar0 + 32 * i);
  const int kg = tid >> 5, ng = tid & 31;
  const float* bp = bcol(ng * 4);
  if (bp) bp += (size_t)(kg * 8) * ldb;
  u32x4 areg[4]; f32x4 breg[8];
  const int nk1 = K / 64, nk = SPLIT3 ? 3 * nk1 : nk1;
  auto gload = [&](int kt) {
    const int seg = SPLIT3 ? kt / nk1 : 0, k0 = (SPLIT3 ? kt % nk1 : kt) * 64;
    const int aoff = (seg == 2 ? K : 0) + k0 + ac * 8;
#pragma unroll
    for (int i = 0; i < 4; ++i) areg[i] = ap[i] ? *(const u32x4*)(ap[i] + aoff) : (u32x4){0u, 0u, 0u, 0u};
#pragma unroll
    for (int i = 0; i < 8; ++i) breg[i] = bp ? *(const f32x4*)(bp + (size_t)(k0 + i) * ldb) : (f32x4){0.f, 0.f, 0.f, 0.f};
    if (SPLIT3 && seg == 1) {
#pragma unroll
      for (int i = 0; i < 8; ++i)
#pragma unroll
        for (int j = 0; j < 4; ++j) breg[i][j] = breg[i][j] - bf16_round(breg[i][j]);
    }
  };
  auto lstore = [&]() {
#pragma unroll
    for (int i = 0; i < 4; ++i) { const int r = ar0 + 32 * i; *(u32x4*)(As + r * 128 + ((ac ^ ((r >> 1) & 7)) << 4)) = areg[i]; }
#pragma unroll
    for (int j = 0; j < 4; ++j) {
      const int n = ng * 4 + j;
      u32x4 v = {pk_bf16(breg[0][j], breg[1][j]), pk_bf16(breg[2][j], breg[3][j]), pk_bf16(breg[4][j], breg[5][j]), pk_bf16(breg[6][j], breg[7][j])};
      *(u32x4*)(Bs + n * 128 + ((kg ^ ((n >> 1) & 7)) << 4)) = v;
    }
  };
  f32x4 acc[4][4];
#pragma unroll
  for (int i = 0; i < 4; ++i)
#pragma unroll
    for (int j = 0; j < 4; ++j) acc[i][j] = (f32x4){0.f, 0.f, 0.f, 0.f};
  gload(0);
  const int sw = l15 >> 1;
  for (int kt = 0; kt < nk; ++kt) {
    __syncthreads();
    lstore();
    __syncthreads();
    if (kt + 1 < nk) gload(kt + 1);
#pragma unroll
    for (int ks = 0; ks < 2; ++ks) {
      const int coff = ((ks * 4 + l4) ^ sw) << 4;
      bf16x8 af[4], bfr[4];
#pragma unroll
      for (int mt = 0; mt < 4; ++mt) af[mt] = *(const bf16x8*)(As + (wm * 64 + mt * 16 + l15) * 128 + coff);
#pragma unroll
      for (int nt = 0; nt < 4; ++nt) bfr[nt] = *(const bf16x8*)(Bs + (wn * 64 + nt * 16 + l15) * 128 + coff);
#pragma unroll
      for (int mt = 0; mt < 4; ++mt)
#pragma unroll
        for (int nt = 0; nt < 4; ++nt) acc[mt][nt] = __builtin_amdgcn_mfma_f32_16x16x32_bf16(bfr[nt], af[mt], acc[mt][nt], 0, 0, 0);
    }
  }
  epi(acc, wm * 64 + l15, wn * 64 + l4 * 4);
}

typedef unsigned u32x2v __attribute__((ext_vector_type(2)));
__device__ __forceinline__ void xpose4(unsigned (&d)[4][2], int) {
#pragma unroll
  for (int a = 0; a < 2; ++a)
#pragma unroll
    for (int h = 0; h < 2; ++h) { const u32x2v r = __builtin_amdgcn_permlane16_swap(d[2 * a][h], d[2 * a + 1][h], false, false); d[2 * a][h] = r.x; d[2 * a + 1][h] = r.y; }
#pragma unroll
  for (int j = 0; j < 2; ++j)
#pragma unroll
    for (int h = 0; h < 2; ++h) { const u32x2v r = __builtin_amdgcn_permlane32_swap(d[j][h], d[2 + j][h], false, false); d[j][h] = r.x; d[2 + j][h] = r.y; }
}
__device__ __forceinline__ void store_row64_bf16(const f32x4& a0, const f32x4& a1, const f32x4& a2, const f32x4& a3, int l4, bf16_t* rowp, bool doit) {
  unsigned d[4][2] = {{pk_bf16(a0[0], a0[1]), pk_bf16(a0[2], a0[3])}, {pk_bf16(a1[0], a1[1]), pk_bf16(a1[2], a1[3])},
                      {pk_bf16(a2[0], a2[1]), pk_bf16(a2[2], a2[3])}, {pk_bf16(a3[0], a3[1]), pk_bf16(a3[2], a3[3])}};
  xpose4(d, l4);
  if (doit) {
    *(u32x4*)(rowp + 16 * l4) = (u32x4){d[0][0], d[0][1], d[1][0], d[1][1]};
    *(u32x4*)(rowp + 16 * l4 + 8) = (u32x4){d[2][0], d[2][1], d[3][0], d[3][1]};
  }
}

template <bool LO>
__device__ __forceinline__ void cvt_kn_tile(const float* src, int ldn, bf16_t* dst, int ldk, int k0, int n0, int nmax) {
  const int tid = threadIdx.x, kg = tid & 7, ng = tid >> 3, n = n0 + ng * 4;
  if (n >= nmax) return;
  f32x4 r[8];
#pragma unroll
  for (int i = 0; i < 8; ++i) r[i] = *(const f32x4*)(src + (size_t)(k0 + kg * 8 + i) * ldn + n);
  if (LO) {
#pragma unroll
    for (int i = 0; i < 8; ++i)
#pragma unroll
      for (int j = 0; j < 4; ++j) r[i][j] = r[i][j] - bf16_round(r[i][j]);
  }
#pragma unroll
  for (int j = 0; j < 4; ++j) {
    u32x4 v = {pk_bf16(r[0][j], r[1][j]), pk_bf16(r[2][j], r[3][j]), pk_bf16(r[4][j], r[5][j]), pk_bf16(r[6][j], r[7][j])};
    *(u32x4*)(dst + (size_t)(n + j) * ldk + k0 + kg * 8) = v;
  }
}
template <bool LO>
__device__ __forceinline__ void cvt_matrix(const float* src, bf16_t* dst, int K, int N, int& item_base) {
  const int nkt = K / 64, nnt = (N + 127) / 128, total = nkt * nnt;
  for (int it = (int)blockIdx.x - item_base; it < total; it += gridDim.x) {
    if (it < 0) continue;
    cvt_kn_tile<LO>(src, N, dst, K, (it % nkt) * 64, (it / nkt) * 128, N);
  }
  item_base = (item_base + total) % gridDim.x;
}

constexpr int G2_STAGE = 24576;
template <int NSEG, int AB = 0, class AF, class BF, class EF>
__device__ __forceinline__ void gemm2(char* smem_, int K, AF arow, BF brow, EF epi, int aseg1 = 0, int bseg1 = 0, int aseg2 = 0, int bseg2 = 0) {
  LAS char* smem = (LAS char*)smem_;
  const int tid = otid(), lane = tid & 63, wv = __builtin_amdgcn_readfirstlane(tid >> 6), wm = wv >> 1, wn = wv & 1;
  const int l15 = lane & 15, l4 = lane >> 4;
  const int row_l = lane >> 2, csrc = ((lane & 3) ^ (((row_l >> 3) & 1) * 3)) * 8;
  const bf16_t* ap[4]; const bf16_t* bp[2];
#pragma unroll
  for (int j = 0; j < 4; ++j) ap[j] = arow((wv + 4 * j) * 16 + row_l) + csrc;
#pragma unroll
  for (int j = 0; j < 2; ++j) bp[j] = brow((wv + 4 * j) * 16 + row_l) + csrc;
  const int nk1 = K / 32, nk = NSEG * nk1;
  auto issue = [&](int kt) {
    LAS char* st = smem + (kt % 3) * G2_STAGE;
    int ka = kt * 32, kb = kt * 32;
    if (NSEG > 1) { const int seg = kt / nk1, kk = (kt - seg * nk1) * 32; ka = kk + (seg == 1 ? aseg1 : (seg == 2 ? aseg2 : 0)); kb = kk + (seg == 1 ? bseg1 : (seg == 2 ? bseg2 : 0)); }
#pragma unroll
    for (int j = 0; j < 4; ++j) __builtin_amdgcn_global_load_lds((const unsigned*)(ap[j] + ka), (LAS unsigned*)(st + (wv + 4 * j) * 1024), 16, 0, 0);
#pragma unroll
    for (int j = 0; j < 2; ++j) __builtin_amdgcn_global_load_lds((const unsigned*)(bp[j] + kb), (LAS unsigned*)(st + 16384 + (wv + 4 * j) * 1024), 16, 0, 0);
  };
  f32x4 acc[8][4];
#pragma unroll
  for (int i = 0; i < 8; ++i)
#pragma unroll
    for (int j = 0; j < 4; ++j) acc[i][j] = (f32x4){0.f, 0.f, 0.f, 0.f};
  const int coff = (l4 ^ (((l15 >> 3) & 1) * 3)) << 4;
  const int aoff = (wm * 128 + l15) * 64 + coff, boff = 16384 + (wn * 64 + l15) * 64 + coff;
  asm volatile("s_waitcnt lgkmcnt(0)" ::: "memory");
  __builtin_amdgcn_s_barrier();
  asm volatile("" ::: "memory");
  issue(0);
  if (nk > 1) issue(1);
  for (int kt = 0; kt < nk; ++kt) {
    if (kt + 1 < nk) asm volatile("s_waitcnt vmcnt(6)" ::: "memory"); else asm volatile("s_waitcnt vmcnt(0)" ::: "memory");
    __builtin_amdgcn_s_barrier();
    asm volatile("" ::: "memory");
    if (AB != 2 && kt + 2 < nk) issue(kt + 2);
    const LAS char* st = smem + (kt % 3) * G2_STAGE;
    bf16x8 bfr[4], af[8];
    if (AB != 3) {
#pragma unroll
    for (int nt = 0; nt < 4; ++nt) bfr[nt] = *(const LAS bf16x8*)(st + boff + nt * 1024);
#pragma unroll
    for (int mt = 0; mt < 8; ++mt) af[mt] = *(const LAS bf16x8*)(st + aoff + mt * 1024);
    }
    __builtin_amdgcn_sched_barrier(0);
    if (AB == 1) {
#pragma unroll
      for (int nt = 0; nt < 4; ++nt) asm volatile("" :: "v"(bfr[nt]));
#pragma unroll
      for (int mt = 0; mt < 8; ++mt) asm volatile("" :: "v"(af[mt]));
    }
    if (AB == 0 || AB == 2) {
    __builtin_amdgcn_s_setprio(1);
#pragma unroll
    for (int mt = 0; mt < 8; ++mt)
#pragma unroll
      for (int nt = 0; nt < 4; ++nt) acc[mt][nt] = __builtin_amdgcn_mfma_f32_16x16x32_bf16(bfr[nt], af[mt], acc[mt][nt], 0, 0, 0);
    __builtin_amdgcn_s_setprio(0);
    }
    __builtin_amdgcn_sched_barrier(0);
  }
  epi(acc, wm * 128 + l15, wn * 64 + l4 * 4);
}

template <int NREP = 1, class AF, class BF, class EF>
__device__ __forceinline__ void gemm2q(char* smem_, int K, AF arow, BF brow, EF epi, size_t bstep = 0, bool half = false) {
  LAS char* smem = (LAS char*)smem_;
  const int tid = otid(), lane = tid & 63, wv = __builtin_amdgcn_readfirstlane(tid >> 6), wm = wv >> 1, wn = wv & 1;
  const int l15 = lane & 15, l4 = lane >> 4;
  const int row_l = lane >> 2, csrc = ((lane & 3) ^ ((row_l >> 2) & 3)) * 16;
  const unsigned char* ap[4]; const unsigned char* bp[2];
#pragma unroll
  for (int j = 0; j < 4; ++j) ap[j] = arow((wv + 4 * j) * 16 + row_l) + csrc;
#pragma unroll
  for (int j = 0; j < 2; ++j) bp[j] = brow((wv + 4 * j) * 16 + row_l) + csrc;
  const int nk1 = K / 64, nk = nk1 * NREP;
  auto issue = [&](int kt) {
    LAS char* st = smem + (kt % 3) * G2_STAGE;
    const int rp = NREP > 1 ? kt / nk1 : 0, kk = NREP > 1 ? kt - rp * nk1 : kt;
#pragma unroll
    for (int j = 0; j < 4; ++j) __builtin_amdgcn_global_load_lds((const unsigned*)(ap[j] + kk * 64), (LAS unsigned*)(st + (wv + 4 * j) * 1024), 16, 0, 0);
#pragma unroll
    for (int j = 0; j < 2; ++j) __builtin_amdgcn_global_load_lds((const unsigned*)(bp[j] + rp * bstep + kk * 64), (LAS unsigned*)(st + 16384 + (wv + 4 * j) * 1024), 16, 0, 0);
  };
  f32x4 acc[8][4];
#pragma unroll
  for (int i = 0; i < 8; ++i)
#pragma unroll
    for (int j = 0; j < 4; ++j) acc[i][j] = (f32x4){0.f, 0.f, 0.f, 0.f};
  const int sw = (l15 >> 2) & 3, sub = (l4 & 1) * 8, ch = l4 >> 1;
  const int aoff = (wm * 128 + l15) * 64 + sub, boff = 16384 + (wn * 64 + l15) * 64 + sub;
  asm volatile("s_waitcnt lgkmcnt(0)" ::: "memory");
  __builtin_amdgcn_s_barrier();
  asm volatile("" ::: "memory");
  issue(0);
  if (nk > 1) issue(1);
  for (int kt = 0; kt < nk; ++kt) {
    if (kt + 1 < nk) asm volatile("s_waitcnt vmcnt(6)" ::: "memory"); else asm volatile("s_waitcnt vmcnt(0)" ::: "memory");
    __builtin_amdgcn_s_barrier();
    asm volatile("" ::: "memory");
    if (kt + 2 < nk) issue(kt + 2);
    const LAS char* st = smem + (kt % 3) * G2_STAGE;
    if (!(half && wm == 1))
#pragma unroll
    for (int ks = 0; ks < 2; ++ks) {
      const int coff = ((2 * ks + ch) ^ sw) << 4;
      long bfr[4], af[8];
#pragma unroll
      for (int nt = 0; nt < 4; ++nt) bfr[nt] = *(const LAS long*)(st + boff + nt * 1024 + coff);
#pragma unroll
      for (int mt = 0; mt < 8; ++mt) af[mt] = *(const LAS long*)(st + aoff + mt * 1024 + coff);
      __builtin_amdgcn_s_setprio(1);
#pragma unroll
      for (int mt = 0; mt < 8; ++mt)
#pragma unroll
        for (int nt = 0; nt < 4; ++nt) acc[mt][nt] = __builtin_amdgcn_mfma_f32_16x16x32_fp8_fp8(bfr[nt], af[mt], acc[mt][nt], 0, 0, 0);
      __builtin_amdgcn_s_setprio(0);
    }
    __builtin_amdgcn_sched_barrier(0);
    if (NREP > 1 && (kt + 1) % nk1 == 0 && kt + 1 < nk) {
      epi(acc, wm * 128 + l15, wn * 64 + l4 * 4, kt / nk1);
#pragma unroll
      for (int i = 0; i < 8; ++i)
#pragma unroll
        for (int j = 0; j < 4; ++j) acc[i][j] = (f32x4){0.f, 0.f, 0.f, 0.f};
    }
  }
  epi(acc, wm * 128 + l15, wn * 64 + l4 * 4, NREP - 1);
}


typedef int i32x8 __attribute__((ext_vector_type(8)));
typedef float f32x16 __attribute__((ext_vector_type(16)));
template <int NREP = 1, class AF, class BF, class EF>
__device__ __forceinline__ void gemm2x(char* smem_, int K, AF arow, BF brow, EF epi, size_t bstep = 0, bool half = false) {
  LAS char* smem = (LAS char*)smem_;
  const int tid = otid(), lane = tid & 63, wv = __builtin_amdgcn_readfirstlane(tid >> 6), wm = wv >> 1, wn = wv & 1;
  const int l31 = lane & 31, hh = lane >> 5;
  const int row_l = lane >> 2, csrc = ((lane & 3) ^ ((row_l >> 1) & 3)) * 16;
  const unsigned char* ap[4]; const unsigned char* bp[2];
#pragma unroll
  for (int j = 0; j < 4; ++j) ap[j] = arow((wv + 4 * j) * 16 + row_l) + csrc;
#pragma unroll
  for (int j = 0; j < 2; ++j) bp[j] = brow((wv + 4 * j) * 16 + row_l) + csrc;
  const int nk1 = K / 64, nk = nk1 * NREP;
  auto issue = [&](int kt) {
    LAS char* st = smem + (kt % 3) * G2_STAGE;
    const int rp = NREP > 1 ? kt / nk1 : 0, kk = NREP > 1 ? kt - rp * nk1 : kt;
#pragma unroll
    for (int j = 0; j < 4; ++j) __builtin_amdgcn_global_load_lds((const unsigned*)(ap[j] + kk * 64), (LAS unsigned*)(st + (wv + 4 * j) * 1024), 16, 0, 0);
#pragma unroll
    for (int j = 0; j < 2; ++j) __builtin_amdgcn_global_load_lds((const unsigned*)(bp[j] + rp * bstep + kk * 64), (LAS unsigned*)(st + 16384 + (wv + 4 * j) * 1024), 16, 0, 0);
  };
  f32x16 acc[4][2];
#pragma unroll
  for (int i = 0; i < 4; ++i)
#pragma unroll
    for (int j = 0; j < 2; ++j)
#pragma unroll
      for (int e = 0; e < 16; ++e) acc[i][j][e] = 0.f;
  const int sw = (l31 >> 1) & 3, c0 = ((2 * hh) ^ sw) << 4, c1 = c0 ^ 16;
  const int aoff = (wm * 128 + l31) * 64, boff = 16384 + (wn * 64 + l31) * 64;
  asm volatile("s_waitcnt lgkmcnt(0)" ::: "memory");
  __builtin_amdgcn_s_barrier();
  asm volatile("" ::: "memory");
  issue(0);
  if (nk > 1) issue(1);
#pragma unroll 1
  for (int kt = 0; kt < nk; ++kt) {
    if (kt + 1 < nk) asm volatile("s_waitcnt vmcnt(6)" ::: "memory"); else asm volatile("s_waitcnt vmcnt(0)" ::: "memory");
    __builtin_amdgcn_s_barrier();
    asm volatile("" ::: "memory");
    if (kt + 2 < nk) issue(kt + 2);
    const LAS char* st = smem + (kt % 3) * G2_STAGE;
    if (!(half && wm == 1)) {
      i32x8 bfr[2], af[4];
#pragma unroll
      for (int nt = 0; nt < 2; ++nt) {
        const u32x4 lo = *(const LAS u32x4*)(st + boff + nt * 2048 + c0), hi = *(const LAS u32x4*)(st + boff + nt * 2048 + c1);
        bfr[nt] = (i32x8){(int)lo.x, (int)lo.y, (int)lo.z, (int)lo.w, (int)hi.x, (int)hi.y, (int)hi.z, (int)hi.w};
      }
#pragma unroll
      for (int mt = 0; mt < 4; ++mt) {
        const u32x4 lo = *(const LAS u32x4*)(st + aoff + mt * 2048 + c0), hi = *(const LAS u32x4*)(st + aoff + mt * 2048 + c1);
        af[mt] = (i32x8){(int)lo.x, (int)lo.y, (int)lo.z, (int)lo.w, (int)hi.x, (int)hi.y, (int)hi.z, (int)hi.w};
      }
      __builtin_amdgcn_s_setprio(1);
#pragma unroll
      for (int mt = 0; mt < 4; ++mt)
#pragma unroll
        for (int nt = 0; nt < 2; ++nt)
          acc[mt][nt] = __builtin_amdgcn_mfma_scale_f32_32x32x64_f8f6f4(bfr[nt], af[mt], acc[mt][nt], 0, 0, 0, 0x7F7F7F7F, 0, 0x7F7F7F7F);
      __builtin_amdgcn_s_setprio(0);
    }
    __builtin_amdgcn_sched_barrier(0);
    if (NREP > 1 && (kt + 1) % nk1 == 0 && kt + 1 < nk) {
      epi(acc, wm * 128 + l31, wn * 64 + 4 * hh, kt / nk1);
#pragma unroll
      for (int i = 0; i < 4; ++i)
#pragma unroll
        for (int j = 0; j < 2; ++j)
#pragma unroll
          for (int e = 0; e < 16; ++e) acc[i][j][e] = 0.f;
    }
  }
  epi(acc, wm * 128 + l31, wn * 64 + 4 * hh, NREP - 1);
}

template <class F>
__device__ __forceinline__ void gemm2_grid(int NT, F body) {
  const int xcd = blockIdx.x & 7, lb = blockIdx.x >> 3, nlb = gridDim.x >> 3;
  for (int i = lb; i < 8 * NT; i += nlb) body(xcd * 8 + (i & 7), i >> 3);
}

template <class F>
__device__ __forceinline__ void gemm_grid(int NT, F body) {
  const int xcd = blockIdx.x & 7, lb = blockIdx.x >> 3, nlb = gridDim.x >> 3;
  for (int i = lb; i < 16 * NT; i += nlb) {
    const int g = i / (8 * NT), rem = i % (8 * NT), nt = rem >> 3, mi = rem & 7;
    body(xcd * 16 + g * 8 + mi, nt);
  }
}

template <int MT>
__device__ __forceinline__ void proj_epi(const P& p, const f32x4 (&acc)[MT][4], int row_base, int ntile, int r0, int c0, float ascale = 1.f, const float* rope_tile = nullptr) {
  const int wn = c0 >> 6, l4 = (c0 & 63) >> 2;
  const int col0 = ntile * 128 + wn * 64;
  if (col0 >= INC) return;
  if (col0 == C_GB) {
#pragma unroll
    for (int mt = 0; mt < MT; ++mt) {
      const int m = row_base + r0 + mt * 16;
      f32x4 a = acc[mt][0] * ascale, g0 = {sigmoidf(a[0]), sigmoidf(a[1]), sigmoidf(a[2]), sigmoidf(a[3])};
      *(f32x4*)(p.GS + (size_t)m * 24 + 4 * l4) = g0;
      if (l4 < 2) { a = acc[mt][1] * ascale; f32x4 g1 = {sigmoidf(a[0]), sigmoidf(a[1]), sigmoidf(a[2]), sigmoidf(a[3])}; *(f32x4*)(p.GS + (size_t)m * 24 + 16 + 4 * l4) = g1; }
    }
    return;
  }
  const float* g = nullptr; bf16_t* dst; bf16_t* dst2 = nullptr; int hh, H; float qs = 1.f; bool dorope = false;
  if (col0 < 512) { g = p.g_q_dil; dst = p.QA; hh = col0 >> 6; H = 8; qs = 0.125f; dorope = true; }
  else if (col0 < 1024) { g = p.g_k_dil; dst = p.KA; hh = (col0 - 512) >> 6; H = 8; dorope = true; }
  else if (col0 < 1536) { dst = p.VA; hh = (col0 - 1024) >> 6; H = 8; }
  else if (col0 < 2048) { g = p.g_q_nsa; dst = p.QR; dst2 = p.QN; hh = (col0 - 1536) >> 6; H = 8; qs = 0.125f; dorope = true; }
  else {
    const int idx = (col0 - 2048) >> 6, which = idx >> 1; hh = idx & 1; H = 2;
    if (which == 0) dst = p.KC; else if (which == 1) dst = p.VC;
    else if (which == 2) { dst = p.KSL; g = p.g_k_slc; dorope = true; } else if (which == 3) dst = p.VSL;
    else if (which == 4) { dst = p.KW; g = p.g_k_win; dorope = true; } else dst = p.VW;
  }
  f32x4 gv[4];
  if (g) {
#pragma unroll
    for (int nt = 0; nt < 4; ++nt) gv[nt] = *(const f32x4*)(g + nt * 16 + 4 * l4);
  }
  const int bb = row_base / S;
#pragma unroll
  for (int mt = 0; mt < MT; ++mt) {
    const int m = row_base + r0 + mt * 16, s = m - bb * S;
    f32x4 v[4];
#pragma unroll
    for (int nt = 0; nt < 4; ++nt) v[nt] = acc[mt][nt] * ascale;
    if (g) {
      float ss = 0.f;
#pragma unroll
      for (int nt = 0; nt < 4; ++nt) ss += v[nt][0] * v[nt][0] + v[nt][1] * v[nt][1] + v[nt][2] * v[nt][2] + v[nt][3] * v[nt][3];
      ss += __shfl_xor(ss, 16); ss += __shfl_xor(ss, 32);
      const float r = rsqrtf(ss * (1.f / 64.f) + EPS) * qs;
#pragma unroll
      for (int nt = 0; nt < 4; ++nt) v[nt] = v[nt] * gv[nt] * r;
    }
    f32x4 vr = v[0];
    if (dorope) {
      const float* rp = rope_tile ? rope_tile + ((size_t)(m - row_base) * 8 + 4 * (l4 & 1)) * 2 : p.rope + ((size_t)s * 8 + 4 * (l4 & 1)) * 2;
      const f32x4 ra = *(const f32x4*)rp, rb = *(const f32x4*)(rp + 4);
      const float cs[4] = {ra[0], ra[2], rb[0], rb[2]}, sn[4] = {ra[1], ra[3], rb[1], rb[3]};
#pragma unroll
      for (int i = 0; i < 4; ++i) {
        const float pt = __shfl_xor(v[0][i], 32);
        vr[i] = (l4 < 2) ? (v[0][i] * cs[i] - pt * sn[i]) : (v[0][i] * cs[i] + pt * sn[i]);
      }
    }
    bf16_t* row = dst + ((size_t)(bb * H + hh) * S + s) * 64 + 16 * l4;
    unsigned dd[4][2] = {{pk_bf16(vr[0], vr[1]), pk_bf16(vr[2], vr[3])}, {pk_bf16(v[1][0], v[1][1]), pk_bf16(v[1][2], v[1][3])},
                         {pk_bf16(v[2][0], v[2][1]), pk_bf16(v[2][2], v[2][3])}, {pk_bf16(v[3][0], v[3][1]), pk_bf16(v[3][2], v[3][3])}};
    if (dst2) {
      unsigned d2[4][2] = {{pk_bf16(v[0][0], v[0][1]), pk_bf16(v[0][2], v[0][3])}, {dd[1][0], dd[1][1]}, {dd[2][0], dd[2][1]}, {dd[3][0], dd[3][1]}};
      xpose4(d2, l4);
      bf16_t* row2 = dst2 + ((size_t)(bb * H + hh) * S + s) * 64 + 16 * l4;
      *(u32x4*)row2 = (u32x4){d2[0][0], d2[0][1], d2[1][0], d2[1][1]};
      *(u32x4*)(row2 + 8) = (u32x4){d2[2][0], d2[2][1], d2[3][0], d2[3][1]};
    }
    xpose4(dd, l4);
    *(u32x4*)row = (u32x4){dd[0][0], dd[0][1], dd[1][0], dd[1][1]};
    *(u32x4*)(row + 8) = (u32x4){dd[2][0], dd[2][1], dd[3][0], dd[3][1]};
    asm volatile("" ::: "memory");
  }
}
__device__ __forceinline__ u32x4 pair8(u32x2 a, u32x2 b) {
  const u32x2v s1 = __builtin_amdgcn_permlane32_swap(a.x, b.x, false, false), s2 = __builtin_amdgcn_permlane32_swap(a.y, b.y, false, false);
  return (u32x4){s1.x, s2.x, s1.y, s2.y};
}
__device__ __forceinline__ u32x2 pk4_bf16(const f32x4& v) { return (u32x2){pk_bf16(v[0], v[1]), pk_bf16(v[2], v[3])}; }
__device__ __forceinline__ void proj_epi_x(const P& p, const f32x16 (&acc)[4][2], int row_base, int ntile, int r0, int c0, float ascale, const float* rope_tile) {
  const int wn = c0 >> 6, hh = (c0 >> 2) & 1;
  const int col0 = ntile * 128 + wn * 64;
  if (col0 >= INC) return;
  if (col0 == C_GB) {
#pragma unroll
    for (int mt = 0; mt < 4; ++mt) {
      const int m = row_base + r0 + mt * 32;
#pragma unroll
      for (int gq = 0; gq < 3; ++gq) {
        const f32x4 g0 = {sigmoidf(acc[mt][0][4 * gq] * ascale), sigmoidf(acc[mt][0][4 * gq + 1] * ascale), sigmoidf(acc[mt][0][4 * gq + 2] * ascale), sigmoidf(acc[mt][0][4 * gq + 3] * ascale)};
        *(f32x4*)(p.GS + (size_t)m * 24 + 8 * gq + 4 * hh) = g0;
      }
    }
    return;
  }
  const float* g = nullptr; bf16_t* dst; bf16_t* dst2 = nullptr; int hd, H; float qs = 1.f; bool dorope = false;
  if (col0 < 512) { g = p.g_q_dil; dst = p.QA; hd = col0 >> 6; H = 8; qs = 0.125f; dorope = true; }
  else if (col0 < 1024) { g = p.g_k_dil; dst = p.KA; hd = (col0 - 512) >> 6; H = 8; dorope = true; }
  else if (col0 < 1536) { dst = p.VA; hd = (col0 - 1024) >> 6; H = 8; }
  else if (col0 < 2048) { g = p.g_q_nsa; dst = p.QR; dst2 = p.QN; hd = (col0 - 1536) >> 6; H = 8; qs = 0.125f; dorope = true; }
  else {
    const int idx = (col0 - 2048) >> 6, which = idx >> 1; hd = idx & 1; H = 2;
    if (which == 0) dst = p.KC; else if (which == 1) dst = p.VC;
    else if (which == 2) { dst = p.KSL; g = p.g_k_slc; dorope = true; } else if (which == 3) dst = p.VSL;
    else if (which == 4) { dst = p.KW; g = p.g_k_win; dorope = true; } else dst = p.VW;
  }
  f32x4 gv[2][4];
  if (g) {
#pragma unroll
    for (int nt = 0; nt < 2; ++nt)
#pragma unroll
      for (int gq = 0; gq < 4; ++gq) gv[nt][gq] = *(const f32x4*)(g + nt * 32 + 8 * gq + 4 * hh);
  }
  const int bb = row_base / S;
#pragma unroll
  for (int mt = 0; mt < 4; ++mt) {
    const int m = row_base + r0 + mt * 32, s = m - bb * S;
    float r = ascale;
    if (g) {
      float ss = 0.f;
#pragma unroll
      for (int nt = 0; nt < 2; ++nt)
#pragma unroll
        for (int e = 0; e < 16; ++e) ss += acc[mt][nt][e] * acc[mt][nt][e];
      ss += __shfl_xor(ss, 32);
      r = rsqrtf(ss * (ascale * ascale * (1.f / 64.f)) + EPS) * (qs * ascale);
    }
    bf16_t* row = dst + ((size_t)(bb * H + hd) * S + s) * 64 + 8 * hh;
    bf16_t* row2 = dst2 ? dst2 + ((size_t)(bb * H + hd) * S + s) * 64 + 8 * hh : nullptr;
#pragma unroll
    for (int nt = 0; nt < 2; ++nt)
#pragma unroll
      for (int pq = 0; pq < 2; ++pq) {
        f32x4 va = (f32x4){acc[mt][nt][8 * pq], acc[mt][nt][8 * pq + 1], acc[mt][nt][8 * pq + 2], acc[mt][nt][8 * pq + 3]} * r;
        f32x4 vb = (f32x4){acc[mt][nt][8 * pq + 4], acc[mt][nt][8 * pq + 5], acc[mt][nt][8 * pq + 6], acc[mt][nt][8 * pq + 7]} * r;
        if (g) { va = va * gv[nt][2 * pq]; vb = vb * gv[nt][2 * pq + 1]; }
        if (nt == 0 && pq == 0) {
          if (row2) *(u32x4*)row2 = pair8(pk4_bf16(va), pk4_bf16(vb));
          if (dorope) {
            const float* rp = rope_tile + ((size_t)(m - row_base) * 8 + 4 * hh) * 2;
            const f32x4 ra = *(const f32x4*)rp, rb = *(const f32x4*)(rp + 4);
            const float cs[4] = {ra[0], ra[2], rb[0], rb[2]}, sn[4] = {ra[1], ra[3], rb[1], rb[3]};
            const f32x4 x1 = va, x2 = vb;
#pragma unroll
            for (int i = 0; i < 4; ++i) { va[i] = x1[i] * cs[i] - x2[i] * sn[i]; vb[i] = x2[i] * cs[i] + x1[i] * sn[i]; }
          }
          *(u32x4*)row = pair8(pk4_bf16(va), pk4_bf16(vb));
        } else {
          const u32x4 w = pair8(pk4_bf16(va), pk4_bf16(vb));
          *(u32x4*)(row + nt * 32 + pq * 16) = w;
          if (row2) *(u32x4*)(row2 + nt * 32 + pq * 16) = w;
        }
      }
    asm volatile("" ::: "memory");
  }
}
__device__ __forceinline__ void ph_proj(const P& p, char* smem) {
  gemm2_grid(23, [&](int mtile, int ntile) {
    const unsigned char* A = p.h1q + (size_t)mtile * 256 * D; const unsigned char* W = p.Wq_in + (size_t)ntile * 128 * D; const unsigned char* Z = (const unsigned char*)p.zrow;
    const int nvalid = INC - ntile * 128;
    gemm2x<1>(smem, D, [=](int r) { return A + (size_t)r * D; }, [=](int n) { return n < nvalid ? W + (size_t)n * D : Z; },
              [&](const f32x16 (&acc)[4][2], int r0, int c0, int) {
                float* rl = (float*)smem;
                __syncthreads();
                { const int s0 = (mtile * 256) % S; const f32x4* srcp = (const f32x4*)(p.rope + (size_t)s0 * 16);
#pragma unroll
                  for (int i = 0; i < 4; ++i) ((f32x4*)rl)[threadIdx.x + 256 * i] = srcp[threadIdx.x + 256 * i]; }
                __syncthreads();
                proj_epi_x(p, acc, mtile * 256, ntile, r0, c0, 1.f / WQ_SCALE, rl);
              });
  });
}
__device__ __forceinline__ void ph_outproj(const P& p, char* smem) {
  gemm2_grid(8, [&](int mtile, int ntile) {
    const unsigned char* A = p.mixq + (size_t)mtile * 256 * D; const unsigned char* W = p.Wq_out + (size_t)ntile * 128 * D; bf16_t* C = (bf16_t*)p.x1; const float* x = p.x;
    const float* gt = p.mod + ((mtile * 256) / S) * 6 * D + 2 * D;
    gemm2x<1>(smem, D, [=](int r) { return A + (size_t)r * D; }, [=](int n) { return W + (size_t)n * D; },
              [=](const f32x16 (&acc)[4][2], int r0, int c0, int) {
                const int hh = (c0 >> 2) & 1;
                const float s = 1.f / (WQ_SCALE * MQ_SCALE);
#pragma unroll
                for (int mt = 0; mt < 4; ++mt) {
                  const int m = mtile * 256 + r0 + mt * 32;
#pragma unroll
                  for (int nt = 0; nt < 2; ++nt) {
                    u32x2 o[4];
#pragma unroll
                    for (int gq = 0; gq < 4; ++gq) {
                      const int n = ntile * 128 + c0 + nt * 32 + 8 * gq;
                      const f32x4 a = {acc[mt][nt][4 * gq], acc[mt][nt][4 * gq + 1], acc[mt][nt][4 * gq + 2], acc[mt][nt][4 * gq + 3]};
                      o[gq] = pk4_bf16(*(const f32x4*)(x + (size_t)m * D + n) + *(const f32x4*)(gt + n) * (a * s));
                    }
                    bf16_t* crow = C + (size_t)m * D + ntile * 128 + (c0 & ~63) + nt * 32 + 8 * hh;
                    *(u32x4*)crow = pair8(o[0], o[1]); *(u32x4*)(crow + 16) = pair8(o[2], o[3]);
                  }
                  asm volatile("" ::: "memory");
                }
              });
  });
}
template <int AB>
__device__ __forceinline__ void ph_outproj_abl(const P& p, char* smem) {
  gemm2_grid(8, [&](int mtile, int ntile) {
    const bf16_t* A = p.mixinb + (size_t)mtile * 256 * D; const bf16_t* W = p.Wt_out + (size_t)ntile * 128 * D; float* C = (float*)p.Ybuf;
    gemm2<1, AB>(smem, D, [=](int r) { return A + (size_t)r * D; }, [=](int n) { return W + (size_t)n * D; },
             [=](const f32x4 (&acc)[8][4], int r0, int c0) {
#pragma unroll
               for (int mt = 0; mt < 8; ++mt)
#pragma unroll
                 for (int nt = 0; nt < 4; ++nt) {
                   const int m = mtile * 256 + r0 + mt * 16, n = ntile * 128 + c0 + nt * 16;
                   *(f32x4*)(C + (size_t)m * D + n) = acc[mt][nt];
                 }
             });
  });
}
__device__ __forceinline__ void router_unit(const P& p, char* smem, int mtile, int j) {
  const int seg = j >> 1, ntile = j & 1;
  const bf16_t* A = p.h2s + (size_t)mtile * 256 * 2 * D + (seg == 2 ? D : 0);
  const bf16_t* W = (seg == 1 ? p.Wt_rtl : p.Wt_rth) + (size_t)ntile * 128 * D; float* C = p.logits + (size_t)seg * T * NE;
  gemm2<1>(smem, D, [=](int r) { return A + (size_t)r * 2 * D; }, [=](int n) { return W + (size_t)n * D; },
           [=](const f32x4 (&acc)[8][4], int r0, int c0) {
#pragma unroll
             for (int mt = 0; mt < 8; ++mt)
#pragma unroll
               for (int nt = 0; nt < 4; ++nt) {
                 const int m = mtile * 256 + r0 + mt * 16, n = ntile * 128 + c0 + nt * 16;
                 *(f32x4*)(C + (size_t)m * NE + n) = acc[mt][nt];
               }
           });
}
__device__ __forceinline__ const bf16_t* gu_row(const bf16_t* Wg, const bf16_t* Wu, int f0, int n) {
  const int wn = n >> 6, wi = n & 63;
  return (wi >= 32 ? Wu : Wg) + (size_t)(f0 + wn * 32 + (wi & 31)) * D;
}
template <int MT>
__device__ __forceinline__ void gu_store(const f32x4 (&acc)[MT][4], int mt, float scale, bf16_t* dstrow  ) {
#pragma unroll
  for (int q = 0; q < 2; ++q) {
    const f32x4 g = acc[mt][q], u = acc[mt][q + 2];
    float h[4];
#pragma unroll
    for (int i = 0; i < 4; ++i) h[i] = silu(g[i]) * u[i] * scale;
    u32x2 v = {pk_bf16(h[0], h[1]), pk_bf16(h[2], h[3])};
    *(u32x2*)(dstrow + q * 16) = v;
  }
}
__device__ __forceinline__ const unsigned char* gu_rowq(const unsigned char* Wg, const unsigned char* Wu, int f0, int n);
__device__ __forceinline__ void shared_gu_unit(const P& p, char* smem, int mtile, int ntile) {
  const unsigned char* A = p.h2q + (size_t)mtile * 256 * D; const unsigned char* Wg = p.Wq_sg; const unsigned char* Wu = p.Wq_su; bf16_t* H = p.Hs;
  gemm2x<1>(smem, D, [=](int r) { return A + (size_t)r * D; }, [=](int n) { return gu_rowq(Wg, Wu, ntile * 64, n); },
            [=](const f32x16 (&acc)[4][2], int r0, int c0, int) {
              const int wn = c0 >> 6, hh = (c0 >> 2) & 1;
#pragma unroll
              for (int mt = 0; mt < 4; ++mt) {
                bf16_t* dstrow = H + (size_t)(mtile * 256 + r0 + mt * 32) * FF + ntile * 64 + wn * 32 + 8 * hh;
                u32x2 d[4];
#pragma unroll
                for (int gq = 0; gq < 4; ++gq) {
                  f32x4 h;
#pragma unroll
                  for (int i = 0; i < 4; ++i) h[i] = silu(acc[mt][0][4 * gq + i] * (1.f / WQ_SCALE)) * acc[mt][1][4 * gq + i] * (1.f / WQ_SCALE);
                  d[gq] = pk4_bf16(h);
                }
                *(u32x4*)dstrow = pair8(d[0], d[1]); *(u32x4*)(dstrow + 16) = pair8(d[2], d[3]);
              }
            });
}
__device__ __forceinline__ void ph_router_shared_gu(const P& p, char* smem) {
  const int xcd = blockIdx.x & 7, lb = blockIdx.x >> 3, nlb = gridDim.x >> 3;
  if (nlb == 64) {
    if (lb < 48) router_unit(p, smem, xcd * 8 + (lb & 7), lb >> 3);
    else for (int i = lb - 48; i < 32; i += 16) shared_gu_unit(p, smem, xcd * 8 + (i & 7), i >> 3);
  } else {
    gemm2_grid(10, [&](int mtile, int j) { if (j < 6) router_unit(p, smem, mtile, j); else shared_gu_unit(p, smem, mtile, j - 6); });
  }
}
__device__ __forceinline__ void ph_shared_d(const P& p, char* smem) {
  gemm2_grid(8, [&](int mtile, int ntile) {
    const bf16_t* A = p.Hs + (size_t)mtile * 256 * FF; const bf16_t* W = p.Wt_sd + (size_t)ntile * 128 * FF; bf16_t* Y = p.Ys;
    gemm2<1>(smem, FF, [=](int r) { return A + (size_t)r * FF; }, [=](int n) { return W + (size_t)n * FF; },
             [=](const f32x4 (&acc)[8][4], int r0, int c0) {
#pragma unroll
               for (int mt = 0; mt < 8; ++mt)
                 store_row64_bf16(acc[mt][0], acc[mt][1], acc[mt][2], acc[mt][3], (c0 & 63) >> 2, Y + (size_t)(mtile * 256 + r0 + mt * 16) * D + ntile * 128 + (c0 & ~63), true);
             });
  });
}
struct CvtQ { const float* src; unsigned char* dst; int ldn, ldk; };
__device__ __forceinline__ void cvtq_load(const CvtQ& d, f32x4 (&r)[16]) {
#pragma unroll
  for (int i = 0; i < 16; ++i) r[i] = __builtin_nontemporal_load((const f32x4*)(d.src + (size_t)i * d.ldn));
}
__device__ __forceinline__ void cvtq_store(const CvtQ& d, const f32x4 (&r)[16]) {
#pragma unroll
  for (int j = 0; j < 4; ++j) {
    u32x4 v = {pk4_fp8(r[0][j] * WQ_SCALE, r[1][j] * WQ_SCALE, r[2][j] * WQ_SCALE, r[3][j] * WQ_SCALE), pk4_fp8(r[4][j] * WQ_SCALE, r[5][j] * WQ_SCALE, r[6][j] * WQ_SCALE, r[7][j] * WQ_SCALE),
               pk4_fp8(r[8][j] * WQ_SCALE, r[9][j] * WQ_SCALE, r[10][j] * WQ_SCALE, r[11][j] * WQ_SCALE), pk4_fp8(r[12][j] * WQ_SCALE, r[13][j] * WQ_SCALE, r[14][j] * WQ_SCALE, r[15][j] * WQ_SCALE)};
    *(u32x4*)(d.dst + (size_t)j * d.ldk) = v;
  }
}
__device__ __forceinline__ CvtQ cvtq_desc(const float* src, int ldn, unsigned char* dst, int ldk, int k0, int n0) {
  const int kg = threadIdx.x & 7, n = n0 + (threadIdx.x >> 3) * 4;
  CvtQ d; d.src = src + (size_t)(k0 + kg * 16) * ldn + n; d.dst = dst + (size_t)n * ldk + k0 + kg * 16; d.ldn = ldn; d.ldk = ldk; return d;
}
__device__ __forceinline__ void cvtq_tile(const float* src, int ldn, unsigned char* dst, int ldk, int k0, int n0, int nmax = 1 << 30) {
  if (n0 + (int)(threadIdx.x >> 3) * 4 >= nmax) return;
  const CvtQ d = cvtq_desc(src, ldn, dst, ldk, k0, n0); f32x4 r[16]; cvtq_load(d, r); cvtq_store(d, r);
}
__device__ __forceinline__ CvtQ cvt_expert_desc(const P& p, int it) {
  const int e = it / 48, q = it - e * 48;
  if (q < 32) { const int up = q >> 4, qq = q & 15;
    return cvtq_desc((up ? p.w_up : p.w_gate) + (size_t)e * D * FF, FF, (up ? p.Wq_u : p.Wq_g) + (size_t)e * FF * D, D, (qq & 7) * 128, (qq >> 3) * 128);
  }
  const int qq = q - 32;
  return cvtq_desc(p.w_down + (size_t)e * FF * D, D, p.Wq_d + (size_t)e * D * FF, FF, (qq & 1) * 128, (qq >> 1) * 128);
}
__device__ __forceinline__ void cvt_expert_item(const P& p, int it) { const CvtQ d = cvt_expert_desc(p, it); f32x4 r[16]; cvtq_load(d, r); cvtq_store(d, r); }
__device__ __forceinline__ void ph_cvt_experts(const P& p) { WLOOP(w, NE * 48) cvt_expert_item(p, w); }

__device__ __forceinline__ bf16x8 pack8(const f32x16& x, int s) {
  u32x4 r = {pk_bf16(x[8 * s], x[8 * s + 1]), pk_bf16(x[8 * s + 2], x[8 * s + 3]), pk_bf16(x[8 * s + 4], x[8 * s + 5]), pk_bf16(x[8 * s + 6], x[8 * s + 7])};
  return __builtin_bit_cast(bf16x8, r);
}
__device__ __forceinline__ bf16x8 tr_pair(const LAS char* a) {
  const s16x4 lo = __builtin_amdgcn_ds_read_tr16_b64_v4i16((LAS s16x4*)a);
  const s16x4 hi = __builtin_amdgcn_ds_read_tr16_b64_v4i16((LAS s16x4*)(a + 8 * 128));
  return __builtin_shufflevector(lo, hi, 0, 1, 2, 3, 4, 5, 6, 7);
}
__device__ __forceinline__ int next_item(int* ctr, char* smem) {
  volatile int* slot = (volatile int*)(smem + SMEM_BYTES - 16);
  __syncthreads();
  if (threadIdx.x == 0) *slot = atomicAdd(ctr, 1);
  __syncthreads();
  return *slot;
}

__device__ __forceinline__ void compress_item(const P& p, char* smem, int item) {
  const int which = item >> 3, mtile = item & 7;
  const bf16_t* X = which ? p.VC : p.KC; const bf16_t* W1 = which ? p.Wt_c1v : p.Wt_c1k; const bf16_t* Z = p.zrow;
  const float* b1 = p.b1c + which * 128; bf16_t* hid = (bf16_t*)smem;
  gemm2<1>(smem, 2048,
           [=](int r) { const int R = mtile * 256 + r; if (R >= 2040) return Z; const int bg = R / 255, c = R - bg * 255; return X + ((size_t)bg * S + 16 * c) * 64; },
           [=](int n) { return W1 + (size_t)n * 2048; },
           [=](const f32x4 (&acc)[8][4], int r0, int c0) {
             __syncthreads();
#pragma unroll
             for (int nt = 0; nt < 4; ++nt) {
               const f32x4 bv = *(const f32x4*)(b1 + c0 + nt * 16);
#pragma unroll
               for (int mt = 0; mt < 8; ++mt) {
                 float h[4];
#pragma unroll
                 for (int i = 0; i < 4; ++i) { const float a = acc[mt][nt][i] + bv[i]; const float u = 0.7978845608028654f * (a + 0.044715f * a * a * a); h[i] = a - a / (1.f + __expf(2.f * u)); }
                 u32x2 w = {pk_bf16(h[0], h[1]), pk_bf16(h[2], h[3])};
                 *(u32x2*)(hid + (r0 + mt * 16) * 136 + c0 + nt * 16) = w;
               }
             }
           });
  __syncthreads();
  const float* W2 = which ? p.w2_v : p.w2_k;
  const int rl = threadIdx.x >> 3, pt = threadIdx.x & 7;
#pragma unroll 1
  for (int g = 0; g < 8; ++g) {
    const int row = g * 32 + rl, R = mtile * 256 + row;
    float o[8];
#pragma unroll
    for (int d = 0; d < 8; ++d) o[d] = 0.f;
#pragma unroll 2
    for (int n8 = 0; n8 < 16; ++n8) {
      const u32x4 hv4 = *(const u32x4*)(hid + row * 136 + n8 * 8);
#pragma unroll
      for (int k = 0; k < 8; ++k) {
        const float hv = (k & 1) ? __uint_as_float(hv4[k >> 1] & 0xffff0000u) : __uint_as_float(hv4[k >> 1] << 16);
        const f32x4 w0 = *(const f32x4*)(W2 + (n8 * 8 + k) * 64 + pt * 8), w1 = *(const f32x4*)(W2 + (n8 * 8 + k) * 64 + pt * 8 + 4);
        o[0] += hv * w0[0]; o[1] += hv * w0[1]; o[2] += hv * w0[2]; o[3] += hv * w0[3];
        o[4] += hv * w1[0]; o[5] += hv * w1[1]; o[6] += hv * w1[2]; o[7] += hv * w1[3];
      }
    }
    float rs = 1.f;
    if (!which) {
      float ss = 0.f;
#pragma unroll
      for (int d = 0; d < 8; ++d) ss += o[d] * o[d];
      ss += __shfl_xor(ss, 1); ss += __shfl_xor(ss, 2); ss += __shfl_xor(ss, 4);
      rs = rsqrtf(ss * (1.f / 64.f) + EPS);
    }
    if (R < 2040) {
      const int bg = R / 255, c = R - bg * 255;
      bf16_t* orow = (which ? p.vcb : p.kcb) + ((size_t)bg * 256 + c) * 64 + pt * 8;
      float gg[8];
      if (!which) { const f32x4 g0 = *(const f32x4*)(p.g_k_cmp + pt * 8), g1 = *(const f32x4*)(p.g_k_cmp + pt * 8 + 4); gg[0] = g0[0]; gg[1] = g0[1]; gg[2] = g0[2]; gg[3] = g0[3]; gg[4] = g1[0]; gg[5] = g1[1]; gg[6] = g1[2]; gg[7] = g1[3]; }
      else {
#pragma unroll
        for (int k = 0; k < 8; ++k) gg[k] = 1.f;
      }
      u32x4 w = {pk_bf16(o[0] * rs * gg[0], o[1] * rs * gg[1]), pk_bf16(o[2] * rs * gg[2], o[3] * rs * gg[3]), pk_bf16(o[4] * rs * gg[4], o[5] * rs * gg[5]), pk_bf16(o[6] * rs * gg[6], o[7] * rs * gg[7])};
      *(u32x4*)orow = w;
    }
  }
}

template <int MODE, int NSLOT>
__device__ __forceinline__ void nsa_pass(LAS char* kv, const bf16_t* Kg, const bf16_t* Vg, int t_lo, int t_hi, const bf16x8 (&qf)[4], float shf, int si,
                                         unsigned long long selm, f32x16& o0, f32x16& o1, float& l, LAS float* psl  ,
                                         int pos0 = 0, int pstride = 1, int kkmin = 0) {
  const int tid = otid(), lane = tid & 63, wv = __builtin_amdgcn_readfirstlane(tid >> 6), i = lane & 31, h5 = lane >> 5;
  const int ksw = (i >> 1) & 7;
  const int tq = (lane & 15) >> 2, tp = lane & 3, tds = (lane >> 4) & 1, vsw = ((tq >> 1) & 1) << 2;
  const int row_l = lane >> 3, cpos = lane & 7;
  const int kc8 = (cpos ^ ((wv & 1) * 4 + (row_l >> 1))) * 8, vc8 = (cpos ^ (((row_l >> 1) & 1) << 2)) * 8;
  const bf16_t* kgl = Kg + (size_t)(wv * 8 + row_l) * 64 + kc8;
  const bf16_t* vgl = Vg + (size_t)(wv * 8 + row_l) * 64 + vc8;
  auto stage = [&](int t, int buf) {
    LAS char* Ks = kv + buf * 16384 + wv * 1024; LAS char* Vs = Ks + 8192;
#pragma unroll
    for (int q = 0; q < 2; ++q) {
      if (MODE >= 3) {
        int pos = pos0 + pstride * (64 * t + 32 * q + wv * 8 + row_l);
        pos = pos < 0 ? 0 : (pos > S - 1 ? S - 1 : pos);
        __builtin_amdgcn_global_load_lds((const unsigned*)(Kg + (size_t)pos * 64 + kc8), (LAS unsigned*)(Ks + q * 4096), 16, 0, 0);
        __builtin_amdgcn_global_load_lds((const unsigned*)(Vg + (size_t)pos * 64 + vc8), (LAS unsigned*)(Vs + q * 4096), 16, 0, 0);
      } else {
        __builtin_amdgcn_global_load_lds((const unsigned*)(kgl + (size_t)(64 * t + 32 * q) * 64), (LAS unsigned*)(Ks + q * 4096), 16, 0, 0);
        __builtin_amdgcn_global_load_lds((const unsigned*)(vgl + (size_t)(64 * t + 32 * q) * 64), (LAS unsigned*)(Vs + q * 4096), 16, 0, 0);
      }
    }
  };
  float carry = 0.f;
  if (t_lo > t_hi) return;
  float dm16[4] = {0.f, 0.f, 0.f, 0.f}; int dmaxA = 0, dmaxB = 0; const int wq = wv & 3;
  if (MODE == 3) {
#pragma unroll
    for (int rg = 0; rg < 4; ++rg) dm16[rg] = (((wv - h5 - 2 * rg) & 3) == 0) ? 3.f : 2.f;
    dmaxA = si - kkmin < 128 ? si - kkmin : 128;
  }
  if (MODE == 4) { const int lim = si - kkmin; dmaxA = lim < 128 ? lim : 128; dmaxB = lim < 512 ? lim : 512; }
  asm volatile("s_waitcnt vmcnt(0) lgkmcnt(0)" ::: "memory");
  __builtin_amdgcn_s_barrier();
  asm volatile("" ::: "memory");
#pragma unroll
  for (int k = 0; k < NSLOT - 1; ++k) if (t_lo + k <= t_hi) stage(t_lo + k, k);
  for (int t = t_lo; t <= t_hi; ++t) {
    const int buf = (t - t_lo) % NSLOT;
    const int ahead = t_hi - t;
    if (NSLOT == 4 && ahead >= 2) asm volatile("s_waitcnt vmcnt(8)" ::: "memory");
    else if (NSLOT == 4 && ahead == 1) asm volatile("s_waitcnt vmcnt(4)" ::: "memory");
    else asm volatile("s_waitcnt vmcnt(0)" ::: "memory");
    __builtin_amdgcn_s_barrier();
    asm volatile("" ::: "memory");
    if (t + NSLOT - 1 <= t_hi) stage(t + NSLOT - 1, (t + NSLOT - 1 - t_lo) % NSLOT);
    const LAS char* Ks = kv + buf * 16384; const LAS char* Vs = Ks + 8192;
    const bool tsel = MODE == 1 ? ((selm >> t) & 1ull) != 0ull : true;
#pragma unroll
    for (int sub = 0; sub < 2; ++sub) {
      f32x16 sa;
#pragma unroll
      for (int q = 0; q < 16; ++q) sa[q] = 0.f;
      bf16x8 kf[4];
#pragma unroll
      for (int s4 = 0; s4 < 4; ++s4) kf[s4] = *(const LAS bf16x8*)(Ks + (32 * sub + i) * 128 + (((2 * s4 + h5) ^ ksw) << 4));
      __builtin_amdgcn_s_setprio(1);
#pragma unroll
      for (int s4 = 0; s4 < 4; ++s4) sa = MFMA32(kf[s4], qf[s4], sa);
      __builtin_amdgcn_s_setprio(0);
      const int k0 = 64 * t + 32 * sub + 4 * h5;
#pragma unroll
      for (int q = 0; q < 16; ++q) {
        const int kidx = k0 + (q & 3) + 8 * (q >> 2);
        float pv;
        if (MODE >= 3) {
          const int dl = si - kidx;
          const float e = __builtin_amdgcn_exp2f(sa[q] * LOG2E - shf);
          if (MODE == 3) {
            const float cw = (q & 3) ? 1.f : dm16[q >> 2];
            pv = (unsigned)dl <= (unsigned)dmaxA ? cw * e : 0.f;
          } else {
            const bool lo = dl >= 33;
            float cw = (lo && dl <= dmaxA) ? 1.f : 0.f;
            if ((q & 3) == wq) cw += (lo && dl <= dmaxB) ? 1.f : 0.f;
            pv = cw * e;
          }
        } else {
          bool valid;
          if (MODE == 0) valid = 16 * kidx + 31 <= si;
          else if (MODE == 1) valid = tsel && kidx <= si;
          else valid = (unsigned)(si - kidx) <= 511u;
          pv = valid ? __builtin_amdgcn_exp2f(sa[q] * LOG2E - shf) : 0.f;
        }
        l += pv; sa[q] = pv;
      }
      if (MODE == 0) {
#pragma unroll
        for (int rg = 0; rg < 4; ++rg) {
          const float a = 2.f * (sa[4 * rg] + sa[4 * rg + 1] + sa[4 * rg + 2]) + sa[4 * rg + 3];
          const float recv = __shfl_xor(sa[4 * rg + 3], 32);
          const float val = h5 ? a + recv : a + carry;
          carry = recv;
          psl[16 * t + 8 * sub + 2 * rg + h5] = val;
        }
      }
      const bf16x8 pf0 = pack8(sa, 0), pf1 = pack8(sa, 1);
      bf16x8 vf[2][2];
#pragma unroll
      for (int s2 = 0; s2 < 2; ++s2) {
        const LAS char* vb = Vs + (32 * sub + 16 * s2 + 4 * h5 + tq) * 128 + 8 * (tp & 1);
        vf[s2][0] = tr_pair(vb + (((tds * 2 + (tp >> 1)) ^ vsw) << 4));
        vf[s2][1] = tr_pair(vb + (((4 + tds * 2 + (tp >> 1)) ^ vsw) << 4));
      }
      __builtin_amdgcn_s_setprio(1);
#pragma unroll
      for (int s2 = 0; s2 < 2; ++s2) { o0 = MFMA32(vf[s2][0], s2 ? pf1 : pf0, o0); o1 = MFMA32(vf[s2][1], s2 ? pf1 : pf0, o1); }
      __builtin_amdgcn_s_setprio(0);
    }
    __builtin_amdgcn_sched_barrier(0);
  }
}

__device__ __forceinline__ void dilated_item(const P& p, char* smem_, int unit) {
  LAS char* kv = (LAS char*)smem_;
  const int tid = otid(), lane = tid & 63, wv = tid >> 6, i = lane & 31, h5 = lane >> 5;
  const int r4 = unit & 3, ti = (unit >> 2) & 7, hh = (unit >> 5) & 7, b = unit >> 8;
  const size_t hb = (size_t)(b * 8 + hh) * S * 64;
  const int si = ti * 512 + r4 + 4 * wv + 16 * i;
  bf16x8 qf[4];
#pragma unroll
  for (int s4 = 0; s4 < 4; ++s4) qf[s4] = *(const bf16x8*)(p.QA + hb + (size_t)si * 64 + 16 * s4 + 8 * h5);
  f32x16 o0, o1;
#pragma unroll
  for (int q = 0; q < 16; ++q) { o0[q] = 0.f; o1[q] = 0.f; }
  float l = 0.f;
  const float shf = p.smaxv[0] * LOG2E;
  const int pbase = ti * 512 + r4 - 128, ubase = ti * 128 - 512;
  nsa_pass<3, 4>(kv, p.KA + hb, p.VA + hb, 0, 9, qf, shf, 4 * wv + 16 * i + 128, 0ull, o0, o1, l, nullptr, pbase, 1, pbase < 0 ? -pbase : 0);
  nsa_pass<4, 4>(kv, p.KA + hb, p.VA + hb, 0, 9, qf, shf, wv + 4 * i + 512, 0ull, o0, o1, l, nullptr, r4 + 4 * ubase, 4, ubase < 0 ? -ubase : 0);
  l += __shfl_xor(l, 32);
  const float inv = 1.f / l;
  unsigned char* orow = p.mixq + (size_t)(b * S + si) * D + hh * 64 + 4 * h5;
  const float invq = inv * MQ_SCALE;
#pragma unroll
  for (int rg = 0; rg < 4; ++rg) {
    *(unsigned*)(orow + 8 * rg) = pk4_fp8(clamp_e4m3(o0[4 * rg] * invq), clamp_e4m3(o0[4 * rg + 1] * invq), clamp_e4m3(o0[4 * rg + 2] * invq), clamp_e4m3(o0[4 * rg + 3] * invq));
    *(unsigned*)(orow + 32 + 8 * rg) = pk4_fp8(clamp_e4m3(o1[4 * rg] * invq), clamp_e4m3(o1[4 * rg + 1] * invq), clamp_e4m3(o1[4 * rg + 2] * invq), clamp_e4m3(o1[4 * rg + 3] * invq));
  }
}

__device__ __forceinline__ void nsa_item(const P& p, char* smem_, int item) {
  LAS char* smem = (LAS char*)smem_;
  LAS char* kv = smem;
  LAS float* pslcw = (LAS float*)(smem + 32768);
  LAS float* invl = (LAS float*)(smem + 32768 + 33280);
  LAS unsigned* msk = (LAS unsigned*)(smem + 32768 + 33280 + 512);
  const int tid = otid(), lane = tid & 63, wv = tid >> 6, i = lane & 31, h5 = lane >> 5;
  const int qt = 127 - (item >> 3), bg = item & 7, b = bg >> 1, g = bg & 1, hq = g * 4 + wv;
  const int s0 = qt * 32, si = s0 + i, cur = s0 >> 6;
  const size_t qoff = ((size_t)(b * 8 + hq) * S + si) * 64 + 8 * h5;
  bf16x8 qf[4];
#pragma unroll
  for (int s4 = 0; s4 < 4; ++s4) qf[s4] = *(const bf16x8*)(p.QN + qoff + 16 * s4);
  const float* gs = p.GS + (size_t)(b * S + si) * 24 + hq * 3;
  const float g0 = gs[0], g1 = gs[1], g2 = gs[2];
  f32x16 oa0, oa1, o0, o1;
#pragma unroll
  for (int q = 0; q < 16; ++q) { o0[q] = 0.f; o1[q] = 0.f; }
  float l = 0.f;
  LAS float* psl = pslcw + (wv * 32 + i) * 65;
  const int ncv = (s0 + 31 - 31) >> 4;
  const int tc_hi = (ncv < 254 ? ncv : 254) >> 6;
#pragma unroll
  for (int k = 0; k < 32; ++k) psl[2 * k + h5] = 0.f;
  nsa_pass<0, 2>(kv, p.kcb + (size_t)bg * 256 * 64, p.vcb + (size_t)bg * 256 * 64, 0, tc_hi, qf, p.smaxv[1] * LOG2E, si, 0ull, o0, o1, l, psl);
  l += __shfl_xor(l, 32);
  {
    const float il = l > 0.f ? 1.f / l : 0.f;
    if (h5 == 0) invl[wv * 32 + i] = il;
    const float sc = g0 * il;
#pragma unroll
    for (int q = 0; q < 16; ++q) { oa0[q] = o0[q] * sc; oa1[q] = o1[q] * sc; o0[q] = 0.f; o1[q] = 0.f; }
  }
  __syncthreads();
  LAS float* scr = pslcw;
  {
    const int q = tid >> 3, jj = tid & 7;
    float tot[8];
#pragma unroll
    for (int k = 0; k < 8; ++k) {
      const int j = jj + 8 * k;
      float v = 0.f;
#pragma unroll
      for (int w4 = 0; w4 < 4; ++w4) v += pslcw[(w4 * 32 + q) * 65 + j] * invl[w4 * 32 + q];
      const bool forced = (j == 0) || (j == cur) || (j == cur - 1);
      tot[k] = forced ? INFINITY : (j <= cur ? v : -INFINITY);
    }
    __syncthreads();
#pragma unroll
    for (int k = 0; k < 8; ++k) scr[q * 65 + jj + 8 * k] = tot[k];
    if (tid < 64) msk[tid] = 0u;
    __syncthreads();
    unsigned lo = 0u, hi = 0u;
#pragma unroll
    for (int k = 0; k < 8; ++k) {
      const int j = jj + 8 * k; const float v = tot[k];
      int rank = 0;
      for (int c = 0; c < 64; ++c) { const float sv = scr[q * 65 + c]; rank += (sv > v) || (sv == v && c < j); }
      if (rank < 16 && j <= cur) { if (j < 32) lo |= 1u << j; else hi |= 1u << (j - 32); }
    }
    if (lo) atomicOr((unsigned*)&msk[q * 2], lo);
    if (hi) atomicOr((unsigned*)&msk[q * 2 + 1], hi);
    __syncthreads();
  }
  const unsigned long long selm = (unsigned long long)msk[i * 2] | ((unsigned long long)msk[i * 2 + 1] << 32);
#pragma unroll
  for (int s4 = 0; s4 < 4; ++s4) qf[s4] = *(const bf16x8*)(p.QR + qoff + 16 * s4);
  const size_t kvoff = (size_t)bg * S * 64;
  l = 0.f;
  nsa_pass<1, 4>(kv, p.KSL + kvoff, p.VSL + kvoff, 0, cur, qf, p.smaxv[2] * LOG2E, si, selm, o0, o1, l, nullptr);
  l += __shfl_xor(l, 32);
  {
    const float sc = g1 / l;
#pragma unroll
    for (int q = 0; q < 16; ++q) { oa0[q] += o0[q] * sc; oa1[q] += o1[q] * sc; o0[q] = 0.f; o1[q] = 0.f; }
  }
  l = 0.f;
  const int tw_lo = s0 >= 511 ? (s0 - 511) >> 6 : 0;
  nsa_pass<2, 4>(kv, p.KW + kvoff, p.VW + kvoff, tw_lo, cur, qf, p.smaxv[3] * LOG2E, si, 0ull, o0, o1, l, nullptr);
  l += __shfl_xor(l, 32);
  {
    const float sc = g2 / l;
#pragma unroll
    for (int q = 0; q < 16; ++q) { oa0[q] += o0[q] * sc; oa1[q] += o1[q] * sc; }
  }
  unsigned char* orow = p.mixq + (size_t)(b * S + si) * D + 512 + hq * 64 + 4 * h5;
#pragma unroll
  for (int rg = 0; rg < 4; ++rg) {
    *(unsigned*)(orow + 8 * rg) = pk4_fp8(clamp_e4m3(oa0[4 * rg] * MQ_SCALE), clamp_e4m3(oa0[4 * rg + 1] * MQ_SCALE), clamp_e4m3(oa0[4 * rg + 2] * MQ_SCALE), clamp_e4m3(oa0[4 * rg + 3] * MQ_SCALE));
    *(unsigned*)(orow + 32 + 8 * rg) = pk4_fp8(clamp_e4m3(oa1[4 * rg] * MQ_SCALE), clamp_e4m3(oa1[4 * rg + 1] * MQ_SCALE), clamp_e4m3(oa1[4 * rg + 2] * MQ_SCALE), clamp_e4m3(oa1[4 * rg + 3] * MQ_SCALE));
  }
}
__device__ __forceinline__ void cvt_queue_item(const P& p, int ci) {
  f32x4 ra[16], rb[16];
  const CvtQ d0 = cvt_expert_desc(p, ci * 4), d1 = cvt_expert_desc(p, ci * 4 + 1), d2 = cvt_expert_desc(p, ci * 4 + 2), d3 = cvt_expert_desc(p, ci * 4 + 3);
  cvtq_load(d0, ra); cvtq_load(d1, rb);
  cvtq_store(d0, ra); cvtq_load(d2, ra);
  cvtq_store(d1, rb); cvtq_load(d3, rb);
  cvtq_store(d2, ra); cvtq_store(d3, rb);
}
__device__ __forceinline__ void ph_attn_a(const P& p, char* smem) {
  for (;;) {
    const int q = next_item(p.ctr + 0, smem);
    if (q >= 16 + 2560) break;
    if (q < 16) { compress_item(p, smem, q); continue; }
    const int j = q - 16, g = j / 5, r = j - g * 5;
    if (r == 0 || r == 3) dilated_item(p, smem, g * 2 + (r == 3)); else cvt_queue_item(p, g * 3 + (r == 1 ? 0 : (r == 2 ? 1 : 2)));
  }
}
__device__ __forceinline__ void ph_attn_b(const P& p, char* smem) {
  for (;;) {
    const int q = next_item(p.ctr + 1, smem);
    if (q >= 2560) break;
    const int g = q / 5, r = q - g * 5;
    if (r == 0 || r == 3) nsa_item(p, smem, g * 2 + (r == 3)); else cvt_queue_item(p, 1536 + g * 3 + (r == 1 ? 0 : (r == 2 ? 1 : 2)));
  }
}

__device__ __forceinline__ void ph_route(const P& p, char* smem) {
  const int lane = threadIdx.x & 63, wv = threadIdx.x >> 6;
  int* hist = (int*)smem;
  __syncthreads();
  hist[threadIdx.x] = 0;
  __syncthreads();
  const int tpb = T / gridDim.x, t0 = blockIdx.x * tpb;
  float bias[4];
#pragma unroll
  for (int i = 0; i < 4; ++i) bias[i] = p.r_bias[lane + 64 * i];
  for (int tt = wv; tt < tpb; tt += 4) {
    const int t = t0 + tt;
    float aff[4], bv[4], ta[4], tb[4];
#pragma unroll
    for (int i = 0; i < 4; ++i) { { const size_t li = (size_t)t * NE + lane + 64 * i; aff[i] = sigmoidf((p.logits[li] + p.logits[li + (size_t)T * NE]) + p.logits[li + (size_t)2 * T * NE]); } bv[i] = aff[i] + bias[i]; ta[i] = bv[i]; tb[i] = -INFINITY; }
#pragma unroll
    for (int o = 16; o; o >>= 1)
#pragma unroll
      for (int i = 0; i < 4; ++i) {
        const float a2 = __shfl_xor(ta[i], o), b2 = __shfl_xor(tb[i], o);
        const float na = fmaxf(ta[i], a2), nb = fmaxf(fminf(ta[i], a2), fmaxf(tb[i], b2));
        ta[i] = na; tb[i] = nb;
      }
    float gs[8];
#pragma unroll
    for (int i = 0; i < 4; ++i) { const float s2 = ta[i] + tb[i]; gs[2 * i] = __shfl(s2, 0); gs[2 * i + 1] = __shfl(s2, 32); }
    unsigned gmask = 0;
#pragma unroll
    for (int g = 0; g < 8; ++g) {
      int rank = 0;
#pragma unroll
      for (int i = 0; i < 8; ++i) rank += (gs[i] > gs[g]) || (gs[i] == gs[g] && i < g);
      if (rank < 4) gmask |= 1u << g;
    }
#pragma unroll
    for (int i = 0; i < 4; ++i) if (!((gmask >> (2 * i + (lane >> 5))) & 1u)) bv[i] = -INFINITY;
    unsigned key[4];
#pragma unroll
    for (int i = 0; i < 4; ++i) { const unsigned u = __float_as_uint(bv[i]); key[i] = (u & 0x80000000u) ? ~u : (u | 0x80000000u); }
    unsigned thr = 0u;
#pragma unroll 1
    for (int bit = 31; bit >= 0; --bit) {
      const unsigned trial = thr | (1u << bit);
      int c = 0;
#pragma unroll
      for (int i = 0; i < 4; ++i) c += __builtin_popcountll(__ballot(key[i] >= trial));
      if (c >= 8) thr = trial;
    }
    int ngt = 0;
#pragma unroll
    for (int i = 0; i < 4; ++i) ngt += __builtin_popcountll(__ballot(key[i] > thr));
    const int need = 8 - ngt;
    const unsigned long long ltmask = (1ull << lane) - 1ull;
    int eqbefore = 0, selbefore = 0;
    bool sel[4]; int slot[4];
#pragma unroll
    for (int i = 0; i < 4; ++i) {
      const unsigned long long eqm = __ballot(key[i] == thr);
      const bool s = key[i] > thr || (key[i] == thr && eqbefore + __builtin_popcountll(eqm & ltmask) < need);
      eqbefore += __builtin_popcountll(eqm);
      const unsigned long long sm = __ballot(s);
      sel[i] = s; slot[i] = selbefore + __builtin_popcountll(sm & ltmask);
      selbefore += __builtin_popcountll(sm);
    }
    float part = 0.f;
#pragma unroll
    for (int i = 0; i < 4; ++i) part += sel[i] ? aff[i] : 0.f;
    const float ssum = wave_sum(part);
#pragma unroll
    for (int i = 0; i < 4; ++i)
      if (sel[i]) {
        const int e = lane + 64 * i;
        p.eidx[t * 8 + slot[i]] = e;
        p.gates[t * 8 + slot[i]] = aff[i] / ssum * 2.5f;
        p.pos[t * 8 + slot[i]] = atomicAdd(&hist[e], 1);
      }
  }
  __syncthreads();
  p.bhist[(size_t)blockIdx.x * NE + threadIdx.x] = hist[threadIdx.x];
}
__device__ __forceinline__ void ph_fill(const P& p, char* smem) {
  int* soff = (int*)smem;
  int* wsum = soff + 260;
  int* sbase = soff + 272;
  const int tid = threadIdx.x, lane = tid & 63, wv = tid >> 6;
  __syncthreads();
  int c = 0, before = 0;
  for (int bb = 0; bb < (int)gridDim.x; ++bb) { const int v = p.bhist[(size_t)bb * NE + tid]; c += v; before += (bb < (int)blockIdx.x) ? v : 0; }
  int incl = c;
#pragma unroll
  for (int o = 1; o < 64; o <<= 1) { const int v = __shfl_up(incl, o); if (lane >= o) incl += v; }
  if (lane == 63) wsum[wv] = incl;
  __syncthreads();
  int base = 0;
  for (int i = 0; i < wv; ++i) base += wsum[i];
  soff[tid] = base + incl - c;
  sbase[tid] = base + incl - c + before;
  if (tid == 255) soff[256] = base + incl;
  __syncthreads();
  if (blockIdx.x == 0) {
    p.off[tid] = soff[tid]; p.cnt[tid] = c;
    if (tid == 255) p.off[256] = soff[256];
  }
  if (blockIdx.x == 1) {
    const int x = tid >> 5, i = tid & 31, e = x + 8 * i;
    const int tl = (soff[e + 1] - soff[e] + 255) >> 8;
    int inc2 = tl;
#pragma unroll
    for (int o = 1; o < 32; o <<= 1) { const int v = __shfl_up(inc2, o, 32); if (i >= o) inc2 += v; }
    p.tstart[x * 33 + i] = inc2 - tl;
    if (i == 31) p.tstart[x * 33 + 32] = inc2;
  }
  const int tpb = T / gridDim.x, a0 = blockIdx.x * tpb * 8;
  for (int a = a0 + tid; a < a0 + tpb * 8; a += 256) p.sorted[sbase[p.eidx[a]] + p.pos[a]] = a;
}

template <int NTL, class F>
__device__ __forceinline__ void moe_grid(const P& p, F body) {
  const int xcd = blockIdx.x & 7, lb = blockIdx.x >> 3, nlb = gridDim.x >> 3;
  const int* ts = p.tstart + xcd * 33;
  const int total = ts[32] * NTL;
  int i = 0;
  for (int j = lb; j < total; j += nlb) {
    while (ts[i + 1] * NTL <= j) ++i;
    const int tiles = ts[i + 1] - ts[i], rem = j - ts[i] * NTL;
    body(xcd + 8 * i, rem / tiles, rem % tiles);
  }
}
__device__ __forceinline__ const unsigned char* gu_rowq(const unsigned char* Wg, const unsigned char* Wu, int f0, int n) {
  const int wn = n >> 6, wi = n & 63;
  return (wi >= 32 ? Wu : Wg) + (size_t)(f0 + wn * 32 + (wi & 31)) * D;
}
__device__ __forceinline__ void ph_moe_gu(const P& p, char* smem) {
  moe_grid<4>(p, [&](int e, int ntile, int mtile) {
    const int cnt = p.cnt[e] - mtile * 256; const int* srt = p.sorted + p.off[e] + mtile * 256;
    const unsigned char* A = p.h2q; const unsigned char* Wg = p.Wq_g + (size_t)e * FF * D; const unsigned char* Wu = p.Wq_u + (size_t)e * FF * D; unsigned char* H = p.Hq;
    const float* gates = p.gates; const unsigned char* Z = (const unsigned char*)p.zrow;
    gemm2x(smem, D, [=](int r) { return r < cnt ? A + (size_t)(srt[r] >> 3) * D : Z; }, [=](int n) { return gu_rowq(Wg, Wu, ntile * 64, n); },
           [=](const f32x16 (&acc)[4][2], int r0, int c0, int) {
             const int wn = c0 >> 6, hh = (c0 >> 2) & 1;
#pragma unroll
             for (int mt = 0; mt < 4; ++mt) {
               const int r = r0 + mt * 32; const bool ok = r < cnt; const int a = ok ? srt[r] : 0;
               const float sc = ok ? gates[a] * (HQ_SCALE / WQ_SCALE) : 0.f;
               unsigned d[4];
#pragma unroll
               for (int g = 0; g < 4; ++g) {
                 float h[4];
#pragma unroll
                 for (int i = 0; i < 4; ++i) h[i] = clamp_e4m3(silu(acc[mt][0][4 * g + i] * (1.f / WQ_SCALE)) * acc[mt][1][4 * g + i] * sc);
                 d[g] = pk4_fp8(h[0], h[1], h[2], h[3]);
               }
               const u32x2v p01 = __builtin_amdgcn_permlane32_swap(d[0], d[1], false, false), p23 = __builtin_amdgcn_permlane32_swap(d[2], d[3], false, false);
               if (ok) {
                 unsigned char* dst = H + (size_t)a * FF + ntile * 64 + wn * 32 + 8 * hh;
                 *(u32x2*)dst = (u32x2){p01.x, p01.y};
                 *(u32x2*)(dst + 16) = (u32x2){p23.x, p23.y};
               }
             }
           }, 0, cnt <= 128);
  });
}
__device__ __forceinline__ void ph_moe_d(const P& p, char* smem) {
  moe_grid<4>(p, [&](int e, int ntp, int mtile) {
    const int cnt = p.cnt[e] - mtile * 256; const int* srt = p.sorted + p.off[e] + mtile * 256;
    const unsigned char* A = p.Hq; const unsigned char* W = p.Wq_d + (size_t)e * D * FF + (size_t)ntp * 256 * FF; unsigned char* Yq = p.Yq; const unsigned char* Z = (const unsigned char*)p.zrow;
    const int tid_ = otid(), lrow = ((tid_ >> 7) & 1) * 128 + (tid_ & 31);
    LAS int* ridt = (LAS int*)((LAS char*)smem + 3 * G2_STAGE);
    __syncthreads();
    ridt[tid_] = tid_ < cnt ? srt[tid_] : -1;
    gemm2x<2>(smem, FF, [=](int r) { return r < cnt ? A + (size_t)srt[r] * FF : Z; }, [=](int n) { return W + (size_t)n * FF; },
           [=](const f32x16 (&acc)[4][2], int r0, int c0, int rp) {
             const int wn64 = c0 & ~63, hh = (c0 >> 2) & 1;
             const float s = YQ_SCALE / (WQ_SCALE * HQ_SCALE);
#pragma unroll
             for (int mt = 0; mt < 4; ++mt) {
               const int rd = ridt[lrow + mt * 32]; const bool ok = rd >= 0;
               unsigned char* dst = Yq + (size_t)rd * D + (ntp * 2 + rp) * 128 + wn64 + 8 * hh;
#pragma unroll
               for (int nt = 0; nt < 2; ++nt) {
                 unsigned d[4];
#pragma unroll
                 for (int g = 0; g < 4; ++g) d[g] = pk4_fp8(clamp_e4m3(acc[mt][nt][4 * g] * s), clamp_e4m3(acc[mt][nt][4 * g + 1] * s), clamp_e4m3(acc[mt][nt][4 * g + 2] * s), clamp_e4m3(acc[mt][nt][4 * g + 3] * s));
                 const u32x2v p01 = __builtin_amdgcn_permlane32_swap(d[0], d[1], false, false), p23 = __builtin_amdgcn_permlane32_swap(d[2], d[3], false, false);
                 if (ok) { *(u32x2*)(dst + nt * 32) = (u32x2){p01.x, p01.y}; *(u32x2*)(dst + nt * 32 + 16) = (u32x2){p23.x, p23.y}; }
               }
               asm volatile("" ::: "memory");
             }
           }, (size_t)128 * FF, cnt <= 128);
  });
}
__device__ __forceinline__ void ph_combine(const P& p) {
  WLOOP(w, T / 4) {
    const int tid_ = otid(), t = w * 4 + (tid_ >> 6), c = (tid_ & 63) * 16, b = t / S;
    float acc[16];
#pragma unroll
    for (int i = 0; i < 16; ++i) acc[i] = 0.f;
#pragma unroll
    for (int k = 0; k < 8; ++k) {
      const u32x4 v = *(const u32x4*)(p.Yq + ((size_t)t * 8 + k) * D + c);
#pragma unroll
      for (int i = 0; i < 4; ++i) {
        const f32x2 lo = __builtin_amdgcn_cvt_pk_f32_fp8((int)v[i], false), hi = __builtin_amdgcn_cvt_pk_f32_fp8((int)v[i], true);
        acc[4 * i] += lo[0]; acc[4 * i + 1] += lo[1]; acc[4 * i + 2] += hi[0]; acc[4 * i + 3] += hi[1];
      }
    }
    const bf16_t* ys = p.Ys + (size_t)t * D + c; const float* gt = p.mod + b * 6 * D + 5 * D + c; const bf16_t* x1 = (const bf16_t*)p.x1 + (size_t)t * D + c; float* o = p.out + (size_t)t * D + c;
#pragma unroll
    for (int h = 0; h < 4; ++h) {
      const u32x2 sv = *(const u32x2*)(ys + 4 * h);
      const float s0 = __uint_as_float(sv.x << 16), s1 = __uint_as_float(sv.x & 0xffff0000u), s2 = __uint_as_float(sv.y << 16), s3 = __uint_as_float(sv.y & 0xffff0000u);
      const u32x2 xq = *(const u32x2*)(x1 + 4 * h);
      const f32x4 xv = {__uint_as_float(xq.x << 16), __uint_as_float(xq.x & 0xffff0000u), __uint_as_float(xq.y << 16), __uint_as_float(xq.y & 0xffff0000u)}, gv = *(const f32x4*)(gt + 4 * h);
      f32x4 r = {xv[0] + gv[0] * (s0 + acc[4 * h] * (1.f / YQ_SCALE)), xv[1] + gv[1] * (s1 + acc[4 * h + 1] * (1.f / YQ_SCALE)),
                 xv[2] + gv[2] * (s2 + acc[4 * h + 2] * (1.f / YQ_SCALE)), xv[3] + gv[3] * (s3 + acc[4 * h + 3] * (1.f / YQ_SCALE))};
      *(f32x4*)(o + 4 * h) = r;
    }
  }
}


#define XB_TMO      128
#define XB_XCNT(j)  (256  + 64 * (j))
#define XB_XSUB(j)  (1280 + 64 * (j))
#define XB_XGEN(j)  (2304 + 64 * (j))
#define XB_TOP      3328
#define XB_TOPGEN   3392
#define XCD_BAR_WORDS 3456
#define XB_SPIN_CAP (1u << 22)
__device__ __forceinline__ unsigned xb_ld(unsigned* p)              { return __hip_atomic_load(p, __ATOMIC_RELAXED, __HIP_MEMORY_SCOPE_AGENT); }
__device__ __forceinline__ unsigned xb_add(unsigned* p, unsigned v) { return __hip_atomic_fetch_add(p, v, __ATOMIC_RELAXED, __HIP_MEMORY_SCOPE_AGENT); }
__device__ __forceinline__ unsigned xb_xcc_id() { return (unsigned)__builtin_amdgcn_s_getreg((3 << 11) | 20) & 0xFu; }
#define XB_SPIN(cond, bar) do { unsigned _sp = 0; while (cond) { __builtin_amdgcn_s_sleep(1); \
    if ((++_sp & 255u) == 0u) { if (xb_ld(&(bar)[XB_TMO])) break; if (_sp > XB_SPIN_CAP) { atomicAdd(&(bar)[XB_TMO], 1u); break; } } } } while (0)
struct XcdBarrier { unsigned* bar; unsigned x; volatile LAS unsigned* st; };
__device__ __forceinline__ XcdBarrier xcd_barrier_post(unsigned* bar, volatile LAS unsigned* st) {
  XcdBarrier b; b.bar = bar; b.x = xb_xcc_id(); b.st = st;
  if (threadIdx.x == 0) (void)xb_add(&bar[XB_XCNT(b.x)], 1u);
  return b;
}
__device__ __forceinline__ void xcd_barrier_complete(unsigned* bar, unsigned x, unsigned& nloc, unsigned& nx) {
  const unsigned G = gridDim.x * gridDim.y * gridDim.z;
  unsigned sum, cnt, mine, sp = 0u;
  for (;;) {
    sum = 0u; cnt = 0u; mine = 0u;
#pragma unroll
    for (unsigned j = 0; j < 16; ++j) { const unsigned c = xb_ld(&bar[XB_XCNT(j)]); sum += c; cnt += (c > 0u) ? 1u : 0u; mine = (j == x) ? c : mine; }
    if (sum == G) break;
    __builtin_amdgcn_s_sleep(1);
    if ((++sp & 255u) == 0u) { if (xb_ld(&bar[XB_TMO])) break; if (sp > XB_SPIN_CAP) { atomicAdd(&bar[XB_TMO], 1u); break; } }
  }
  nloc = mine > 0u ? mine : 1u; nx = cnt > 0u ? cnt : 1u;
}
__device__ __forceinline__ void xcd_barrier(const XcdBarrier& b) {
  asm volatile("s_waitcnt vmcnt(0)" ::: "memory");
  __syncthreads();
  if (threadIdx.x == 0) {
    unsigned* bar = b.bar;
    __builtin_amdgcn_s_waitcnt(0);
    unsigned nloc = b.st[0], nx = b.st[1];
    if (nloc == 0u) { xcd_barrier_complete(bar, b.x, nloc, nx); b.st[0] = nloc; b.st[1] = nx; }
    const unsigned old = xb_add(&bar[XB_XSUB(b.x)], 1u);
    const unsigned gen = old / nloc;
    if (old + 1u == (gen + 1u) * nloc) {
      __builtin_amdgcn_fence(__ATOMIC_RELEASE, "agent");
      asm volatile("s_waitcnt vmcnt(0)" ::: "memory");
      const unsigned og = xb_add(&bar[XB_TOP], 1u);
      const unsigned tg = og / nx;
      if (og + 1u == (tg + 1u) * nx) xb_add(&bar[XB_TOPGEN], 1u);
      else XB_SPIN(xb_ld(&bar[XB_TOPGEN]) == tg, bar);
      __builtin_amdgcn_fence(__ATOMIC_ACQUIRE, "agent");
      xb_add(&bar[XB_XGEN(b.x)], 1u);
      asm volatile("s_waitcnt vmcnt(0)" ::: "memory");
    } else {
      XB_SPIN(xb_ld(&bar[XB_XGEN(b.x)]) == gen, bar);
      __builtin_amdgcn_fence(__ATOMIC_ACQUIRE, "agent");
      asm volatile("s_waitcnt vmcnt(0)" ::: "memory");
    }
  }
  __syncthreads();
}

__global__ void __launch_bounds__(256, 2) mega(P p) {
  extern __shared__ __attribute__((aligned(16))) char smem[];
  {
    volatile LAS unsigned* st0 = (volatile LAS unsigned*)((LAS char*)smem + SMEM_BYTES - 32);
    if (threadIdx.x == 0) { st0[0] = 0u; st0[1] = 0u; }
    __syncthreads();
  }
  const XcdBarrier xb = xcd_barrier_post(p.bar, (volatile LAS unsigned*)((LAS char*)smem + SMEM_BYTES - 32));
  ph_ada(p, smem); ph_rope_tab(p);
  { int ib = 0;
    for (int it = (int)blockIdx.x; it < 8 * 23; it += gridDim.x) cvtq_tile(p.w_in, INC, p.Wq_in, D, (it & 7) * 128, (it >> 3) * 128, INC);
    ib = (8 * 23) % gridDim.x; for (int it = (int)blockIdx.x - ib; it < 64; it += gridDim.x) if (it >= 0) cvtq_tile(p.w_out, D, p.Wq_out, D, (it & 7) * 128, (it >> 3) * 128);
    ib = (ib + 64) % gridDim.x;
    cvt_matrix<false>(p.w_router, p.Wt_rth, D, NE, ib); cvt_matrix<true>(p.w_router, p.Wt_rtl, D, NE, ib);
    cvt_matrix<false>(p.w1_k, p.Wt_c1k, 2048, 128, ib); cvt_matrix<false>(p.w1_v, p.Wt_c1v, 2048, 128, ib);
    for (int it = (int)blockIdx.x - ib; it < 32; it += gridDim.x) if (it >= 0) cvtq_tile(it < 16 ? p.ws_gate : p.ws_up, FF, it < 16 ? p.Wq_sg : p.Wq_su, D, (it & 7) * 128, ((it >> 3) & 1) * 128);
    ib = (ib + 32) % gridDim.x; cvt_matrix<false>(p.ws_down, p.Wt_sd, FF, D, ib); }
  if (blockIdx.x == gridDim.x - 4) { for (int i = threadIdx.x; i < 2048; i += 256) p.zrow[i] = 0; }
  if (blockIdx.x == gridDim.x - 1) {
    const int which = threadIdx.x >> 7, n = threadIdx.x & 127;
    const float* pe = which ? p.pe_v : p.pe_k; const float* w1 = which ? p.w1_v : p.w1_k;
    float a = 0.f;
    for (int k = 0; k < 2048; ++k) a += pe[k] * w1[(size_t)k * 128 + n];
    p.b1c[threadIdx.x] = a;
  }
  if (blockIdx.x == gridDim.x - 2) {
    for (int i = threadIdx.x; i < 8 * 64; i += 256) { p.kcb[((size_t)(i >> 6) * 256 + 255) * 64 + (i & 63)] = 0; p.vcb[((size_t)(i >> 6) * 256 + 255) * 64 + (i & 63)] = 0; }
  }
  if (blockIdx.x == gridDim.x - 3) {
    p.cnt[threadIdx.x] = 0;
    if (threadIdx.x < 8) p.ctr[threadIdx.x] = 0;
    if (threadIdx.x < 64) {
      const int ln = threadIdx.x;
      const float a = wave_max(fabsf(p.g_q_dil[ln])), bq = wave_max(fabsf(p.g_k_dil[ln])), c = wave_max(fabsf(p.g_q_nsa[ln]));
      const float d1 = wave_max(fabsf(p.g_k_cmp[ln])), d2 = wave_max(fabsf(p.g_k_slc[ln])), d3 = wave_max(fabsf(p.g_k_win[ln]));
      if (ln == 0) { p.smaxv[0] = 8.f * a * bq; p.smaxv[1] = 8.f * c * d1; p.smaxv[2] = 8.f * c * d2; p.smaxv[3] = 8.f * c * d3; }
    }
  }
  xcd_barrier(xb);
  ph_norm_mod<false>(p.x, p.g_mix, p.mod, 0, D, nullptr, p.h1q);
  xcd_barrier(xb);
  ph_proj(p, smem);
  xcd_barrier(xb);
  ph_attn_a(p, smem);
  xcd_barrier(xb);
  ph_attn_b(p, smem);
  xcd_barrier(xb);
  ph_outproj(p, smem);
  xcd_barrier(xb);
  if (DUP == 10) { ph_outproj_abl<0>(p, smem); xcd_barrier(xb); }
  if (DUP == 11) { ph_outproj_abl<1>(p, smem); xcd_barrier(xb); }
  if (DUP == 12) { ph_outproj_abl<2>(p, smem); xcd_barrier(xb); }
  if (DUP == 13) { ph_outproj_abl<3>(p, smem); xcd_barrier(xb); }
  ph_norm_mod<true, true>(p.x1, p.g_ffn, p.mod, 3 * D, 4 * D, p.h2s, p.h2q);
  xcd_barrier(xb);
  ph_router_shared_gu(p, smem);
  xcd_barrier(xb);
  ph_route(p, smem); ph_shared_d(p, smem);
  xcd_barrier(xb);
  ph_fill(p, smem);
  xcd_barrier(xb);
  ph_moe_gu(p, smem);
  xcd_barrier(xb);
  ph_moe_d(p, smem);
  xcd_barrier(xb);
  ph_combine(p);
}
}

extern "C" void kernel_launch(void* const* d_in, const int* in_sizes, int n_in, void* d_out, int out_size, void* d_ws, size_t ws_size,
                              hipStream_t stream) {
  P p{};
  const float** f = (const float**)d_in;
  p.x = f[0]; p.c = f[1]; p.w_ada = f[2]; p.b_ada = f[3]; p.g_mix = f[4]; p.g_ffn = f[5]; p.w_in = f[6]; p.g_q_dil = f[7]; p.g_k_dil = f[8];
  p.g_q_nsa = f[9]; p.g_k_cmp = f[10]; p.g_k_slc = f[11]; p.g_k_win = f[12]; p.pe_k = f[13]; p.w1_k = f[14]; p.w2_k = f[15]; p.pe_v = f[16];
  p.w1_v = f[17]; p.w2_v = f[18]; p.w_out = f[19]; p.w_router = f[20]; p.r_bias = f[21]; p.w_gate = f[22]; p.w_up = f[23]; p.w_down = f[24];
  p.ws_gate = f[25]; p.ws_up = f[26]; p.ws_down = f[27];
  p.out = (float*)d_out;
  char* w = (char*)d_ws; size_t o = 0;
  auto alloc = [&](size_t bytes) { void* r = w + o; o += (bytes + 255) & ~(size_t)255; return r; };
  p.mod = (float*)alloc(4 * 6 * D * 4);
  p.rope = (float*)alloc(S * 16 * 4);
  p.selmask = (unsigned long long*)alloc((size_t)T * 2 * 8);
  p.eidx = (int*)alloc(T * 8 * 4); p.gates = (float*)alloc(T * 8 * 4);
  p.cnt = (int*)alloc(NE * 4); p.off = (int*)alloc((NE + 1) * 4); p.pos = (int*)alloc(T * 8 * 4); p.sorted = (int*)alloc(T * 8 * 4);
  p.tstart = (int*)alloc(8 * 33 * 4);
  p.smaxv = (float*)alloc(64);
  p.b1c = (float*)alloc(256 * 4);
  p.ctr = (int*)alloc(64);
  p.kcb = (bf16_t*)alloc(8 * 256 * 64 * 2); p.vcb = (bf16_t*)alloc(8 * 256 * 64 * 2);
  p.GS = (float*)alloc((size_t)T * 24 * 4);
  p.QA = (bf16_t*)alloc((size_t)T * 512 * 2); p.KA = (bf16_t*)alloc((size_t)T * 512 * 2); p.VA = (bf16_t*)alloc((size_t)T * 512 * 2);
  p.QN = (bf16_t*)alloc((size_t)T * 512 * 2); p.QR = (bf16_t*)alloc((size_t)T * 512 * 2);
  p.KC = (bf16_t*)alloc((size_t)T * 128 * 2); p.VC = (bf16_t*)alloc((size_t)T * 128 * 2);
  p.KSL = (bf16_t*)alloc((size_t)T * 128 * 2); p.VSL = (bf16_t*)alloc((size_t)T * 128 * 2);
  p.KW = (bf16_t*)alloc((size_t)T * 128 * 2); p.VW = (bf16_t*)alloc((size_t)T * 128 * 2);
  p.logits = (float*)alloc((size_t)3 * T * NE * 4);
  p.x1 = (float*)alloc((size_t)T * D * 4);
  p.mixinb = (bf16_t*)alloc((size_t)T * D * 2);
  p.h1b = (bf16_t*)alloc((size_t)T * D * 2);
  p.h2s = (bf16_t*)alloc((size_t)T * 2 * D * 2);
  p.Hs = (bf16_t*)alloc((size_t)T * FF * 2);
  p.Ys = (bf16_t*)alloc((size_t)T * D * 2);
  p.bar = (unsigned*)alloc(XCD_BAR_WORDS * 4);
  p.bhist = (int*)alloc((size_t)2048 * NE * 4);
  p.Wt_c1k = (bf16_t*)alloc((size_t)128 * 2048 * 2); p.Wt_c1v = (bf16_t*)alloc((size_t)128 * 2048 * 2);
  p.zrow = (bf16_t*)alloc(2048 * 2);
  p.Wt_in = (bf16_t*)alloc((size_t)2944 * D * 2);
  p.Wt_out = (bf16_t*)alloc((size_t)D * D * 2);
  p.Wt_rth = (bf16_t*)alloc((size_t)NE * D * 2); p.Wt_rtl = (bf16_t*)alloc((size_t)NE * D * 2);
  p.Wt_sg = (bf16_t*)alloc((size_t)FF * D * 2); p.Wt_su = (bf16_t*)alloc((size_t)FF * D * 2); p.Wt_sd = (bf16_t*)alloc((size_t)D * FF * 2);
  p.Wq_g = (unsigned char*)alloc((size_t)NE * FF * D); p.Wq_u = (unsigned char*)alloc((size_t)NE * FF * D); p.Wq_d = (unsigned char*)alloc((size_t)NE * D * FF);
  p.h2q = (unsigned char*)alloc((size_t)T * D); p.h1q = (unsigned char*)alloc((size_t)T * D); p.Wq_in = (unsigned char*)alloc((size_t)2944 * D); p.Hq = (unsigned char*)alloc((size_t)T * 8 * FF);
  p.Yq = (unsigned char*)alloc((size_t)T * 8 * D);
  p.Wq_sg = (unsigned char*)alloc((size_t)FF * D); p.Wq_su = (unsigned char*)alloc((size_t)FF * D);
  p.mixq = (unsigned char*)alloc((size_t)T * D); p.Wq_out = (unsigned char*)alloc((size_t)D * D);
  (void)hipMemsetAsync(p.bar, 0, XCD_BAR_WORDS * 4, stream);
  static int grid_blocks = 0;
  if (!grid_blocks) {
    int dev = 0, cus = 0, per_cu = 0;
    (void)hipGetDevice(&dev);
    (void)hipDeviceGetAttribute(&cus, hipDeviceAttributeMultiprocessorCount, dev);
    (void)hipOccupancyMaxActiveBlocksPerMultiprocessor(&per_cu, mega, 256, SMEM_BYTES);
    if (per_cu > 2) per_cu = 2;
    if (per_cu < 1) per_cu = 1;
    grid_blocks = cus * per_cu;
  }
  void* args[] = {&p};
  hipError_t e = hipLaunchCooperativeKernel((void*)mega, dim3(grid_blocks), dim3(256), args, SMEM_BYTES, stream);
  if (e != hipSuccess) fprintf(stderr, "cooperative launch failed: %s (grid %d)\n", hipGetErrorString(e), grid_blocks);
}
```

```cpp
#include <hip/hip_runtime.h>
#include <hip/hip_cooperative_groups.h>
#include <stdint.h>
#include <cstdio>
namespace cg = cooperative_groups;

namespace {
constexpr int D = 1024, NB = 4, S = 4096, T = NB * S, HD = 64;
constexpr int INC = 2840;
constexpr int C_QA = 0, C_KA = 512, C_VA = 1024, C_QB = 1536, C_KC = 2048, C_VC = 2176, C_KSL = 2304, C_VSL = 2432,
              C_KW = 2560, C_VW = 2688, C_GB = 2816;
constexpr int NC = 255, NE = 256, TOPK = 8, FF = 256;
constexpr float EPS = 1e-6f;
#ifndef DUP
#define DUP 0
#endif
constexpr int SMEM_BYTES = 74 * 1024;
typedef unsigned short bf16_t;
typedef short bf16x8 __attribute__((ext_vector_type(8)));
typedef float f32x4 __attribute__((ext_vector_type(4)));
typedef unsigned u32x4 __attribute__((ext_vector_type(4)));
typedef unsigned u32x2 __attribute__((ext_vector_type(2)));
typedef __bf16 bf2_t __attribute__((ext_vector_type(2)));
typedef float f32x2 __attribute__((ext_vector_type(2)));
typedef float f32x16 __attribute__((ext_vector_type(16)));
typedef short s16x4 __attribute__((ext_vector_type(4)));
#define LAS __attribute__((address_space(3)))
#define MFMA32(a, b, c) __builtin_amdgcn_mfma_f32_32x32x16_bf16((a), (b), (c), 0, 0, 0)
constexpr float LOG2E = 1.4426950408889634f;

struct P {
  const float *x, *c, *w_ada, *b_ada, *g_mix, *g_ffn, *w_in, *g_q_dil, *g_k_dil, *g_q_nsa, *g_k_cmp, *g_k_slc, *g_k_win;
  const float *pe_k, *w1_k, *w2_k, *pe_v, *w1_v, *w2_v, *w_out, *w_router, *r_bias, *w_gate, *w_up, *w_down, *ws_gate, *ws_up, *ws_down;
  float* out;
  float *mod, *rope, *h1, *proj, *qrope, *kcmp, *vcmp, *ocmp, *oslc, *owin, *mixin, *x1, *h2, *logits, *gates, *hs_g, *hs, *shared, *Hbuf;
  unsigned long long* selmask;
  int *eidx, *cnt, *off, *pos, *sorted, *tstart;
  bf16_t *h1b, *h2s, *mixinb, *Hb, *Hs, *Ybuf, *Ys;
  bf16_t *QA, *KA, *VA, *QN, *QR, *KC, *VC, *KSL, *VSL, *KW, *VW;
  float *GS, *smaxv, *b1c;
  bf16_t *kcb, *vcb;
  int* ctr;
  int* bhist;
  unsigned char *h2q, *Hq, *Wq_g, *Wq_u, *Wq_d, *h1q, *Wq_in, *Yq, *mixq, *Wq_out, *Wq_sg, *Wq_su;
  unsigned* bar;
  bf16_t *zrow, *Wt_in, *Wt_out, *Wt_rth, *Wt_rtl, *Wt_sg, *Wt_su, *Wt_sd, *Wt_c1k, *Wt_c1v, *Wt_g, *Wt_u, *Wt_d;
};

#define WLOOP(w, n) for (int w = blockIdx.x; w < (n); w += gridDim.x)

__device__ __forceinline__ int otid() { int t = threadIdx.x; asm volatile("" : "+v"(t)); return t; }
__device__ __forceinline__ unsigned pk_bf16(float lo, float hi) {
  f32x2 v = {lo, hi};
  bf2_t r = __builtin_convertvector(v, bf2_t);
  return __builtin_bit_cast(unsigned, r);
}
__device__ __forceinline__ float clamp_e4m3(float v) { return __builtin_amdgcn_fmed3f(v, -448.f, 448.f); }
__device__ __forceinline__ unsigned pk4_fp8(float a, float b, float c, float d) {
  int t = __builtin_amdgcn_cvt_pk_fp8_f32(a, b, 0, false);
  t = __builtin_amdgcn_cvt_pk_fp8_f32(c, d, t, true);
  return (unsigned)t;
}
constexpr float WQ_SCALE = 64.f, HQ_SCALE = 8.f, YQ_SCALE = 16.f, MQ_SCALE = 16.f;
__device__ __forceinline__ float bf16_to_f32(unsigned short b) { return __uint_as_float((unsigned)b << 16); }
__device__ __forceinline__ float bf16_round(float v) { return __uint_as_float(pk_bf16(v, 0.f) << 16); }
__device__ __forceinline__ float silu(float v) { return v / (1.f + expf(-v)); }
__device__ __forceinline__ float sigmoidf(float v) { return 1.f / (1.f + expf(-v)); }
__device__ __forceinline__ float wave_sum(float v) { for (int o = 32; o; o >>= 1) v += __shfl_xor(v, o); return v; }
__device__ __forceinline__ float wave_max(float v) { for (int o = 32; o; o >>= 1) v = fmaxf(v, __shfl_xor(v, o)); return v; }

__device__ __forceinline__ void ph_ada(const P& p, char* smem) {
  float* sc = (float*)smem;
  f32x4* red = (f32x4*)(smem + 16384);
  bool loaded = false;
  WLOOP(w, 6 * D / 32) {
    const int tid = threadIdx.x, kg = tid >> 3, cl = tid & 7, j0 = w * 32 + cl * 4;
    __syncthreads();
    if (!loaded) { for (int i = tid; i < 4 * D; i += 256) sc[i] = silu(p.c[i]); loaded = true; __syncthreads(); }
    f32x4 acc[4];
#pragma unroll
    for (int b = 0; b < 4; ++b) acc[b] = (f32x4){0.f, 0.f, 0.f, 0.f};
#pragma unroll 8
    for (int it = 0; it < 32; ++it) {
      const int k = kg + 32 * it;
      const f32x4 wv = *(const f32x4*)(p.w_ada + (size_t)k * 6 * D + j0);
#pragma unroll
      for (int b = 0; b < 4; ++b) acc[b] += wv * sc[b * D + k];
    }
#pragma unroll
    for (int b = 0; b < 4; ++b) red[(kg * 8 + cl) * 4 + b] = acc[b];
    __syncthreads();
    if (tid < 128) {
      const int b = tid >> 5, c = tid & 31;
      float s = p.b_ada[w * 32 + c];
      for (int g = 0; g < 32; ++g) s += ((const float*)&red[(g * 8 + (c >> 2)) * 4 + b])[c & 3];
      p.mod[b * 6 * D + w * 32 + c] = s;
    }
  }
}
__device__ __forceinline__ void ph_rope_tab(const P& p) {
  WLOOP(w, S * 8 / 256) {
    int i = w * 256 + threadIdx.x;
    int pos = i >> 3, f = i & 7;
    double ang = (double)pos * pow(500000.0, -(double)f / 8.0);
    p.rope[i * 2] = (float)cos(ang);
    p.rope[i * 2 + 1] = (float)sin(ang);
  }
}
template <bool SPLIT, bool INBF = false>
__device__ __forceinline__ void ph_norm_mod(const float* in, const float* g, const float* mod, int shift_off, int scale_off, bf16_t* out, unsigned char* outq = nullptr) {
  const int lane = threadIdx.x & 63, wv = threadIdx.x >> 6;
  WLOOP(w, T / 4) {
    const int t = w * 4 + wv, b = t / S;
    f32x4 v[4];
    float ss = 0.f;
#pragma unroll
    for (int i = 0; i < 4; ++i) {
      if (INBF) { const u32x2 q = *(const u32x2*)((const bf16_t*)in + (size_t)t * D + i * 256 + lane * 4); v[i] = (f32x4){__uint_as_float(q.x << 16), __uint_as_float(q.x & 0xffff0000u), __uint_as_float(q.y << 16), __uint_as_float(q.y & 0xffff0000u)}; }
      else v[i] = *(const f32x4*)(in + (size_t)t * D + i * 256 + lane * 4);
      ss += v[i][0] * v[i][0] + v[i][1] * v[i][1] + v[i][2] * v[i][2] + v[i][3] * v[i][3]; }
    ss = wave_sum(ss);
    const float r = rsqrtf(ss * (1.f / D) + EPS);
    const int ld = SPLIT ? 2 * D : D;
#pragma unroll
    for (int i = 0; i < 4; ++i) {
      const int d = i * 256 + lane * 4;
      const f32x4 gg = *(const f32x4*)(g + d), sc = *(const f32x4*)(mod + b * 6 * D + scale_off + d), sh = *(const f32x4*)(mod + b * 6 * D + shift_off + d);
      const f32x4 o = v[i] * r * gg * (sc + 1.f) + sh;
      u32x2 hi = {pk_bf16(o[0], o[1]), pk_bf16(o[2], o[3])};
      if (out) *(u32x2*)(out + (size_t)t * ld + d) = hi;
      if (!SPLIT && outq) *(unsigned*)(outq + (size_t)t * D + d) = pk4_fp8(o[0], o[1], o[2], o[3]);
      if (SPLIT) {
        *(unsigned*)(outq + (size_t)t * D + d) = pk4_fp8(o[0], o[1], o[2], o[3]);
        const float l0 = o[0] - __uint_as_float(hi.x << 16), l1 = o[1] - __uint_as_float(hi.x & 0xffff0000u);
        const float l2 = o[2] - __uint_as_float(hi.y << 16), l3 = o[3] - __uint_as_float(hi.y & 0xffff0000u);
        u32x2 lo = {pk_bf16(l0, l1), pk_bf16(l2, l3)};
        *(u32x2*)(out + (size_t)t * ld + D + d) = lo;
      }
    }
  }
}

template <bool SPLIT3, class AF, class BF, class EF>
__device__ __forceinline__ void gemm128(char* smem, int K, int ldb, AF arow, BF bcol, EF epi) {
  const int tid = otid(), lane = tid & 63, wid = tid >> 6, wm = wid >> 1, wn = wid & 1;
  const int l15 = lane & 15, l4 = lane >> 4;
  char* As = smem; char* Bs = smem + 16384;
  const int ac = tid & 7, ar0 = tid >> 3;
  const bf16_t* ap[4];
#pragma unroll
  for (int i = 0; i < 4; ++i) ap[i] = arow(ar0 + 32 * i);
  const int kg = tid >> 5, ng = tid & 31;
  const float* bp = bcol(ng * 4);
  if (bp) bp += (size_t)(kg * 8) * ldb;
  u32x4 areg[4]; f32x4 breg[8];
  const int nk1 = K / 64, nk = SPLIT3 ? 3 * nk1 : nk1;
  auto gload = [&](int kt) {
    const int seg = SPLIT3 ? kt / nk1 : 0, k0 = (SPLIT3 ? kt % nk1 : kt) * 64;
    const int aoff = (seg == 2 ? K : 0) + k0 + ac * 8;
#pragma unroll
    for (int i = 0; i < 4; ++i) areg[i] = ap[i] ? *(const u32x4*)(ap[i] + aoff) : (u32x4){0u, 0u, 0u, 0u};
#pragma unroll
    for (int i = 0; i < 8; ++i) breg[i] = bp ? *(const f32x4*)(bp + (size_t)(k0 + i) * ldb) : (f32x4){0.f, 0.f, 0.f, 0.f};
    if (SPLIT3 && seg == 1) {
#pragma unroll
      for (int i = 0; i < 8; ++i)
#pragma unroll
        for (int j = 0; j < 4; ++j) breg[i][j] = breg[i][j] - bf16_round(breg[i][j]);
    }
  };
  auto lstore = [&]() {
#pragma unroll
    for (int i = 0; i < 4; ++i) { const int r = ar0 + 32 * i; *(u32x4*)(As + r * 128 + ((ac ^ ((r >> 1) & 7)) << 4)) = areg[i]; }
#pragma unroll
    for (int j = 0; j < 4; ++j) {
      const int n = ng * 4 + j;
      u32x4 v = {pk_bf16(breg[0][j], breg[1][j]), pk_bf16(breg[2][j], breg[3][j]), pk_bf16(breg[4][j], breg[5][j]), pk_bf16(breg[6][j], breg[7][j])};
      *(u32x4*)(Bs + n * 128 + ((kg ^ ((n >> 1) & 7)) << 4)) = v;
    }
  };
  f32x4 acc[4][4];
#pragma unroll
  for (int i = 0; i < 4; ++i)
#pragma unroll
    for (int j = 0; j < 4; ++j) acc[i][j] = (f32x4){0.f, 0.f, 0.f, 0.f};
  gload(0);
  const int sw = l15 >> 1;
  for (int kt = 0; kt < nk; ++kt) {
    __syncthreads();
    lstore();
    __syncthreads();
    if (kt + 1 < nk) gload(kt + 1);
#pragma unroll
    for (int ks = 0; ks < 2; ++ks) {
      const int coff = ((ks * 4 + l4) ^ sw) << 4;
      bf16x8 af[4], bfr[4];
#pragma unroll
      for (int mt = 0; mt < 4; ++mt) af[mt] = *(const bf16x8*)(As + (wm * 64 + mt * 16 + l15) * 128 + coff);
#pragma unroll
      for (int nt = 0; nt < 4; ++nt) bfr[nt] = *(const bf16x8*)(Bs + (wn * 64 + nt * 16 + l15) * 128 + coff);
#pragma unroll
      for (int mt = 0; mt < 4; ++mt)
#pragma unroll
        for (int nt = 0; nt < 4; ++nt) acc[mt][nt] = __builtin_amdgcn_mfma_f32_16x16x32_bf16(bfr[nt], af[mt], acc[mt][nt], 0, 0, 0);
    }
  }
  epi(acc, wm * 64 + l15, wn * 64 + l4 * 4);
}

typedef unsigned u32x2v __attribute__((ext_vector_type(2)));
__device__ __forceinline__ void xpose4(unsigned (&d)[4][2], int) {
#pragma unroll
  for (int a = 0; a < 2; ++a)
#pragma unroll
    for (int h = 0; h < 2; ++h) { const u32x2v r = __builtin_amdgcn_permlane16_swap(d[2 * a][h], d[2 * a + 1][h], false, false); d[2 * a][h] = r.x; d[2 * a + 1][h] = r.y; }
#pragma unroll
  for (int j = 0; j < 2; ++j)
#pragma unroll
    for (int h = 0; h < 2; ++h) { const u32x2v r = __builtin_amdgcn_permlane32_swap(d[j][h], d[2 + j][h], false, false); d[j][h] = r.x; d[2 + j][h] = r.y; }
}
__device__ __forceinline__ void store_row64_bf16(const f32x4& a0, const f32x4& a1, const f32x4& a2, const f32x4& a3, int l4, bf16_t* rowp, bool doit) {
  unsigned d[4][2] = {{pk_bf16(a0[0], a0[1]), pk_bf16(a0[2], a0[3])}, {pk_bf16(a1[0], a1[1]), pk_bf16(a1[2], a1[3])},
                      {pk_bf16(a2[0], a2[1]), pk_bf16(a2[2], a2[3])}, {pk_bf16(a3[0], a3[1]), pk_bf16(a3[2], a3[3])}};
  xpose4(d, l4);
  if (doit) {
    *(u32x4*)(rowp + 16 * l4) = (u32x4){d[0][0], d[0][1], d[1][0], d[1][1]};
    *(u32x4*)(rowp + 16 * l4 + 8) = (u32x4){d[2][0], d[2][1], d[3][0], d[3][1]};
  }
}

template <bool LO>
__device__ __forceinline__ void cvt_kn_tile(const float* src, int ldn, bf16_t* dst, int ldk, int k0, int n0, int nmax) {
  const int tid = threadIdx.x, kg = tid & 7, ng = tid >> 3, n = n0 + ng * 4;
  if (n >= nmax) return;
  f32x4 r[8];
#pragma unroll
  for (int i = 0; i < 8; ++i) r[i] = *(const f32x4*)(src + (size_t)(k0 + kg * 8 + i) * ldn + n);
  if (LO) {
#pragma unroll
    for (int i = 0; i < 8; ++i)
#pragma unroll
      for (int j = 0; j < 4; ++j) r[i][j] = r[i][j] - bf16_round(r[i][j]);
  }
#pragma unroll
  for (int j = 0; j < 4; ++j) {
    u32x4 v = {pk_bf16(r[0][j], r[1][j]), pk_bf16(r[2][j], r[3][j]), pk_bf16(r[4][j], r[5][j]), pk_bf16(r[6][j], r[7][j])};
    *(u32x4*)(dst + (size_t)(n + j) * ldk + k0 + kg * 8) = v;
  }
}
template <bool LO>
__device__ __forceinline__ void cvt_matrix(const float* src, bf16_t* dst, int K, int N, int& item_base) {
  const int nkt = K / 64, nnt = (N + 127) / 128, total = nkt * nnt;
  for (int it = (int)blockIdx.x - item_base; it < total; it += gridDim.x) {
    if (it < 0) continue;
    cvt_kn_tile<LO>(src, N, dst, K, (it % nkt) * 64, (it / nkt) * 128, N);
  }
  item_base = (item_base + total) % gridDim.x;
}

constexpr int G2_STAGE = 24576;
template <int NSEG, int AB = 0, class AF, class BF, class EF>
__device__ __forceinline__ void gemm2(char* smem_, int K, AF arow, BF brow, EF epi, int aseg1 = 0, int bseg1 = 0, int aseg2 = 0, int bseg2 = 0) {
  LAS char* smem = (LAS char*)smem_;
  const int tid = otid(), lane = tid & 63, wv = __builtin_amdgcn_readfirstlane(tid >> 6), wm = wv >> 1, wn = wv & 1;
  const int l15 = lane & 15, l4 = lane >> 4;
  const int row_l = lane >> 2, csrc = ((lane & 3) ^ (((row_l >> 3) & 1) * 3)) * 8;
  const bf16_t* ap[4]; const bf16_t* bp[2];
#pragma unroll
  for (int j = 0; j < 4; ++j) ap[j] = arow((wv + 4 * j) * 16 + row_l) + csrc;
#pragma unroll
  for (int j = 0; j < 2; ++j) bp[j] = brow((wv + 4 * j) * 16 + row_l) + csrc;
  const int nk1 = K / 32, nk = NSEG * nk1;
  auto issue = [&](int kt) {
    LAS char* st = smem + (kt % 3) * G2_STAGE;
    int ka = kt * 32, kb = kt * 32;
    if (NSEG > 1) { const int seg = kt / nk1, kk = (kt - seg * nk1) * 32; ka = kk + (seg == 1 ? aseg1 : (seg == 2 ? aseg2 : 0)); kb = kk + (seg == 1 ? bseg1 : (seg == 2 ? bseg2 : 0)); }
#pragma unroll
    for (int j = 0; j < 4; ++j) __builtin_amdgcn_global_load_lds((const unsigned*)(ap[j] + ka), (LAS unsigned*)(st + (wv + 4 * j) * 1024), 16, 0, 0);
#pragma unroll
    for (int j = 0; j < 2; ++j) __builtin_amdgcn_global_load_lds((const unsigned*)(bp[j] + kb), (LAS unsigned*)(st + 16384 + (wv + 4 * j) * 1024), 16, 0, 0);
  };
  f32x4 acc[8][4];
#pragma unroll
  for (int i = 0; i < 8; ++i)
#pragma unroll
    for (int j = 0; j < 4; ++j) acc[i][j] = (f32x4){0.f, 0.f, 0.f, 0.f};
  const int coff = (l4 ^ (((l15 >> 3) & 1) * 3)) << 4;
  const int aoff = (wm * 128 + l15) * 64 + coff, boff = 16384 + (wn * 64 + l15) * 64 + coff;
  asm volatile("s_waitcnt lgkmcnt(0)" ::: "memory");
  __builtin_amdgcn_s_barrier();
  asm volatile("" ::: "memory");
  issue(0);
  if (nk > 1) issue(1);
  for (int kt = 0; kt < nk; ++kt) {
    if (kt + 1 < nk) asm volatile("s_waitcnt vmcnt(6)" ::: "memory"); else asm volatile("s_waitcnt vmcnt(0)" ::: "memory");
    __builtin_amdgcn_s_barrier();
    asm volatile("" ::: "memory");
    if (AB != 2 && kt + 2 < nk) issue(kt + 2);
    const LAS char* st = smem + (kt % 3) * G2_STAGE;
    bf16x8 bfr[4], af[8];
    if (AB != 3) {
#pragma unroll
    for (int nt = 0; nt < 4; ++nt) bfr[nt] = *(const LAS bf16x8*)(st + boff + nt * 1024);
#pragma unroll
    for (int mt = 0; mt < 8; ++mt) af[mt] = *(const LAS bf16x8*)(st + aoff + mt * 1024);
    }
    __builtin_amdgcn_sched_barrier(0);
    if (AB == 1) {
#pragma unroll
      for (int nt = 0; nt < 4; ++nt) asm volatile("" :: "v"(bfr[nt]));
#pragma unroll
      for (int mt = 0; mt < 8; ++mt) asm volatile("" :: "v"(af[mt]));
    }
    if (AB == 0 || AB == 2) {
    __builtin_amdgcn_s_setprio(1);
#pragma unroll
    for (int mt = 0; mt < 8; ++mt)
#pragma unroll
      for (int nt = 0; nt < 4; ++nt) acc[mt][nt] = __builtin_amdgcn_mfma_f32_16x16x32_bf16(bfr[nt], af[mt], acc[mt][nt], 0, 0, 0);
    __builtin_amdgcn_s_setprio(0);
    }
    __builtin_amdgcn_sched_barrier(0);
  }
  epi(acc, wm * 128 + l15, wn * 64 + l4 * 4);
}

template <int NREP = 1, class AF, class BF, class EF>
__device__ __forceinline__ void gemm2q(char* smem_, int K, AF arow, BF brow, EF epi, size_t bstep = 0, bool half = false) {
  LAS char* smem = (LAS char*)smem_;
  const int tid = otid(), lane = tid & 63, wv = __builtin_amdgcn_readfirstlane(tid >> 6), wm = wv >> 1, wn = wv & 1;
  const int l15 = lane & 15, l4 = lane >> 4;
  const int row_l = lane >> 2, csrc = ((lane & 3) ^ ((row_l >> 2) & 3)) * 16;
  const unsigned char* ap[4]; const unsigned char* bp[2];
#pragma unroll
  for (int j = 0; j < 4; ++j) ap[j] = arow((wv + 4 * j) * 16 + row_l) + csrc;
#pragma unroll
  for (int j = 0; j < 2; ++j) bp[j] = brow((wv + 4 * j) * 16 + row_l) + csrc;
  const int nk1 = K / 64, nk = nk1 * NREP;
  auto issue = [&](int kt) {
    LAS char* st = smem + (kt % 3) * G2_STAGE;
    const int rp = NREP > 1 ? kt / nk1 : 0, kk = NREP > 1 ? kt - rp * nk1 : kt;
#pragma unroll
    for (int j = 0; j < 4; ++j) __builtin_amdgcn_global_load_lds((const unsigned*)(ap[j] + kk * 64), (LAS unsigned*)(st + (wv + 4 * j) * 1024), 16, 0, 0);
#pragma unroll
    for (int j = 0; j < 2; ++j) __builtin_amdgcn_global_load_lds((const unsigned*)(bp[j] + rp * bstep + kk * 64), (LAS unsigned*)(st + 16384 + (wv + 4 * j) * 1024), 16, 0, 0);
  };
  f32x4 acc[8][4];
#pragma unroll
  for (int i = 0; i < 8; ++i)
#pragma unroll
    for (int j = 0; j < 4; ++j) acc[i][j] = (f32x4){0.f, 0.f, 0.f, 0.f};
  const int sw = (l15 >> 2) & 3, sub = (l4 & 1) * 8, ch = l4 >> 1;
  const int aoff = (wm * 128 + l15) * 64 + sub, boff = 16384 + (wn * 64 + l15) * 64 + sub;
  asm volatile("s_waitcnt lgkmcnt(0)" ::: "memory");
  __builtin_amdgcn_s_barrier();
  asm volatile("" ::: "memory");
  issue(0);
  if (nk > 1) issue(1);
  for (int kt = 0; kt < nk; ++kt) {
    if (kt + 1 < nk) asm volatile("s_waitcnt vmcnt(6)" ::: "memory"); else asm volatile("s_waitcnt vmcnt(0)" ::: "memory");
    __builtin_amdgcn_s_barrier();
    asm volatile("" ::: "memory");
    if (kt + 2 < nk) issue(kt + 2);
    const LAS char* st = smem + (kt % 3) * G2_STAGE;
    if (!(half && wm == 1))
#pragma unroll
    for (int ks = 0; ks < 2; ++ks) {
      const int coff = ((2 * ks + ch) ^ sw) << 4;
      long bfr[4], af[8];
#pragma unroll
      for (int nt = 0; nt < 4; ++nt) bfr[nt] = *(const LAS long*)(st + boff + nt * 1024 + coff);
#pragma unroll
      for (int mt = 0; mt < 8; ++mt) af[mt] = *(const LAS long*)(st + aoff + mt * 1024 + coff);
      __builtin_amdgcn_s_setprio(1);
#pragma unroll
      for (int mt = 0; mt < 8; ++mt)
#pragma unroll
        for (int nt = 0; nt < 4; ++nt) acc[mt][nt] = __builtin_amdgcn_mfma_f32_16x16x32_fp8_fp8(bfr[nt], af[mt], acc[mt][nt], 0, 0, 0);
      __builtin_amdgcn_s_setprio(0);
    }
    __builtin_amdgcn_sched_barrier(0);
    if (NREP > 1 && (kt + 1) % nk1 == 0 && kt + 1 < nk) {
      epi(acc, wm * 128 + l15, wn * 64 + l4 * 4, kt / nk1);
#pragma unroll
      for (int i = 0; i < 8; ++i)
#pragma unroll
        for (int j = 0; j < 4; ++j) acc[i][j] = (f32x4){0.f, 0.f, 0.f, 0.f};
    }
  }
  epi(acc, wm * 128 + l15, wn * 64 + l4 * 4, NREP - 1);
}


typedef int i32x8 __attribute__((ext_vector_type(8)));
typedef float f32x16 __attribute__((ext_vector_type(16)));
template <int NREP = 1, class AF, class BF, class EF>
__device__ __forceinline__ void gemm2x(char* smem_, int K, AF arow, BF brow, EF epi, size_t bstep = 0, bool half = false, bool dual = false) {
  LAS char* smem = (LAS char*)smem_;
  const int tid = otid(), lane = tid & 63, wv = __builtin_amdgcn_readfirstlane(tid >> 6), wm = wv >> 1, wn = wv & 1;
  const int l31 = lane & 31, hh = lane >> 5;
  const int row_l = lane >> 2, csrc = ((lane & 3) ^ ((row_l >> 1) & 3)) * 16;
  const unsigned char* ap[4]; const unsigned char* bp[2];
#pragma unroll
  for (int j = 0; j < 4; ++j) ap[j] = arow((wv + 4 * j) * 16 + row_l) + csrc;
#pragma unroll
  for (int j = 0; j < 2; ++j) bp[j] = brow((wv + 4 * j) * 16 + row_l) + csrc;
  const int nk1 = K / 64, nk = nk1 * NREP;
  const size_t astep = dual ? bstep : 0;
  auto issue = [&](int kt) {
    LAS char* st = smem + (kt % 3) * G2_STAGE;
    const int rp = NREP > 1 ? kt / nk1 : 0, kk = NREP > 1 ? kt - rp * nk1 : kt;
#pragma unroll
    for (int j = 0; j < 4; ++j) __builtin_amdgcn_global_load_lds((const unsigned*)(ap[j] + (j >= 2 ? rp * astep : 0) + kk * 64), (LAS unsigned*)(st + (wv + 4 * j) * 1024), 16, 0, 0);
#pragma unroll
    for (int j = 0; j < 2; ++j) __builtin_amdgcn_global_load_lds((const unsigned*)(bp[j] + rp * bstep + kk * 64), (LAS unsigned*)(st + 16384 + (wv + 4 * j) * 1024), 16, 0, 0);
  };
  f32x16 acc[4][2];
#pragma unroll
  for (int i = 0; i < 4; ++i)
#pragma unroll
    for (int j = 0; j < 2; ++j)
#pragma unroll
      for (int e = 0; e < 16; ++e) acc[i][j][e] = 0.f;
  const int sw = (l31 >> 1) & 3, c0 = ((2 * hh) ^ sw) << 4, c1 = c0 ^ 16;
  const int arow0 = dual ? 0 : wm * 128, ecol = wn * 64 + 4 * hh + ((dual && wm) ? 128 : 0);
  const int aoff = (arow0 + l31) * 64, boff = (dual && wm) ? (128 + wn * 64 + l31) * 64 : 16384 + (wn * 64 + l31) * 64;
  asm volatile("s_waitcnt lgkmcnt(0)" ::: "memory");
  __builtin_amdgcn_s_barrier();
  asm volatile("" ::: "memory");
  issue(0);
  if (nk > 1) issue(1);
#pragma unroll 1
  for (int kt = 0; kt < nk; ++kt) {
    if (kt + 1 < nk) asm volatile("s_waitcnt vmcnt(6)" ::: "memory"); else asm volatile("s_waitcnt vmcnt(0)" ::: "memory");
    __builtin_amdgcn_s_barrier();
    asm volatile("" ::: "memory");
    if (kt + 2 < nk) issue(kt + 2);
    const LAS char* st = smem + (kt % 3) * G2_STAGE;
    if (!(half && wm == 1)) {
      i32x8 bfr[2], af[4];
#pragma unroll
      for (int nt = 0; nt < 2; ++nt) {
        const u32x4 lo = *(const LAS u32x4*)(st + boff + nt * 2048 + c0), hi = *(const LAS u32x4*)(st + boff + nt * 2048 + c1);
        bfr[nt] = (i32x8){(int)lo.x, (int)lo.y, (int)lo.z, (int)lo.w, (int)hi.x, (int)hi.y, (int)hi.z, (int)hi.w};
      }
#pragma unroll
      for (int mt = 0; mt < 4; ++mt) {
        const u32x4 lo = *(const LAS u32x4*)(st + aoff + mt * 2048 + c0), hi = *(const LAS u32x4*)(st + aoff + mt * 2048 + c1);
        af[mt] = (i32x8){(int)lo.x, (int)lo.y, (int)lo.z, (int)lo.w, (int)hi.x, (int)hi.y, (int)hi.z, (int)hi.w};
      }
      __builtin_amdgcn_s_setprio(1);
#pragma unroll
      for (int mt = 0; mt < 4; ++mt)
#pragma unroll
        for (int nt = 0; nt < 2; ++nt)
          acc[mt][nt] = __builtin_amdgcn_mfma_scale_f32_32x32x64_f8f6f4(bfr[nt], af[mt], acc[mt][nt], 0, 0, 0, 0x7F7F7F7F, 0, 0x7F7F7F7F);
      __builtin_amdgcn_s_setprio(0);
    }
    __builtin_amdgcn_sched_barrier(0);
    if (NREP > 1 && (kt + 1) % nk1 == 0 && kt + 1 < nk) {
      epi(acc, arow0 + l31, ecol, kt / nk1);
#pragma unroll
      for (int i = 0; i < 4; ++i)
#pragma unroll
        for (int j = 0; j < 2; ++j)
#pragma unroll
          for (int e = 0; e < 16; ++e) acc[i][j][e] = 0.f;
    }
  }
  epi(acc, arow0 + l31, ecol, NREP - 1);
}

template <class F>
__device__ __forceinline__ void gemm2_grid(int NT, F body) {
  const int xcd = blockIdx.x & 7, lb = blockIdx.x >> 3, nlb = gridDim.x >> 3;
  for (int i = lb; i < 8 * NT; i += nlb) body(xcd * 8 + (i & 7), i >> 3);
}

template <class F>
__device__ __forceinline__ void gemm_grid(int NT, F body) {
  const int xcd = blockIdx.x & 7, lb = blockIdx.x >> 3, nlb = gridDim.x >> 3;
  for (int i = lb; i < 16 * NT; i += nlb) {
    const int g = i / (8 * NT), rem = i % (8 * NT), nt = rem >> 3, mi = rem & 7;
    body(xcd * 16 + g * 8 + mi, nt);
  }
}

template <int MT>
__device__ __forceinline__ void proj_epi(const P& p, const f32x4 (&acc)[MT][4], int row_base, int ntile, int r0, int c0, float ascale = 1.f, const float* rope_tile = nullptr) {
  const int wn = c0 >> 6, l4 = (c0 & 63) >> 2;
  const int col0 = ntile * 128 + wn * 64;
  if (col0 >= INC) return;
  if (col0 == C_GB) {
#pragma unroll
    for (int mt = 0; mt < MT; ++mt) {
      const int m = row_base + r0 + mt * 16;
      f32x4 a = acc[mt][0] * ascale, g0 = {sigmoidf(a[0]), sigmoidf(a[1]), sigmoidf(a[2]), sigmoidf(a[3])};
      *(f32x4*)(p.GS + (size_t)m * 24 + 4 * l4) = g0;
      if (l4 < 2) { a = acc[mt][1] * ascale; f32x4 g1 = {sigmoidf(a[0]), sigmoidf(a[1]), sigmoidf(a[2]), sigmoidf(a[3])}; *(f32x4*)(p.GS + (size_t)m * 24 + 16 + 4 * l4) = g1; }
    }
    return;
  }
  const float* g = nullptr; bf16_t* dst; bf16_t* dst2 = nullptr; int hh, H; float qs = 1.f; bool dorope = false;
  if (col0 < 512) { g = p.g_q_dil; dst = p.QA; hh = col0 >> 6; H = 8; qs = 0.125f; dorope = true; }
  else if (col0 < 1024) { g = p.g_k_dil; dst = p.KA; hh = (col0 - 512) >> 6; H = 8; dorope = true; }
  else if (col0 < 1536) { dst = p.VA; hh = (col0 - 1024) >> 6; H = 8; }
  else if (col0 < 2048) { g = p.g_q_nsa; dst = p.QR; dst2 = p.QN; hh = (col0 - 1536) >> 6; H = 8; qs = 0.125f; dorope = true; }
  else {
    const int idx = (col0 - 2048) >> 6, which = idx >> 1; hh = idx & 1; H = 2;
    if (which == 0) dst = p.KC; else if (which == 1) dst = p.VC;
    else if (which == 2) { dst = p.KSL; g = p.g_k_slc; dorope = true; } else if (which == 3) dst = p.VSL;
    else if (which == 4) { dst = p.KW; g = p.g_k_win; dorope = true; } else dst = p.VW;
  }
  f32x4 gv[4];
  if (g) {
#pragma unroll
    for (int nt = 0; nt < 4; ++nt) gv[nt] = *(const f32x4*)(g + nt * 16 + 4 * l4);
  }
  const int bb = row_base / S;
#pragma unroll
  for (int mt = 0; mt < MT; ++mt) {
    const int m = row_base + r0 + mt * 16, s = m - bb * S;
    f32x4 v[4];
#pragma unroll
    for (int nt = 0; nt < 4; ++nt) v[nt] = acc[mt][nt] * ascale;
    if (g) {
      float ss = 0.f;
#pragma unroll
      for (int nt = 0; nt < 4; ++nt) ss += v[nt][0] * v[nt][0] + v[nt][1] * v[nt][1] + v[nt][2] * v[nt][2] + v[nt][3] * v[nt][3];
      ss += __shfl_xor(ss, 16); ss += __shfl_xor(ss, 32);
      const float r = rsqrtf(ss * (1.f / 64.f) + EPS) * qs;
#pragma unroll
      for (int nt = 0; nt < 4; ++nt) v[nt] = v[nt] * gv[nt] * r;
    }
    f32x4 vr = v[0];
    if (dorope) {
      const float* rp = rope_tile ? rope_tile + ((size_t)(m - row_base) * 8 + 4 * (l4 & 1)) * 2 : p.rope + ((size_t)s * 8 + 4 * (l4 & 1)) * 2;
      const f32x4 ra = *(const f32x4*)rp, rb = *(const f32x4*)(rp + 4);
      const float cs[4] = {ra[0], ra[2], rb[0], rb[2]}, sn[4] = {ra[1], ra[3], rb[1], rb[3]};
#pragma unroll
      for (int i = 0; i < 4; ++i) {
        const float pt = __shfl_xor(v[0][i], 32);
        vr[i] = (l4 < 2) ? (v[0][i] * cs[i] - pt * sn[i]) : (v[0][i] * cs[i] + pt * sn[i]);
      }
    }
    bf16_t* row = dst + ((size_t)(bb * H + hh) * S + s) * 64 + 16 * l4;
    unsigned dd[4][2] = {{pk_bf16(vr[0], vr[1]), pk_bf16(vr[2], vr[3])}, {pk_bf16(v[1][0], v[1][1]), pk_bf16(v[1][2], v[1][3])},
                         {pk_bf16(v[2][0], v[2][1]), pk_bf16(v[2][2], v[2][3])}, {pk_bf16(v[3][0], v[3][1]), pk_bf16(v[3][2], v[3][3])}};
    if (dst2) {
      unsigned d2[4][2] = {{pk_bf16(v[0][0], v[0][1]), pk_bf16(v[0][2], v[0][3])}, {dd[1][0], dd[1][1]}, {dd[2][0], dd[2][1]}, {dd[3][0], dd[3][1]}};
      xpose4(d2, l4);
      bf16_t* row2 = dst2 + ((size_t)(bb * H + hh) * S + s) * 64 + 16 * l4;
      *(u32x4*)row2 = (u32x4){d2[0][0], d2[0][1], d2[1][0], d2[1][1]};
      *(u32x4*)(row2 + 8) = (u32x4){d2[2][0], d2[2][1], d2[3][0], d2[3][1]};
    }
    xpose4(dd, l4);
    *(u32x4*)row = (u32x4){dd[0][0], dd[0][1], dd[1][0], dd[1][1]};
    *(u32x4*)(row + 8) = (u32x4){dd[2][0], dd[2][1], dd[3][0], dd[3][1]};
    asm volatile("" ::: "memory");
  }
}
__device__ __forceinline__ u32x4 pair8(u32x2 a, u32x2 b) {
  const u32x2v s1 = __builtin_amdgcn_permlane32_swap(a.x, b.x, false, false), s2 = __builtin_amdgcn_permlane32_swap(a.y, b.y, false, false);
  return (u32x4){s1.x, s2.x, s1.y, s2.y};
}
__device__ __forceinline__ u32x2 pk4_bf16(const f32x4& v) { return (u32x2){pk_bf16(v[0], v[1]), pk_bf16(v[2], v[3])}; }
__device__ __forceinline__ void proj_epi_x(const P& p, const f32x16 (&acc)[4][2], int row_base, int ntile, int r0, int c0, float ascale, const float* rope_tile) {
  const int wn = c0 >> 6, hh = (c0 >> 2) & 1;
  const int col0 = ntile * 128 + wn * 64;
  if (col0 >= INC) return;
  if (col0 == C_GB) {
#pragma unroll
    for (int mt = 0; mt < 4; ++mt) {
      const int m = row_base + r0 + mt * 32;
#pragma unroll
      for (int gq = 0; gq < 3; ++gq) {
        const f32x4 g0 = {sigmoidf(acc[mt][0][4 * gq] * ascale), sigmoidf(acc[mt][0][4 * gq + 1] * ascale), sigmoidf(acc[mt][0][4 * gq + 2] * ascale), sigmoidf(acc[mt][0][4 * gq + 3] * ascale)};
        *(f32x4*)(p.GS + (size_t)m * 24 + 8 * gq + 4 * hh) = g0;
      }
    }
    return;
  }
  const float* g = nullptr; bf16_t* dst; bf16_t* dst2 = nullptr; int hd, H; float qs = 1.f; bool dorope = false;
  if (col0 < 512) { g = p.g_q_dil; dst = p.QA; hd = col0 >> 6; H = 8; qs = 0.125f; dorope = true; }
  else if (col0 < 1024) { g = p.g_k_dil; dst = p.KA; hd = (col0 - 512) >> 6; H = 8; dorope = true; }
  else if (col0 < 1536) { dst = p.VA; hd = (col0 - 1024) >> 6; H = 8; }
  else if (col0 < 2048) { g = p.g_q_nsa; dst = p.QR; dst2 = p.QN; hd = (col0 - 1536) >> 6; H = 8; qs = 0.125f; dorope = true; }
  else {
    const int idx = (col0 - 2048) >> 6, which = idx >> 1; hd = idx & 1; H = 2;
    if (which == 0) dst = p.KC; else if (which == 1) dst = p.VC;
    else if (which == 2) { dst = p.KSL; g = p.g_k_slc; dorope = true; } else if (which == 3) dst = p.VSL;
    else if (which == 4) { dst = p.KW; g = p.g_k_win; dorope = true; } else dst = p.VW;
  }
  f32x4 gv[2][4];
  if (g) {
#pragma unroll
    for (int nt = 0; nt < 2; ++nt)
#pragma unroll
      for (int gq = 0; gq < 4; ++gq) gv[nt][gq] = *(const f32x4*)(g + nt * 32 + 8 * gq + 4 * hh);
  }
  const int bb = row_base / S;
#pragma unroll
  for (int mt = 0; mt < 4; ++mt) {
    const int m = row_base + r0 + mt * 32, s = m - bb * S;
    float r = ascale;
    if (g) {
      float ss = 0.f;
#pragma unroll
      for (int nt = 0; nt < 2; ++nt)
#pragma unroll
        for (int e = 0; e < 16; ++e) ss += acc[mt][nt][e] * acc[mt][nt][e];
      ss += __shfl_xor(ss, 32);
      r = rsqrtf(ss * (ascale * ascale * (1.f / 64.f)) + EPS) * (qs * ascale);
    }
    bf16_t* row = dst + ((size_t)(bb * H + hd) * S + s) * 64 + 8 * hh;
    bf16_t* row2 = dst2 ? dst2 + ((size_t)(bb * H + hd) * S + s) * 64 + 8 * hh : nullptr;
#pragma unroll
    for (int nt = 0; nt < 2; ++nt)
#pragma unroll
      for (int pq = 0; pq < 2; ++pq) {
        f32x4 va = (f32x4){acc[mt][nt][8 * pq], acc[mt][nt][8 * pq + 1], acc[mt][nt][8 * pq + 2], acc[mt][nt][8 * pq + 3]} * r;
        f32x4 vb = (f32x4){acc[mt][nt][8 * pq + 4], acc[mt][nt][8 * pq + 5], acc[mt][nt][8 * pq + 6], acc[mt][nt][8 * pq + 7]} * r;
        if (g) { va = va * gv[nt][2 * pq]; vb = vb * gv[nt][2 * pq + 1]; }
        if (nt == 0 && pq == 0) {
          if (row2) *(u32x4*)row2 = pair8(pk4_bf16(va), pk4_bf16(vb));
          if (dorope) {
            const float* rp = rope_tile + ((size_t)(m - row_base) * 8 + 4 * hh) * 2;
            const f32x4 ra = *(const f32x4*)rp, rb = *(const f32x4*)(rp + 4);
            const float cs[4] = {ra[0], ra[2], rb[0], rb[2]}, sn[4] = {ra[1], ra[3], rb[1], rb[3]};
            const f32x4 x1 = va, x2 = vb;
#pragma unroll
            for (int i = 0; i < 4; ++i) { va[i] = x1[i] * cs[i] - x2[i] * sn[i]; vb[i] = x2[i] * cs[i] + x1[i] * sn[i]; }
          }
          *(u32x4*)row = pair8(pk4_bf16(va), pk4_bf16(vb));
        } else {
          const u32x4 w = pair8(pk4_bf16(va), pk4_bf16(vb));
          *(u32x4*)(row + nt * 32 + pq * 16) = w;
          if (row2) *(u32x4*)(row2 + nt * 32 + pq * 16) = w;
        }
      }
    asm volatile("" ::: "memory");
  }
}
__device__ __forceinline__ void ph_proj(const P& p, char* smem) {
  gemm2_grid(23, [&](int mtile, int ntile) {
    const unsigned char* A = p.h1q + (size_t)mtile * 256 * D; const unsigned char* W = p.Wq_in + (size_t)ntile * 128 * D; const unsigned char* Z = (const unsigned char*)p.zrow;
    const int nvalid = INC - ntile * 128;
    gemm2x<1>(smem, D, [=](int r) { return A + (size_t)r * D; }, [=](int n) { return n < nvalid ? W + (size_t)n * D : Z; },
              [&](const f32x16 (&acc)[4][2], int r0, int c0, int) {
                float* rl = (float*)smem;
                __syncthreads();
                { const int s0 = (mtile * 256) % S; const f32x4* srcp = (const f32x4*)(p.rope + (size_t)s0 * 16);
#pragma unroll
                  for (int i = 0; i < 4; ++i) ((f32x4*)rl)[threadIdx.x + 256 * i] = srcp[threadIdx.x + 256 * i]; }
                __syncthreads();
                proj_epi_x(p, acc, mtile * 256, ntile, r0, c0, 1.f / WQ_SCALE, rl);
              });
  });
}
__device__ __forceinline__ void ph_outproj(const P& p, char* smem) {
  gemm2_grid(8, [&](int mtile, int ntile) {
    const unsigned char* A = p.mixq + (size_t)mtile * 256 * D; const unsigned char* W = p.Wq_out + (size_t)ntile * 128 * D; bf16_t* C = (bf16_t*)p.x1; const float* x = p.x;
    const float* gt = p.mod + ((mtile * 256) / S) * 6 * D + 2 * D;
    gemm2x<1>(smem, D, [=](int r) { return A + (size_t)r * D; }, [=](int n) { return W + (size_t)n * D; },
              [=](const f32x16 (&acc)[4][2], int r0, int c0, int) {
                const int hh = (c0 >> 2) & 1;
                const float s = 1.f / (WQ_SCALE * MQ_SCALE);
#pragma unroll
                for (int mt = 0; mt < 4; ++mt) {
                  const int m = mtile * 256 + r0 + mt * 32;
#pragma unroll
                  for (int nt = 0; nt < 2; ++nt) {
                    u32x2 o[4];
#pragma unroll
                    for (int gq = 0; gq < 4; ++gq) {
                      const int n = ntile * 128 + c0 + nt * 32 + 8 * gq;
                      const f32x4 a = {acc[mt][nt][4 * gq], acc[mt][nt][4 * gq + 1], acc[mt][nt][4 * gq + 2], acc[mt][nt][4 * gq + 3]};
                      o[gq] = pk4_bf16(*(const f32x4*)(x + (size_t)m * D + n) + *(const f32x4*)(gt + n) * (a * s));
                    }
                    bf16_t* crow = C + (size_t)m * D + ntile * 128 + (c0 & ~63) + nt * 32 + 8 * hh;
                    *(u32x4*)crow = pair8(o[0], o[1]); *(u32x4*)(crow + 16) = pair8(o[2], o[3]);
                  }
                  asm volatile("" ::: "memory");
                }
              });
  });
}
template <int AB>
__device__ __forceinline__ void ph_outproj_abl(const P& p, char* smem) {
  gemm2_grid(8, [&](int mtile, int ntile) {
    const bf16_t* A = p.mixinb + (size_t)mtile * 256 * D; const bf16_t* W = p.Wt_out + (size_t)ntile * 128 * D; float* C = (float*)p.Ybuf;
    gemm2<1, AB>(smem, D, [=](int r) { return A + (size_t)r * D; }, [=](int n) { return W + (size_t)n * D; },
             [=](const f32x4 (&acc)[8][4], int r0, int c0) {
#pragma unroll
               for (int mt = 0; mt < 8; ++mt)
#pragma unroll
                 for (int nt = 0; nt < 4; ++nt) {
                   const int m = mtile * 256 + r0 + mt * 16, n = ntile * 128 + c0 + nt * 16;
                   *(f32x4*)(C + (size_t)m * D + n) = acc[mt][nt];
                 }
             });
  });
}
__device__ __forceinline__ void router_unit(const P& p, char* smem, int mtile, int j) {
  const int seg = j >> 1, ntile = j & 1;
  const bf16_t* A = p.h2s + (size_t)mtile * 256 * 2 * D + (seg == 2 ? D : 0);
  const bf16_t* W = (seg == 1 ? p.Wt_rtl : p.Wt_rth) + (size_t)ntile * 128 * D; float* C = p.logits + (size_t)seg * T * NE;
  gemm2<1>(smem, D, [=](int r) { return A + (size_t)r * 2 * D; }, [=](int n) { return W + (size_t)n * D; },
           [=](const f32x4 (&acc)[8][4], int r0, int c0) {
#pragma unroll
             for (int mt = 0; mt < 8; ++mt)
#pragma unroll
               for (int nt = 0; nt < 4; ++nt) {
                 const int m = mtile * 256 + r0 + mt * 16, n = ntile * 128 + c0 + nt * 16;
                 *(f32x4*)(C + (size_t)m * NE + n) = acc[mt][nt];
               }
           });
}
__device__ __forceinline__ const bf16_t* gu_row(const bf16_t* Wg, const bf16_t* Wu, int f0, int n) {
  const int wn = n >> 6, wi = n & 63;
  return (wi >= 32 ? Wu : Wg) + (size_t)(f0 + wn * 32 + (wi & 31)) * D;
}
template <int MT>
__device__ __forceinline__ void gu_store(const f32x4 (&acc)[MT][4], int mt, float scale, bf16_t* dstrow  ) {
#pragma unroll
  for (int q = 0; q < 2; ++q) {
    const f32x4 g = acc[mt][q], u = acc[mt][q + 2];
    float h[4];
#pragma unroll
    for (int i = 0; i < 4; ++i) h[i] = silu(g[i]) * u[i] * scale;
    u32x2 v = {pk_bf16(h[0], h[1]), pk_bf16(h[2], h[3])};
    *(u32x2*)(dstrow + q * 16) = v;
  }
}
__device__ __forceinline__ const unsigned char* gu_rowq(const unsigned char* Wg, const unsigned char* Wu, int f0, int n);
__device__ __forceinline__ void shared_gu_unit(const P& p, char* smem, int mtile, int ntile) {
  const unsigned char* A = p.h2q + (size_t)mtile * 256 * D; const unsigned char* Wg = p.Wq_sg; const unsigned char* Wu = p.Wq_su; bf16_t* H = p.Hs;
  gemm2x<1>(smem, D, [=](int r) { return A + (size_t)r * D; }, [=](int n) { return gu_rowq(Wg, Wu, ntile * 64, n); },
            [=](const f32x16 (&acc)[4][2], int r0, int c0, int) {
              const int wn = c0 >> 6, hh = (c0 >> 2) & 1;
#pragma unroll
              for (int mt = 0; mt < 4; ++mt) {
                bf16_t* dstrow = H + (size_t)(mtile * 256 + r0 + mt * 32) * FF + ntile * 64 + wn * 32 + 8 * hh;
                u32x2 d[4];
#pragma unroll
                for (int gq = 0; gq < 4; ++gq) {
                  f32x4 h;
#pragma unroll
                  for (int i = 0; i < 4; ++i) h[i] = silu(acc[mt][0][4 * gq + i] * (1.f / WQ_SCALE)) * acc[mt][1][4 * gq + i] * (1.f / WQ_SCALE);
                  d[gq] = pk4_bf16(h);
                }
                *(u32x4*)dstrow = pair8(d[0], d[1]); *(u32x4*)(dstrow + 16) = pair8(d[2], d[3]);
              }
            });
}
__device__ __forceinline__ void ph_router_shared_gu(const P& p, char* smem) {
  const int xcd = blockIdx.x & 7, lb = blockIdx.x >> 3, nlb = gridDim.x >> 3;
  if (nlb == 64) {
    if (lb < 48) router_unit(p, smem, xcd * 8 + (lb & 7), lb >> 3);
    else for (int i = lb - 48; i < 32; i += 16) shared_gu_unit(p, smem, xcd * 8 + (i & 7), i >> 3);
  } else {
    gemm2_grid(10, [&](int mtile, int j) { if (j < 6) router_unit(p, smem, mtile, j); else shared_gu_unit(p, smem, mtile, j - 6); });
  }
}
__device__ __forceinline__ void ph_shared_d(const P& p, char* smem) {
  gemm2_grid(8, [&](int mtile, int ntile) {
    const bf16_t* A = p.Hs + (size_t)mtile * 256 * FF; const bf16_t* W = p.Wt_sd + (size_t)ntile * 128 * FF; bf16_t* Y = p.Ys;
    gemm2<1>(smem, FF, [=](int r) { return A + (size_t)r * FF; }, [=](int n) { return W + (size_t)n * FF; },
             [=](const f32x4 (&acc)[8][4], int r0, int c0) {
#pragma unroll
               for (int mt = 0; mt < 8; ++mt)
                 store_row64_bf16(acc[mt][0], acc[mt][1], acc[mt][2], acc[mt][3], (c0 & 63) >> 2, Y + (size_t)(mtile * 256 + r0 + mt * 16) * D + ntile * 128 + (c0 & ~63), true);
             });
  });
}
struct CvtQ { const float* src; unsigned char* dst; int ldn, ldk; };
__device__ __forceinline__ void cvtq_load(const CvtQ& d, f32x4 (&r)[16]) {
#pragma unroll
  for (int i = 0; i < 16; ++i) r[i] = __builtin_nontemporal_load((const f32x4*)(d.src + (size_t)i * d.ldn));
}
__device__ __forceinline__ void cvtq_store(const CvtQ& d, const f32x4 (&r)[16]) {
#pragma unroll
  for (int j = 0; j < 4; ++j) {
    u32x4 v = {pk4_fp8(r[0][j] * WQ_SCALE, r[1][j] * WQ_SCALE, r[2][j] * WQ_SCALE, r[3][j] * WQ_SCALE), pk4_fp8(r[4][j] * WQ_SCALE, r[5][j] * WQ_SCALE, r[6][j] * WQ_SCALE, r[7][j] * WQ_SCALE),
               pk4_fp8(r[8][j] * WQ_SCALE, r[9][j] * WQ_SCALE, r[10][j] * WQ_SCALE, r[11][j] * WQ_SCALE), pk4_fp8(r[12][j] * WQ_SCALE, r[13][j] * WQ_SCALE, r[14][j] * WQ_SCALE, r[15][j] * WQ_SCALE)};
    *(u32x4*)(d.dst + (size_t)j * d.ldk) = v;
  }
}
__device__ __forceinline__ CvtQ cvtq_desc(const float* src, int ldn, unsigned char* dst, int ldk, int k0, int n0) {
  const int kg = threadIdx.x & 7, n = n0 + (threadIdx.x >> 3) * 4;
  CvtQ d; d.src = src + (size_t)(k0 + kg * 16) * ldn + n; d.dst = dst + (size_t)n * ldk + k0 + kg * 16; d.ldn = ldn; d.ldk = ldk; return d;
}
__device__ __forceinline__ void cvtq_tile(const float* src, int ldn, unsigned char* dst, int ldk, int k0, int n0, int nmax = 1 << 30) {
  if (n0 + (int)(threadIdx.x >> 3) * 4 >= nmax) return;
  const CvtQ d = cvtq_desc(src, ldn, dst, ldk, k0, n0); f32x4 r[16]; cvtq_load(d, r); cvtq_store(d, r);
}
__device__ __forceinline__ CvtQ cvt_expert_desc(const P& p, int it) {
  const int e = it / 48, q = it - e * 48;
  if (q < 32) { const int up = q >> 4, qq = q & 15;
    return cvtq_desc((up ? p.w_up : p.w_gate) + (size_t)e * D * FF, FF, (up ? p.Wq_u : p.Wq_g) + (size_t)e * FF * D, D, (qq & 7) * 128, (qq >> 3) * 128);
  }
  const int qq = q - 32;
  return cvtq_desc(p.w_down + (size_t)e * FF * D, D, p.Wq_d + (size_t)e * D * FF, FF, (qq & 1) * 128, (qq >> 1) * 128);
}
__device__ __forceinline__ void cvt_expert_item(const P& p, int it) { const CvtQ d = cvt_expert_desc(p, it); f32x4 r[16]; cvtq_load(d, r); cvtq_store(d, r); }
__device__ __forceinline__ void ph_cvt_experts(const P& p) { WLOOP(w, NE * 48) cvt_expert_item(p, w); }

__device__ __forceinline__ bf16x8 pack8(const f32x16& x, int s) {
  u32x4 r = {pk_bf16(x[8 * s], x[8 * s + 1]), pk_bf16(x[8 * s + 2], x[8 * s + 3]), pk_bf16(x[8 * s + 4], x[8 * s + 5]), pk_bf16(x[8 * s + 6], x[8 * s + 7])};
  return __builtin_bit_cast(bf16x8, r);
}
__device__ __forceinline__ bf16x8 tr_pair(const LAS char* a) {
  const s16x4 lo = __builtin_amdgcn_ds_read_tr16_b64_v4i16((LAS s16x4*)a);
  const s16x4 hi = __builtin_amdgcn_ds_read_tr16_b64_v4i16((LAS s16x4*)(a + 8 * 128));
  return __builtin_shufflevector(lo, hi, 0, 1, 2, 3, 4, 5, 6, 7);
}
__device__ __forceinline__ int next_item(int* ctr, char* smem) {
  volatile int* slot = (volatile int*)(smem + SMEM_BYTES - 16);
  __syncthreads();
  if (threadIdx.x == 0) *slot = atomicAdd(ctr, 1);
  __syncthreads();
  return *slot;
}

__device__ __forceinline__ void compress_item(const P& p, char* smem, int item) {
  const int which = item >> 3, mtile = item & 7;
  const bf16_t* X = which ? p.VC : p.KC; const bf16_t* W1 = which ? p.Wt_c1v : p.Wt_c1k; const bf16_t* Z = p.zrow;
  const float* b1 = p.b1c + which * 128; bf16_t* hid = (bf16_t*)smem;
  gemm2<1>(smem, 2048,
           [=](int r) { const int R = mtile * 256 + r; if (R >= 2040) return Z; const int bg = R / 255, c = R - bg * 255; return X + ((size_t)bg * S + 16 * c) * 64; },
           [=](int n) { return W1 + (size_t)n * 2048; },
           [=](const f32x4 (&acc)[8][4], int r0, int c0) {
             __syncthreads();
#pragma unroll
             for (int nt = 0; nt < 4; ++nt) {
               const f32x4 bv = *(const f32x4*)(b1 + c0 + nt * 16);
#pragma unroll
               for (int mt = 0; mt < 8; ++mt) {
                 float h[4];
#pragma unroll
                 for (int i = 0; i < 4; ++i) { const float a = acc[mt][nt][i] + bv[i]; const float u = 0.7978845608028654f * (a + 0.044715f * a * a * a); h[i] = a - a / (1.f + __expf(2.f * u)); }
                 u32x2 w = {pk_bf16(h[0], h[1]), pk_bf16(h[2], h[3])};
                 *(u32x2*)(hid + (r0 + mt * 16) * 136 + c0 + nt * 16) = w;
               }
             }
           });
  __syncthreads();
  const float* W2 = which ? p.w2_v : p.w2_k;
  const int rl = threadIdx.x >> 3, pt = threadIdx.x & 7;
#pragma unroll 1
  for (int g = 0; g < 8; ++g) {
    const int row = g * 32 + rl, R = mtile * 256 + row;
    float o[8];
#pragma unroll
    for (int d = 0; d < 8; ++d) o[d] = 0.f;
#pragma unroll 2
    for (int n8 = 0; n8 < 16; ++n8) {
      const u32x4 hv4 = *(const u32x4*)(hid + row * 136 + n8 * 8);
#pragma unroll
      for (int k = 0; k < 8; ++k) {
        const float hv = (k & 1) ? __uint_as_float(hv4[k >> 1] & 0xffff0000u) : __uint_as_float(hv4[k >> 1] << 16);
        const f32x4 w0 = *(const f32x4*)(W2 + (n8 * 8 + k) * 64 + pt * 8), w1 = *(const f32x4*)(W2 + (n8 * 8 + k) * 64 + pt * 8 + 4);
        o[0] += hv * w0[0]; o[1] += hv * w0[1]; o[2] += hv * w0[2]; o[3] += hv * w0[3];
        o[4] += hv * w1[0]; o[5] += hv * w1[1]; o[6] += hv * w1[2]; o[7] += hv * w1[3];
      }
    }
    float rs = 1.f;
    if (!which) {
      float ss = 0.f;
#pragma unroll
      for (int d = 0; d < 8; ++d) ss += o[d] * o[d];
      ss += __shfl_xor(ss, 1); ss += __shfl_xor(ss, 2); ss += __shfl_xor(ss, 4);
      rs = rsqrtf(ss * (1.f / 64.f) + EPS);
    }
    if (R < 2040) {
      const int bg = R / 255, c = R - bg * 255;
      bf16_t* orow = (which ? p.vcb : p.kcb) + ((size_t)bg * 256 + c) * 64 + pt * 8;
      float gg[8];
      if (!which) { const f32x4 g0 = *(const f32x4*)(p.g_k_cmp + pt * 8), g1 = *(const f32x4*)(p.g_k_cmp + pt * 8 + 4); gg[0] = g0[0]; gg[1] = g0[1]; gg[2] = g0[2]; gg[3] = g0[3]; gg[4] = g1[0]; gg[5] = g1[1]; gg[6] = g1[2]; gg[7] = g1[3]; }
      else {
#pragma unroll
        for (int k = 0; k < 8; ++k) gg[k] = 1.f;
      }
      u32x4 w = {pk_bf16(o[0] * rs * gg[0], o[1] * rs * gg[1]), pk_bf16(o[2] * rs * gg[2], o[3] * rs * gg[3]), pk_bf16(o[4] * rs * gg[4], o[5] * rs * gg[5]), pk_bf16(o[6] * rs * gg[6], o[7] * rs * gg[7])};
      *(u32x4*)orow = w;
    }
  }
}

template <int MODE, int NSLOT>
__device__ __forceinline__ void nsa_pass(LAS char* kv, const bf16_t* Kg, const bf16_t* Vg, int t_lo, int t_hi, const bf16x8 (&qf)[4], float shf, int si,
                                         unsigned long long selm, f32x16& o0, f32x16& o1, float& l, LAS float* psl  ,
                                         int pos0 = 0, int pstride = 1, int kkmin = 0) {
  const int tid = otid(), lane = tid & 63, wv = __builtin_amdgcn_readfirstlane(tid >> 6), i = lane & 31, h5 = lane >> 5;
  const int ksw = (i >> 1) & 7;
  const int tq = (lane & 15) >> 2, tp = lane & 3, tds = (lane >> 4) & 1, vsw = ((tq >> 1) & 1) << 2;
  const int row_l = lane >> 3, cpos = lane & 7;
  const int kc8 = (cpos ^ ((wv & 1) * 4 + (row_l >> 1))) * 8, vc8 = (cpos ^ (((row_l >> 1) & 1) << 2)) * 8;
  const bf16_t* kgl = Kg + (size_t)(wv * 8 + row_l) * 64 + kc8;
  const bf16_t* vgl = Vg + (size_t)(wv * 8 + row_l) * 64 + vc8;
  auto stage = [&](int t, int buf) {
    LAS char* Ks = kv + buf * 16384 + wv * 1024; LAS char* Vs = Ks + 8192;
#pragma unroll
    for (int q = 0; q < 2; ++q) {
      if (MODE >= 3) {
        int pos = pos0 + pstride * (64 * t + 32 * q + wv * 8 + row_l);
        pos = pos < 0 ? 0 : (pos > S - 1 ? S - 1 : pos);
        __builtin_amdgcn_global_load_lds((const unsigned*)(Kg + (size_t)pos * 64 + kc8), (LAS unsigned*)(Ks + q * 4096), 16, 0, 0);
        __builtin_amdgcn_global_load_lds((const unsigned*)(Vg + (size_t)pos * 64 + vc8), (LAS unsigned*)(Vs + q * 4096), 16, 0, 0);
      } else {
        __builtin_amdgcn_global_load_lds((const unsigned*)(kgl + (size_t)(64 * t + 32 * q) * 64), (LAS unsigned*)(Ks + q * 4096), 16, 0, 0);
        __builtin_amdgcn_global_load_lds((const unsigned*)(vgl + (size_t)(64 * t + 32 * q) * 64), (LAS unsigned*)(Vs + q * 4096), 16, 0, 0);
      }
    }
  };
  float carry = 0.f;
  if (t_lo > t_hi) return;
  float dm16[4] = {0.f, 0.f, 0.f, 0.f}; int dmaxA = 0, dmaxB = 0; const int wq = wv & 3;
  if (MODE == 3) {
#pragma unroll
    for (int rg = 0; rg < 4; ++rg) dm16[rg] = (((wv - h5 - 2 * rg) & 3) == 0) ? 3.f : 2.f;
    dmaxA = si - kkmin < 128 ? si - kkmin : 128;
  }
  if (MODE == 4) { const int lim = si - kkmin; dmaxA = lim < 128 ? lim : 128; dmaxB = lim < 512 ? lim : 512; }
  asm volatile("s_waitcnt vmcnt(0) lgkmcnt(0)" ::: "memory");
  __builtin_amdgcn_s_barrier();
  asm volatile("" ::: "memory");
#pragma unroll
  for (int k = 0; k < NSLOT - 1; ++k) if (t_lo + k <= t_hi) stage(t_lo + k, k);
  for (int t = t_lo; t <= t_hi; ++t) {
    const int buf = (t - t_lo) % NSLOT;
    const int ahead = t_hi - t;
    if (NSLOT == 4 && ahead >= 2) asm volatile("s_waitcnt vmcnt(8)" ::: "memory");
    else if (NSLOT == 4 && ahead == 1) asm volatile("s_waitcnt vmcnt(4)" ::: "memory");
    else asm volatile("s_waitcnt vmcnt(0)" ::: "memory");
    __builtin_amdgcn_s_barrier();
    asm volatile("" ::: "memory");
    if (t + NSLOT - 1 <= t_hi) stage(t + NSLOT - 1, (t + NSLOT - 1 - t_lo) % NSLOT);
    const LAS char* Ks = kv + buf * 16384; const LAS char* Vs = Ks + 8192;
    const bool tsel = MODE == 1 ? ((selm >> t) & 1ull) != 0ull : true;
#pragma unroll
    for (int sub = 0; sub < 2; ++sub) {
      f32x16 sa;
#pragma unroll
      for (int q = 0; q < 16; ++q) sa[q] = 0.f;
      bf16x8 kf[4];
#pragma unroll
      for (int s4 = 0; s4 < 4; ++s4) kf[s4] = *(const LAS bf16x8*)(Ks + (32 * sub + i) * 128 + (((2 * s4 + h5) ^ ksw) << 4));
      __builtin_amdgcn_s_setprio(1);
#pragma unroll
      for (int s4 = 0; s4 < 4; ++s4) sa = MFMA32(kf[s4], qf[s4], sa);
      __builtin_amdgcn_s_setprio(0);
      const int k0 = 64 * t + 32 * sub + 4 * h5;
#pragma unroll
      for (int q = 0; q < 16; ++q) {
        const int kidx = k0 + (q & 3) + 8 * (q >> 2);
        float pv;
        if (MODE >= 3) {
          const int dl = si - kidx;
          const float e = __builtin_amdgcn_exp2f(sa[q] * LOG2E - shf);
          if (MODE == 3) {
            const float cw = (q & 3) ? 1.f : dm16[q >> 2];
            pv = (unsigned)dl <= (unsigned)dmaxA ? cw * e : 0.f;
          } else {
            const bool lo = dl >= 33;
            float cw = (lo && dl <= dmaxA) ? 1.f : 0.f;
            if ((q & 3) == wq) cw += (lo && dl <= dmaxB) ? 1.f : 0.f;
            pv = cw * e;
          }
        } else {
          bool valid;
          if (MODE == 0) valid = 16 * kidx + 31 <= si;
          else if (MODE == 1) valid = tsel && kidx <= si;
          else valid = (unsigned)(si - kidx) <= 511u;
          pv = valid ? __builtin_amdgcn_exp2f(sa[q] * LOG2E - shf) : 0.f;
        }
        l += pv; sa[q] = pv;
      }
      if (MODE == 0) {
#pragma unroll
        for (int rg = 0; rg < 4; ++rg) {
          const float a = 2.f * (sa[4 * rg] + sa[4 * rg + 1] + sa[4 * rg + 2]) + sa[4 * rg + 3];
          const float recv = __shfl_xor(sa[4 * rg + 3], 32);
          const float val = h5 ? a + recv : a + carry;
          carry = recv;
          psl[16 * t + 8 * sub + 2 * rg + h5] = val;
        }
      }
      const bf16x8 pf0 = pack8(sa, 0), pf1 = pack8(sa, 1);
      bf16x8 vf[2][2];
#pragma unroll
      for (int s2 = 0; s2 < 2; ++s2) {
        const LAS char* vb = Vs + (32 * sub + 16 * s2 + 4 * h5 + tq) * 128 + 8 * (tp & 1);
        vf[s2][0] = tr_pair(vb + (((tds * 2 + (tp >> 1)) ^ vsw) << 4));
        vf[s2][1] = tr_pair(vb + (((4 + tds * 2 + (tp >> 1)) ^ vsw) << 4));
      }
      __builtin_amdgcn_s_setprio(1);
#pragma unroll
      for (int s2 = 0; s2 < 2; ++s2) { o0 = MFMA32(vf[s2][0], s2 ? pf1 : pf0, o0); o1 = MFMA32(vf[s2][1], s2 ? pf1 : pf0, o1); }
      __builtin_amdgcn_s_setprio(0);
    }
    __builtin_amdgcn_sched_barrier(0);
  }
}

__device__ __forceinline__ void dilated_item(const P& p, char* smem_, int unit) {
  LAS char* kv = (LAS char*)smem_;
  const int tid = otid(), lane = tid & 63, wv = tid >> 6, i = lane & 31, h5 = lane >> 5;
  const int r4 = unit & 3, ti = (unit >> 2) & 7, hh = (unit >> 5) & 7, b = unit >> 8;
  const size_t hb = (size_t)(b * 8 + hh) * S * 64;
  const int si = ti * 512 + r4 + 4 * wv + 16 * i;
  bf16x8 qf[4];
#pragma unroll
  for (int s4 = 0; s4 < 4; ++s4) qf[s4] = *(const bf16x8*)(p.QA + hb + (size_t)si * 64 + 16 * s4 + 8 * h5);
  f32x16 o0, o1;
#pragma unroll
  for (int q = 0; q < 16; ++q) { o0[q] = 0.f; o1[q] = 0.f; }
  float l = 0.f;
  const float shf = p.smaxv[0] * LOG2E;
  const int pbase = ti * 512 + r4 - 128, ubase = ti * 128 - 512;
  nsa_pass<3, 4>(kv, p.KA + hb, p.VA + hb, 0, 9, qf, shf, 4 * wv + 16 * i + 128, 0ull, o0, o1, l, nullptr, pbase, 1, pbase < 0 ? -pbase : 0);
  nsa_pass<4, 4>(kv, p.KA + hb, p.VA + hb, 0, 9, qf, shf, wv + 4 * i + 512, 0ull, o0, o1, l, nullptr, r4 + 4 * ubase, 4, ubase < 0 ? -ubase : 0);
  l += __shfl_xor(l, 32);
  const float inv = 1.f / l;
  unsigned char* orow = p.mixq + (size_t)(b * S + si) * D + hh * 64 + 4 * h5;
  const float invq = inv * MQ_SCALE;
#pragma unroll
  for (int rg = 0; rg < 4; ++rg) {
    *(unsigned*)(orow + 8 * rg) = pk4_fp8(clamp_e4m3(o0[4 * rg] * invq), clamp_e4m3(o0[4 * rg + 1] * invq), clamp_e4m3(o0[4 * rg + 2] * invq), clamp_e4m3(o0[4 * rg + 3] * invq));
    *(unsigned*)(orow + 32 + 8 * rg) = pk4_fp8(clamp_e4m3(o1[4 * rg] * invq), clamp_e4m3(o1[4 * rg + 1] * invq), clamp_e4m3(o1[4 * rg + 2] * invq), clamp_e4m3(o1[4 * rg + 3] * invq));
  }
}

__device__ __forceinline__ void nsa_item(const P& p, char* smem_, int item) {
  LAS char* smem = (LAS char*)smem_;
  LAS char* kv = smem;
  LAS float* pslcw = (LAS float*)(smem + 32768);
  LAS float* invl = (LAS float*)(smem + 32768 + 33280);
  LAS unsigned* msk = (LAS unsigned*)(smem + 32768 + 33280 + 512);
  const int tid = otid(), lane = tid & 63, wv = tid >> 6, i = lane & 31, h5 = lane >> 5;
  const int qt = 127 - (item >> 3), bg = item & 7, b = bg >> 1, g = bg & 1, hq = g * 4 + wv;
  const int s0 = qt * 32, si = s0 + i, cur = s0 >> 6;
  const size_t qoff = ((size_t)(b * 8 + hq) * S + si) * 64 + 8 * h5;
  bf16x8 qf[4];
#pragma unroll
  for (int s4 = 0; s4 < 4; ++s4) qf[s4] = *(const bf16x8*)(p.QN + qoff + 16 * s4);
  const float* gs = p.GS + (size_t)(b * S + si) * 24 + hq * 3;
  const float g0 = gs[0], g1 = gs[1], g2 = gs[2];
  f32x16 oa0, oa1, o0, o1;
#pragma unroll
  for (int q = 0; q < 16; ++q) { o0[q] = 0.f; o1[q] = 0.f; }
  float l = 0.f;
  LAS float* psl = pslcw + (wv * 32 + i) * 65;
  const int ncv = (s0 + 31 - 31) >> 4;
  const int tc_hi = (ncv < 254 ? ncv : 254) >> 6;
#pragma unroll
  for (int k = 0; k < 32; ++k) psl[2 * k + h5] = 0.f;
  nsa_pass<0, 2>(kv, p.kcb + (size_t)bg * 256 * 64, p.vcb + (size_t)bg * 256 * 64, 0, tc_hi, qf, p.smaxv[1] * LOG2E, si, 0ull, o0, o1, l, psl);
  l += __shfl_xor(l, 32);
  {
    const float il = l > 0.f ? 1.f / l : 0.f;
    if (h5 == 0) invl[wv * 32 + i] = il;
    const float sc = g0 * il;
#pragma unroll
    for (int q = 0; q < 16; ++q) { oa0[q] = o0[q] * sc; oa1[q] = o1[q] * sc; o0[q] = 0.f; o1[q] = 0.f; }
  }
  __syncthreads();
  LAS float* scr = pslcw;
  {
    const int q = tid >> 3, jj = tid & 7;
    float tot[8];
#pragma unroll
    for (int k = 0; k < 8; ++k) {
      const int j = jj + 8 * k;
      float v = 0.f;
#pragma unroll
      for (int w4 = 0; w4 < 4; ++w4) v += pslcw[(w4 * 32 + q) * 65 + j] * invl[w4 * 32 + q];
      const bool forced = (j == 0) || (j == cur) || (j == cur - 1);
      tot[k] = forced ? INFINITY : (j <= cur ? v : -INFINITY);
    }
    __syncthreads();
#pragma unroll
    for (int k = 0; k < 8; ++k) scr[q * 65 + jj + 8 * k] = tot[k];
    if (tid < 64) msk[tid] = 0u;
    __syncthreads();
    unsigned lo = 0u, hi = 0u;
#pragma unroll
    for (int k = 0; k < 8; ++k) {
      const int j = jj + 8 * k; const float v = tot[k];
      int rank = 0;
      for (int c = 0; c < 64; ++c) { const float sv = scr[q * 65 + c]; rank += (sv > v) || (sv == v && c < j); }
      if (rank < 16 && j <= cur) { if (j < 32) lo |= 1u << j; else hi |= 1u << (j - 32); }
    }
    if (lo) atomicOr((unsigned*)&msk[q * 2], lo);
    if (hi) atomicOr((unsigned*)&msk[q * 2 + 1], hi);
    __syncthreads();
  }
  const unsigned long long selm = (unsigned long long)msk[i * 2] | ((unsigned long long)msk[i * 2 + 1] << 32);
#pragma unroll
  for (int s4 = 0; s4 < 4; ++s4) qf[s4] = *(const bf16x8*)(p.QR + qoff + 16 * s4);
  const size_t kvoff = (size_t)bg * S * 64;
  l = 0.f;
  nsa_pass<1, 4>(kv, p.KSL + kvoff, p.VSL + kvoff, 0, cur, qf, p.smaxv[2] * LOG2E, si, selm, o0, o1, l, nullptr);
  l += __shfl_xor(l, 32);
  {
    const float sc = g1 / l;
#pragma unroll
    for (int q = 0; q < 16; ++q) { oa0[q] += o0[q] * sc; oa1[q] += o1[q] * sc; o0[q] = 0.f; o1[q] = 0.f; }
  }
  l = 0.f;
  const int tw_lo = s0 >= 511 ? (s0 - 511) >> 6 : 0;
  nsa_pass<2, 4>(kv, p.KW + kvoff, p.VW + kvoff, tw_lo, cur, qf, p.smaxv[3] * LOG2E, si, 0ull, o0, o1, l, nullptr);
  l += __shfl_xor(l, 32);
  {
    const float sc = g2 / l;
#pragma unroll
    for (int q = 0; q < 16; ++q) { oa0[q] += o0[q] * sc; oa1[q] += o1[q] * sc; }
  }
  unsigned char* orow = p.mixq + (size_t)(b * S + si) * D + 512 + hq * 64 + 4 * h5;
#pragma unroll
  for (int rg = 0; rg < 4; ++rg) {
    *(unsigned*)(orow + 8 * rg) = pk4_fp8(clamp_e4m3(oa0[4 * rg] * MQ_SCALE), clamp_e4m3(oa0[4 * rg + 1] * MQ_SCALE), clamp_e4m3(oa0[4 * rg + 2] * MQ_SCALE), clamp_e4m3(oa0[4 * rg + 3] * MQ_SCALE));
    *(unsigned*)(orow + 32 + 8 * rg) = pk4_fp8(clamp_e4m3(oa1[4 * rg] * MQ_SCALE), clamp_e4m3(oa1[4 * rg + 1] * MQ_SCALE), clamp_e4m3(oa1[4 * rg + 2] * MQ_SCALE), clamp_e4m3(oa1[4 * rg + 3] * MQ_SCALE));
  }
}
__device__ __forceinline__ void cvt_queue_item(const P& p, int ci) {
  f32x4 ra[16], rb[16];
  const CvtQ d0 = cvt_expert_desc(p, ci * 4), d1 = cvt_expert_desc(p, ci * 4 + 1), d2 = cvt_expert_desc(p, ci * 4 + 2), d3 = cvt_expert_desc(p, ci * 4 + 3);
  cvtq_load(d0, ra); cvtq_load(d1, rb);
  cvtq_store(d0, ra); cvtq_load(d2, ra);
  cvtq_store(d1, rb); cvtq_load(d3, rb);
  cvtq_store(d2, ra); cvtq_store(d3, rb);
}
__device__ __forceinline__ void ph_attn_a(const P& p, char* smem) {
  for (;;) {
    const int q = next_item(p.ctr + 0, smem);
    if (q >= 16 + 2560) break;
    if (q < 16) { compress_item(p, smem, q); continue; }
    const int j = q - 16, g = j / 5, r = j - g * 5;
    if (r == 0 || r == 3) dilated_item(p, smem, g * 2 + (r == 3)); else cvt_queue_item(p, g * 3 + (r == 1 ? 0 : (r == 2 ? 1 : 2)));
  }
}
__device__ __forceinline__ void ph_attn_b(const P& p, char* smem) {
  for (;;) {
    const int q = next_item(p.ctr + 1, smem);
    if (q >= 2560) break;
    const int g = q / 5, r = q - g * 5;
    if (r == 0 || r == 3) nsa_item(p, smem, g * 2 + (r == 3)); else cvt_queue_item(p, 1536 + g * 3 + (r == 1 ? 0 : (r == 2 ? 1 : 2)));
  }
}

__device__ __forceinline__ void ph_route(const P& p, char* smem) {
  const int lane = threadIdx.x & 63, wv = threadIdx.x >> 6;
  int* hist = (int*)smem;
  __syncthreads();
  hist[threadIdx.x] = 0;
  __syncthreads();
  const int tpb = T / gridDim.x, t0 = blockIdx.x * tpb;
  float bias[4];
#pragma unroll
  for (int i = 0; i < 4; ++i) bias[i] = p.r_bias[lane + 64 * i];
  for (int tt = wv; tt < tpb; tt += 4) {
    const int t = t0 + tt;
    float aff[4], bv[4], ta[4], tb[4];
#pragma unroll
    for (int i = 0; i < 4; ++i) { { const size_t li = (size_t)t * NE + lane + 64 * i; aff[i] = sigmoidf((p.logits[li] + p.logits[li + (size_t)T * NE]) + p.logits[li + (size_t)2 * T * NE]); } bv[i] = aff[i] + bias[i]; ta[i] = bv[i]; tb[i] = -INFINITY; }
#pragma unroll
    for (int o = 16; o; o >>= 1)
#pragma unroll
      for (int i = 0; i < 4; ++i) {
        const float a2 = __shfl_xor(ta[i], o), b2 = __shfl_xor(tb[i], o);
        const float na = fmaxf(ta[i], a2), nb = fmaxf(fminf(ta[i], a2), fmaxf(tb[i], b2));
        ta[i] = na; tb[i] = nb;
      }
    float gs[8];
#pragma unroll
    for (int i = 0; i < 4; ++i) { const float s2 = ta[i] + tb[i]; gs[2 * i] = __shfl(s2, 0); gs[2 * i + 1] = __shfl(s2, 32); }
    unsigned gmask = 0;
#pragma unroll
    for (int g = 0; g < 8; ++g) {
      int rank = 0;
#pragma unroll
      for (int i = 0; i < 8; ++i) rank += (gs[i] > gs[g]) || (gs[i] == gs[g] && i < g);
      if (rank < 4) gmask |= 1u << g;
    }
#pragma unroll
    for (int i = 0; i < 4; ++i) if (!((gmask >> (2 * i + (lane >> 5))) & 1u)) bv[i] = -INFINITY;
    unsigned key[4];
#pragma unroll
    for (int i = 0; i < 4; ++i) { const unsigned u = __float_as_uint(bv[i]); key[i] = (u & 0x80000000u) ? ~u : (u | 0x80000000u); }
    unsigned thr = 0u;
#pragma unroll 1
    for (int bit = 31; bit >= 0; --bit) {
      const unsigned trial = thr | (1u << bit);
      int c = 0;
#pragma unroll
      for (int i = 0; i < 4; ++i) c += __builtin_popcountll(__ballot(key[i] >= trial));
      if (c >= 8) thr = trial;
    }
    int ngt = 0;
#pragma unroll
    for (int i = 0; i < 4; ++i) ngt += __builtin_popcountll(__ballot(key[i] > thr));
    const int need = 8 - ngt;
    const unsigned long long ltmask = (1ull << lane) - 1ull;
    int eqbefore = 0, selbefore = 0;
    bool sel[4]; int slot[4];
#pragma unroll
    for (int i = 0; i < 4; ++i) {
      const unsigned long long eqm = __ballot(key[i] == thr);
      const bool s = key[i] > thr || (key[i] == thr && eqbefore + __builtin_popcountll(eqm & ltmask) < need);
      eqbefore += __builtin_popcountll(eqm);
      const unsigned long long sm = __ballot(s);
      sel[i] = s; slot[i] = selbefore + __builtin_popcountll(sm & ltmask);
      selbefore += __builtin_popcountll(sm);
    }
    float part = 0.f;
#pragma unroll
    for (int i = 0; i < 4; ++i) part += sel[i] ? aff[i] : 0.f;
    const float ssum = wave_sum(part);
#pragma unroll
    for (int i = 0; i < 4; ++i)
      if (sel[i]) {
        const int e = lane + 64 * i;
        p.eidx[t * 8 + slot[i]] = e;
        p.gates[t * 8 + slot[i]] = aff[i] / ssum * 2.5f;
        p.pos[t * 8 + slot[i]] = atomicAdd(&hist[e], 1);
      }
  }
  __syncthreads();
  p.bhist[(size_t)blockIdx.x * NE + threadIdx.x] = hist[threadIdx.x];
}
__device__ __forceinline__ void ph_fill(const P& p, char* smem) {
  int* soff = (int*)smem;
  int* wsum = soff + 260;
  int* sbase = soff + 272;
  const int tid = threadIdx.x, lane = tid & 63, wv = tid >> 6;
  __syncthreads();
  int c = 0, before = 0;
  for (int bb = 0; bb < (int)gridDim.x; ++bb) { const int v = p.bhist[(size_t)bb * NE + tid]; c += v; before += (bb < (int)blockIdx.x) ? v : 0; }
  int incl = c;
#pragma unroll
  for (int o = 1; o < 64; o <<= 1) { const int v = __shfl_up(incl, o); if (lane >= o) incl += v; }
  if (lane == 63) wsum[wv] = incl;
  __syncthreads();
  int base = 0;
  for (int i = 0; i < wv; ++i) base += wsum[i];
  soff[tid] = base + incl - c;
  sbase[tid] = base + incl - c + before;
  if (tid == 255) soff[256] = base + incl;
  __syncthreads();
  if (blockIdx.x == 0) {
    p.off[tid] = soff[tid]; p.cnt[tid] = c;
    if (tid == 255) p.off[256] = soff[256];
  }
  if (blockIdx.x == 1) {
    const int x = tid >> 5, i = tid & 31, e = x + 8 * i;
    const int ce = soff[e + 1] - soff[e], tle = (ce + 255) >> 8, hfe = (tle > 0 && ce - (tle - 1) * 256 <= 128) ? 1 : 0;
    const int tl = 2 * (tle - hfe) + hfe;
    int inc2 = tl;
#pragma unroll
    for (int o = 1; o < 32; o <<= 1) { const int v = __shfl_up(inc2, o, 32); if (i >= o) inc2 += v; }
    p.tstart[x * 33 + i] = inc2 - tl;
    if (i == 31) p.tstart[x * 33 + 32] = inc2;
  }
  const int tpb = T / gridDim.x, a0 = blockIdx.x * tpb * 8;
  for (int a = a0 + tid; a < a0 + tpb * 8; a += 256) p.sorted[sbase[p.eidx[a]] + p.pos[a]] = a;
}

template <class F_>
__device__ __forceinline__ void moe_grid2(const P& p, F_ body) {
  const int xcd = blockIdx.x & 7, lb = blockIdx.x >> 3, nlb = gridDim.x >> 3;
  const int* ts = p.tstart + xcd * 33;
  const int total = ts[32] * 2;
  int i = 0;
  for (int j = lb; j < total; j += nlb) {
    while (ts[i + 1] * 2 <= j) ++i;
    const int e = xcd + 8 * i, c = p.cnt[e];
    const int tiles = (c + 255) >> 8, hf = (tiles > 0 && c - (tiles - 1) * 256 <= 128) ? 1 : 0, F = tiles - hf;
    const int rem = j - ts[i] * 2;
    if (rem < 4 * F) body(e, rem % F, rem / F, false);
    else body(e, F, rem - 4 * F, true);
  }
}
__device__ __forceinline__ const unsigned char* gu_rowq(const unsigned char* Wg, const unsigned char* Wu, int f0, int n) {
  const int wn = n >> 6, wi = n & 63;
  return (wi >= 32 ? Wu : Wg) + (size_t)(f0 + wn * 32 + (wi & 31)) * D;
}
__device__ __forceinline__ void ph_moe_gu(const P& p, char* smem) {
  moe_grid2(p, [&](int e, int mtile, int nsel, bool dual) {
    const int ntile = dual ? 2 * nsel : nsel;
    const int cnt = p.cnt[e] - mtile * 256; const int* srt = p.sorted + p.off[e] + mtile * 256;
    const unsigned char* A = p.h2q; const unsigned char* Wg = p.Wq_g + (size_t)e * FF * D; const unsigned char* Wu = p.Wq_u + (size_t)e * FF * D; unsigned char* H = p.Hq;
    const float* gates = p.gates; const unsigned char* Z = (const unsigned char*)p.zrow;
    gemm2x(smem, D, [=](int r) { return (dual && r >= 128) ? gu_rowq(Wg, Wu, ntile * 64 + 64, r - 128) : (r < cnt ? A + (size_t)(srt[r] >> 3) * D : Z); },
           [=](int n) { return gu_rowq(Wg, Wu, ntile * 64, n); },
           [=](const f32x16 (&acc)[4][2], int r0, int c0, int) {
             const int wn = c0 >> 6, hh = (c0 >> 2) & 1;
#pragma unroll
             for (int mt = 0; mt < 4; ++mt) {
               const int r = r0 + mt * 32; const bool ok = r < cnt; const int a = ok ? srt[r] : 0;
               const float sc = ok ? gates[a] * (HQ_SCALE / WQ_SCALE) : 0.f;
               unsigned d[4];
#pragma unroll
               for (int g = 0; g < 4; ++g) {
                 float h[4];
#pragma unroll
                 for (int i = 0; i < 4; ++i) h[i] = clamp_e4m3(silu(acc[mt][0][4 * g + i] * (1.f / WQ_SCALE)) * acc[mt][1][4 * g + i] * sc);
                 d[g] = pk4_fp8(h[0], h[1], h[2], h[3]);
               }
               const u32x2v p01 = __builtin_amdgcn_permlane32_swap(d[0], d[1], false, false), p23 = __builtin_amdgcn_permlane32_swap(d[2], d[3], false, false);
               if (ok) {
                 unsigned char* dst = H + (size_t)a * FF + ntile * 64 + wn * 32 + 8 * hh;
                 *(u32x2*)dst = (u32x2){p01.x, p01.y};
                 *(u32x2*)(dst + 16) = (u32x2){p23.x, p23.y};
               }
             }
           }, 0, !dual && cnt <= 128, dual);
  });
}
__device__ __forceinline__ void ph_moe_d(const P& p, char* smem) {
  moe_grid2(p, [&](int e, int mtile, int nsel, bool dual) {
    const int nt0 = dual ? 4 * nsel : 2 * nsel;
    const int cnt = p.cnt[e] - mtile * 256; const int* srt = p.sorted + p.off[e] + mtile * 256;
    const unsigned char* A = p.Hq; const unsigned char* W = p.Wq_d + (size_t)e * D * FF + (size_t)nt0 * 128 * FF; unsigned char* Yq = p.Yq; const unsigned char* Z = (const unsigned char*)p.zrow;
    const int tid_ = otid();
    LAS int* ridt = (LAS int*)((LAS char*)smem + 3 * G2_STAGE);
    __syncthreads();
    ridt[tid_] = tid_ < cnt ? srt[tid_] : -1;
    gemm2x<2>(smem, FF, [=](int r) { return (dual && r >= 128) ? W + (size_t)(256 + r - 128) * FF : (r < cnt ? A + (size_t)srt[r] * FF : Z); }, [=](int n) { return W + (size_t)n * FF; },
           [=](const f32x16 (&acc)[4][2], int r0, int c0, int rp) {
             const int wn64 = c0 & 64, hh = (c0 >> 2) & 1, second = c0 >> 7;
             const float s = YQ_SCALE / (WQ_SCALE * HQ_SCALE);
#pragma unroll
             for (int mt = 0; mt < 4; ++mt) {
               const int rd = ridt[r0 + mt * 32]; const bool ok = rd >= 0;
               unsigned char* dst = Yq + (size_t)rd * D + (nt0 + 2 * second + rp) * 128 + wn64 + 8 * hh;
#pragma unroll
               for (int nt = 0; nt < 2; ++nt) {
                 unsigned d[4];
#pragma unroll
                 for (int g = 0; g < 4; ++g) d[g] = pk4_fp8(clamp_e4m3(acc[mt][nt][4 * g] * s), clamp_e4m3(acc[mt][nt][4 * g + 1] * s), clamp_e4m3(acc[mt][nt][4 * g + 2] * s), clamp_e4m3(acc[mt][nt][4 * g + 3] * s));
                 const u32x2v p01 = __builtin_amdgcn_permlane32_swap(d[0], d[1], false, false), p23 = __builtin_amdgcn_permlane32_swap(d[2], d[3], false, false);
                 if (ok) { *(u32x2*)(dst + nt * 32) = (u32x2){p01.x, p01.y}; *(u32x2*)(dst + nt * 32 + 16) = (u32x2){p23.x, p23.y}; }
               }
               asm volatile("" ::: "memory");
             }
           }, (size_t)128 * FF, !dual && cnt <= 128, dual);
  });
}
__device__ __forceinline__ void ph_combine(const P& p) {
  WLOOP(w, T / 4) {
    const int tid_ = otid(), t = w * 4 + (tid_ >> 6), c = (tid_ & 63) * 16, b = t / S;
    float acc[16];
#pragma unroll
    for (int i = 0; i < 16; ++i) acc[i] = 0.f;
#pragma unroll
    for (int k = 0; k < 8; ++k) {
      const u32x4 v = *(const u32x4*)(p.Yq + ((size_t)t * 8 + k) * D + c);
#pragma unroll
      for (int i = 0; i < 4; ++i) {
        const f32x2 lo = __builtin_amdgcn_cvt_pk_f32_fp8((int)v[i], false), hi = __builtin_amdgcn_cvt_pk_f32_fp8((int)v[i], true);
        acc[4 * i] += lo[0]; acc[4 * i + 1] += lo[1]; acc[4 * i + 2] += hi[0]; acc[4 * i + 3] += hi[1];
      }
    }
    const bf16_t* ys = p.Ys + (size_t)t * D + c; const float* gt = p.mod + b * 6 * D + 5 * D + c; const bf16_t* x1 = (const bf16_t*)p.x1 + (size_t)t * D + c; float* o = p.out + (size_t)t * D + c;
#pragma unroll
    for (int h = 0; h < 4; ++h) {
      const u32x2 sv = *(const u32x2*)(ys + 4 * h);
      const float s0 = __uint_as_float(sv.x << 16), s1 = __uint_as_float(sv.x & 0xffff0000u), s2 = __uint_as_float(sv.y << 16), s3 = __uint_as_float(sv.y & 0xffff0000u);
      const u32x2 xq = *(const u32x2*)(x1 + 4 * h);
      const f32x4 xv = {__uint_as_float(xq.x << 16), __uint_as_float(xq.x & 0xffff0000u), __uint_as_float(xq.y << 16), __uint_as_float(xq.y & 0xffff0000u)}, gv = *(const f32x4*)(gt + 4 * h);
      f32x4 r = {xv[0] + gv[0] * (s0 + acc[4 * h] * (1.f / YQ_SCALE)), xv[1] + gv[1] * (s1 + acc[4 * h + 1] * (1.f / YQ_SCALE)),
                 xv[2] + gv[2] * (s2 + acc[4 * h + 2] * (1.f / YQ_SCALE)), xv[3] + gv[3] * (s3 + acc[4 * h + 3] * (1.f / YQ_SCALE))};
      *(f32x4*)(o + 4 * h) = r;
    }
  }
}


#define XB_TMO      128
#define XB_XCNT(j)  (256  + 64 * (j))
#define XB_XSUB(j)  (1280 + 64 * (j))
#define XB_XGEN(j)  (2304 + 64 * (j))
#define XB_TOP      3328
#define XB_TOPGEN   3392
#define XCD_BAR_WORDS 3456
#define XB_SPIN_CAP (1u << 22)
__device__ __forceinline__ unsigned xb_ld(unsigned* p)              { return __hip_atomic_load(p, __ATOMIC_RELAXED, __HIP_MEMORY_SCOPE_AGENT); }
__device__ __forceinline__ unsigned xb_add(unsigned* p, unsigned v) { return __hip_atomic_fetch_add(p, v, __ATOMIC_RELAXED, __HIP_MEMORY_SCOPE_AGENT); }
__device__ __forceinline__ unsigned xb_xcc_id() { return (unsigned)__builtin_amdgcn_s_getreg((3 << 11) | 20) & 0xFu; }
#define XB_SPIN(cond, bar) do { unsigned _sp = 0; while (cond) { __builtin_amdgcn_s_sleep(1); \
    if ((++_sp & 255u) == 0u) { if (xb_ld(&(bar)[XB_TMO])) break; if (_sp > XB_SPIN_CAP) { atomicAdd(&(bar)[XB_TMO], 1u); break; } } } } while (0)
struct XcdBarrier { unsigned* bar; unsigned x; volatile LAS unsigned* st; };
__device__ __forceinline__ XcdBarrier xcd_barrier_post(unsigned* bar, volatile LAS unsigned* st) {
  XcdBarrier b; b.bar = bar; b.x = xb_xcc_id(); b.st = st;
  if (threadIdx.x == 0) (void)xb_add(&bar[XB_XCNT(b.x)], 1u);
  return b;
}
__device__ __forceinline__ void xcd_barrier_complete(unsigned* bar, unsigned x, unsigned& nloc, unsigned& nx) {
  const unsigned G = gridDim.x * gridDim.y * gridDim.z;
  unsigned sum, cnt, mine, sp = 0u;
  for (;;) {
    sum = 0u; cnt = 0u; mine = 0u;
#pragma unroll
    for (unsigned j = 0; j < 16; ++j) { const unsigned c = xb_ld(&bar[XB_XCNT(j)]); sum += c; cnt += (c > 0u) ? 1u : 0u; mine = (j == x) ? c : mine; }
    if (sum == G) break;
    __builtin_amdgcn_s_sleep(1);
    if ((++sp & 255u) == 0u) { if (xb_ld(&bar[XB_TMO])) break; if (sp > XB_SPIN_CAP) { atomicAdd(&bar[XB_TMO], 1u); break; } }
  }
  nloc = mine > 0u ? mine : 1u; nx = cnt > 0u ? cnt : 1u;
}
__device__ __forceinline__ void xcd_barrier(const XcdBarrier& b) {
  asm volatile("s_waitcnt vmcnt(0)" ::: "memory");
  __syncthreads();
  if (threadIdx.x == 0) {
    unsigned* bar = b.bar;
    __builtin_amdgcn_s_waitcnt(0);
    unsigned nloc = b.st[0], nx = b.st[1];
    if (nloc == 0u) { xcd_barrier_complete(bar, b.x, nloc, nx); b.st[0] = nloc; b.st[1] = nx; }
    const unsigned old = xb_add(&bar[XB_XSUB(b.x)], 1u);
    const unsigned gen = old / nloc;
    if (old + 1u == (gen + 1u) * nloc) {
      __builtin_amdgcn_fence(__ATOMIC_RELEASE, "agent");
      asm volatile("s_waitcnt vmcnt(0)" ::: "memory");
      const unsigned og = xb_add(&bar[XB_TOP], 1u);
      const unsigned tg = og / nx;
      if (og + 1u == (tg + 1u) * nx) xb_add(&bar[XB_TOPGEN], 1u);
      else XB_SPIN(xb_ld(&bar[XB_TOPGEN]) == tg, bar);
      __builtin_amdgcn_fence(__ATOMIC_ACQUIRE, "agent");
      xb_add(&bar[XB_XGEN(b.x)], 1u);
      asm volatile("s_waitcnt vmcnt(0)" ::: "memory");
    } else {
      XB_SPIN(xb_ld(&bar[XB_XGEN(b.x)]) == gen, bar);
      __builtin_amdgcn_fence(__ATOMIC_ACQUIRE, "agent");
      asm volatile("s_waitcnt vmcnt(0)" ::: "memory");
    }
  }
  __syncthreads();
}

__global__ void __launch_bounds__(256, 2) mega(P p) {
  extern __shared__ __attribute__((aligned(16))) char smem[];
  {
    volatile LAS unsigned* st0 = (volatile LAS unsigned*)((LAS char*)smem + SMEM_BYTES - 32);
    if (threadIdx.x == 0) { st0[0] = 0u; st0[1] = 0u; }
    __syncthreads();
  }
  const XcdBarrier xb = xcd_barrier_post(p.bar, (volatile LAS unsigned*)((LAS char*)smem + SMEM_BYTES - 32));
  ph_ada(p, smem); ph_rope_tab(p);
  { int ib = 0;
    for (int it = (int)blockIdx.x; it < 8 * 23; it += gridDim.x) cvtq_tile(p.w_in, INC, p.Wq_in, D, (it & 7) * 128, (it >> 3) * 128, INC);
    ib = (8 * 23) % gridDim.x; for (int it = (int)blockIdx.x - ib; it < 64; it += gridDim.x) if (it >= 0) cvtq_tile(p.w_out, D, p.Wq_out, D, (it & 7) * 128, (it >> 3) * 128);
    ib = (ib + 64) % gridDim.x;
    cvt_matrix<false>(p.w_router, p.Wt_rth, D, NE, ib); cvt_matrix<true>(p.w_router, p.Wt_rtl, D, NE, ib);
    cvt_matrix<false>(p.w1_k, p.Wt_c1k, 2048, 128, ib); cvt_matrix<false>(p.w1_v, p.Wt_c1v, 2048, 128, ib);
    for (int it = (int)blockIdx.x - ib; it < 32; it += gridDim.x) if (it >= 0) cvtq_tile(it < 16 ? p.ws_gate : p.ws_up, FF, it < 16 ? p.Wq_sg : p.Wq_su, D, (it & 7) * 128, ((it >> 3) & 1) * 128);
    ib = (ib + 32) % gridDim.x; cvt_matrix<false>(p.ws_down, p.Wt_sd, FF, D, ib); }
  if (blockIdx.x == gridDim.x - 4) { for (int i = threadIdx.x; i < 2048; i += 256) p.zrow[i] = 0; }
  if (blockIdx.x == gridDim.x - 1) {
    const int which = threadIdx.x >> 7, n = threadIdx.x & 127;
    const float* pe = which ? p.pe_v : p.pe_k; const float* w1 = which ? p.w1_v : p.w1_k;
    float a = 0.f;
    for (int k = 0; k < 2048; ++k) a += pe[k] * w1[(size_t)k * 128 + n];
    p.b1c[threadIdx.x] = a;
  }
  if (blockIdx.x == gridDim.x - 2) {
    for (int i = threadIdx.x; i < 8 * 64; i += 256) { p.kcb[((size_t)(i >> 6) * 256 + 255) * 64 + (i & 63)] = 0; p.vcb[((size_t)(i >> 6) * 256 + 255) * 64 + (i & 63)] = 0; }
  }
  if (blockIdx.x == gridDim.x - 3) {
    p.cnt[threadIdx.x] = 0;
    if (threadIdx.x < 8) p.ctr[threadIdx.x] = 0;
    if (threadIdx.x < 64) {
      const int ln = threadIdx.x;
      const float a = wave_max(fabsf(p.g_q_dil[ln])), bq = wave_max(fabsf(p.g_k_dil[ln])), c = wave_max(fabsf(p.g_q_nsa[ln]));
      const float d1 = wave_max(fabsf(p.g_k_cmp[ln])), d2 = wave_max(fabsf(p.g_k_slc[ln])), d3 = wave_max(fabsf(p.g_k_win[ln]));
      if (ln == 0) { p.smaxv[0] = 8.f * a * bq; p.smaxv[1] = 8.f * c * d1; p.smaxv[2] = 8.f * c * d2; p.smaxv[3] = 8.f * c * d3; }
    }
  }
  xcd_barrier(xb);
  ph_norm_mod<false>(p.x, p.g_mix, p.mod, 0, D, nullptr, p.h1q);
  xcd_barrier(xb);
  ph_proj(p, smem);
  xcd_barrier(xb);
  ph_attn_a(p, smem);
  xcd_barrier(xb);
  ph_attn_b(p, smem);
  xcd_barrier(xb);
  ph_outproj(p, smem);
  xcd_barrier(xb);
  if (DUP == 10) { ph_outproj_abl<0>(p, smem); xcd_barrier(xb); }
  if (DUP == 11) { ph_outproj_abl<1>(p, smem); xcd_barrier(xb); }
  if (DUP == 12) { ph_outproj_abl<2>(p, smem); xcd_barrier(xb); }
  if (DUP == 13) { ph_outproj_abl<3>(p, smem); xcd_barrier(xb); }
  ph_norm_mod<true, true>(p.x1, p.g_ffn, p.mod, 3 * D, 4 * D, p.h2s, p.h2q);
  xcd_barrier(xb);
  ph_router_shared_gu(p, smem);
  xcd_barrier(xb);
  ph_route(p, smem); ph_shared_d(p, smem);
  xcd_barrier(xb);
  ph_fill(p, smem);
  xcd_barrier(xb);
  ph_moe_gu(p, smem);
  xcd_barrier(xb);
  ph_moe_d(p, smem);
  xcd_barrier(xb);
  ph_combine(p);
}
}

extern "C" void kernel_launch(void* const* d_in, const int* in_sizes, int n_in, void* d_out, int out_size, void* d_ws, size_t ws_size,
                              hipStream_t stream) {
  P p{};
  const float** f = (const float**)d_in;
  p.x = f[0]; p.c = f[1]; p.w_ada = f[2]; p.b_ada = f[3]; p.g_mix = f[4]; p.g_ffn = f[5]; p.w_in = f[6]; p.g_q_dil = f[7]; p.g_k_dil = f[8];
  p.g_q_nsa = f[9]; p.g_k_cmp = f[10]; p.g_k_slc = f[11]; p.g_k_win = f[12]; p.pe_k = f[13]; p.w1_k = f[14]; p.w2_k = f[15]; p.pe_v = f[16];
  p.w1_v = f[17]; p.w2_v = f[18]; p.w_out = f[19]; p.w_router = f[20]; p.r_bias = f[21]; p.w_gate = f[22]; p.w_up = f[23]; p.w_down = f[24];
  p.ws_gate = f[25]; p.ws_up = f[26]; p.ws_down = f[27];
  p.out = (float*)d_out;
  char* w = (char*)d_ws; size_t o = 0;
  auto alloc = [&](size_t bytes) { void* r = w + o; o += (bytes + 255) & ~(size_t)255; return r; };
  p.mod = (float*)alloc(4 * 6 * D * 4);
  p.rope = (float*)alloc(S * 16 * 4);
  p.selmask = (unsigned long long*)alloc((size_t)T * 2 * 8);
  p.eidx = (int*)alloc(T * 8 * 4); p.gates = (float*)alloc(T * 8 * 4);
  p.cnt = (int*)alloc(NE * 4); p.off = (int*)alloc((NE + 1) * 4); p.pos = (int*)alloc(T * 8 * 4); p.sorted = (int*)alloc(T * 8 * 4);
  p.tstart = (int*)alloc(8 * 33 * 4);
  p.smaxv = (float*)alloc(64);
  p.b1c = (float*)alloc(256 * 4);
  p.ctr = (int*)alloc(64);
  p.kcb = (bf16_t*)alloc(8 * 256 * 64 * 2); p.vcb = (bf16_t*)alloc(8 * 256 * 64 * 2);
  p.GS = (float*)alloc((size_t)T * 24 * 4);
  p.QA = (bf16_t*)alloc((size_t)T * 512 * 2); p.KA = (bf16_t*)alloc((size_t)T * 512 * 2); p.VA = (bf16_t*)alloc((size_t)T * 512 * 2);
  p.QN = (bf16_t*)alloc((size_t)T * 512 * 2); p.QR = (bf16_t*)alloc((size_t)T * 512 * 2);
  p.KC = (bf16_t*)alloc((size_t)T * 128 * 2); p.VC = (bf16_t*)alloc((size_t)T * 128 * 2);
  p.KSL = (bf16_t*)alloc((size_t)T * 128 * 2); p.VSL = (bf16_t*)alloc((size_t)T * 128 * 2);
  p.KW = (bf16_t*)alloc((size_t)T * 128 * 2); p.VW = (bf16_t*)alloc((size_t)T * 128 * 2);
  p.logits = (float*)alloc((size_t)3 * T * NE * 4);
  p.x1 = (float*)alloc((size_t)T * D * 4);
  p.mixinb = (bf16_t*)alloc((size_t)T * D * 2);
  p.h1b = (bf16_t*)alloc((size_t)T * D * 2);
  p.h2s = (bf16_t*)alloc((size_t)T * 2 * D * 2);
  p.Hs = (bf16_t*)alloc((size_t)T * FF * 2);
  p.Ys = (bf16_t*)alloc((size_t)T * D * 2);
  p.bar = (unsigned*)alloc(XCD_BAR_WORDS * 4);
  p.bhist = (int*)alloc((size_t)2048 * NE * 4);
  p.Wt_c1k = (bf16_t*)alloc((size_t)128 * 2048 * 2); p.Wt_c1v = (bf16_t*)alloc((size_t)128 * 2048 * 2);
  p.zrow = (bf16_t*)alloc(2048 * 2);
  p.Wt_in = (bf16_t*)alloc((size_t)2944 * D * 2);
  p.Wt_out = (bf16_t*)alloc((size_t)D * D * 2);
  p.Wt_rth = (bf16_t*)alloc((size_t)NE * D * 2); p.Wt_rtl = (bf16_t*)alloc((size_t)NE * D * 2);
  p.Wt_sg = (bf16_t*)alloc((size_t)FF * D * 2); p.Wt_su = (bf16_t*)alloc((size_t)FF * D * 2); p.Wt_sd = (bf16_t*)alloc((size_t)D * FF * 2);
  p.Wq_g = (unsigned char*)alloc((size_t)NE * FF * D); p.Wq_u = (unsigned char*)alloc((size_t)NE * FF * D); p.Wq_d = (unsigned char*)alloc((size_t)NE * D * FF);
  p.h2q = (unsigned char*)alloc((size_t)T * D); p.h1q = (unsigned char*)alloc((size_t)T * D); p.Wq_in = (unsigned char*)alloc((size_t)2944 * D); p.Hq = (unsigned char*)alloc((size_t)T * 8 * FF);
  p.Yq = (unsigned char*)alloc((size_t)T * 8 * D);
  p.Wq_sg = (unsigned char*)alloc((size_t)FF * D); p.Wq_su = (unsigned char*)alloc((size_t)FF * D);
  p.mixq = (unsigned char*)alloc((size_t)T * D); p.Wq_out = (unsigned char*)alloc((size_t)D * D);
  (void)hipMemsetAsync(p.bar, 0, XCD_BAR_WORDS * 4, stream);
  static int grid_blocks = 0;
  if (!grid_blocks) {
    int dev = 0, cus = 0, per_cu = 0;
    (void)hipGetDevice(&dev);
    (void)hipDeviceGetAttribute(&cus, hipDeviceAttributeMultiprocessorCount, dev);
    (void)hipOccupancyMaxActiveBlocksPerMultiprocessor(&per_cu, mega, 256, SMEM_BYTES);
    if (per_cu > 2) per_cu = 2;
    if (per_cu < 1) per_cu = 1;
    grid_blocks = cus * per_cu;
  }
  void* args[] = {&p};
  hipError_t e = hipLaunchCooperativeKernel((void*)mega, dim3(grid_blocks), dim3(256), args, SMEM_BYTES, stream);
  if (e != hipSuccess) fprintf(stderr, "cooperative launch failed: %s (grid %d)\n", hipGetErrorString(e), grid_blocks);
}
```

```cpp
#include <hip/hip_runtime.h>
#include <hip/hip_cooperative_groups.h>
#include <stdint.h>
#include <cstdio>
namespace cg = cooperative_groups;

namespace {
constexpr int D = 1024, NB = 4, S = 4096, T = NB * S, HD = 64;
constexpr int INC = 2840;
constexpr int C_QA = 0, C_KA = 512, C_VA = 1024, C_QB = 1536, C_KC = 2048, C_VC = 2176, C_KSL = 2304, C_VSL = 2432,
              C_KW = 2560, C_VW = 2688, C_GB = 2816;
constexpr int NC = 255, NE = 256, TOPK = 8, FF = 256;
constexpr float EPS = 1e-6f;
#ifndef DUP
#define DUP 0
#endif
constexpr int SMEM_BYTES = 74 * 1024;
typedef unsigned short bf16_t;
typedef short bf16x8 __attribute__((ext_vector_type(8)));
typedef float f32x4 __attribute__((ext_vector_type(4)));
typedef unsigned u32x4 __attribute__((ext_vector_type(4)));
typedef unsigned u32x2 __attribute__((ext_vector_type(2)));
typedef __bf16 bf2_t __attribute__((ext_vector_type(2)));
typedef float f32x2 __attribute__((ext_vector_type(2)));
typedef float f32x16 __attribute__((ext_vector_type(16)));
typedef short s16x4 __attribute__((ext_vector_type(4)));
#define LAS __attribute__((address_space(3)))
#define MFMA32(a, b, c) __builtin_amdgcn_mfma_f32_32x32x16_bf16((a), (b), (c), 0, 0, 0)
constexpr float LOG2E = 1.4426950408889634f;

struct P {
  const float *x, *c, *w_ada, *b_ada, *g_mix, *g_ffn, *w_in, *g_q_dil, *g_k_dil, *g_q_nsa, *g_k_cmp, *g_k_slc, *g_k_win;
  const float *pe_k, *w1_k, *w2_k, *pe_v, *w1_v, *w2_v, *w_out, *w_router, *r_bias, *w_gate, *w_up, *w_down, *ws_gate, *ws_up, *ws_down;
  float* out;
  float *mod, *rope, *h1, *proj, *qrope, *kcmp, *vcmp, *ocmp, *oslc, *owin, *mixin, *x1, *h2, *logits, *gates, *hs_g, *hs, *shared, *Hbuf;
  unsigned long long* selmask;
  int *eidx, *cnt, *off, *pos, *sorted, *tstart, *xpre, *xhist;
  bf16_t *h1b, *h2s, *mixinb, *Hb, *Hs, *Ybuf, *Ys;
  bf16_t *QA, *KA, *VA, *QN, *QR, *KC, *VC, *KSL, *VSL, *KW, *VW;
  float *GS, *smaxv, *b1c, *b1p;
  bf16_t *kcb, *vcb;
  int* ctr;
  int* bhist;
  unsigned char *h2q, *Hq, *Wq_g, *Wq_u, *Wq_d, *h1q, *Wq_in, *Yq, *mixq, *Wq_out, *Wq_sg, *Wq_su, *KCq, *VCq, *Wq_c1k, *Wq_c1v;
  unsigned* bar;
  bf16_t *zrow, *Wt_in, *Wt_out, *Wt_rth, *Wt_rtl, *Wt_sg, *Wt_su, *Wt_sd, *Wt_c1k, *Wt_c1v, *Wt_c2, *Wt_g, *Wt_u, *Wt_d;
};

#define WLOOP(w, n) for (int w = blockIdx.x; w < (n); w += gridDim.x)
constexpr int GST_OFF = 74 * 1024 - 64;
__device__ __forceinline__ int vbid() { extern __shared__ __attribute__((aligned(16))) char smem_v[]; return __builtin_amdgcn_readfirstlane(*(const LAS int*)((const LAS char*)smem_v + GST_OFF + 4)); }

__device__ __forceinline__ int otid() { int t = threadIdx.x; asm volatile("" : "+v"(t)); return t; }
__device__ __forceinline__ unsigned pk_bf16(float lo, float hi) {
  f32x2 v = {lo, hi};
  bf2_t r = __builtin_convertvector(v, bf2_t);
  return __builtin_bit_cast(unsigned, r);
}
__device__ __forceinline__ float clamp_e4m3(float v) { return __builtin_amdgcn_fmed3f(v, -448.f, 448.f); }
__device__ __forceinline__ unsigned pk4_fp8(float a, float b, float c, float d) {
  int t = __builtin_amdgcn_cvt_pk_fp8_f32(a, b, 0, false);
  t = __builtin_amdgcn_cvt_pk_fp8_f32(c, d, t, true);
  return (unsigned)t;
}
constexpr float WQ_SCALE = 64.f, HQ_SCALE = 8.f, YQ_SCALE = 16.f, MQ_SCALE = 16.f, CQ_SCALE = 8.f;
__device__ __forceinline__ float bf16_to_f32(unsigned short b) { return __uint_as_float((unsigned)b << 16); }
__device__ __forceinline__ float bf16_round(float v) { return __uint_as_float(pk_bf16(v, 0.f) << 16); }
__device__ __forceinline__ float silu(float v) { return v / (1.f + expf(-v)); }
__device__ __forceinline__ float sigmoidf(float v) { return 1.f / (1.f + expf(-v)); }
__device__ __forceinline__ float wave_sum(float v) { for (int o = 32; o; o >>= 1) v += __shfl_xor(v, o); return v; }
__device__ __forceinline__ float wave_max(float v) { for (int o = 32; o; o >>= 1) v = fmaxf(v, __shfl_xor(v, o)); return v; }

__device__ __forceinline__ void ph_ada(const P& p, char* smem) {
  float* sc = (float*)smem;
  f32x4* red = (f32x4*)(smem + 16384);
  bool loaded = false;
  WLOOP(w, 6 * D / 32) {
    const int tid = threadIdx.x, kg = tid >> 3, cl = tid & 7, j0 = w * 32 + cl * 4;
    __syncthreads();
    if (!loaded) { for (int i = tid; i < 4 * D; i += 256) sc[i] = silu(p.c[i]); loaded = true; __syncthreads(); }
    f32x4 acc[4];
#pragma unroll
    for (int b = 0; b < 4; ++b) acc[b] = (f32x4){0.f, 0.f, 0.f, 0.f};
#pragma unroll 16
    for (int it = 0; it < 32; ++it) {
      const int k = kg + 32 * it;
      const f32x4 wv = *(const f32x4*)(p.w_ada + (size_t)k * 6 * D + j0);
#pragma unroll
      for (int b = 0; b < 4; ++b) acc[b] += wv * sc[b * D + k];
    }
#pragma unroll
    for (int b = 0; b < 4; ++b) red[(kg * 8 + cl) * 4 + b] = acc[b];
    __syncthreads();
    if (tid < 128) {
      const int b = tid >> 5, c = tid & 31;
      float s = p.b_ada[w * 32 + c];
      for (int g = 0; g < 32; ++g) s += ((const float*)&red[(g * 8 + (c >> 2)) * 4 + b])[c & 3];
      p.mod[b * 6 * D + w * 32 + c] = s;
    }
  }
}
__device__ __forceinline__ void ph_rope_tab(const P& p) {
  const double invf[8] = {1.0, 0.19392274474868576, 0.03760603093086393, 0.007292664737217109, 0.001414213562373095, 0.0002742481756762073, 5.318295896944988e-05, 1.031338537721246e-05};
  const int first = (int)gridDim.x >= 512 ? 384 : 0;
  for (int w = (int)blockIdx.x - first; w < S * 8 / 256; w += gridDim.x) {
    if (w < 0) continue;
    int i = w * 256 + threadIdx.x;
    int pos = i >> 3, f = i & 7;
    const double ang = (double)pos * invf[f];
    const double red = ang - rint(ang * 0.15915494309189535) * 6.283185307179586;
    const float rf = (float)red;
    p.rope[i * 2] = cosf(rf);
    p.rope[i * 2 + 1] = sinf(rf);
  }
}
template <bool SPLIT, bool INBF = false>
__device__ __forceinline__ void ph_norm_mod(const float* in, const float* g, const float* mod, int shift_off, int scale_off, bf16_t* out, unsigned char* outq = nullptr) {
  const int lane = threadIdx.x & 63, wv = threadIdx.x >> 6;
  auto ldrow = [&](int t, f32x4 (&dst)[4]) {
#pragma unroll
    for (int i = 0; i < 4; ++i) {
      if (INBF) { const u32x2 q = *(const u32x2*)((const bf16_t*)in + (size_t)t * D + i * 256 + lane * 4); dst[i] = (f32x4){__uint_as_float(q.x << 16), __uint_as_float(q.x & 0xffff0000u), __uint_as_float(q.y << 16), __uint_as_float(q.y & 0xffff0000u)}; }
      else dst[i] = *(const f32x4*)(in + (size_t)t * D + i * 256 + lane * 4);
    }
  };
  f32x4 nv[4];
  const int vb = vbid(), nlb = gridDim.x >> 3, wbase = (vb & 7) * (T / 32), wend = wbase + T / 32;
  if (wbase + (vb >> 3) < wend) ldrow((wbase + (vb >> 3)) * 4 + wv, nv);
  for (int w = wbase + (vb >> 3); w < wend; w += nlb) {
    const int t = w * 4 + wv, b = t / S;
    f32x4 v[4];
#pragma unroll
    for (int i = 0; i < 4; ++i) v[i] = nv[i];
    if (w + nlb < wend) ldrow((w + nlb) * 4 + wv, nv);
    f32x4 gg[4], sc[4], sh[4];
#pragma unroll
    for (int i = 0; i < 4; ++i) {
      const int d = i * 256 + lane * 4;
      gg[i] = *(const f32x4*)(g + d); sc[i] = *(const f32x4*)(mod + b * 6 * D + scale_off + d); sh[i] = *(const f32x4*)(mod + b * 6 * D + shift_off + d);
    }
    float ss = 0.f;
#pragma unroll
    for (int i = 0; i < 4; ++i) ss += v[i][0] * v[i][0] + v[i][1] * v[i][1] + v[i][2] * v[i][2] + v[i][3] * v[i][3];
    ss = wave_sum(ss);
    const float r = rsqrtf(ss * (1.f / D) + EPS);
    const int ld = SPLIT ? 2 * D : D;
#pragma unroll
    for (int i = 0; i < 4; ++i) {
      const int d = i * 256 + lane * 4;
      const f32x4 o = v[i] * r * gg[i] * (sc[i] + 1.f) + sh[i];
      u32x2 hi = {pk_bf16(o[0], o[1]), pk_bf16(o[2], o[3])};
      if (out) *(u32x2*)(out + (size_t)t * ld + d) = hi;
      if (!SPLIT && outq) *(unsigned*)(outq + (size_t)t * D + d) = pk4_fp8(o[0], o[1], o[2], o[3]);
      if (SPLIT) {
        *(unsigned*)(outq + (size_t)t * D + d) = pk4_fp8(o[0], o[1], o[2], o[3]);
        const float l0 = o[0] - __uint_as_float(hi.x << 16), l1 = o[1] - __uint_as_float(hi.x & 0xffff0000u);
        const float l2 = o[2] - __uint_as_float(hi.y << 16), l3 = o[3] - __uint_as_float(hi.y & 0xffff0000u);
        u32x2 lo = {pk_bf16(l0, l1), pk_bf16(l2, l3)};
        *(u32x2*)(out + (size_t)t * ld + D + d) = lo;
      }
    }
  }
}

template <bool SPLIT3, class AF, class BF, class EF>
__device__ __forceinline__ void gemm128(char* smem, int K, int ldb, AF arow, BF bcol, EF epi) {
  const int tid = otid(), lane = tid & 63, wid = tid >> 6, wm = wid >> 1, wn = wid & 1;
  const int l15 = lane & 15, l4 = lane >> 4;
  char* As = smem; char* Bs = smem + 16384;
  const int ac = tid & 7, ar0 = tid >> 3;
  const bf16_t* ap[4];
#pragma unroll
  for (int i = 0; i < 4; ++i) ap[i] = arow(ar0 + 32 * i);
  const int kg = tid >> 5, ng = tid & 31;
  const float* bp = bcol(ng * 4);
  if (bp) bp += (size_t)(kg * 8) * ldb;
  u32x4 areg[4]; f32x4 breg[8];
  const int nk1 = K / 64, nk = SPLIT3 ? 3 * nk1 : nk1;
  auto gload = [&](int kt) {
    const int seg = SPLIT3 ? kt / nk1 : 0, k0 = (SPLIT3 ? kt % nk1 : kt) * 64;
    const int aoff = (seg == 2 ? K : 0) + k0 + ac * 8;
#pragma unroll
    for (int i = 0; i < 4; ++i) areg[i] = ap[i] ? *(const u32x4*)(ap[i] + aoff) : (u32x4){0u, 0u, 0u, 0u};
#pragma unroll
    for (int i = 0; i < 8; ++i) breg[i] = bp ? *(const f32x4*)(bp + (size_t)(k0 + i) * ldb) : (f32x4){0.f, 0.f, 0.f, 0.f};
    if (SPLIT3 && seg == 1) {
#pragma unroll
      for (int i = 0; i < 8; ++i)
#pragma unroll
        for (int j = 0; j < 4; ++j) breg[i][j] = breg[i][j] - bf16_round(breg[i][j]);
    }
  };
  auto lstore = [&]() {
#pragma unroll
    for (int i = 0; i < 4; ++i) { const int r = ar0 + 32 * i; *(u32x4*)(As + r * 128 + ((ac ^ ((r >> 1) & 7)) << 4)) = areg[i]; }
#pragma unroll
    for (int j = 0; j < 4; ++j) {
      const int n = ng * 4 + j;
      u32x4 v = {pk_bf16(breg[0][j], breg[1][j]), pk_bf16(breg[2][j], breg[3][j]), pk_bf16(breg[4][j], breg[5][j]), pk_bf16(breg[6][j], breg[7][j])};
      *(u32x4*)(Bs + n * 128 + ((kg ^ ((n >> 1) & 7)) << 4)) = v;
    }
  };
  f32x4 acc[4][4];
#pragma unroll
  for (int i = 0; i < 4; ++i)
#pragma unroll
    for (int j = 0; j < 4; ++j) acc[i][j] = (f32x4){0.f, 0.f, 0.f, 0.f};
  gload(0);
  const int sw = l15 >> 1;
  for (int kt = 0; kt < nk; ++kt) {
    __syncthreads();
    lstore();
    __syncthreads();
    if (kt + 1 < nk) gload(kt + 1);
#pragma unroll
    for (int ks = 0; ks < 2; ++ks) {
      const int coff = ((ks * 4 + l4) ^ sw) << 4;
      bf16x8 af[4], bfr[4];
#pragma unroll
      for (int mt = 0; mt < 4; ++mt) af[mt] = *(const bf16x8*)(As + (wm * 64 + mt * 16 + l15) * 128 + coff);
#pragma unroll
      for (int nt = 0; nt < 4; ++nt) bfr[nt] = *(const bf16x8*)(Bs + (wn * 64 + nt * 16 + l15) * 128 + coff);
#pragma unroll
      for (int mt = 0; mt < 4; ++mt)
#pragma unroll
        for (int nt = 0; nt < 4; ++nt) acc[mt][nt] = __builtin_amdgcn_mfma_f32_16x16x32_bf16(bfr[nt], af[mt], acc[mt][nt], 0, 0, 0);
    }
  }
  epi(acc, wm * 64 + l15, wn * 64 + l4 * 4);
}

typedef unsigned u32x2v __attribute__((ext_vector_type(2)));
__device__ __forceinline__ void xpose4(unsigned (&d)[4][2], int) {
#pragma unroll
  for (int a = 0; a < 2; ++a)
#pragma unroll
    for (int h = 0; h < 2; ++h) { const u32x2v r = __builtin_amdgcn_permlane16_swap(d[2 * a][h], d[2 * a + 1][h], false, false); d[2 * a][h] = r.x; d[2 * a + 1][h] = r.y; }
#pragma unroll
  for (int j = 0; j < 2; ++j)
#pragma unroll
    for (int h = 0; h < 2; ++h) { const u32x2v r = __builtin_amdgcn_permlane32_swap(d[j][h], d[2 + j][h], false, false); d[j][h] = r.x; d[2 + j][h] = r.y; }
}
__device__ __forceinline__ void store_row64_bf16(const f32x4& a0, const f32x4& a1, const f32x4& a2, const f32x4& a3, int l4, bf16_t* rowp, bool doit) {
  unsigned d[4][2] = {{pk_bf16(a0[0], a0[1]), pk_bf16(a0[2], a0[3])}, {pk_bf16(a1[0], a1[1]), pk_bf16(a1[2], a1[3])},
                      {pk_bf16(a2[0], a2[1]), pk_bf16(a2[2], a2[3])}, {pk_bf16(a3[0], a3[1]), pk_bf16(a3[2], a3[3])}};
  xpose4(d, l4);
  if (doit) {
    *(u32x4*)(rowp + 16 * l4) = (u32x4){d[0][0], d[0][1], d[1][0], d[1][1]};
    *(u32x4*)(rowp + 16 * l4 + 8) = (u32x4){d[2][0], d[2][1], d[3][0], d[3][1]};
  }
}

template <bool LO>
__device__ __forceinline__ void cvt_kn_tile(const float* src, int ldn, bf16_t* dst, int ldk, int k0, int n0, int nmax) {
  const int tid = threadIdx.x, kg = tid & 7, ng = tid >> 3, n = n0 + ng * 4;
  if (n >= nmax) return;
  f32x4 r[8];
#pragma unroll
  for (int i = 0; i < 8; ++i) r[i] = *(const f32x4*)(src + (size_t)(k0 + kg * 8 + i) * ldn + n);
  if (LO) {
#pragma unroll
    for (int i = 0; i < 8; ++i)
#pragma unroll
      for (int j = 0; j < 4; ++j) r[i][j] = r[i][j] - bf16_round(r[i][j]);
  }
#pragma unroll
  for (int j = 0; j < 4; ++j) {
    u32x4 v = {pk_bf16(r[0][j], r[1][j]), pk_bf16(r[2][j], r[3][j]), pk_bf16(r[4][j], r[5][j]), pk_bf16(r[6][j], r[7][j])};
    *(u32x4*)(dst + (size_t)(n + j) * ldk + k0 + kg * 8) = v;
  }
}
template <bool LO>
__device__ __forceinline__ void cvt_matrix(const float* src, bf16_t* dst, int K, int N, int& item_base) {
  const int nkt = K / 64, nnt = (N + 127) / 128, total = nkt * nnt;
  for (int it = (int)blockIdx.x - item_base; it < total; it += gridDim.x) {
    if (it < 0) continue;
    cvt_kn_tile<LO>(src, N, dst, K, (it % nkt) * 64, (it / nkt) * 128, N);
  }
  item_base = (item_base + total) % gridDim.x;
}

constexpr int G2_STAGE = 24576;
template <int NSEG, int AB = 0, class AF, class BF, class EF>
__device__ __forceinline__ void gemm2(char* smem_, int K, AF arow, BF brow, EF epi, int aseg1 = 0, int bseg1 = 0, int aseg2 = 0, int bseg2 = 0) {
  LAS char* smem = (LAS char*)smem_;
  const int tid = otid(), lane = tid & 63, wv = __builtin_amdgcn_readfirstlane(tid >> 6), wm = wv >> 1, wn = wv & 1;
  const int l15 = lane & 15, l4 = lane >> 4;
  const int row_l = lane >> 2, csrc = ((lane & 3) ^ (((row_l >> 3) & 1) * 3)) * 8;
  const bf16_t* ap[4]; const bf16_t* bp[2];
#pragma unroll
  for (int j = 0; j < 4; ++j) ap[j] = arow((wv + 4 * j) * 16 + row_l) + csrc;
#pragma unroll
  for (int j = 0; j < 2; ++j) bp[j] = brow((wv + 4 * j) * 16 + row_l) + csrc;
  const int nk1 = K / 32, nk = NSEG * nk1;
  auto issue = [&](int kt) {
    LAS char* st = smem + (kt % 3) * G2_STAGE;
    int ka = kt * 32, kb = kt * 32;
    if (NSEG > 1) { const int seg = kt / nk1, kk = (kt - seg * nk1) * 32; ka = kk + (seg == 1 ? aseg1 : (seg == 2 ? aseg2 : 0)); kb = kk + (seg == 1 ? bseg1 : (seg == 2 ? bseg2 : 0)); }
#pragma unroll
    for (int j = 0; j < 4; ++j) __builtin_amdgcn_global_load_lds((const unsigned*)(ap[j] + ka), (LAS unsigned*)(st + (wv + 4 * j) * 1024), 16, 0, 0);
#pragma unroll
    for (int j = 0; j < 2; ++j) __builtin_amdgcn_global_load_lds((const unsigned*)(bp[j] + kb), (LAS unsigned*)(st + 16384 + (wv + 4 * j) * 1024), 16, 0, 0);
  };
  f32x4 acc[8][4];
#pragma unroll
  for (int i = 0; i < 8; ++i)
#pragma unroll
    for (int j = 0; j < 4; ++j) acc[i][j] = (f32x4){0.f, 0.f, 0.f, 0.f};
  const int coff = (l4 ^ (((l15 >> 3) & 1) * 3)) << 4;
  const int aoff = (wm * 128 + l15) * 64 + coff, boff = 16384 + (wn * 64 + l15) * 64 + coff;
  asm volatile("s_waitcnt lgkmcnt(0)" ::: "memory");
  __builtin_amdgcn_s_barrier();
  asm volatile("" ::: "memory");
  issue(0);
  if (nk > 1) issue(1);
  for (int kt = 0; kt < nk; ++kt) {
    if (kt + 1 < nk) asm volatile("s_waitcnt vmcnt(6)" ::: "memory"); else asm volatile("s_waitcnt vmcnt(0)" ::: "memory");
    __builtin_amdgcn_s_barrier();
    asm volatile("" ::: "memory");
    if (AB != 2 && kt + 2 < nk) issue(kt + 2);
    const LAS char* st = smem + (kt % 3) * G2_STAGE;
    bf16x8 bfr[4], af[8];
    if (AB != 3) {
#pragma unroll
    for (int nt = 0; nt < 4; ++nt) bfr[nt] = *(const LAS bf16x8*)(st + boff + nt * 1024);
#pragma unroll
    for (int mt = 0; mt < 8; ++mt) af[mt] = *(const LAS bf16x8*)(st + aoff + mt * 1024);
    }
    __builtin_amdgcn_sched_barrier(0);
    if (AB == 1) {
#pragma unroll
      for (int nt = 0; nt < 4; ++nt) asm volatile("" :: "v"(bfr[nt]));
#pragma unroll
      for (int mt = 0; mt < 8; ++mt) asm volatile("" :: "v"(af[mt]));
    }
    if (AB == 0 || AB == 2) {
    __builtin_amdgcn_s_setprio(1);
#pragma unroll
    for (int mt = 0; mt < 8; ++mt)
#pragma unroll
      for (int nt = 0; nt < 4; ++nt) acc[mt][nt] = __builtin_amdgcn_mfma_f32_16x16x32_bf16(bfr[nt], af[mt], acc[mt][nt], 0, 0, 0);
    __builtin_amdgcn_s_setprio(0);
    }
    __builtin_amdgcn_sched_barrier(0);
  }
  epi(acc, wm * 128 + l15, wn * 64 + l4 * 4);
}

template <int NREP = 1, class AF, class BF, class EF>
__device__ __forceinline__ void gemm2q(char* smem_, int K, AF arow, BF brow, EF epi, size_t bstep = 0, bool half = false) {
  LAS char* smem = (LAS char*)smem_;
  const int tid = otid(), lane = tid & 63, wv = __builtin_amdgcn_readfirstlane(tid >> 6), wm = wv >> 1, wn = wv & 1;
  const int l15 = lane & 15, l4 = lane >> 4;
  const int row_l = lane >> 2, csrc = ((lane & 3) ^ ((row_l >> 2) & 3)) * 16;
  const unsigned char* ap[4]; const unsigned char* bp[2];
#pragma unroll
  for (int j = 0; j < 4; ++j) ap[j] = arow((wv + 4 * j) * 16 + row_l) + csrc;
#pragma unroll
  for (int j = 0; j < 2; ++j) bp[j] = brow((wv + 4 * j) * 16 + row_l) + csrc;
  const int nk1 = K / 64, nk = nk1 * NREP;
  auto issue = [&](int kt) {
    LAS char* st = smem + (kt % 3) * G2_STAGE;
    const int rp = NREP > 1 ? kt / nk1 : 0, kk = NREP > 1 ? kt - rp * nk1 : kt;
#pragma unroll
    for (int j = 0; j < 4; ++j) __builtin_amdgcn_global_load_lds((const unsigned*)(ap[j] + kk * 64), (LAS unsigned*)(st + (wv + 4 * j) * 1024), 16, 0, 0);
#pragma unroll
    for (int j = 0; j < 2; ++j) __builtin_amdgcn_global_load_lds((const unsigned*)(bp[j] + rp * bstep + kk * 64), (LAS unsigned*)(st + 16384 + (wv + 4 * j) * 1024), 16, 0, 0);
  };
  f32x4 acc[8][4];
#pragma unroll
  for (int i = 0; i < 8; ++i)
#pragma unroll
    for (int j = 0; j < 4; ++j) acc[i][j] = (f32x4){0.f, 0.f, 0.f, 0.f};
  const int sw = (l15 >> 2) & 3, sub = (l4 & 1) * 8, ch = l4 >> 1;
  const int aoff = (wm * 128 + l15) * 64 + sub, boff = 16384 + (wn * 64 + l15) * 64 + sub;
  asm volatile("s_waitcnt lgkmcnt(0)" ::: "memory");
  __builtin_amdgcn_s_barrier();
  asm volatile("" ::: "memory");
  issue(0);
  if (nk > 1) issue(1);
  for (int kt = 0; kt < nk; ++kt) {
    if (kt + 1 < nk) asm volatile("s_waitcnt vmcnt(6)" ::: "memory"); else asm volatile("s_waitcnt vmcnt(0)" ::: "memory");
    __builtin_amdgcn_s_barrier();
    asm volatile("" ::: "memory");
    if (kt + 2 < nk) issue(kt + 2);
    const LAS char* st = smem + (kt % 3) * G2_STAGE;
    if (!(half && wm == 1))
#pragma unroll
    for (int ks = 0; ks < 2; ++ks) {
      const int coff = ((2 * ks + ch) ^ sw) << 4;
      long bfr[4], af[8];
#pragma unroll
      for (int nt = 0; nt < 4; ++nt) bfr[nt] = *(const LAS long*)(st + boff + nt * 1024 + coff);
#pragma unroll
      for (int mt = 0; mt < 8; ++mt) af[mt] = *(const LAS long*)(st + aoff + mt * 1024 + coff);
      __builtin_amdgcn_s_setprio(1);
#pragma unroll
      for (int mt = 0; mt < 8; ++mt)
#pragma unroll
        for (int nt = 0; nt < 4; ++nt) acc[mt][nt] = __builtin_amdgcn_mfma_f32_16x16x32_fp8_fp8(bfr[nt], af[mt], acc[mt][nt], 0, 0, 0);
      __builtin_amdgcn_s_setprio(0);
    }
    __builtin_amdgcn_sched_barrier(0);
    if (NREP > 1 && (kt + 1) % nk1 == 0 && kt + 1 < nk) {
      epi(acc, wm * 128 + l15, wn * 64 + l4 * 4, kt / nk1);
#pragma unroll
      for (int i = 0; i < 8; ++i)
#pragma unroll
        for (int j = 0; j < 4; ++j) acc[i][j] = (f32x4){0.f, 0.f, 0.f, 0.f};
    }
  }
  epi(acc, wm * 128 + l15, wn * 64 + l4 * 4, NREP - 1);
}


typedef int i32x8 __attribute__((ext_vector_type(8)));
typedef float f32x16 __attribute__((ext_vector_type(16)));
template <int NREP = 1, class AF, class BF, class EF>
__device__ __forceinline__ void gemm2x(char* smem_, int K, AF arow, BF brow, EF epi, size_t bstep = 0, bool half = false, bool dual = false) {
  LAS char* smem = (LAS char*)smem_;
  const int tid = otid(), lane = tid & 63, wv = __builtin_amdgcn_readfirstlane(tid >> 6), wm = wv >> 1, wn = wv & 1;
  const int l31 = lane & 31, hh = lane >> 5;
  const int row_l = lane >> 2, csrc = ((lane & 3) ^ ((row_l >> 2) & 3)) * 16;
  const unsigned char* ap[4]; const unsigned char* bp[2];
#pragma unroll
  for (int j = 0; j < 4; ++j) ap[j] = arow((wv + 4 * j) * 16 + row_l) + csrc;
#pragma unroll
  for (int j = 0; j < 2; ++j) bp[j] = brow((wv + 4 * j) * 16 + row_l) + csrc;
  const int nk1 = K / 64, nk = nk1 * NREP;
  const size_t astep = dual ? bstep : 0;
  auto issue = [&](int kt) {
    LAS char* st = smem + (kt % 3) * G2_STAGE;
    const int rp = NREP > 1 ? kt / nk1 : 0, kk = NREP > 1 ? kt - rp * nk1 : kt;
#pragma unroll
    for (int j = 0; j < 4; ++j) __builtin_amdgcn_global_load_lds((const unsigned*)(ap[j] + (j >= 2 ? rp * astep : 0) + kk * 64), (LAS unsigned*)(st + (wv + 4 * j) * 1024), 16, 0, 0);
#pragma unroll
    for (int j = 0; j < 2; ++j) __builtin_amdgcn_global_load_lds((const unsigned*)(bp[j] + rp * bstep + kk * 64), (LAS unsigned*)(st + 16384 + (wv + 4 * j) * 1024), 16, 0, 0);
  };
  f32x16 acc[4][2];
#pragma unroll
  for (int i = 0; i < 4; ++i)
#pragma unroll
    for (int j = 0; j < 2; ++j)
#pragma unroll
      for (int e = 0; e < 16; ++e) acc[i][j][e] = 0.f;
  const int sw = (l31 >> 2) & 3, c0 = ((2 * hh) ^ sw) << 4, c1 = c0 ^ 16;
  const int arow0 = dual ? 0 : wm * 128, ecol = wn * 64 + 4 * hh + ((dual && wm) ? 128 : 0);
  const int aoff = (arow0 + l31) * 64, boff = (dual && wm) ? (128 + wn * 64 + l31) * 64 : 16384 + (wn * 64 + l31) * 64;
  asm volatile("s_waitcnt lgkmcnt(0)" ::: "memory");
  __builtin_amdgcn_s_barrier();
  asm volatile("" ::: "memory");
  issue(0);
  if (nk > 1) issue(1);
#pragma unroll 1
  for (int kt = 0; kt < nk; ++kt) {
    if (kt + 1 < nk) asm volatile("s_waitcnt vmcnt(6)" ::: "memory"); else asm volatile("s_waitcnt vmcnt(0)" ::: "memory");
    __builtin_amdgcn_s_barrier();
    asm volatile("" ::: "memory");
    if (kt + 2 < nk) issue(kt + 2);
    const LAS char* st = smem + (kt % 3) * G2_STAGE;
    if (!(half && wm == 1)) {
      i32x8 bfr[2], af[4];
#pragma unroll
      for (int nt = 0; nt < 2; ++nt) {
        const u32x4 lo = *(const LAS u32x4*)(st + boff + nt * 2048 + c0), hi = *(const LAS u32x4*)(st + boff + nt * 2048 + c1);
        bfr[nt] = (i32x8){(int)lo.x, (int)lo.y, (int)lo.z, (int)lo.w, (int)hi.x, (int)hi.y, (int)hi.z, (int)hi.w};
      }
#pragma unroll
      for (int mt = 0; mt < 4; ++mt) {
        const u32x4 lo = *(const LAS u32x4*)(st + aoff + mt * 2048 + c0), hi = *(const LAS u32x4*)(st + aoff + mt * 2048 + c1);
        af[mt] = (i32x8){(int)lo.x, (int)lo.y, (int)lo.z, (int)lo.w, (int)hi.x, (int)hi.y, (int)hi.z, (int)hi.w};
      }
      __builtin_amdgcn_s_setprio(1);
#pragma unroll
      for (int mt = 0; mt < 4; ++mt)
#pragma unroll
        for (int nt = 0; nt < 2; ++nt)
          acc[mt][nt] = __builtin_amdgcn_mfma_scale_f32_32x32x64_f8f6f4(bfr[nt], af[mt], acc[mt][nt], 0, 0, 0, 0x7F7F7F7F, 0, 0x7F7F7F7F);
      __builtin_amdgcn_s_setprio(0);
    }
    __builtin_amdgcn_sched_barrier(0);
    if (NREP > 1 && (kt + 1) % nk1 == 0 && kt + 1 < nk) {
      epi(acc, arow0 + l31, ecol, kt / nk1);
#pragma unroll
      for (int i = 0; i < 4; ++i)
#pragma unroll
        for (int j = 0; j < 2; ++j)
#pragma unroll
          for (int e = 0; e < 16; ++e) acc[i][j][e] = 0.f;
    }
  }
  epi(acc, arow0 + l31, ecol, NREP - 1);
}

template <class F>
__device__ __forceinline__ void gemm2_grid(int NT, F body) {
  const int vb = vbid(), xcd = vb & 7, lb = vb >> 3, nlb = gridDim.x >> 3;
  for (int i = lb; i < 8 * NT; i += nlb) body(xcd * 8 + (i & 7), i >> 3);
}

template <class F>
__device__ __forceinline__ void gemm_grid(int NT, F body) {
  const int xcd = blockIdx.x & 7, lb = blockIdx.x >> 3, nlb = gridDim.x >> 3;
  for (int i = lb; i < 16 * NT; i += nlb) {
    const int g = i / (8 * NT), rem = i % (8 * NT), nt = rem >> 3, mi = rem & 7;
    body(xcd * 16 + g * 8 + mi, nt);
  }
}

template <int MT>
__device__ __forceinline__ void proj_epi(const P& p, const f32x4 (&acc)[MT][4], int row_base, int ntile, int r0, int c0, float ascale = 1.f, const float* rope_tile = nullptr) {
  const int wn = c0 >> 6, l4 = (c0 & 63) >> 2;
  const int col0 = ntile * 128 + wn * 64;
  if (col0 >= INC) return;
  if (col0 == C_GB) {
#pragma unroll
    for (int mt = 0; mt < MT; ++mt) {
      const int m = row_base + r0 + mt * 16;
      f32x4 a = acc[mt][0] * ascale, g0 = {sigmoidf(a[0]), sigmoidf(a[1]), sigmoidf(a[2]), sigmoidf(a[3])};
      *(f32x4*)(p.GS + (size_t)m * 24 + 4 * l4) = g0;
      if (l4 < 2) { a = acc[mt][1] * ascale; f32x4 g1 = {sigmoidf(a[0]), sigmoidf(a[1]), sigmoidf(a[2]), sigmoidf(a[3])}; *(f32x4*)(p.GS + (size_t)m * 24 + 16 + 4 * l4) = g1; }
    }
    return;
  }
  const float* g = nullptr; bf16_t* dst; bf16_t* dst2 = nullptr; int hh, H; float qs = 1.f; bool dorope = false;
  if (col0 < 512) { g = p.g_q_dil; dst = p.QA; hh = col0 >> 6; H = 8; qs = 0.125f; dorope = true; }
  else if (col0 < 1024) { g = p.g_k_dil; dst = p.KA; hh = (col0 - 512) >> 6; H = 8; dorope = true; }
  else if (col0 < 1536) { dst = p.VA; hh = (col0 - 1024) >> 6; H = 8; }
  else if (col0 < 2048) { g = p.g_q_nsa; dst = p.QR; dst2 = p.QN; hh = (col0 - 1536) >> 6; H = 8; qs = 0.125f; dorope = true; }
  else {
    const int idx = (col0 - 2048) >> 6, which = idx >> 1; hh = idx & 1; H = 2;
    if (which == 0) dst = p.KC; else if (which == 1) dst = p.VC;
    else if (which == 2) { dst = p.KSL; g = p.g_k_slc; dorope = true; } else if (which == 3) dst = p.VSL;
    else if (which == 4) { dst = p.KW; g = p.g_k_win; dorope = true; } else dst = p.VW;
  }
  f32x4 gv[4];
  if (g) {
#pragma unroll
    for (int nt = 0; nt < 4; ++nt) gv[nt] = *(const f32x4*)(g + nt * 16 + 4 * l4);
  }
  const int bb = row_base / S;
#pragma unroll
  for (int mt = 0; mt < MT; ++mt) {
    const int m = row_base + r0 + mt * 16, s = m - bb * S;
    f32x4 v[4];
#pragma unroll
    for (int nt = 0; nt < 4; ++nt) v[nt] = acc[mt][nt] * ascale;
    if (g) {
      float ss = 0.f;
#pragma unroll
      for (int nt = 0; nt < 4; ++nt) ss += v[nt][0] * v[nt][0] + v[nt][1] * v[nt][1] + v[nt][2] * v[nt][2] + v[nt][3] * v[nt][3];
      ss += __shfl_xor(ss, 16); ss += __shfl_xor(ss, 32);
      const float r = rsqrtf(ss * (1.f / 64.f) + EPS) * qs;
#pragma unroll
      for (int nt = 0; nt < 4; ++nt) v[nt] = v[nt] * gv[nt] * r;
    }
    f32x4 vr = v[0];
    if (dorope) {
      const float* rp = rope_tile ? rope_tile + ((size_t)(m - row_base) * 8 + 4 * (l4 & 1)) * 2 : p.rope + ((size_t)s * 8 + 4 * (l4 & 1)) * 2;
      const f32x4 ra = *(const f32x4*)rp, rb = *(const f32x4*)(rp + 4);
      const float cs[4] = {ra[0], ra[2], rb[0], rb[2]}, sn[4] = {ra[1], ra[3], rb[1], rb[3]};
#pragma unroll
      for (int i = 0; i < 4; ++i) {
        const float pt = __shfl_xor(v[0][i], 32);
        vr[i] = (l4 < 2) ? (v[0][i] * cs[i] - pt * sn[i]) : (v[0][i] * cs[i] + pt * sn[i]);
      }
    }
    bf16_t* row = dst + ((size_t)(bb * H + hh) * S + s) * 64 + 16 * l4;
    unsigned dd[4][2] = {{pk_bf16(vr[0], vr[1]), pk_bf16(vr[2], vr[3])}, {pk_bf16(v[1][0], v[1][1]), pk_bf16(v[1][2], v[1][3])},
                         {pk_bf16(v[2][0], v[2][1]), pk_bf16(v[2][2], v[2][3])}, {pk_bf16(v[3][0], v[3][1]), pk_bf16(v[3][2], v[3][3])}};
    if (dst2) {
      unsigned d2[4][2] = {{pk_bf16(v[0][0], v[0][1]), pk_bf16(v[0][2], v[0][3])}, {dd[1][0], dd[1][1]}, {dd[2][0], dd[2][1]}, {dd[3][0], dd[3][1]}};
      xpose4(d2, l4);
      bf16_t* row2 = dst2 + ((size_t)(bb * H + hh) * S + s) * 64 + 16 * l4;
      *(u32x4*)row2 = (u32x4){d2[0][0], d2[0][1], d2[1][0], d2[1][1]};
      *(u32x4*)(row2 + 8) = (u32x4){d2[2][0], d2[2][1], d2[3][0], d2[3][1]};
    }
    xpose4(dd, l4);
    *(u32x4*)row = (u32x4){dd[0][0], dd[0][1], dd[1][0], dd[1][1]};
    *(u32x4*)(row + 8) = (u32x4){dd[2][0], dd[2][1], dd[3][0], dd[3][1]};
    asm volatile("" ::: "memory");
  }
}
__device__ __forceinline__ u32x4 pair8(u32x2 a, u32x2 b) {
  const u32x2v s1 = __builtin_amdgcn_permlane32_swap(a.x, b.x, false, false), s2 = __builtin_amdgcn_permlane32_swap(a.y, b.y, false, false);
  return (u32x4){s1.x, s2.x, s1.y, s2.y};
}
__device__ __forceinline__ u32x2 pk4_bf16(const f32x4& v) { return (u32x2){pk_bf16(v[0], v[1]), pk_bf16(v[2], v[3])}; }
__device__ __forceinline__ void proj_epi_x(const P& p, const f32x16 (&acc)[4][2], int row_base, int ntile, int r0, int c0, float ascale, const f32x4 (&ropev)[4][2]) {
  const int wn = c0 >> 6, hh = (c0 >> 2) & 1;
  const int col0 = ntile * 128 + wn * 64;
  if (col0 >= INC) return;
  if (col0 == C_GB) {
#pragma unroll
    for (int mt = 0; mt < 4; ++mt) {
      const int m = row_base + r0 + mt * 32;
#pragma unroll
      for (int gq = 0; gq < 3; ++gq) {
        const f32x4 g0 = {sigmoidf(acc[mt][0][4 * gq] * ascale), sigmoidf(acc[mt][0][4 * gq + 1] * ascale), sigmoidf(acc[mt][0][4 * gq + 2] * ascale), sigmoidf(acc[mt][0][4 * gq + 3] * ascale)};
        *(f32x4*)(p.GS + (size_t)m * 24 + 8 * gq + 4 * hh) = g0;
      }
    }
    return;
  }
  if (col0 >= 2048 && col0 < 2048 + 256) {
    const int idx = (col0 - 2048) >> 6, hdq = idx & 1; unsigned char* dq = (idx >> 1) ? p.VCq : p.KCq;
    const int bbq = row_base / S; const float sq = ascale * CQ_SCALE;
#pragma unroll
    for (int mt = 0; mt < 4; ++mt) {
      const int m = row_base + r0 + mt * 32, s = m - bbq * S;
      unsigned char* rowq = dq + ((size_t)(bbq * 2 + hdq) * S + s) * 64 + 8 * hh;
#pragma unroll
      for (int nt = 0; nt < 2; ++nt)
#pragma unroll
        for (int pq = 0; pq < 2; ++pq) {
          const unsigned d0 = pk4_fp8(clamp_e4m3(acc[mt][nt][8 * pq] * sq), clamp_e4m3(acc[mt][nt][8 * pq + 1] * sq), clamp_e4m3(acc[mt][nt][8 * pq + 2] * sq), clamp_e4m3(acc[mt][nt][8 * pq + 3] * sq));
          const unsigned d1 = pk4_fp8(clamp_e4m3(acc[mt][nt][8 * pq + 4] * sq), clamp_e4m3(acc[mt][nt][8 * pq + 5] * sq), clamp_e4m3(acc[mt][nt][8 * pq + 6] * sq), clamp_e4m3(acc[mt][nt][8 * pq + 7] * sq));
          const u32x2v pr = __builtin_amdgcn_permlane32_swap(d0, d1, false, false);
          *(u32x2*)(rowq + nt * 32 + pq * 16) = (u32x2){pr.x, pr.y};
        }
    }
    return;
  }
  const float* g = nullptr; bf16_t* dst; bf16_t* dst2 = nullptr; int hd, H; float qs = 1.f; bool dorope = false;
  if (col0 < 512) { g = p.g_q_dil; dst = p.QA; hd = col0 >> 6; H = 8; qs = 0.125f; dorope = true; }
  else if (col0 < 1024) { g = p.g_k_dil; dst = p.KA; hd = (col0 - 512) >> 6; H = 8; dorope = true; }
  else if (col0 < 1536) { dst = p.VA; hd = (col0 - 1024) >> 6; H = 8; }
  else if (col0 < 2048) { g = p.g_q_nsa; dst = p.QR; dst2 = p.QN; hd = (col0 - 1536) >> 6; H = 8; qs = 0.125f; dorope = true; }
  else {
    const int idx = (col0 - 2048) >> 6, which = idx >> 1; hd = idx & 1; H = 2;
    if (which == 0) dst = p.KC; else if (which == 1) dst = p.VC;
    else if (which == 2) { dst = p.KSL; g = p.g_k_slc; dorope = true; } else if (which == 3) dst = p.VSL;
    else if (which == 4) { dst = p.KW; g = p.g_k_win; dorope = true; } else dst = p.VW;
  }
  f32x4 gv[2][4];
  if (g) {
#pragma unroll
    for (int nt = 0; nt < 2; ++nt)
#pragma unroll
      for (int gq = 0; gq < 4; ++gq) gv[nt][gq] = *(const f32x4*)(g + nt * 32 + 8 * gq + 4 * hh);
  }
  const int bb = row_base / S;
#pragma unroll
  for (int mt = 0; mt < 4; ++mt) {
    const int m = row_base + r0 + mt * 32, s = m - bb * S;
    float r = ascale;
    if (g) {
      float ss = 0.f;
#pragma unroll
      for (int nt = 0; nt < 2; ++nt)
#pragma unroll
        for (int e = 0; e < 16; ++e) ss += acc[mt][nt][e] * acc[mt][nt][e];
      ss += __shfl_xor(ss, 32);
      r = rsqrtf(ss * (ascale * ascale * (1.f / 64.f)) + EPS) * (qs * ascale);
    }
    bf16_t* row = dst + ((size_t)(bb * H + hd) * S + s) * 64 + 8 * hh;
    bf16_t* row2 = dst2 ? dst2 + ((size_t)(bb * H + hd) * S + s) * 64 + 8 * hh : nullptr;
#pragma unroll
    for (int nt = 0; nt < 2; ++nt)
#pragma unroll
      for (int pq = 0; pq < 2; ++pq) {
        f32x4 va = (f32x4){acc[mt][nt][8 * pq], acc[mt][nt][8 * pq + 1], acc[mt][nt][8 * pq + 2], acc[mt][nt][8 * pq + 3]} * r;
        f32x4 vb = (f32x4){acc[mt][nt][8 * pq + 4], acc[mt][nt][8 * pq + 5], acc[mt][nt][8 * pq + 6], acc[mt][nt][8 * pq + 7]} * r;
        if (g) { va = va * gv[nt][2 * pq]; vb = vb * gv[nt][2 * pq + 1]; }
        if (nt == 0 && pq == 0) {
          if (row2) *(u32x4*)row2 = pair8(pk4_bf16(va), pk4_bf16(vb));
          if (dorope) {
            const f32x4 ra = ropev[mt][0], rb = ropev[mt][1];
            const float cs[4] = {ra[0], ra[2], rb[0], rb[2]}, sn[4] = {ra[1], ra[3], rb[1], rb[3]};
            const f32x4 x1 = va, x2 = vb;
#pragma unroll
            for (int i = 0; i < 4; ++i) { va[i] = x1[i] * cs[i] - x2[i] * sn[i]; vb[i] = x2[i] * cs[i] + x1[i] * sn[i]; }
          }
          *(u32x4*)row = pair8(pk4_bf16(va), pk4_bf16(vb));
        } else {
          const u32x4 w = pair8(pk4_bf16(va), pk4_bf16(vb));
          *(u32x4*)(row + nt * 32 + pq * 16) = w;
          if (row2) *(u32x4*)(row2 + nt * 32 + pq * 16) = w;
        }
      }
    asm volatile("" ::: "memory");
  }
}
__device__ __forceinline__ void ph_proj(const P& p, char* smem) {
  gemm2_grid(23, [&](int mtile, int ntile) {
    const unsigned char* A = p.h1q + (size_t)mtile * 256 * D; const unsigned char* W = p.Wq_in + (size_t)ntile * 128 * D; const unsigned char* Z = (const unsigned char*)p.zrow;
    const int nvalid = INC - ntile * 128;
    f32x4 ropev[4][2];
    { const int tid_ = otid(), er0 = ((tid_ >> 7) & 1) * 128 + (tid_ & 31), ehh = (tid_ >> 5) & 1;
#pragma unroll
      for (int mt = 0; mt < 4; ++mt) { const float* rp = p.rope + ((size_t)((mtile * 256 + er0 + mt * 32) % S) * 8 + 4 * ehh) * 2; ropev[mt][0] = *(const f32x4*)rp; ropev[mt][1] = *(const f32x4*)(rp + 4); } }
    gemm2x<1>(smem, D, [=](int r) { return A + (size_t)r * D; }, [=](int n) { return n < nvalid ? W + (size_t)n * D : Z; },
              [&](const f32x16 (&acc)[4][2], int r0, int c0, int) { proj_epi_x(p, acc, mtile * 256, ntile, r0, c0, 1.f / WQ_SCALE, ropev); });
  });
}
__device__ __forceinline__ void ph_outproj(const P& p, char* smem) {
  gemm2_grid(8, [&](int mtile, int ntile) {
    const unsigned char* A = p.mixq + (size_t)mtile * 256 * D; const unsigned char* W = p.Wq_out + (size_t)ntile * 128 * D; bf16_t* C = (bf16_t*)p.x1; const float* x = p.x;
    const float* gt = p.mod + ((mtile * 256) / S) * 6 * D + 2 * D;
    gemm2x<1>(smem, D, [=](int r) { return A + (size_t)r * D; }, [=](int n) { return W + (size_t)n * D; },
              [=](const f32x16 (&acc)[4][2], int r0, int c0, int) {
                const int hh = (c0 >> 2) & 1;
                const float s = 1.f / (WQ_SCALE * MQ_SCALE);
                f32x4 xn[2][4];
                auto ldx = [&](int mt, f32x4 (&d)[2][4]) {
                  const float* xr = x + (size_t)(mtile * 256 + r0 + mt * 32) * D + ntile * 128 + c0;
#pragma unroll
                  for (int nt = 0; nt < 2; ++nt)
#pragma unroll
                    for (int gq = 0; gq < 4; ++gq) d[nt][gq] = *(const f32x4*)(xr + nt * 32 + 8 * gq);
                };
                ldx(0, xn);
#pragma unroll
                for (int mt = 0; mt < 4; ++mt) {
                  const int m = mtile * 256 + r0 + mt * 32;
                  f32x4 xc[2][4];
#pragma unroll
                  for (int nt = 0; nt < 2; ++nt)
#pragma unroll
                    for (int gq = 0; gq < 4; ++gq) xc[nt][gq] = xn[nt][gq];
                  if (mt < 3) ldx(mt + 1, xn);
#pragma unroll
                  for (int nt = 0; nt < 2; ++nt) {
                    u32x2 o[4];
#pragma unroll
                    for (int gq = 0; gq < 4; ++gq) {
                      const int n = ntile * 128 + c0 + nt * 32 + 8 * gq;
                      const f32x4 a = {acc[mt][nt][4 * gq], acc[mt][nt][4 * gq + 1], acc[mt][nt][4 * gq + 2], acc[mt][nt][4 * gq + 3]};
                      o[gq] = pk4_bf16(xc[nt][gq] + *(const f32x4*)(gt + n) * (a * s));
                    }
                    bf16_t* crow = C + (size_t)m * D + ntile * 128 + (c0 & ~63) + nt * 32 + 8 * hh;
                    *(u32x4*)crow = pair8(o[0], o[1]); *(u32x4*)(crow + 16) = pair8(o[2], o[3]);
                  }
                  asm volatile("" ::: "memory");
                }
              });
  });
}
template <int AB>
__device__ __forceinline__ void ph_outproj_abl(const P& p, char* smem) {
  gemm2_grid(8, [&](int mtile, int ntile) {
    const bf16_t* A = p.mixinb + (size_t)mtile * 256 * D; const bf16_t* W = p.Wt_out + (size_t)ntile * 128 * D; float* C = (float*)p.Ybuf;
    gemm2<1, AB>(smem, D, [=](int r) { return A + (size_t)r * D; }, [=](int n) { return W + (size_t)n * D; },
             [=](const f32x4 (&acc)[8][4], int r0, int c0) {
#pragma unroll
               for (int mt = 0; mt < 8; ++mt)
#pragma unroll
                 for (int nt = 0; nt < 4; ++nt) {
                   const int m = mtile * 256 + r0 + mt * 16, n = ntile * 128 + c0 + nt * 16;
                   *(f32x4*)(C + (size_t)m * D + n) = acc[mt][nt];
                 }
             });
  });
}
__device__ __forceinline__ void router_unit(const P& p, char* smem, int mtile, int j) {
  const int seg = j >> 1, ntile = j & 1;
  const bf16_t* A = p.h2s + (size_t)mtile * 256 * 2 * D + (seg == 2 ? D : 0);
  const bf16_t* W = (seg == 1 ? p.Wt_rtl : p.Wt_rth) + (size_t)ntile * 128 * D; float* C = p.logits + (size_t)seg * T * NE;
  gemm2<1>(smem, D, [=](int r) { return A + (size_t)r * 2 * D; }, [=](int n) { return W + (size_t)n * D; },
           [=](const f32x4 (&acc)[8][4], int r0, int c0) {
#pragma unroll
             for (int mt = 0; mt < 8; ++mt)
#pragma unroll
               for (int nt = 0; nt < 4; ++nt) {
                 const int m = mtile * 256 + r0 + mt * 16, n = ntile * 128 + c0 + nt * 16;
                 *(f32x4*)(C + (size_t)m * NE + n) = acc[mt][nt];
               }
           });
}
__device__ __forceinline__ const bf16_t* gu_row(const bf16_t* Wg, const bf16_t* Wu, int f0, int n) {
  const int wn = n >> 6, wi = n & 63;
  return (wi >= 32 ? Wu : Wg) + (size_t)(f0 + wn * 32 + (wi & 31)) * D;
}
template <int MT>
__device__ __forceinline__ void gu_store(const f32x4 (&acc)[MT][4], int mt, float scale, bf16_t* dstrow  ) {
#pragma unroll
  for (int q = 0; q < 2; ++q) {
    const f32x4 g = acc[mt][q], u = acc[mt][q + 2];
    float h[4];
#pragma unroll
    for (int i = 0; i < 4; ++i) h[i] = silu(g[i]) * u[i] * scale;
    u32x2 v = {pk_bf16(h[0], h[1]), pk_bf16(h[2], h[3])};
    *(u32x2*)(dstrow + q * 16) = v;
  }
}
__device__ __forceinline__ const unsigned char* gu_rowq(const unsigned char* Wg, const unsigned char* Wu, int f0, int n);
__device__ __forceinline__ void shared_gu_unit(const P& p, char* smem, int mtile, int ntile) {
  const unsigned char* A = p.h2q + (size_t)mtile * 256 * D; const unsigned char* Wg = p.Wq_sg; const unsigned char* Wu = p.Wq_su; bf16_t* H = p.Hs;
  gemm2x<1>(smem, D, [=](int r) { return A + (size_t)r * D; }, [=](int n) { return gu_rowq(Wg, Wu, ntile * 64, n); },
            [=](const f32x16 (&acc)[4][2], int r0, int c0, int) {
              const int wn = c0 >> 6, hh = (c0 >> 2) & 1;
#pragma unroll
              for (int mt = 0; mt < 4; ++mt) {
                bf16_t* dstrow = H + (size_t)(mtile * 256 + r0 + mt * 32) * FF + ntile * 64 + wn * 32 + 8 * hh;
                u32x2 d[4];
#pragma unroll
                for (int gq = 0; gq < 4; ++gq) {
                  f32x4 h;
#pragma unroll
                  for (int i = 0; i < 4; ++i) h[i] = silu(acc[mt][0][4 * gq + i] * (1.f / WQ_SCALE)) * acc[mt][1][4 * gq + i] * (1.f / WQ_SCALE);
                  d[gq] = pk4_bf16(h);
                }
                *(u32x4*)dstrow = pair8(d[0], d[1]); *(u32x4*)(dstrow + 16) = pair8(d[2], d[3]);
              }
            });
}
__device__ __forceinline__ void ph_router_shared_gu(const P& p, char* smem) {
  const int vb = vbid(), xcd = vb & 7, lb = vb >> 3, nlb = gridDim.x >> 3;
  if (nlb == 64) {
    if (lb < 48) router_unit(p, smem, xcd * 8 + (lb & 7), lb >> 3);
    else for (int i = lb - 48; i < 32; i += 16) shared_gu_unit(p, smem, xcd * 8 + (i & 7), i >> 3);
  } else {
    gemm2_grid(10, [&](int mtile, int j) { if (j < 6) router_unit(p, smem, mtile, j); else shared_gu_unit(p, smem, mtile, j - 6); });
  }
}
__device__ __forceinline__ void ph_shared_d(const P& p, char* smem) {
  gemm2_grid(8, [&](int mtile, int ntile) {
    const bf16_t* A = p.Hs + (size_t)mtile * 256 * FF; const bf16_t* W = p.Wt_sd + (size_t)ntile * 128 * FF; bf16_t* Y = p.Ys;
    const bf16_t* X1 = (const bf16_t*)p.x1; const float* gt = p.mod + ((mtile * 256) / S) * 6 * D + 5 * D;
    gemm2<1>(smem, FF, [=](int r) { return A + (size_t)r * FF; }, [=](int n) { return W + (size_t)n * FF; },
             [=](const f32x4 (&acc)[8][4], int r0, int c0) {
               f32x4 g4[4];
#pragma unroll
               for (int nt = 0; nt < 4; ++nt) g4[nt] = *(const f32x4*)(gt + ntile * 128 + c0 + nt * 16);
#pragma unroll
               for (int mt = 0; mt < 8; ++mt) {
                 const size_t m = (size_t)(mtile * 256 + r0 + mt * 16);
                 f32x4 o[4];
#pragma unroll
                 for (int nt = 0; nt < 4; ++nt) {
                   const u32x2 xq = *(const u32x2*)(X1 + m * D + ntile * 128 + c0 + nt * 16);
                   const f32x4 xv = {__uint_as_float(xq.x << 16), __uint_as_float(xq.x & 0xffff0000u), __uint_as_float(xq.y << 16), __uint_as_float(xq.y & 0xffff0000u)};
                   o[nt] = xv + g4[nt] * acc[mt][nt];
                 }
                 store_row64_bf16(o[0], o[1], o[2], o[3], (c0 & 63) >> 2, Y + m * D + ntile * 128 + (c0 & ~63), true);
                 asm volatile("" ::: "memory");
               }
             });
  });
}
struct CvtQ { const float* src; unsigned char* dst; int ldn, ldk; };
__device__ __forceinline__ void cvtq_load(const CvtQ& d, f32x4 (&r)[16]) {
#pragma unroll
  for (int i = 0; i < 16; ++i) r[i] = __builtin_nontemporal_load((const f32x4*)(d.src + (size_t)i * d.ldn));
}
__device__ __forceinline__ void cvtq_store(const CvtQ& d, const f32x4 (&r)[16]) {
#pragma unroll
  for (int j = 0; j < 4; ++j) {
    u32x4 v = {pk4_fp8(r[0][j] * WQ_SCALE, r[1][j] * WQ_SCALE, r[2][j] * WQ_SCALE, r[3][j] * WQ_SCALE), pk4_fp8(r[4][j] * WQ_SCALE, r[5][j] * WQ_SCALE, r[6][j] * WQ_SCALE, r[7][j] * WQ_SCALE),
               pk4_fp8(r[8][j] * WQ_SCALE, r[9][j] * WQ_SCALE, r[10][j] * WQ_SCALE, r[11][j] * WQ_SCALE), pk4_fp8(r[12][j] * WQ_SCALE, r[13][j] * WQ_SCALE, r[14][j] * WQ_SCALE, r[15][j] * WQ_SCALE)};
    *(u32x4*)(d.dst + (size_t)j * d.ldk) = v;
  }
}
__device__ __forceinline__ CvtQ cvtq_desc(const float* src, int ldn, unsigned char* dst, int ldk, int k0, int n0) {
  const int kg = threadIdx.x & 7, n = n0 + (threadIdx.x >> 3) * 4;
  CvtQ d; d.src = src + (size_t)(k0 + kg * 16) * ldn + n; d.dst = dst + (size_t)n * ldk + k0 + kg * 16; d.ldn = ldn; d.ldk = ldk; return d;
}
__device__ __forceinline__ void cvtq_tile(const float* src, int ldn, unsigned char* dst, int ldk, int k0, int n0, int nmax = 1 << 30) {
  if (n0 + (int)(threadIdx.x >> 3) * 4 >= nmax) return;
  const CvtQ d = cvtq_desc(src, ldn, dst, ldk, k0, n0); f32x4 r[16]; cvtq_load(d, r); cvtq_store(d, r);
}
__device__ __forceinline__ CvtQ cvt_expert_desc(const P& p, int it) {
  const int e = it / 48, q = it - e * 48;
  if (q < 32) { const int up = q >> 4, qq = q & 15;
    return cvtq_desc((up ? p.w_up : p.w_gate) + (size_t)e * D * FF, FF, (up ? p.Wq_u : p.Wq_g) + (size_t)e * FF * D, D, (qq & 7) * 128, (qq >> 3) * 128);
  }
  const int qq = q - 32;
  return cvtq_desc(p.w_down + (size_t)e * FF * D, D, p.Wq_d + (size_t)e * D * FF, FF, (qq & 1) * 128, (qq >> 1) * 128);
}
__device__ __forceinline__ void cvt_expert_item(const P& p, int it) { const CvtQ d = cvt_expert_desc(p, it); f32x4 r[16]; cvtq_load(d, r); cvtq_store(d, r); }
__device__ __forceinline__ void ph_cvt_experts(const P& p) { WLOOP(w, NE * 48) cvt_expert_item(p, w); }

__device__ __forceinline__ bf16x8 pack8(const f32x16& x, int s) {
  u32x4 r = {pk_bf16(x[8 * s], x[8 * s + 1]), pk_bf16(x[8 * s + 2], x[8 * s + 3]), pk_bf16(x[8 * s + 4], x[8 * s + 5]), pk_bf16(x[8 * s + 6], x[8 * s + 7])};
  return __builtin_bit_cast(bf16x8, r);
}
__device__ __forceinline__ bf16x8 tr_pair(const LAS char* a) {
  const s16x4 lo = __builtin_amdgcn_ds_read_tr16_b64_v4i16((LAS s16x4*)a);
  const s16x4 hi = __builtin_amdgcn_ds_read_tr16_b64_v4i16((LAS s16x4*)(a + 8 * 128));
  return __builtin_shufflevector(lo, hi, 0, 1, 2, 3, 4, 5, 6, 7);
}
__device__ __forceinline__ int next_item(int* ctr, char* smem) {
  volatile int* slot = (volatile int*)(smem + SMEM_BYTES - 16);
  __syncthreads();
  if (threadIdx.x == 0) *slot = atomicAdd(ctr, 1);
  __syncthreads();
  return *slot;
}

__device__ __forceinline__ void compress_item(const P& p, char* smem, int item) {
  const int which = item >> 3, mtile = item & 7;
  const unsigned char* Xq = which ? p.VCq : p.KCq; const unsigned char* W1q = which ? p.Wq_c1v : p.Wq_c1k; const unsigned char* Z = (const unsigned char*)p.zrow;
  const float* b1 = p.b1c + which * 128; bf16_t* hid = (bf16_t*)smem;
  gemm2x<1>(smem, 2048,
           [=](int r) { return r >= 255 ? Z : Xq + ((size_t)mtile * S + 16 * r) * 64; },
           [=](int n) { return W1q + (size_t)n * 2048; },
           [=](const f32x16 (&acc)[4][2], int r0, int c0, int) {
             __syncthreads();
             const float s = 1.f / (WQ_SCALE * CQ_SCALE);
#pragma unroll
             for (int nt = 0; nt < 2; ++nt)
#pragma unroll
               for (int gq = 0; gq < 4; ++gq) {
                 const f32x4 bv = *(const f32x4*)(b1 + c0 + nt * 32 + 8 * gq);
#pragma unroll
                 for (int mt = 0; mt < 4; ++mt) {
                   float h[4];
#pragma unroll
                   for (int i = 0; i < 4; ++i) { const float a = acc[mt][nt][4 * gq + i] * s + bv[i]; const float u = 0.7978845608028654f * (a + 0.044715f * a * a * a); h[i] = a - a / (1.f + __expf(2.f * u)); }
                   u32x2 w = {pk_bf16(h[0], h[1]), pk_bf16(h[2], h[3])};
                   *(u32x2*)(hid + (r0 + mt * 32) * 136 + c0 + nt * 32 + 8 * gq) = w;
                 }
               }
           });
  __syncthreads();
  {
    const int tid = otid(), lane = tid & 63, wv = tid >> 6, l15 = lane & 15, l4 = lane >> 4;
    const bf16_t* W2t = p.Wt_c2 + which * 64 * 128;
    bf16x8 bfr[4][4];
#pragma unroll
    for (int nt = 0; nt < 4; ++nt)
#pragma unroll
      for (int ks = 0; ks < 4; ++ks) bfr[nt][ks] = *(const bf16x8*)(W2t + (nt * 16 + l15) * 128 + ks * 32 + l4 * 8);
    f32x4 acc2[4][4];
#pragma unroll
    for (int mt = 0; mt < 4; ++mt)
#pragma unroll
      for (int nt = 0; nt < 4; ++nt) acc2[mt][nt] = (f32x4){0.f, 0.f, 0.f, 0.f};
#pragma unroll
    for (int ks = 0; ks < 4; ++ks) {
      bf16x8 af[4];
#pragma unroll
      for (int mt = 0; mt < 4; ++mt) af[mt] = *(const bf16x8*)(hid + (wv * 64 + mt * 16 + l15) * 136 + ks * 32 + l4 * 8);
#pragma unroll
      for (int mt = 0; mt < 4; ++mt)
#pragma unroll
        for (int nt = 0; nt < 4; ++nt) acc2[mt][nt] = __builtin_amdgcn_mfma_f32_16x16x32_bf16(bfr[nt][ks], af[mt], acc2[mt][nt], 0, 0, 0);
    }
    f32x4 gg[4];
#pragma unroll
    for (int nt = 0; nt < 4; ++nt) { const f32x4 gl = *(const f32x4*)(p.g_k_cmp + nt * 16 + l4 * 4); const float ks_ = which ? 0.f : 1.f; gg[nt] = gl * ks_ + (1.f - ks_); }
#pragma unroll
    for (int mt = 0; mt < 4; ++mt) {
      const int row = wv * 64 + mt * 16 + l15;
      float rs = 1.f;
      if (!which) {
        float ss = 0.f;
#pragma unroll
        for (int nt = 0; nt < 4; ++nt) ss += acc2[mt][nt][0] * acc2[mt][nt][0] + acc2[mt][nt][1] * acc2[mt][nt][1] + acc2[mt][nt][2] * acc2[mt][nt][2] + acc2[mt][nt][3] * acc2[mt][nt][3];
        ss += __shfl_xor(ss, 16); ss += __shfl_xor(ss, 32);
        rs = rsqrtf(ss * (1.f / 64.f) + EPS);
      }
      if (row < 255) {
        bf16_t* orow = (which ? p.vcb : p.kcb) + ((size_t)mtile * 256 + row) * 64 + l4 * 4;
#pragma unroll
        for (int nt = 0; nt < 4; ++nt) {
          const f32x4 o = acc2[mt][nt] * gg[nt] * rs;
          *(u32x2*)(orow + nt * 16) = (u32x2){pk_bf16(o[0], o[1]), pk_bf16(o[2], o[3])};
        }
      }
    }
  }
}

template <int MODE, int NSLOT>
__device__ __forceinline__ void nsa_pass(LAS char* kv, const bf16_t* Kg, const bf16_t* Vg, int t_lo, int t_hi, const bf16x8 (&qf)[4], float shf, int si,
                                         unsigned long long selm, f32x16& o0, f32x16& o1, float& l, LAS float* psl  ,
                                         int pos0 = 0, int pstride = 1, int kkmin = 0) {
  const int tid = otid(), lane = tid & 63, wv = __builtin_amdgcn_readfirstlane(tid >> 6), i = lane & 31, h5 = lane >> 5;
  const int ksw = (i >> 1) & 7;
  const int tq = (lane & 15) >> 2, tp = lane & 3, tds = (lane >> 4) & 1, vsw = ((tq >> 1) & 1) << 2;
  const int row_l = lane >> 3, cpos = lane & 7;
  const int kc8 = (cpos ^ ((wv & 1) * 4 + (row_l >> 1))) * 8, vc8 = (cpos ^ (((row_l >> 1) & 1) << 2)) * 8;
  const bf16_t* kgl = Kg + (size_t)(wv * 8 + row_l) * 64 + kc8;
  const bf16_t* vgl = Vg + (size_t)(wv * 8 + row_l) * 64 + vc8;
  auto stage = [&](int t, int buf) {
    LAS char* Ks = kv + buf * 16384 + wv * 1024; LAS char* Vs = Ks + 8192;
#pragma unroll
    for (int q = 0; q < 2; ++q) {
      if (MODE >= 3) {
        int pos = pos0 + pstride * (64 * t + 32 * q + wv * 8 + row_l);
        pos = pos < 0 ? 0 : (pos > S - 1 ? S - 1 : pos);
        __builtin_amdgcn_global_load_lds((const unsigned*)(Kg + (size_t)pos * 64 + kc8), (LAS unsigned*)(Ks + q * 4096), 16, 0, 0);
        __builtin_amdgcn_global_load_lds((const unsigned*)(Vg + (size_t)pos * 64 + vc8), (LAS unsigned*)(Vs + q * 4096), 16, 0, 0);
      } else {
        __builtin_amdgcn_global_load_lds((const unsigned*)(kgl + (size_t)(64 * t + 32 * q) * 64), (LAS unsigned*)(Ks + q * 4096), 16, 0, 0);
        __builtin_amdgcn_global_load_lds((const unsigned*)(vgl + (size_t)(64 * t + 32 * q) * 64), (LAS unsigned*)(Vs + q * 4096), 16, 0, 0);
      }
    }
  };
  float carry = 0.f;
  if (t_lo > t_hi) return;
  f32x2 l2 = {0.f, 0.f};
  const int s0w = __builtin_amdgcn_readfirstlane(si);
  float dm16[4] = {0.f, 0.f, 0.f, 0.f}; int dmaxA = 0, dmaxB = 0; const int wq = wv & 3;
  if (MODE == 3) {
#pragma unroll
    for (int rg = 0; rg < 4; ++rg) dm16[rg] = (((wv - h5 - 2 * rg) & 3) == 0) ? 3.f : 2.f;
    dmaxA = si - kkmin < 128 ? si - kkmin : 128;
  }
  if (MODE == 4) { const int lim = si - kkmin; dmaxA = lim < 128 ? lim : 128; dmaxB = lim < 512 ? lim : 512; }
  asm volatile("s_waitcnt lgkmcnt(0)" ::: "memory");
  __builtin_amdgcn_s_barrier();
  asm volatile("" ::: "memory");
  auto tile = [&](int t, int buf) {
    const LAS char* Ks = kv + buf * 16384; const LAS char* Vs = Ks + 8192;
    const bool tsel = MODE == 1 ? ((selm >> t) & 1ull) != 0ull : true;
    const bool interior = MODE == 0 ? (16 * (64 * t + 63) + 31 <= s0w) : MODE == 1 ? (64 * t + 63 <= s0w) : MODE == 2 ? (64 * t + 63 <= s0w && s0w + 31 - 64 * t <= 511) : false;
    const float ebias = (MODE == 1 && !tsel) ? -1e30f : -shf;
    f32x16 sa2[2];
#pragma unroll
    for (int sub = 0; sub < 2; ++sub) {
#pragma unroll
      for (int q = 0; q < 16; ++q) sa2[sub][q] = 0.f;
      bf16x8 kf[4];
#pragma unroll
      for (int s4 = 0; s4 < 4; ++s4) kf[s4] = *(const LAS bf16x8*)(Ks + (32 * sub + i) * 128 + (((2 * s4 + h5) ^ ksw) << 4));
      __builtin_amdgcn_s_setprio(1);
#pragma unroll
      for (int s4 = 0; s4 < 4; ++s4) sa2[sub] = MFMA32(kf[s4], qf[s4], sa2[sub]);
      __builtin_amdgcn_s_setprio(0);
    }
#pragma unroll
    for (int sub = 0; sub < 2; ++sub) {
      f32x16& sa = sa2[sub];
      const int k0 = 64 * t + 32 * sub + 4 * h5;
      if (MODE <= 2 && interior) {
        const f32x2 b2 = {ebias, ebias};
#pragma unroll
        for (int q = 0; q < 16; q += 2) {
          const f32x2 x = (f32x2){sa[q], sa[q + 1]} * LOG2E + b2;
          const f32x2 e = {__builtin_amdgcn_exp2f(x[0]), __builtin_amdgcn_exp2f(x[1])};
          l2 += e;
          sa[q] = e[0]; sa[q + 1] = e[1];
        }
      } else
#pragma unroll
      for (int q = 0; q < 16; ++q) {
        const int kidx = k0 + (q & 3) + 8 * (q >> 2);
        float pv;
        if (MODE >= 3) {
          const int dl = si - kidx;
          const float e = __builtin_amdgcn_exp2f(sa[q] * LOG2E - shf);
          if (MODE == 3) {
            const float cw = (q & 3) ? 1.f : dm16[q >> 2];
            pv = (unsigned)dl <= (unsigned)dmaxA ? cw * e : 0.f;
          } else {
            const bool lo = dl >= 33;
            float cw = (lo && dl <= dmaxA) ? 1.f : 0.f;
            if ((q & 3) == wq) cw += (lo && dl <= dmaxB) ? 1.f : 0.f;
            pv = cw * e;
          }
        } else {
          bool valid;
          if (MODE == 0) valid = 16 * kidx + 31 <= si;
          else if (MODE == 1) valid = tsel && kidx <= si;
          else valid = (unsigned)(si - kidx) <= 511u;
          pv = valid ? __builtin_amdgcn_exp2f(sa[q] * LOG2E - shf) : 0.f;
        }
        l += pv; sa[q] = pv;
      }
      if (MODE == 0) {
#pragma unroll
        for (int rg = 0; rg < 4; ++rg) {
          const float a = 2.f * (sa[4 * rg] + sa[4 * rg + 1] + sa[4 * rg + 2]) + sa[4 * rg + 3];
          const float recv = __shfl_xor(sa[4 * rg + 3], 32);
          const float val = h5 ? a + recv : a + carry;
          carry = recv;
          psl[16 * t + 8 * sub + 2 * rg + h5] = val;
        }
      }
      const bf16x8 pf0 = pack8(sa, 0), pf1 = pack8(sa, 1);
      bf16x8 vf[2][2];
#pragma unroll
      for (int s2 = 0; s2 < 2; ++s2) {
        const LAS char* vb = Vs + (32 * sub + 16 * s2 + 4 * h5 + tq) * 128 + 8 * (tp & 1);
        vf[s2][0] = tr_pair(vb + (((tds * 2 + (tp >> 1)) ^ vsw) << 4));
        vf[s2][1] = tr_pair(vb + (((4 + tds * 2 + (tp >> 1)) ^ vsw) << 4));
      }
      __builtin_amdgcn_s_setprio(1);
#pragma unroll
      for (int s2 = 0; s2 < 2; ++s2) { o0 = MFMA32(vf[s2][0], s2 ? pf1 : pf0, o0); o1 = MFMA32(vf[s2][1], s2 ? pf1 : pf0, o1); }
      __builtin_amdgcn_s_setprio(0);
    }
    __builtin_amdgcn_sched_barrier(0);
  };
  if (NSLOT == 4) {
    stage(t_lo, 0);
    if (t_lo + 1 <= t_hi) stage(t_lo + 1, 1);
    for (int t = t_lo; t <= t_hi; t += 2) {
      const int pb = (((t - t_lo) >> 1) & 1) * 2;
      asm volatile("s_waitcnt vmcnt(0)" ::: "memory");
      __builtin_amdgcn_s_barrier();
      asm volatile("" ::: "memory");
      if (t + 2 <= t_hi) stage(t + 2, pb ^ 2);
      if (t + 3 <= t_hi) stage(t + 3, (pb ^ 2) + 1);
      tile(t, pb);
      if (t + 1 <= t_hi) tile(t + 1, pb + 1);
    }
  } else {
#pragma unroll
    for (int k = 0; k < NSLOT - 1; ++k) if (t_lo + k <= t_hi) stage(t_lo + k, k);
    for (int t = t_lo; t <= t_hi; ++t) {
      const int buf = (t - t_lo) % NSLOT;
      asm volatile("s_waitcnt vmcnt(0)" ::: "memory");
      __builtin_amdgcn_s_barrier();
      asm volatile("" ::: "memory");
      if (t + NSLOT - 1 <= t_hi) stage(t + NSLOT - 1, (t + NSLOT - 1 - t_lo) % NSLOT);
      tile(t, buf);
    }
  }
  l += l2[0] + l2[1];
}

__device__ __forceinline__ void dilated_item(const P& p, char* smem_, int unit) {
  LAS char* kv = (LAS char*)smem_;
  const int tid = otid(), lane = tid & 63, wv = tid >> 6, i = lane & 31, h5 = lane >> 5;
  const int r4 = unit & 3, ti = (unit >> 2) & 7, hh = (unit >> 5) & 7, b = unit >> 8;
  const size_t hb = (size_t)(b * 8 + hh) * S * 64;
  const int si = ti * 512 + r4 + 4 * wv + 16 * i;
  bf16x8 qf[4];
#pragma unroll
  for (int s4 = 0; s4 < 4; ++s4) qf[s4] = *(const bf16x8*)(p.QA + hb + (size_t)si * 64 + 16 * s4 + 8 * h5);
  f32x16 o0, o1;
#pragma unroll
  for (int q = 0; q < 16; ++q) { o0[q] = 0.f; o1[q] = 0.f; }
  float l = 0.f;
  const float shf = p.smaxv[0] * LOG2E;
  const int pbase = ti * 512 + r4 - 128, ubase = ti * 128 - 512;
  nsa_pass<3, 4>(kv, p.KA + hb, p.VA + hb, 0, 9, qf, shf, 4 * wv + 16 * i + 128, 0ull, o0, o1, l, nullptr, pbase, 1, pbase < 0 ? -pbase : 0);
  nsa_pass<4, 4>(kv, p.KA + hb, p.VA + hb, 0, 9, qf, shf, wv + 4 * i + 512, 0ull, o0, o1, l, nullptr, r4 + 4 * ubase, 4, ubase < 0 ? -ubase : 0);
  l += __shfl_xor(l, 32);
  const float inv = 1.f / l;
  unsigned char* orow = p.mixq + (size_t)(b * S + si) * D + hh * 64 + 4 * h5;
  const float invq = inv * MQ_SCALE;
#pragma unroll
  for (int rg = 0; rg < 4; ++rg) {
    *(unsigned*)(orow + 8 * rg) = pk4_fp8(clamp_e4m3(o0[4 * rg] * invq), clamp_e4m3(o0[4 * rg + 1] * invq), clamp_e4m3(o0[4 * rg + 2] * invq), clamp_e4m3(o0[4 * rg + 3] * invq));
    *(unsigned*)(orow + 32 + 8 * rg) = pk4_fp8(clamp_e4m3(o1[4 * rg] * invq), clamp_e4m3(o1[4 * rg + 1] * invq), clamp_e4m3(o1[4 * rg + 2] * invq), clamp_e4m3(o1[4 * rg + 3] * invq));
  }
}

__device__ __forceinline__ void nsa_item(const P& p, char* smem_, int item) {
  LAS char* smem = (LAS char*)smem_;
  LAS char* kv = smem;
  LAS float* pslcw = (LAS float*)(smem + 32768);
  LAS float* invl = (LAS float*)(smem + 32768 + 33280);
  LAS unsigned* msk = (LAS unsigned*)(smem + 32768 + 33280 + 512);
  const int tid = otid(), lane = tid & 63, wv = tid >> 6, i = lane & 31, h5 = lane >> 5;
  const int qt = 127 - (item >> 3), bg = item & 7, b = bg >> 1, g = bg & 1, hq = g * 4 + wv;
  const int s0 = qt * 32, si = s0 + i, cur = s0 >> 6;
  const size_t qoff = ((size_t)(b * 8 + hq) * S + si) * 64 + 8 * h5;
  bf16x8 qf[4];
#pragma unroll
  for (int s4 = 0; s4 < 4; ++s4) qf[s4] = *(const bf16x8*)(p.QN + qoff + 16 * s4);
  const float* gs = p.GS + (size_t)(b * S + si) * 24 + hq * 3;
  const float g0 = gs[0], g1 = gs[1], g2 = gs[2];
  f32x16 oa0, oa1, o0, o1;
#pragma unroll
  for (int q = 0; q < 16; ++q) { o0[q] = 0.f; o1[q] = 0.f; }
  float l = 0.f;
  LAS float* psl = pslcw + (wv * 32 + i) * 65;
  const int ncv = (s0 + 31 - 31) >> 4;
  const int tc_hi = (ncv < 254 ? ncv : 254) >> 6;
#pragma unroll
  for (int k = 0; k < 32; ++k) psl[2 * k + h5] = 0.f;
  nsa_pass<0, 2>(kv, p.kcb + (size_t)bg * 256 * 64, p.vcb + (size_t)bg * 256 * 64, 0, tc_hi, qf, p.smaxv[1] * LOG2E, si, 0ull, o0, o1, l, psl);
  l += __shfl_xor(l, 32);
  {
    const float il = l > 0.f ? 1.f / l : 0.f;
    if (h5 == 0) invl[wv * 32 + i] = il;
    const float sc = g0 * il;
#pragma unroll
    for (int q = 0; q < 16; ++q) { oa0[q] = o0[q] * sc; oa1[q] = o1[q] * sc; o0[q] = 0.f; o1[q] = 0.f; }
  }
#pragma unroll
  for (int s4 = 0; s4 < 4; ++s4) qf[s4] = *(const bf16x8*)(p.QR + qoff + 16 * s4);
  __syncthreads();
  LAS float* scr = pslcw;
  {
    const int q = tid >> 3, jj = tid & 7;
    float tot[8];
#pragma unroll
    for (int k = 0; k < 8; ++k) {
      const int j = jj + 8 * k;
      float v = 0.f;
#pragma unroll
      for (int w4 = 0; w4 < 4; ++w4) v += pslcw[(w4 * 32 + q) * 65 + j] * invl[w4 * 32 + q];
      const bool forced = (j == 0) || (j == cur) || (j == cur - 1);
      tot[k] = forced ? INFINITY : (j <= cur ? v : -INFINITY);
    }
    __syncthreads();
#pragma unroll
    for (int k = 0; k < 8; ++k) scr[q * 65 + jj + 8 * k] = tot[k];
    if (tid < 64) msk[tid] = 0u;
    __syncthreads();
    unsigned lo = 0u, hi = 0u;
    int rank[8];
#pragma unroll
    for (int k = 0; k < 8; ++k) rank[k] = 0;
    if (cur >= 16)
      for (int c = 0; c <= cur; ++c) {
        const float sv = scr[q * 65 + c];
#pragma unroll
        for (int k = 0; k < 8; ++k) rank[k] += ((sv > tot[k]) || (sv == tot[k] && c < jj + 8 * k)) ? 1 : 0;
      }
#pragma unroll
    for (int k = 0; k < 8; ++k) {
      const int j = jj + 8 * k;
      if (rank[k] < 16 && j <= cur) { if (j < 32) lo |= 1u << j; else hi |= 1u << (j - 32); }
    }
    if (lo) atomicOr((unsigned*)&msk[q * 2], lo);
    if (hi) atomicOr((unsigned*)&msk[q * 2 + 1], hi);
    __syncthreads();
  }
  const unsigned long long selm = (unsigned long long)msk[i * 2] | ((unsigned long long)msk[i * 2 + 1] << 32);
  const size_t kvoff = (size_t)bg * S * 64;
  l = 0.f;
  nsa_pass<1, 4>(kv, p.KSL + kvoff, p.VSL + kvoff, 0, cur, qf, p.smaxv[2] * LOG2E, si, selm, o0, o1, l, nullptr);
  l += __shfl_xor(l, 32);
  {
    const float sc = g1 / l;
#pragma unroll
    for (int q = 0; q < 16; ++q) { oa0[q] += o0[q] * sc; oa1[q] += o1[q] * sc; o0[q] = 0.f; o1[q] = 0.f; }
  }
  l = 0.f;
  const int tw_lo = s0 >= 511 ? (s0 - 511) >> 6 : 0;
  nsa_pass<2, 4>(kv, p.KW + kvoff, p.VW + kvoff, tw_lo, cur, qf, p.smaxv[3] * LOG2E, si, 0ull, o0, o1, l, nullptr);
  l += __shfl_xor(l, 32);
  {
    const float sc = g2 / l;
#pragma unroll
    for (int q = 0; q < 16; ++q) { oa0[q] += o0[q] * sc; oa1[q] += o1[q] * sc; }
  }
  unsigned char* orow = p.mixq + (size_t)(b * S + si) * D + 512 + hq * 64 + 4 * h5;
#pragma unroll
  for (int rg = 0; rg < 4; ++rg) {
    *(unsigned*)(orow + 8 * rg) = pk4_fp8(clamp_e4m3(oa0[4 * rg] * MQ_SCALE), clamp_e4m3(oa0[4 * rg + 1] * MQ_SCALE), clamp_e4m3(oa0[4 * rg + 2] * MQ_SCALE), clamp_e4m3(oa0[4 * rg + 3] * MQ_SCALE));
    *(unsigned*)(orow + 32 + 8 * rg) = pk4_fp8(clamp_e4m3(oa1[4 * rg] * MQ_SCALE), clamp_e4m3(oa1[4 * rg + 1] * MQ_SCALE), clamp_e4m3(oa1[4 * rg + 2] * MQ_SCALE), clamp_e4m3(oa1[4 * rg + 3] * MQ_SCALE));
  }
}
__device__ __forceinline__ void cvt_queue_item(const P& p, int ci) {
  f32x4 ra[16], rb[16];
  const CvtQ d0 = cvt_expert_desc(p, ci * 4), d1 = cvt_expert_desc(p, ci * 4 + 1), d2 = cvt_expert_desc(p, ci * 4 + 2), d3 = cvt_expert_desc(p, ci * 4 + 3);
  cvtq_load(d0, ra); cvtq_load(d1, rb);
  cvtq_store(d0, ra); cvtq_load(d2, ra);
  cvtq_store(d1, rb); cvtq_load(d3, rb);
  cvtq_store(d2, ra); cvtq_store(d3, rb);
}
__device__ __forceinline__ void ph_attn(const P& p, char* smem, bool same_l2) {
  const int x = vbid() & 7;
  bool nsa_ready = false;
  for (;;) {
    const int q = next_item(p.ctr + 8 + x, smem);
    if (q >= 2 + 320 + 320) break;
    if (q < 2) {
      compress_item(p, smem, 8 * q + x);
      asm volatile("s_waitcnt vmcnt(0)" ::: "memory");
      __syncthreads();
      if (threadIdx.x == 0) {
        if (!same_l2) __builtin_amdgcn_fence(__ATOMIC_RELEASE, "agent");
        __hip_atomic_fetch_add(p.ctr + 24 + x, 1, __ATOMIC_RELAXED, __HIP_MEMORY_SCOPE_AGENT);
      }
      continue;
    }
    auto conv = [&](int c) { cvt_queue_item(p, c < 192 ? 192 * x + c : 1536 + 192 * x + (c - 192)); };
    if (q < 2 + 256) {
      const int j = q - 2, m = j >> 1;
      if (!(j & 1)) dilated_item(p, smem, ((m >> 5) << 8) | (x << 5) | (m & 31));
      else conv(m);
      continue;
    }
    const int j = q - (2 + 256), g = j / 3, r = j - g * 3;
    if (r == 0) {
      if (!nsa_ready) {
        if (threadIdx.x == 0) {
          unsigned sp = 0;
          while (__hip_atomic_load(p.ctr + 24 + x, __ATOMIC_RELAXED, __HIP_MEMORY_SCOPE_AGENT) < 2) { __builtin_amdgcn_s_sleep(2); if (++sp > (1u << 22)) break; }
          __builtin_amdgcn_fence(__ATOMIC_ACQUIRE, "agent");
          asm volatile("s_waitcnt vmcnt(0)" ::: "memory");
        }
        __syncthreads();
        nsa_ready = true;
      }
      nsa_item(p, smem, (g << 3) | x);
    } else conv(128 + 2 * g + (r - 1));
  }
}

__device__ __forceinline__ void ph_route(const P& p, char* smem) {
  const int lane = threadIdx.x & 63, wv = threadIdx.x >> 6;
  int* hist = (int*)smem;
  __syncthreads();
  hist[threadIdx.x] = 0;
  __syncthreads();
  const int vb = vbid(), chunk = (vb & 7) * (gridDim.x >> 3) + (vb >> 3);
  const int tpb = T / gridDim.x, t0 = chunk * tpb;
  float bias[4];
#pragma unroll
  for (int i = 0; i < 4; ++i) bias[i] = p.r_bias[lane + 64 * i];
  for (int tt = wv; tt < tpb; tt += 4) {
    const int t = t0 + tt;
    float aff[4], bv[4], ta[4], tb[4];
#pragma unroll
    for (int i = 0; i < 4; ++i) { { const size_t li = (size_t)t * NE + lane + 64 * i; aff[i] = sigmoidf((p.logits[li] + p.logits[li + (size_t)T * NE]) + p.logits[li + (size_t)2 * T * NE]); } bv[i] = aff[i] + bias[i]; ta[i] = bv[i]; tb[i] = -INFINITY; }
#pragma unroll
    for (int o = 16; o; o >>= 1)
#pragma unroll
      for (int i = 0; i < 4; ++i) {
        const float a2 = __shfl_xor(ta[i], o), b2 = __shfl_xor(tb[i], o);
        const float na = fmaxf(ta[i], a2), nb = fmaxf(fminf(ta[i], a2), fmaxf(tb[i], b2));
        ta[i] = na; tb[i] = nb;
      }
    float gs[8];
#pragma unroll
    for (int i = 0; i < 4; ++i) { const float s2 = ta[i] + tb[i]; gs[2 * i] = __shfl(s2, 0); gs[2 * i + 1] = __shfl(s2, 32); }
    unsigned gmask = 0;
#pragma unroll
    for (int g = 0; g < 8; ++g) {
      int rank = 0;
#pragma unroll
      for (int i = 0; i < 8; ++i) rank += (gs[i] > gs[g]) || (gs[i] == gs[g] && i < g);
      if (rank < 4) gmask |= 1u << g;
    }
#pragma unroll
    for (int i = 0; i < 4; ++i) if (!((gmask >> (2 * i + (lane >> 5))) & 1u)) bv[i] = -INFINITY;
    unsigned key[4];
#pragma unroll
    for (int i = 0; i < 4; ++i) { const unsigned u = __float_as_uint(bv[i]); key[i] = (u & 0x80000000u) ? ~u : (u | 0x80000000u); }
    unsigned thr = 0u;
#pragma unroll 1
    for (int bit = 31; bit >= 0; --bit) {
      const unsigned trial = thr | (1u << bit);
      int c = 0;
#pragma unroll
      for (int i = 0; i < 4; ++i) c += __builtin_popcountll(__ballot(key[i] >= trial));
      if (c >= 8) thr = trial;
      if (c == 8) break;
    }
    int ngt = 0;
#pragma unroll
    for (int i = 0; i < 4; ++i) ngt += __builtin_popcountll(__ballot(key[i] > thr));
    const int need = 8 - ngt;
    const unsigned long long ltmask = (1ull << lane) - 1ull;
    int eqbefore = 0, selbefore = 0;
    bool sel[4]; int slot[4];
#pragma unroll
    for (int i = 0; i < 4; ++i) {
      const unsigned long long eqm = __ballot(key[i] == thr);
      const bool s = key[i] > thr || (key[i] == thr && eqbefore + __builtin_popcountll(eqm & ltmask) < need);
      eqbefore += __builtin_popcountll(eqm);
      const unsigned long long sm = __ballot(s);
      sel[i] = s; slot[i] = selbefore + __builtin_popcountll(sm & ltmask);
      selbefore += __builtin_popcountll(sm);
    }
    float part = 0.f;
#pragma unroll
    for (int i = 0; i < 4; ++i) part += sel[i] ? aff[i] : 0.f;
    const float ssum = wave_sum(part);
#pragma unroll
    for (int i = 0; i < 4; ++i)
      if (sel[i]) {
        const int e = lane + 64 * i;
        p.eidx[t * 8 + slot[i]] = e;
        p.gates[t * 8 + slot[i]] = aff[i] / ssum * 2.5f;
        p.pos[t * 8 + slot[i]] = atomicAdd(&hist[e], 1);
      }
  }
  __syncthreads();
  p.bhist[(size_t)chunk * NE + threadIdx.x] = hist[threadIdx.x];
}
__device__ __forceinline__ void ph_hist_local(const P& p) {
  const int vb = vbid(), nlb = gridDim.x >> 3, x = vb & 7, lb = vb >> 3, tid = threadIdx.x;
  const int* row = p.bhist + (size_t)(x * nlb) * NE + tid;
  int pre = 0;
#pragma unroll 16
  for (int l = 0; l < lb; ++l) pre += row[(size_t)l * NE];
  p.xpre[(size_t)(x * nlb + lb) * NE + tid] = pre;
  if (lb == nlb - 1) p.xhist[x * NE + tid] = pre + row[(size_t)lb * NE];
}
__device__ __forceinline__ void ph_fill(const P& p, char* smem) {
  int* soff = (int*)smem;
  int* wsum = soff + 260;
  int* sbase = soff + 272;
  const int tid = threadIdx.x, lane = tid & 63, wv = tid >> 6;
  __syncthreads();
  int c = 0, before = 0;
  { const int xb = (int)blockIdx.x / (int)(gridDim.x >> 3);
#pragma unroll
    for (int xg = 0; xg < 8; ++xg) { const int v = p.xhist[xg * NE + tid]; c += v; before += (xg < xb) ? v : 0; }
    before += p.xpre[(size_t)blockIdx.x * NE + tid]; }
  int incl = c;
#pragma unroll
  for (int o = 1; o < 64; o <<= 1) { const int v = __shfl_up(incl, o); if (lane >= o) incl += v; }
  if (lane == 63) wsum[wv] = incl;
  __syncthreads();
  int base = 0;
  for (int i = 0; i < wv; ++i) base += wsum[i];
  soff[tid] = base + incl - c;
  sbase[tid] = base + incl - c + before;
  if (tid == 255) soff[256] = base + incl;
  __syncthreads();
  if (blockIdx.x == 0) {
    p.off[tid] = soff[tid]; p.cnt[tid] = c;
    if (tid == 255) p.off[256] = soff[256];
  }
  if (blockIdx.x == 1) {
    const int x = tid >> 5, i = tid & 31, e = x + 8 * i;
    const int ce = soff[e + 1] - soff[e], tle = (ce + 255) >> 8, hfe = (tle > 0 && ce - (tle - 1) * 256 <= 128) ? 1 : 0;
    const int tl = 2 * (tle - hfe) + hfe;
    int inc2 = tl;
#pragma unroll
    for (int o = 1; o < 32; o <<= 1) { const int v = __shfl_up(inc2, o, 32); if (i >= o) inc2 += v; }
    p.tstart[x * 33 + i] = inc2 - tl;
    if (i == 31) p.tstart[x * 33 + 32] = inc2;
  }
  const int tpb = T / gridDim.x, a0 = blockIdx.x * tpb * 8;
  for (int a = a0 + tid; a < a0 + tpb * 8; a += 256) p.sorted[sbase[p.eidx[a]] + p.pos[a]] = a;
}

template <class F_>
__device__ __forceinline__ void moe_grid2(const P& p, F_ body) {
  const int vb = vbid(), xcd = vb & 7, lb = vb >> 3, nlb = gridDim.x >> 3;
  const int* ts = p.tstart + xcd * 33;
  const int total = ts[32] * 2;
  int i = 0;
  for (int j = lb; j < total; j += nlb) {
    while (ts[i + 1] * 2 <= j) ++i;
    const int e = xcd + 8 * i, c = p.cnt[e];
    const int tiles = (c + 255) >> 8, hf = (tiles > 0 && c - (tiles - 1) * 256 <= 128) ? 1 : 0, F = tiles - hf;
    const int rem = j - ts[i] * 2;
    if (rem < 4 * F) body(e, rem % F, rem / F, false);
    else body(e, F, rem - 4 * F, true);
  }
}
__device__ __forceinline__ const unsigned char* gu_rowq(const unsigned char* Wg, const unsigned char* Wu, int f0, int n) {
  const int wn = n >> 6, wi = n & 63;
  return (wi >= 32 ? Wu : Wg) + (size_t)(f0 + wn * 32 + (wi & 31)) * D;
}
__device__ __forceinline__ void ph_moe_gu(const P& p, char* smem) {
  moe_grid2(p, [&](int e, int mtile, int nsel, bool dual) {
    const int ntile = dual ? 2 * nsel : nsel;
    const int cnt = p.cnt[e] - mtile * 256; const int* srt = p.sorted + p.off[e] + mtile * 256;
    const unsigned char* A = p.h2q; const unsigned char* Wg = p.Wq_g + (size_t)e * FF * D; const unsigned char* Wu = p.Wq_u + (size_t)e * FF * D; unsigned char* H = p.Hq;
    const float* gates = p.gates; const unsigned char* Z = (const unsigned char*)p.zrow;
    int ea[4]; float eg[4];
    { const int tid_ = otid(), er0 = (dual ? 0 : ((tid_ >> 7) & 1) * 128) + (tid_ & 31);
#pragma unroll
      for (int mt = 0; mt < 4; ++mt) { const int r = er0 + mt * 32; ea[mt] = r < cnt ? srt[r] : -1; }
#pragma unroll
      for (int mt = 0; mt < 4; ++mt) eg[mt] = ea[mt] >= 0 ? gates[ea[mt]] * (HQ_SCALE / WQ_SCALE) : 0.f; }
    gemm2x(smem, D, [=](int r) { return (dual && r >= 128) ? gu_rowq(Wg, Wu, ntile * 64 + 64, r - 128) : (r < cnt ? A + (size_t)(srt[r] >> 3) * D : Z); },
           [=](int n) { return gu_rowq(Wg, Wu, ntile * 64, n); },
           [=](const f32x16 (&acc)[4][2], int r0, int c0, int) {
             const int wn = c0 >> 6, hh = (c0 >> 2) & 1;
#pragma unroll
             for (int mt = 0; mt < 4; ++mt) {
               const int a = ea[mt]; const bool ok = a >= 0;
               const float sc = eg[mt];
               unsigned d[4];
#pragma unroll
               for (int g = 0; g < 4; ++g) {
                 float h[4];
#pragma unroll
                 for (int i = 0; i < 4; ++i) h[i] = clamp_e4m3(silu(acc[mt][0][4 * g + i] * (1.f / WQ_SCALE)) * acc[mt][1][4 * g + i] * sc);
                 d[g] = pk4_fp8(h[0], h[1], h[2], h[3]);
               }
               const u32x2v p01 = __builtin_amdgcn_permlane32_swap(d[0], d[1], false, false), p23 = __builtin_amdgcn_permlane32_swap(d[2], d[3], false, false);
               if (ok) {
                 unsigned char* dst = H + (size_t)a * FF + ntile * 64 + wn * 32 + 8 * hh;
                 *(u32x2*)dst = (u32x2){p01.x, p01.y};
                 *(u32x2*)(dst + 16) = (u32x2){p23.x, p23.y};
               }
             }
           }, 0, !dual && cnt <= 128, dual);
  });
}
__device__ __forceinline__ void ph_moe_d(const P& p, char* smem) {
  moe_grid2(p, [&](int e, int mtile, int nsel, bool dual) {
    const int nt0 = dual ? 4 * nsel : 2 * nsel;
    const int cnt = p.cnt[e] - mtile * 256; const int* srt = p.sorted + p.off[e] + mtile * 256;
    const unsigned char* A = p.Hq; const unsigned char* W = p.Wq_d + (size_t)e * D * FF + (size_t)nt0 * 128 * FF; unsigned char* Yq = p.Yq; const unsigned char* Z = (const unsigned char*)p.zrow;
    int erd[4];
    { const int tid_ = otid(), er0 = (dual ? 0 : ((tid_ >> 7) & 1) * 128) + (tid_ & 31);
#pragma unroll
      for (int mt = 0; mt < 4; ++mt) { const int r = er0 + mt * 32; erd[mt] = r < cnt ? srt[r] : -1; } }
    gemm2x<2>(smem, FF, [=](int r) { return (dual && r >= 128) ? W + (size_t)(256 + r - 128) * FF : (r < cnt ? A + (size_t)srt[r] * FF : Z); }, [=](int n) { return W + (size_t)n * FF; },
           [=](const f32x16 (&acc)[4][2], int r0, int c0, int rp) {
             const int wn64 = c0 & 64, hh = (c0 >> 2) & 1, second = c0 >> 7;
             const float s = YQ_SCALE / (WQ_SCALE * HQ_SCALE);
#pragma unroll
             for (int mt = 0; mt < 4; ++mt) {
               const int rd = erd[mt]; const bool ok = rd >= 0;
               unsigned char* dst = Yq + (size_t)rd * D + (nt0 + 2 * second + rp) * 128 + wn64 + 8 * hh;
#pragma unroll
               for (int nt = 0; nt < 2; ++nt) {
                 unsigned d[4];
#pragma unroll
                 for (int g = 0; g < 4; ++g) d[g] = pk4_fp8(clamp_e4m3(acc[mt][nt][4 * g] * s), clamp_e4m3(acc[mt][nt][4 * g + 1] * s), clamp_e4m3(acc[mt][nt][4 * g + 2] * s), clamp_e4m3(acc[mt][nt][4 * g + 3] * s));
                 const u32x2v p01 = __builtin_amdgcn_permlane32_swap(d[0], d[1], false, false), p23 = __builtin_amdgcn_permlane32_swap(d[2], d[3], false, false);
                 if (ok) { *(u32x2*)(dst + nt * 32) = (u32x2){p01.x, p01.y}; *(u32x2*)(dst + nt * 32 + 16) = (u32x2){p23.x, p23.y}; }
               }
               asm volatile("" ::: "memory");
             }
           }, (size_t)128 * FF, !dual && cnt <= 128, dual);
  });
}
__device__ __forceinline__ void ph_combine(const P& p) {
  WLOOP(w, T / 4) {
    const int tid_ = otid(), t = w * 4 + (tid_ >> 6), c = (tid_ & 63) * 16, b = t / S;
    float acc[16];
#pragma unroll
    for (int i = 0; i < 16; ++i) acc[i] = 0.f;
#pragma unroll
    for (int k = 0; k < 8; ++k) {
      const u32x4 v = *(const u32x4*)(p.Yq + ((size_t)t * 8 + k) * D + c);
#pragma unroll
      for (int i = 0; i < 4; ++i) {
        const f32x2 lo = __builtin_amdgcn_cvt_pk_f32_fp8((int)v[i], false), hi = __builtin_amdgcn_cvt_pk_f32_fp8((int)v[i], true);
        acc[4 * i] += lo[0]; acc[4 * i + 1] += lo[1]; acc[4 * i + 2] += hi[0]; acc[4 * i + 3] += hi[1];
      }
    }
    const bf16_t* ys = p.Ys + (size_t)t * D + c; const float* gt = p.mod + b * 6 * D + 5 * D + c; float* o = p.out + (size_t)t * D + c;
#pragma unroll
    for (int h = 0; h < 4; ++h) {
      const u32x2 sv = *(const u32x2*)(ys + 4 * h);
      const float s0 = __uint_as_float(sv.x << 16), s1 = __uint_as_float(sv.x & 0xffff0000u), s2 = __uint_as_float(sv.y << 16), s3 = __uint_as_float(sv.y & 0xffff0000u);
      const f32x4 gv = *(const f32x4*)(gt + 4 * h);
      f32x4 r = {s0 + gv[0] * (acc[4 * h] * (1.f / YQ_SCALE)), s1 + gv[1] * (acc[4 * h + 1] * (1.f / YQ_SCALE)),
                 s2 + gv[2] * (acc[4 * h + 2] * (1.f / YQ_SCALE)), s3 + gv[3] * (acc[4 * h + 3] * (1.f / YQ_SCALE))};
      *(f32x4*)(o + 4 * h) = r;
    }
  }
}


#define XB_TMO      128
#define XB_XCNT(j)  (256  + 64 * (j))
#define XB_XSUB(j)  (1280 + 64 * (j))
#define XB_XGEN(j)  (2304 + 64 * (j))
#define XB_TOP      3328
#define XB_TOPGEN   3392
#define XB_LSUB(j)  (3456 + 64 * (j))
#define XB_LGEN(j)  (4480 + 64 * (j))
#define XCD_BAR_WORDS 5504
#define XB_SPIN_CAP (1u << 22)
__device__ __forceinline__ unsigned xb_ld(unsigned* p)              { return __hip_atomic_load(p, __ATOMIC_RELAXED, __HIP_MEMORY_SCOPE_AGENT); }
__device__ __forceinline__ unsigned xb_add(unsigned* p, unsigned v) { return __hip_atomic_fetch_add(p, v, __ATOMIC_RELAXED, __HIP_MEMORY_SCOPE_AGENT); }
__device__ __forceinline__ unsigned xb_xcc_id() { return (unsigned)__builtin_amdgcn_s_getreg((3 << 11) | 20) & 0xFu; }
#define XB_SPIN(cond, bar) do { unsigned _sp = 0; while (cond) { __builtin_amdgcn_s_sleep(1); \
    if ((++_sp & 255u) == 0u) { if (xb_ld(&(bar)[XB_TMO])) break; if (_sp > XB_SPIN_CAP) { atomicAdd(&(bar)[XB_TMO], 1u); break; } } } } while (0)
struct XcdBarrier { unsigned* bar; unsigned x; volatile LAS unsigned* st; unsigned rank; };
__device__ __forceinline__ XcdBarrier xcd_barrier_post(unsigned* bar, volatile LAS unsigned* st) {
  XcdBarrier b; b.bar = bar; b.x = xb_xcc_id(); b.st = st;
  b.rank = 0u;
  if (threadIdx.x == 0) b.rank = xb_add(&bar[XB_XCNT(b.x)], 1u);
  return b;
}
__device__ __forceinline__ void xcd_barrier_complete(unsigned* bar, unsigned x, unsigned& nloc, unsigned& nx) {
  const unsigned G = gridDim.x * gridDim.y * gridDim.z;
  unsigned sum, cnt, mine, sp = 0u;
  for (;;) {
    sum = 0u; cnt = 0u; mine = 0u;
#pragma unroll
    for (unsigned j = 0; j < 16; ++j) { const unsigned c = xb_ld(&bar[XB_XCNT(j)]); sum += c; cnt += (c > 0u) ? 1u : 0u; mine = (j == x) ? c : mine; }
    if (sum == G) break;
    __builtin_amdgcn_s_sleep(1);
    if ((++sp & 255u) == 0u) { if (xb_ld(&bar[XB_TMO])) break; if (sp > XB_SPIN_CAP) { atomicAdd(&bar[XB_TMO], 1u); break; } }
  }
  nloc = mine > 0u ? mine : 1u; nx = cnt > 0u ? cnt : 1u;
}
__device__ __forceinline__ void xcd_barrier(const XcdBarrier& b) {
  asm volatile("s_waitcnt vmcnt(0)" ::: "memory");
  __syncthreads();
  if (threadIdx.x == 0) {
    unsigned* bar = b.bar;
    __builtin_amdgcn_s_waitcnt(0);
    unsigned nloc = b.st[0], nx = b.st[1];
    if (nloc == 0u) { xcd_barrier_complete(bar, b.x, nloc, nx); b.st[0] = nloc; b.st[1] = nx; }
    const unsigned old = xb_add(&bar[XB_XSUB(b.x)], 1u);
    const unsigned gen = old / nloc;
    if (old + 1u == (gen + 1u) * nloc) {
      __builtin_amdgcn_fence(__ATOMIC_RELEASE, "agent");
      asm volatile("s_waitcnt vmcnt(0)" ::: "memory");
      const unsigned og = xb_add(&bar[XB_TOP], 1u);
      const unsigned tg = og / nx;
      if (og + 1u == (tg + 1u) * nx) xb_add(&bar[XB_TOPGEN], 1u);
      else XB_SPIN(xb_ld(&bar[XB_TOPGEN]) == tg, bar);
      __builtin_amdgcn_fence(__ATOMIC_ACQUIRE, "agent");
      xb_add(&bar[XB_XGEN(b.x)], 1u);
      asm volatile("s_waitcnt vmcnt(0)" ::: "memory");
    } else {
      XB_SPIN(xb_ld(&bar[XB_XGEN(b.x)]) == gen, bar);
      __builtin_amdgcn_fence(__ATOMIC_ACQUIRE, "agent");
      asm volatile("s_waitcnt vmcnt(0)" ::: "memory");
    }
  }
  __syncthreads();
}

__device__ __forceinline__ void xcd_local_barrier(const XcdBarrier& b, unsigned nloc) {
  asm volatile("s_waitcnt vmcnt(0)" ::: "memory");
  __syncthreads();
  if (threadIdx.x == 0) {
    unsigned* bar = b.bar;
    __builtin_amdgcn_s_waitcnt(0);
    const unsigned old = xb_add(&bar[XB_LSUB(b.x)], 1u);
    const unsigned gen = old / nloc;
    if (old + 1u == (gen + 1u) * nloc) xb_add(&bar[XB_LGEN(b.x)], 1u);
    else XB_SPIN(xb_ld(&bar[XB_LGEN(b.x)]) == gen, bar);
    __builtin_amdgcn_fence(__ATOMIC_ACQUIRE, "agent");
    asm volatile("s_waitcnt vmcnt(0)" ::: "memory");
  }
  __syncthreads();
}

__global__ void __launch_bounds__(256, 2) mega(P p) {
  extern __shared__ __attribute__((aligned(16))) char smem[];
  {
    volatile LAS unsigned* st0 = (volatile LAS unsigned*)((LAS char*)smem + SMEM_BYTES - 32);
    if (threadIdx.x == 0) { st0[0] = 0u; st0[1] = 0u; *(volatile LAS unsigned*)((LAS char*)smem + GST_OFF + 4) = blockIdx.x; }
    __syncthreads();
  }
  const XcdBarrier xb = xcd_barrier_post(p.bar, (volatile LAS unsigned*)((LAS char*)smem + SMEM_BYTES - 32));
  ph_ada(p, smem); ph_rope_tab(p);
  { int ib = 192 % gridDim.x;
    for (int it = (int)blockIdx.x - ib; it < 8 * 23; it += gridDim.x) if (it >= 0) cvtq_tile(p.w_in, INC, p.Wq_in, D, (it & 7) * 128, (it >> 3) * 128, INC);
    ib = (ib + 8 * 23) % gridDim.x; for (int it = (int)blockIdx.x - ib; it < 64; it += gridDim.x) if (it >= 0) cvtq_tile(p.w_out, D, p.Wq_out, D, (it & 7) * 128, (it >> 3) * 128);
    ib = (ib + 64) % gridDim.x;
    cvt_matrix<false>(p.w_router, p.Wt_rth, D, NE, ib); cvt_matrix<true>(p.w_router, p.Wt_rtl, D, NE, ib);
    for (int it = (int)blockIdx.x - ib; it < 32; it += gridDim.x) if (it >= 0) cvtq_tile(it < 16 ? p.w1_k : p.w1_v, 128, it < 16 ? p.Wq_c1k : p.Wq_c1v, 2048, (it & 15) * 128, 0);
    ib = (ib + 32) % gridDim.x;
    for (int it = (int)blockIdx.x - ib; it < 32; it += gridDim.x) if (it >= 0) cvtq_tile(it < 16 ? p.ws_gate : p.ws_up, FF, it < 16 ? p.Wq_sg : p.Wq_su, D, (it & 7) * 128, ((it >> 3) & 1) * 128);
    ib = (ib + 32) % gridDim.x; cvt_matrix<false>(p.ws_down, p.Wt_sd, FF, D, ib); }
  if (blockIdx.x == gridDim.x - 4) { for (int i = threadIdx.x; i < 2048; i += 256) p.zrow[i] = 0; }
  if (blockIdx.x == gridDim.x - 5 || blockIdx.x == gridDim.x - 6) {
    const int which = (blockIdx.x == gridDim.x - 6) ? 1 : 0; const float* W2 = which ? p.w2_v : p.w2_k;
    for (int i = threadIdx.x; i < 128 * 64; i += 256) { const int k = i >> 6, n = i & 63; ((unsigned short*)p.Wt_c2)[which * 8192 + n * 128 + k] = (unsigned short)(pk_bf16(W2[i], 0.f) & 0xffffu); }
  }
  const int bb0 = gridDim.x / 2;
  if ((int)blockIdx.x >= bb0 && (int)blockIdx.x < bb0 + 32) {
    const int which = threadIdx.x >> 7, n = threadIdx.x & 127, k0 = ((int)blockIdx.x - bb0) * 64;
    const float* pe = (which ? p.pe_v : p.pe_k) + k0; const float* w1 = (which ? p.w1_v : p.w1_k) + (size_t)k0 * 128 + n;
    float a = 0.f;
#pragma unroll 16
    for (int k = 0; k < 64; ++k) a += pe[k] * w1[(size_t)k * 128];
    p.b1p[((int)blockIdx.x - bb0) * 256 + threadIdx.x] = a;
  }
  if (blockIdx.x == gridDim.x - 2) {
    for (int i = threadIdx.x; i < 8 * 64; i += 256) { p.kcb[((size_t)(i >> 6) * 256 + 255) * 64 + (i & 63)] = 0; p.vcb[((size_t)(i >> 6) * 256 + 255) * 64 + (i & 63)] = 0; }
  }
  if (blockIdx.x == gridDim.x - 3) {
    p.cnt[threadIdx.x] = 0;
    if (threadIdx.x < 32) p.ctr[threadIdx.x] = 0;
    if (threadIdx.x < 64) {
      const int ln = threadIdx.x;
      const float a = wave_max(fabsf(p.g_q_dil[ln])), bq = wave_max(fabsf(p.g_k_dil[ln])), c = wave_max(fabsf(p.g_q_nsa[ln]));
      const float d1 = wave_max(fabsf(p.g_k_cmp[ln])), d2 = wave_max(fabsf(p.g_k_slc[ln])), d3 = wave_max(fabsf(p.g_k_win[ln]));
      if (ln == 0) { p.smaxv[0] = 8.f * a * bq; p.smaxv[1] = 8.f * c * d1; p.smaxv[2] = 8.f * c * d2; p.smaxv[3] = 8.f * c * d3; }
    }
  }
  xcd_barrier(xb);
  {
    volatile LAS unsigned* gst = (volatile LAS unsigned*)((LAS char*)smem + GST_OFF);
    if (threadIdx.x == 0) {
      const unsigned per = gridDim.x >> 3;
      bool ok = (gridDim.x & 7u) == 0u;
      for (unsigned j = 0; j < 16; ++j) { const unsigned c = xb_ld(&p.bar[XB_XCNT(j)]); ok = ok && (j < 8 ? c == per : c == 0u); }
      gst[0] = ok ? 1u : 0u;
      gst[1] = ok ? (xb.x + 8u * xb.rank) : blockIdx.x;
    }
    __syncthreads();
  }
  if (blockIdx.x == 0) { float a = 0.f; for (int j = 0; j < 32; ++j) a += p.b1p[j * 256 + threadIdx.x]; p.b1c[threadIdx.x] = a; }
  const bool grp_local = __builtin_amdgcn_readfirstlane(*(const LAS int*)((const LAS char*)smem + GST_OFF)) != 0;
  const unsigned grp_n = gridDim.x >> 3;
  ph_norm_mod<false>(p.x, p.g_mix, p.mod, 0, D, nullptr, p.h1q);
  if (grp_local) xcd_local_barrier(xb, grp_n); else xcd_barrier(xb);
  ph_proj(p, smem);
  xcd_barrier(xb);
  ph_attn(p, smem, grp_local);
  xcd_barrier(xb);
  ph_outproj(p, smem);
  if (grp_local) xcd_local_barrier(xb, grp_n); else xcd_barrier(xb);
  if (DUP == 10) { ph_outproj_abl<0>(p, smem); xcd_barrier(xb); }
  if (DUP == 11) { ph_outproj_abl<1>(p, smem); xcd_barrier(xb); }
  if (DUP == 12) { ph_outproj_abl<2>(p, smem); xcd_barrier(xb); }
  if (DUP == 13) { ph_outproj_abl<3>(p, smem); xcd_barrier(xb); }
  ph_norm_mod<true, true>(p.x1, p.g_ffn, p.mod, 3 * D, 4 * D, p.h2s, p.h2q);
  if (grp_local) xcd_local_barrier(xb, grp_n); else xcd_barrier(xb);
  ph_router_shared_gu(p, smem);
  if (grp_local) xcd_local_barrier(xb, grp_n); else xcd_barrier(xb);
  ph_route(p, smem);
  if (grp_local) xcd_local_barrier(xb, grp_n); else xcd_barrier(xb);
  ph_hist_local(p); ph_shared_d(p, smem);
  xcd_barrier(xb);
  ph_fill(p, smem);
  xcd_barrier(xb);
  ph_moe_gu(p, smem);
  if (grp_local) xcd_local_barrier(xb, grp_n); else xcd_barrier(xb);
  ph_moe_d(p, smem);
  xcd_barrier(xb);
  ph_combine(p);
}
}

extern "C" void kernel_launch(void* const* d_in, const int* in_sizes, int n_in, void* d_out, int out_size, void* d_ws, size_t ws_size,
                              hipStream_t stream) {
  P p{};
  const float** f = (const float**)d_in;
  p.x = f[0]; p.c = f[1]; p.w_ada = f[2]; p.b_ada = f[3]; p.g_mix = f[4]; p.g_ffn = f[5]; p.w_in = f[6]; p.g_q_dil = f[7]; p.g_k_dil = f[8];
  p.g_q_nsa = f[9]; p.g_k_cmp = f[10]; p.g_k_slc = f[11]; p.g_k_win = f[12]; p.pe_k = f[13]; p.w1_k = f[14]; p.w2_k = f[15]; p.pe_v = f[16];
  p.w1_v = f[17]; p.w2_v = f[18]; p.w_out = f[19]; p.w_router = f[20]; p.r_bias = f[21]; p.w_gate = f[22]; p.w_up = f[23]; p.w_down = f[24];
  p.ws_gate = f[25]; p.ws_up = f[26]; p.ws_down = f[27];
  p.out = (float*)d_out;
  char* w = (char*)d_ws; size_t o = 0;
  auto alloc = [&](size_t bytes) { void* r = w + o; o += (bytes + 255) & ~(size_t)255; return r; };
  p.mod = (float*)alloc(4 * 6 * D * 4);
  p.rope = (float*)alloc(S * 16 * 4);
  p.selmask = (unsigned long long*)alloc((size_t)T * 2 * 8);
  p.eidx = (int*)alloc(T * 8 * 4); p.gates = (float*)alloc(T * 8 * 4);
  p.cnt = (int*)alloc(NE * 4); p.off = (int*)alloc((NE + 1) * 4); p.pos = (int*)alloc(T * 8 * 4); p.sorted = (int*)alloc(T * 8 * 4);
  p.tstart = (int*)alloc(8 * 33 * 4);
  p.smaxv = (float*)alloc(64);
  p.b1c = (float*)alloc(256 * 4); p.b1p = (float*)alloc(32 * 256 * 4);
  p.ctr = (int*)alloc(256);
  p.kcb = (bf16_t*)alloc(8 * 256 * 64 * 2); p.vcb = (bf16_t*)alloc(8 * 256 * 64 * 2);
  p.GS = (float*)alloc((size_t)T * 24 * 4);
  p.QA = (bf16_t*)alloc((size_t)T * 512 * 2); p.KA = (bf16_t*)alloc((size_t)T * 512 * 2); p.VA = (bf16_t*)alloc((size_t)T * 512 * 2);
  p.QN = (bf16_t*)alloc((size_t)T * 512 * 2); p.QR = (bf16_t*)alloc((size_t)T * 512 * 2);
  p.KC = (bf16_t*)alloc((size_t)T * 128 * 2); p.VC = (bf16_t*)alloc((size_t)T * 128 * 2);
  p.KSL = (bf16_t*)alloc((size_t)T * 128 * 2); p.VSL = (bf16_t*)alloc((size_t)T * 128 * 2);
  p.KW = (bf16_t*)alloc((size_t)T * 128 * 2); p.VW = (bf16_t*)alloc((size_t)T * 128 * 2);
  p.logits = (float*)alloc((size_t)3 * T * NE * 4);
  p.x1 = (float*)alloc((size_t)T * D * 4);
  p.mixinb = (bf16_t*)alloc((size_t)T * D * 2);
  p.h1b = (bf16_t*)alloc((size_t)T * D * 2);
  p.h2s = (bf16_t*)alloc((size_t)T * 2 * D * 2);
  p.Hs = (bf16_t*)alloc((size_t)T * FF * 2);
  p.Ys = (bf16_t*)alloc((size_t)T * D * 2);
  p.bar = (unsigned*)alloc(XCD_BAR_WORDS * 4);
  p.bhist = (int*)alloc((size_t)2048 * NE * 4); p.xpre = (int*)alloc((size_t)2048 * NE * 4); p.xhist = (int*)alloc((size_t)8 * NE * 4);
  p.Wt_c2 = (bf16_t*)alloc((size_t)2 * 64 * 128 * 2);
  p.KCq = (unsigned char*)alloc((size_t)T * 128); p.VCq = (unsigned char*)alloc((size_t)T * 128); p.Wq_c1k = (unsigned char*)alloc((size_t)128 * 2048); p.Wq_c1v = (unsigned char*)alloc((size_t)128 * 2048);
  p.Wt_c1k = (bf16_t*)alloc((size_t)128 * 2048 * 2); p.Wt_c1v = (bf16_t*)alloc((size_t)128 * 2048 * 2);
  p.zrow = (bf16_t*)alloc(2048 * 2);
  p.Wt_in = (bf16_t*)alloc((size_t)2944 * D * 2);
  p.Wt_out = (bf16_t*)alloc((size_t)D * D * 2);
  p.Wt_rth = (bf16_t*)alloc((size_t)NE * D * 2); p.Wt_rtl = (bf16_t*)alloc((size_t)NE * D * 2);
  p.Wt_sg = (bf16_t*)alloc((size_t)FF * D * 2); p.Wt_su = (bf16_t*)alloc((size_t)FF * D * 2); p.Wt_sd = (bf16_t*)alloc((size_t)D * FF * 2);
  p.Wq_g = (unsigned char*)alloc((size_t)NE * FF * D); p.Wq_u = (unsigned char*)alloc((size_t)NE * FF * D); p.Wq_d = (unsigned char*)alloc((size_t)NE * D * FF);
  p.h2q = (unsigned char*)alloc((size_t)T * D); p.h1q = (unsigned char*)alloc((size_t)T * D); p.Wq_in = (unsigned char*)alloc((size_t)2944 * D); p.Hq = (unsigned char*)alloc((size_t)T * 8 * FF);
  p.Yq = (unsigned char*)alloc((size_t)T * 8 * D);
  p.Wq_sg = (unsigned char*)alloc((size_t)FF * D); p.Wq_su = (unsigned char*)alloc((size_t)FF * D);
  p.mixq = (unsigned char*)alloc((size_t)T * D); p.Wq_out = (unsigned char*)alloc((size_t)D * D);
  (void)hipMemsetAsync(p.bar, 0, XCD_BAR_WORDS * 4, stream);
  static int grid_blocks = 0;
  if (!grid_blocks) {
    int dev = 0, cus = 0, per_cu = 0;
    (void)hipGetDevice(&dev);
    (void)hipDeviceGetAttribute(&cus, hipDeviceAttributeMultiprocessorCount, dev);
    (void)hipOccupancyMaxActiveBlocksPerMultiprocessor(&per_cu, mega, 256, SMEM_BYTES);
    if (per_cu > 2) per_cu = 2;
    if (per_cu < 1) per_cu = 1;
    grid_blocks = cus * per_cu;
  }
  void* args[] = {&p};
  hipError_t e = hipLaunchCooperativeKernel((void*)mega, dim3(grid_blocks), dim3(256), args, SMEM_BYTES, stream);
  if (e != hipSuccess) fprintf(stderr, "cooperative launch failed: %s (grid %d)\n", hipGetErrorString(e), grid_blocks);
}
```
